# Optimizing an MI355X kernel written in HIP

```python
import math
import jax
import jax.numpy as jnp
from jax import lax
import numpy as np


D_MODEL = 2048
BATCH = 1
SEQ = 16384
DEPTH = 1

RWKV_HEADS = 16
RWKV_HEAD_DIM = 64
RWKV_WIDTH = RWKV_HEADS * RWKV_HEAD_DIM
DECAY_LORA = 96
ICLR_LORA = 96
GATE_LORA = 256
DIFF_HEADS = 8
DIFF_HEAD_DIM = 64
DIFF_V_DIM = 2 * DIFF_HEAD_DIM
DIFF_QK_COLS = DIFF_HEADS * 2 * DIFF_HEAD_DIM
DIFF_WIDTH = DIFF_HEADS * DIFF_V_DIM
Q_BLOCK = 128
N_BRANCHES = 2
RWKV_COLS = 3 * RWKV_WIDTH + DECAY_LORA + ICLR_LORA + GATE_LORA
DIFF_COLS = 2 * DIFF_QK_COLS + DIFF_WIDTH
GATE_COLS = N_BRANCHES * D_MODEL
IN_COLS = RWKV_COLS + DIFF_COLS + GATE_COLS
PEER_HEADS = 8
PEER_QUERY_DIM = 256
PEER_HALF = PEER_QUERY_DIM // 2
N_KEYS = 128
N_EXPERTS = N_KEYS * N_KEYS
PEER_TOPK = 16
PEER_CHUNK = 128
NORM_EPS = 1e-6
LN_X_EPS = 64e-5
SUBLN_EPS = 1e-5
NEG_INF = -1e30

kernel_name = 'hybrid_rwkv7_diffattn_peer'


def rmsnorm(x, g, eps=NORM_EPS):
    x32 = x.astype(jnp.float32)
    y = x32 * lax.rsqrt(jnp.mean(x32 * x32, axis=-1, keepdims=True) + eps)
    return (y * g.astype(jnp.float32)).astype(x.dtype)


def lambda_init_fn(layer):
    return 0.8 - 0.6 * math.exp(-0.3 * layer)


def wkv7_scan(r, decay, k, v, kk, a):
    B, S, H, N = r.shape

    def step(state, inp):
        r_t, w_t, k_t, v_t, kk_t, a_t = inp
        sa = jnp.einsum('bhvk,bhk->bhv', state, -kk_t)
        state = (state * w_t[:, :, None, :]
                 + sa[..., None] * (kk_t * a_t)[:, :, None, :]
                 + v_t[..., None] * k_t[:, :, None, :])
        y_t = jnp.einsum('bhvk,bhk->bhv', state, r_t)
        return state, y_t

    xs = (jnp.moveaxis(r, 1, 0), jnp.moveaxis(decay, 1, 0), jnp.moveaxis(k, 1, 0),
          jnp.moveaxis(v, 1, 0), jnp.moveaxis(kk, 1, 0), jnp.moveaxis(a, 1, 0))
    state0 = jnp.zeros((B, H, N, N), jnp.float32)
    _, ys = lax.scan(step, state0, xs)
    return jnp.moveaxis(ys, 0, 1)


def rwkv7_time_mix(p, mu, w0, w_decay_up, a0, w_iclr_up, w_gate_up, k_k, k_a, r_k, lnx_g, lnx_b):
    B, S, _ = p.shape
    H, N = RWKV_HEADS, RWKV_HEAD_DIM
    prev = jnp.pad(p, ((0, 0), (1, 0), (0, 0)))[:, :-1]
    p = p + (prev - p) * mu
    splits = [RWKV_WIDTH, 2 * RWKV_WIDTH, 3 * RWKV_WIDTH,
              3 * RWKV_WIDTH + DECAY_LORA, 3 * RWKV_WIDTH + DECAY_LORA + ICLR_LORA]
    r, k, v, xw, xa, xg = jnp.split(p, splits, axis=-1)
    w_log = -jax.nn.softplus(-(w0 + jnp.tanh(xw) @ w_decay_up)) - 0.5
    decay = jnp.exp(-jnp.exp(w_log.astype(jnp.float32)))
    a = jax.nn.sigmoid(a0 + xa @ w_iclr_up)
    g = jax.nn.sigmoid(xg) @ w_gate_up
    kk = (k * k_k).reshape(B, S, H, N).astype(jnp.float32)
    kk = kk / jnp.maximum(jnp.sqrt(jnp.sum(kk * kk, axis=-1, keepdims=True)), 1e-12)
    k = k * (1.0 + (a - 1.0) * k_a)
    r_h = r.reshape(B, S, H, N).astype(jnp.float32)
    k_h = k.reshape(B, S, H, N).astype(jnp.float32)
    v_h = v.reshape(B, S, H, N).astype(jnp.float32)
    a_h = a.reshape(B, S, H, N).astype(jnp.float32)
    y = wkv7_scan(r_h, decay.reshape(B, S, H, N), k_h, v_h, kk, a_h)
    mean = jnp.mean(y, axis=-1, keepdims=True)
    var = jnp.mean(jnp.square(y - mean), axis=-1, keepdims=True)
    y = ((y - mean) * lax.rsqrt(var + LN_X_EPS)).reshape(B, S, RWKV_WIDTH)
    y = y * lnx_g.astype(jnp.float32) + lnx_b.astype(jnp.float32)
    bonus = jnp.sum(r_h * k_h * r_k.astype(jnp.float32), axis=-1, keepdims=True) * v_h
    out = (y + bonus.reshape(B, S, RWKV_WIDTH)) * g.astype(jnp.float32)
    return out.astype(p.dtype)


def diff_attention(p, lam_q1, lam_k1, lam_q2, lam_k2, subln_g, lambda_init):
    B, S, _ = p.shape
    H, d = DIFF_HEADS, DIFF_HEAD_DIM
    q, k, v = jnp.split(p, [DIFF_QK_COLS, 2 * DIFF_QK_COLS], axis=-1)
    q = q.reshape(B, S, H, 2, d).transpose(3, 0, 2, 1, 4)
    k = k.reshape(B, S, H, 2, d).transpose(3, 0, 2, 1, 4)
    v = v.reshape(B, S, H, 2 * d).transpose(0, 2, 1, 3)
    lam = (jnp.exp(jnp.sum(lam_q1.astype(jnp.float32) * lam_k1.astype(jnp.float32)))
           - jnp.exp(jnp.sum(lam_q2.astype(jnp.float32) * lam_k2.astype(jnp.float32)))
           + lambda_init)
    scale = d ** -0.5
    n_blocks = S // Q_BLOCK
    q_blocks = q.reshape(2, B, H, n_blocks, Q_BLOCK, d).transpose(3, 0, 1, 2, 4, 5)
    key_pos = jnp.arange(S)

    def attend(args):
        q_blk, blk = args
        q_pos = blk * Q_BLOCK + jnp.arange(Q_BLOCK)
        causal = key_pos[None, :] <= q_pos[:, None]
        s = jnp.einsum('mbhqd,mbhkd->mbhqk', q_blk, k).astype(jnp.float32) * scale
        prob = jax.nn.softmax(jnp.where(causal, s, NEG_INF), axis=-1)
        attn = prob[0] - lam * prob[1]
        return jnp.einsum('bhqk,bhkd->bhqd', attn.astype(v.dtype), v)

    o = lax.map(attend, (q_blocks, jnp.arange(n_blocks)))
    o = o.transpose(1, 0, 3, 2, 4).reshape(B, S, H, 2 * d)
    o = rmsnorm(o, subln_g, SUBLN_EPS) * (1.0 - lambda_init)
    return o.reshape(B, S, DIFF_WIDTH)


def peer_ffn(h, wq, sub_keys, u_tab, v_tab):
    B, S, D = h.shape
    n_chunks = (B * S) // PEER_CHUNK
    xc = h.reshape(n_chunks, PEER_CHUNK, D)

    def chunk(xb):
        q = (xb @ wq).reshape(PEER_CHUNK, PEER_HEADS, 2, PEER_HALF)
        s = jnp.einsum('chpd,hpnd->chpn', q, sub_keys).astype(jnp.float32)
        top_s, top_i = lax.top_k(s, PEER_TOPK)
        cand_s = top_s[:, :, 0, :, None] + top_s[:, :, 1, None, :]
        cand_i = top_i[:, :, 0, :, None] * N_KEYS + top_i[:, :, 1, None, :]
        cand_s = cand_s.reshape(PEER_CHUNK, PEER_HEADS, PEER_TOPK * PEER_TOPK)
        cand_i = cand_i.reshape(PEER_CHUNK, PEER_HEADS, PEER_TOPK * PEER_TOPK)
        best_s, pos = lax.top_k(cand_s, PEER_TOPK)
        idx = jnp.take_along_axis(cand_i, pos, axis=-1)
        gate = jax.nn.softmax(best_s, axis=-1)
        u = jnp.take(u_tab, idx, axis=0)
        act = jax.nn.gelu(jnp.einsum('cd,chkd->chk', xb, u), approximate=False)
        vv = jnp.take(v_tab, idx, axis=0)
        return jnp.einsum('chk,chkd->cd', (gate * act.astype(jnp.float32)).astype(vv.dtype), vv)

    return lax.map(chunk, xc).reshape(B, S, D)


def setup_inputs(seed: int = 0) -> dict:
    key = jax.random.key(seed)
    ks = jax.random.split(key, 32)
    f32 = jnp.float32
    L = DEPTH

    def nrm(k, shape, scale):
        return jax.random.normal(k, shape, f32) * scale

    return {
        'x': nrm(ks[0], (BATCH, SEQ, D_MODEL), 1.0),
        'norm1_g': 1.0 + nrm(ks[1], (L, D_MODEL), 0.02),
        'w_in': nrm(ks[2], (L, D_MODEL, IN_COLS), D_MODEL ** -0.5),
        'shift_mu': jax.random.uniform(ks[3], (L, RWKV_COLS), f32),
        'rwkv_w0': jax.random.uniform(ks[4], (L, RWKV_WIDTH), f32, -5.5, -0.5),
        'w_decay_up': nrm(ks[5], (L, DECAY_LORA, RWKV_WIDTH), 0.5 * DECAY_LORA ** -0.5),
        'rwkv_a0': nrm(ks[6], (L, RWKV_WIDTH), 0.1),
        'w_iclr_up': nrm(ks[7], (L, ICLR_LORA, RWKV_WIDTH), ICLR_LORA ** -0.5),
        'w_gate_up': nrm(ks[8], (L, GATE_LORA, RWKV_WIDTH), GATE_LORA ** -0.5),
        'k_k': 0.85 + nrm(ks[9], (L, RWKV_WIDTH), 0.05),
        'k_a': 1.0 + nrm(ks[10], (L, RWKV_WIDTH), 0.05),
        'r_k': nrm(ks[11], (L, RWKV_HEADS, RWKV_HEAD_DIM), 0.1),
        'lnx_g': 1.0 + nrm(ks[12], (L, RWKV_WIDTH), 0.02),
        'lnx_b': nrm(ks[13], (L, RWKV_WIDTH), 0.02),
        'lam_q1': nrm(ks[14], (L, DIFF_HEAD_DIM), 0.1),
        'lam_k1': nrm(ks[15], (L, DIFF_HEAD_DIM), 0.1),
        'lam_q2': nrm(ks[16], (L, DIFF_HEAD_DIM), 0.1),
        'lam_k2': nrm(ks[17], (L, DIFF_HEAD_DIM), 0.1),
        'subln_g': 1.0 + nrm(ks[18], (L, DIFF_V_DIM), 0.02),
        'w_proj_a': nrm(ks[19], (L, RWKV_WIDTH, D_MODEL), RWKV_WIDTH ** -0.5),
        'w_proj_b': nrm(ks[20], (L, DIFF_WIDTH, D_MODEL), DIFF_WIDTH ** -0.5),
        'w_out': nrm(ks[21], (L, D_MODEL, D_MODEL), D_MODEL ** -0.5),
        'norm2_g': 1.0 + nrm(ks[22], (L, D_MODEL), 0.02),
        'peer_wq': nrm(ks[23], (L, D_MODEL, PEER_HEADS * PEER_QUERY_DIM), D_MODEL ** -0.5),
        'peer_sub_keys': nrm(ks[24], (L, PEER_HEADS, 2, N_KEYS, PEER_HALF), PEER_HALF ** -0.5),
        'peer_u': nrm(ks[25], (L, N_EXPERTS, D_MODEL), D_MODEL ** -0.5),
        'peer_v': nrm(ks[26], (L, N_EXPERTS, D_MODEL), PEER_HEADS ** -0.5),
        'final_g': 1.0 + nrm(ks[27], (D_MODEL,), 0.02),
    }


def reference(x, norm1_g, w_in, shift_mu, rwkv_w0, w_decay_up, rwkv_a0, w_iclr_up, w_gate_up,
              k_k, k_a, r_k, lnx_g, lnx_b, lam_q1, lam_k1, lam_q2, lam_k2, subln_g,
              w_proj_a, w_proj_b, w_out, norm2_g, peer_wq, peer_sub_keys, peer_u, peer_v,
              final_g):
    B, S, D = x.shape
    h = x
    for l in range(DEPTH):
        xn = rmsnorm(h, norm1_g[l])
        proj = xn @ w_in[l]
        p_rwkv, p_diff, p_gate = jnp.split(proj, [RWKV_COLS, RWKV_COLS + DIFF_COLS], axis=-1)
        y_a = rwkv7_time_mix(p_rwkv, shift_mu[l], rwkv_w0[l], w_decay_up[l], rwkv_a0[l],
                             w_iclr_up[l], w_gate_up[l], k_k[l], k_a[l], r_k[l],
                             lnx_g[l], lnx_b[l])
        y_b = diff_attention(p_diff, lam_q1[l], lam_k1[l], lam_q2[l], lam_k2[l], subln_g[l],
                             lambda_init_fn(l))
        gates = jax.nn.sigmoid(p_gate).reshape(B, S, N_BRANCHES, D)
        merged = gates[:, :, 0, :] * (y_a @ w_proj_a[l]) + gates[:, :, 1, :] * (y_b @ w_proj_b[l])
        h = h + merged @ w_out[l]
        h = h + peer_ffn(rmsnorm(h, norm2_g[l]), peer_wq[l], peer_sub_keys[l],
                         peer_u[l], peer_v[l])
    return rmsnorm(h, final_g)
```

```cpp
#include <hip/hip_runtime.h>
#include <cstdio>
#include <cstdint>
namespace pg8 {
#define PG8_LAS __attribute__((address_space(3)))
typedef unsigned short bf16_t;
typedef short bf16x8 __attribute__((ext_vector_type(8)));
typedef float f32x4 __attribute__((ext_vector_type(4)));
typedef unsigned u32x4 __attribute__((ext_vector_type(4)));
constexpr int BM = 256, BK = 64, HALF = 128, HTB = HALF * BK * 2  , STAGE_BYTES = 8 * HTB, NXCD = 8, WGM = 8;

__host__ __device__ __forceinline__ int lds_byte(int r, int c) { const int st = (r >> 4) * 2 + (c >> 5), rr = r & 15, cc = c & 31, ob = rr * 64 + cc * 2; return st * 1024 + (ob ^ (((ob >> 9) & 1) << 5)); }
__host__ __device__ __forceinline__ void stage_rc(int b, int& R, int& C) { const int st = b / 1024, sb = b % 1024, swz = sb ^ (((sb >> 9) & 1) << 5); R = (st >> 1) * 16 + swz / 64; C = (st & 1) * 32 + (swz % 64) / 2; }
__host__ __device__ __forceinline__ int perm32(int rho) { const int n = rho >> 4, i = rho & 15; return 8 * (i >> 2) + 4 * n + (i & 3); }

struct Unit { int pm, pn; };
struct Gemm { const bf16_t* A; const bf16_t* Bt; int M, N, K, lda, ldb; };

struct StaticOrder {
    int nM, nN, nwg, G, c;
    __host__ __device__ void init(int M, int N, int G_, int c_) { nM = M / BM; nN = N / BM; nwg = nM * nN; G = G_; c = c_; }
    __host__ __device__ bool next(int i, Unit& u) const {
        const long L = (long)i * G + c; if (L >= nwg) return false;
        int wgid = (int)L; { const int q = nwg / NXCD, r = nwg % NXCD, xcd = wgid % NXCD, off = wgid / NXCD; wgid = (xcd < r ? xcd * (q + 1) : r * (q + 1) + (xcd - r) * q) + off; }
        const int nig = WGM * nN, gid = wgid / nig, fm = gid * WGM, gsz = (nM - fm) < WGM ? (nM - fm) : WGM;
        u.pm = fm + ((wgid % nig) % gsz); u.pn = (wgid % nig) / gsz; return true;
    }
    __device__ __forceinline__ void a_ready(const Unit&) const {}
    __device__ __forceinline__ void done(const Unit&) const {}
};

__device__ __forceinline__ unsigned cvt_pk_bf16(float lo, float hi) { unsigned r; asm volatile("v_cvt_pk_bf16_f32 %0, %1, %2" : "=v"(r) : "v"(lo), "v"(hi)); return r; }
__device__ __forceinline__ float sigm(float x) { return __builtin_amdgcn_rcpf(1.0f + __expf(-x)); }
__device__ __forceinline__ float bflo(unsigned w) { return __uint_as_float(w << 16); }
__device__ __forceinline__ float bfhi(unsigned w) { return __uint_as_float(w & 0xffff0000u); }
enum { EM_G1 = 0, EM_LORA_W = 1, EM_LORA_A = 2, EM_LORA_G = 3, EM_PROJA = 4, EM_PROJB = 5, EM_WOUT = 6, EM_SCORES = 7 };
template <int MODE> struct Epi {
    static constexpr bool PERM = true, AFTER_DRAIN = false;
    void* o0; void* o1; void* o2; const void* i0; const void* i1; const float* vec; float sc;
    __device__ __forceinline__ void operator()(const f32x4 (&acc)[2][2][4][2], const Unit& u, int wr, int wc, int fr, int fq) const {
        const int row0 = u.pm * BM + wr * 64 + fr;
        int colt = u.pn * BM; int ldc = 2048; int sub = 0;
        bf16_t* ob = (bf16_t*)o0; float scl = 1.f;
        if (MODE == EM_G1) {
            if (u.pn < 14) { ldc = 3584; }
            else if (u.pn < 26) { ob = (bf16_t*)o1; ldc = 3072; colt -= 14 * BM; if (u.pn < 18) scl = sc; }
            else { ob = (bf16_t*)o2; ldc = 4096; colt -= 26 * BM; sub = 1; }
        }
        if (MODE == EM_LORA_W || MODE == EM_LORA_A || MODE == EM_LORA_G) ldc = 1024;
        const int col0 = colt + wc * 32 + 8 * fq;
#pragma unroll
        for (int ai = 0; ai < 2; ++ai)
#pragma unroll
            for (int m = 0; m < 4; ++m) { const size_t row = (size_t)(row0 + ai * HALF + m * 16);
#pragma unroll
                for (int bj = 0; bj < 2; ++bj) { f32x4 v0 = acc[ai][bj][m][0], v1 = acc[ai][bj][m][1]; const int col = col0 + bj * HALF;
                    if (MODE == EM_G1) {
                        if (sub) { v0 = (f32x4){sigm(v0[0]), sigm(v0[1]), sigm(v0[2]), sigm(v0[3])}; v1 = (f32x4){sigm(v1[0]), sigm(v1[1]), sigm(v1[2]), sigm(v1[3])}; }
                        else { v0 = v0 * scl; v1 = v1 * scl; }
                        u32x4 w; w.x = cvt_pk_bf16(v0[0], v0[1]); w.y = cvt_pk_bf16(v0[2], v0[3]); w.z = cvt_pk_bf16(v1[0], v1[1]); w.w = cvt_pk_bf16(v1[2], v1[3]);
                        *(u32x4*)(ob + row * ldc + col) = w;
                    } else if (MODE == EM_LORA_W || MODE == EM_LORA_A) {
                        const f32x4 b0 = *(const f32x4*)(vec + col), b1 = *(const f32x4*)(vec + col + 4);
                        v0 = v0 + b0; v1 = v1 + b1;
                        v0 = (f32x4){sigm(v0[0]), sigm(v0[1]), sigm(v0[2]), sigm(v0[3])}; v1 = (f32x4){sigm(v1[0]), sigm(v1[1]), sigm(v1[2]), sigm(v1[3])};
                        if (MODE == EM_LORA_W) { v0 = v0 * 0.60653065971f; v1 = v1 * 0.60653065971f; }
                        u32x4 w; w.x = cvt_pk_bf16(v0[0], v0[1]); w.y = cvt_pk_bf16(v0[2], v0[3]); w.z = cvt_pk_bf16(v1[0], v1[1]); w.w = cvt_pk_bf16(v1[2], v1[3]);
                        *(u32x4*)(ob + row * ldc + col) = w;
                    } else if (MODE == EM_LORA_G) {
                        u32x4 w; w.x = cvt_pk_bf16(v0[0], v0[1]); w.y = cvt_pk_bf16(v0[2], v0[3]); w.z = cvt_pk_bf16(v1[0], v1[1]); w.w = cvt_pk_bf16(v1[2], v1[3]);
                        *(u32x4*)(ob + row * ldc + col) = w;
                    } else if (MODE == EM_PROJA) {
                        const u32x4 g = *(const u32x4*)((const bf16_t*)i0 + row * 4096 + col);
                        float* op = (float*)o0 + row * 2048 + col;
                        *(f32x4*)op = (f32x4){v0[0] * bflo(g.x), v0[1] * bfhi(g.x), v0[2] * bflo(g.y), v0[3] * bfhi(g.y)};
                        *(f32x4*)(op + 4) = (f32x4){v1[0] * bflo(g.z), v1[1] * bfhi(g.z), v1[2] * bflo(g.w), v1[3] * bfhi(g.w)};
                    } else if (MODE == EM_PROJB) {
                        const u32x4 g = *(const u32x4*)((const bf16_t*)i0 + row * 4096 + 2048 + col);
                        const float* tp = (const float*)i1 + row * 2048 + col; const f32x4 t0 = *(const f32x4*)tp, t1 = *(const f32x4*)(tp + 4);
                        v0 = (f32x4){t0[0] + v0[0] * bflo(g.x), t0[1] + v0[1] * bfhi(g.x), t0[2] + v0[2] * bflo(g.y), t0[3] + v0[3] * bfhi(g.y)};
                        v1 = (f32x4){t1[0] + v1[0] * bflo(g.z), t1[1] + v1[1] * bfhi(g.z), t1[2] + v1[2] * bflo(g.w), t1[3] + v1[3] * bfhi(g.w)};
                        u32x4 w; w.x = cvt_pk_bf16(v0[0], v0[1]); w.y = cvt_pk_bf16(v0[2], v0[3]); w.z = cvt_pk_bf16(v1[0], v1[1]); w.w = cvt_pk_bf16(v1[2], v1[3]);
                        *(u32x4*)(ob + row * 2048 + col) = w;
                    } else if (MODE == EM_WOUT) {
                        const float* xp = (const float*)i1 + row * 2048 + col; const f32x4 t0 = *(const f32x4*)xp, t1 = *(const f32x4*)(xp + 4);
                        float* op = (float*)o0 + row * 2048 + col; *(f32x4*)op = t0 + v0; *(f32x4*)(op + 4) = t1 + v1;
                    } else {
                        float* op = (float*)o0 + row * 2048 + col; *(f32x4*)op = v0; *(f32x4*)(op + 4) = v1;
                    }
                } }
    }
};

template <class Epi, class Sched, bool ALIGN_EPI = false, bool SP2 = false>
__device__ __forceinline__ void gemm_phase(PG8_LAS unsigned char* lds, const Gemm g, const Sched& S, const Epi& E) {
    int tid_ = threadIdx.x; asm volatile("" : "+v"(tid_)); const int tid = tid_, wid = __builtin_amdgcn_readfirstlane(tid >> 6), lane = tid & 63, wr = wid >> 2, wc = wid & 3, fr = lane & 15, fq = lane >> 4;
    const int K = g.K, nt = K / BK;
    unsigned voffA[2], voffB[2];
#pragma unroll
    for (int i = 0; i < 2; ++i) { int R, C; stage_rc(tid * 16 + i * 8192, R, C); const int Rb = Epi::PERM ? ((R & ~31) + perm32(R & 31)) : R;
        voffA[i] = (unsigned)(R * g.lda + C) * 2u; voffB[i] = (unsigned)(Rb * g.ldb + C) * 2u; }
    const size_t kstep = (size_t)(BK * 2);
    const size_t hstepA = (size_t)HALF * g.lda * 2, hstepB = (size_t)HALF * g.ldb * 2;
    const size_t tstepA = 2 * hstepA, tstepB = 2 * hstepB;
    const unsigned ldsw = (unsigned)wid * 1024u;
    const int aoff = lds_byte(wr * 64 + fr, fq * 8), boff = lds_byte(wc * 32 + fr, fq * 8);
#define PG8_SA(b, h) (((b) * 2 + (h)) * HTB)
#define PG8_SB(b, h) ((4 + (b) * 2 + (h)) * HTB)
#define PG8_STAGE(bufoff, gbase, voff) do { _Pragma("unroll") for (int _i = 0; _i < 2; ++_i) \
        __builtin_amdgcn_global_load_lds((const unsigned*)((const char*)(gbase) + (voff)[_i]), (PG8_LAS unsigned*)(lds + (bufoff) + ldsw + _i * 8192), 16, 0, 0); } while (0)
#define PG8_LDA(dst, b, h) do { _Pragma("unroll") for (int m = 0; m < 4; ++m) _Pragma("unroll") for (int k = 0; k < 2; ++k) dst[m][k] = *(const PG8_LAS bf16x8*)(lds + PG8_SA(b, h) + aoff + m * 2048 + k * 1024); } while (0)
#define PG8_LDB(dst, b, h) do { _Pragma("unroll") for (int n = 0; n < 2; ++n) _Pragma("unroll") for (int k = 0; k < 2; ++k) dst[n][k] = *(const PG8_LAS bf16x8*)(lds + PG8_SB(b, h) + boff + n * 2048 + k * 1024); } while (0)
#define PG8_MMA(ai, bj, At, Bt) do { __builtin_amdgcn_s_setprio(1); _Pragma("unroll") for (int m = 0; m < 4; ++m) _Pragma("unroll") for (int n = 0; n < 2; ++n) _Pragma("unroll") for (int k = 0; k < 2; ++k) \
        acc[ai][bj][m][n] = __builtin_amdgcn_mfma_f32_16x16x32_bf16(Bt[n][k], At[m][k], acc[ai][bj][m][n], 0, 0, 0); __builtin_amdgcn_s_setprio(0); } while (0)
#define PG8_WAIT_V(n) asm volatile("s_waitcnt vmcnt(" #n ")" ::: "memory")
#define PG8_WAIT_L(n) asm volatile("s_waitcnt lgkmcnt(" #n ")" ::: "memory")
#define PG8_BAR __builtin_amdgcn_s_barrier()
#define PG8_SCHED __builtin_amdgcn_sched_barrier(0)
    Unit cur, nxt; int ui = 0;
    if (!S.next(0, cur)) return;
    f32x4 acc[2][2][4][2];
#pragma unroll
    for (int a = 0; a < 2; ++a)
#pragma unroll
        for (int b = 0; b < 2; ++b)
#pragma unroll
            for (int m = 0; m < 4; ++m)
#pragma unroll
                for (int n = 0; n < 2; ++n) acc[a][b][m][n] = (f32x4){0.f, 0.f, 0.f, 0.f};
    bf16x8 At[4][2], B0[2][2], B1[2][2];
    const char* cA = (const char*)g.A + (size_t)cur.pm * tstepA; const char* cB = (const char*)g.Bt + (size_t)cur.pn * tstepB;
    S.a_ready(cur);
    if constexpr (SP2) {
        PG8_STAGE(PG8_SB(0, 0), cB, voffB); PG8_STAGE(PG8_SB(0, 1), cB + hstepB, voffB); PG8_STAGE(PG8_SA(0, 0), cA, voffA); PG8_STAGE(PG8_SA(0, 1), cA + hstepA, voffA);
        if (wr == 1) PG8_BAR;
        PG8_WAIT_V(2); PG8_BAR;
        PG8_STAGE(PG8_SB(1, 0), cB + kstep, voffB); PG8_STAGE(PG8_SA(1, 0), cA + kstep, voffA); PG8_STAGE(PG8_SB(1, 1), cB + hstepB + kstep, voffB);
        PG8_WAIT_V(6); PG8_BAR;
    } else {
        PG8_STAGE(PG8_SB(0, 0), cB, voffB); PG8_STAGE(PG8_SA(0, 0), cA, voffA); PG8_STAGE(PG8_SB(0, 1), cB + hstepB, voffB); PG8_STAGE(PG8_SA(0, 1), cA + hstepA, voffA);
        if (wr == 1) PG8_BAR;
        PG8_WAIT_V(4); PG8_BAR;
        PG8_STAGE(PG8_SB(1, 0), cB + kstep, voffB); PG8_STAGE(PG8_SA(1, 0), cA + kstep, voffA); PG8_STAGE(PG8_SB(1, 1), cB + hstepB + kstep, voffB);
        PG8_WAIT_V(6); PG8_BAR;
    }
    for (;;) {
        const bool has_next = S.next(ui + 1, nxt);
        const char* nA = has_next ? (const char*)g.A + (size_t)nxt.pm * tstepA : cA; const char* nB = has_next ? (const char*)g.Bt + (size_t)nxt.pn * tstepB : cB;
        for (int t = 0; t < nt; t += 2) {
            const bool last = (t == nt - 2);
            const char* a1 = cA + (size_t)(t + 1) * kstep;
            const char* a2 = last ? nA : cA + (size_t)(t + 2) * kstep; const char* b2 = last ? nB : cB + (size_t)(t + 2) * kstep;
            const char* a3 = a2 + kstep; const char* b3 = b2 + kstep;
            if (last && has_next) S.a_ready(nxt);
            if constexpr (SP2) {
            PG8_LDB(B0, 0, 0); PG8_LDB(B1, 0, 1); PG8_SCHED; PG8_LDA(At, 0, 0); PG8_STAGE(PG8_SA(1, 1), a1 + hstepA, voffA);
            PG8_WAIT_V(8); PG8_WAIT_L(0); PG8_BAR; PG8_MMA(0, 0, At, B0); PG8_MMA(0, 1, At, B1); PG8_BAR; PG8_SCHED;
            PG8_LDA(At, 0, 1); PG8_STAGE(PG8_SB(0, 0), b2, voffB); PG8_STAGE(PG8_SB(0, 1), b2 + hstepB, voffB); PG8_STAGE(PG8_SA(0, 0), a2, voffA);
            PG8_WAIT_V(8); PG8_WAIT_L(0); PG8_BAR; PG8_MMA(1, 0, At, B0); PG8_MMA(1, 1, At, B1); PG8_BAR; PG8_SCHED;
            PG8_LDB(B0, 1, 0); PG8_LDB(B1, 1, 1); PG8_SCHED; PG8_LDA(At, 1, 0); PG8_STAGE(PG8_SA(0, 1), a2 + hstepA, voffA);
            PG8_WAIT_V(8); PG8_WAIT_L(0); PG8_BAR; PG8_MMA(0, 0, At, B0); PG8_MMA(0, 1, At, B1); PG8_BAR; PG8_SCHED;
            PG8_LDA(At, 1, 1); PG8_STAGE(PG8_SB(1, 0), b3, voffB); PG8_STAGE(PG8_SB(1, 1), b3 + hstepB, voffB); PG8_STAGE(PG8_SA(1, 0), a3, voffA);
            PG8_WAIT_V(8); PG8_WAIT_L(0); PG8_BAR; PG8_MMA(1, 0, At, B0); PG8_MMA(1, 1, At, B1); PG8_BAR; PG8_SCHED;
            } else {
            PG8_LDB(B0, 0, 0); PG8_SCHED; PG8_LDA(At, 0, 0); PG8_STAGE(PG8_SA(1, 1), a1 + hstepA, voffA);
            PG8_WAIT_L(8); PG8_BAR; PG8_WAIT_L(0); PG8_MMA(0, 0, At, B0); PG8_BAR; PG8_SCHED;
            PG8_LDB(B1, 0, 1); PG8_STAGE(PG8_SB(0, 0), b2, voffB);
            PG8_BAR; PG8_WAIT_L(0); PG8_MMA(0, 1, At, B1); PG8_BAR;
            PG8_LDA(At, 0, 1); PG8_STAGE(PG8_SA(0, 0), a2, voffA);
            PG8_BAR; PG8_WAIT_L(0); PG8_MMA(1, 0, At, B0); PG8_BAR; PG8_SCHED;
            PG8_STAGE(PG8_SB(0, 1), b2 + hstepB, voffB);
            PG8_WAIT_V(6); PG8_BAR; PG8_MMA(1, 1, At, B1); PG8_BAR;
            PG8_LDB(B0, 1, 0); PG8_SCHED; PG8_LDA(At, 1, 0); PG8_STAGE(PG8_SA(0, 1), a2 + hstepA, voffA);
            PG8_WAIT_L(8); PG8_BAR; PG8_WAIT_L(0); PG8_MMA(0, 0, At, B0); PG8_BAR; PG8_SCHED;
            PG8_LDB(B1, 1, 1); PG8_STAGE(PG8_SB(1, 0), b3, voffB);
            PG8_BAR; PG8_WAIT_L(0); PG8_MMA(0, 1, At, B1); PG8_BAR;
            PG8_LDA(At, 1, 1); PG8_STAGE(PG8_SA(1, 0), a3, voffA);
            PG8_BAR; PG8_WAIT_L(0); PG8_MMA(1, 0, At, B0); PG8_BAR; PG8_SCHED;
            PG8_STAGE(PG8_SB(1, 1), b3 + hstepB, voffB);
            PG8_WAIT_V(6); PG8_BAR; PG8_MMA(1, 1, At, B1); PG8_BAR;
            }
        }
        if constexpr (ALIGN_EPI) { if (wr == 0) PG8_BAR; }
        if constexpr (!Epi::AFTER_DRAIN) { E(acc, cur, wr, wc, fr, fq); S.done(cur); }
        if (!has_next) break;
#pragma unroll
        for (int a = 0; a < 2; ++a)
#pragma unroll
            for (int b = 0; b < 2; ++b)
#pragma unroll
                for (int m = 0; m < 4; ++m)
#pragma unroll
                    for (int n = 0; n < 2; ++n) acc[a][b][m][n] = (f32x4){0.f, 0.f, 0.f, 0.f};
        cur = nxt; cA = nA; cB = nB; ++ui;
        if constexpr (ALIGN_EPI) { if (wr == 1) PG8_BAR; }
    }
    PG8_WAIT_V(0);
    if constexpr (!ALIGN_EPI) { if (wr == 0) PG8_BAR; }
    PG8_BAR;
    if constexpr (Epi::AFTER_DRAIN) { E.fused(acc, cur, wr, wc, fr, fq, lds, wid, lane); S.done(cur); }
#undef PG8_SA
#undef PG8_SB
#undef PG8_STAGE
#undef PG8_LDA
#undef PG8_LDB
#undef PG8_MMA
#undef PG8_WAIT_V
#undef PG8_WAIT_L
#undef PG8_BAR
#undef PG8_SCHED
}
}
#include <hip/hip_bf16.h>
#include <cmath>
namespace attn_body {
using bf16=__hip_bfloat16;
using bf16x8=__attribute__((ext_vector_type(8)))short;
using s16x4=__attribute__((ext_vector_type(4)))short;
using f32x16=__attribute__((ext_vector_type(16)))float;
using u32x4=__attribute__((ext_vector_type(4)))unsigned;
constexpr int SEQ=16384,D=64,PQ=3072,PO=2048;
constexpr int NW=8,QBLK=32,QB=QBLK*NW,KVBLK=64,NQB=SEQ/QB;
constexpr int ATTN_UNIT_ROWS=QB;
__device__ __forceinline__ int crow(int r,int hi){return (r&3)+8*(r>>2)+4*hi;}
#define SBAR() __builtin_amdgcn_sched_barrier(0)
__device__ __forceinline__ void cmask(f32x16&p0,f32x16&p1,int jb,int qrel,int hi){
  const float NEG=-INFINITY; int kb=64*jb+4*hi;
  #pragma unroll
  for(int r=0;r<16;++r){int kv=kb+(r&3)+8*(r>>2); if(kv>qrel)p0[r]=NEG; if(kv+32>qrel)p1[r]=NEG;}
}

constexpr int NSLOT=3, SLOTB=8192;
constexpr int LDS_K=0, LDS_V=NSLOT*SLOTB, LDS_WS=2*NSLOT*SLOTB, LDS_OST=LDS_WS+NW*64*4, LDS_BYTES=LDS_OST+NW*4096;
constexpr float C2=0.125f*1.4426950408889634f;
__device__ __forceinline__ void glds16(const void*gsrc,unsigned lds_dst){unsigned keep;
  asm volatile("s_mov_b32 %0, m0\n\ts_mov_b32 m0, %2\n\ts_nop 0\n\tglobal_load_lds_dwordx4 %1, off\n\ts_mov_b32 m0, %0":"=&s"(keep):"v"(gsrc),"s"(lds_dst):"memory");}
__device__ __forceinline__ float max3f(float a,float b,float c){float r;asm("v_max3_f32 %0, %1, %2, %3":"=v"(r):"v"(a),"v"(b),"v"(c));return r;}
__device__ __forceinline__ float max2f(float a,float b){float r;asm("v_max_f32_e32 %0, %1, %2":"=v"(r):"v"(a),"v"(b));return r;}
__device__ __forceinline__ float fadd_s(float a,float b){float r;asm("v_add_f32_e32 %0, %1, %2":"=v"(r):"v"(a),"v"(b));return r;}
__device__ __forceinline__ float fsub_s(float a,float b){float r;asm("v_sub_f32_e32 %0, %1, %2":"=v"(r):"v"(a),"v"(b));return r;}
typedef float f32x2_t __attribute__((ext_vector_type(2))); typedef __bf16 bf16x2_t __attribute__((ext_vector_type(2)));
__device__ __forceinline__ unsigned cvtpk_s(float lo,float hi){f32x2_t v={lo,hi};bf16x2_t b=__builtin_convertvector(v,bf16x2_t);return __builtin_bit_cast(unsigned,b);}
#define WAIT_BAR(N) asm volatile("s_waitcnt vmcnt(" #N ") lgkmcnt(0)\n\ts_barrier":::"memory")

__device__ __forceinline__ void qkt(f32x16&p0,f32x16&p1,const char*Kslot,const bf16x8*qr,const f32x16&negm,int r32,int hi){
  const char*kb=Kslot+hi*1024+r32*16;
  #pragma unroll
  for(int d0=0;d0<4;++d0){
    const bf16x8 b0=*reinterpret_cast<const bf16x8*>(kb+d0*2048);
    const bf16x8 b1=*reinterpret_cast<const bf16x8*>(kb+d0*2048+512);
    if(d0==0){p0=__builtin_amdgcn_mfma_f32_32x32x16_bf16(b0,qr[0],negm,0,0,0);p1=__builtin_amdgcn_mfma_f32_32x32x16_bf16(b1,qr[0],negm,0,0,0);}
    else{p0=__builtin_amdgcn_mfma_f32_32x32x16_bf16(b0,qr[d0],p0,0,0,0);p1=__builtin_amdgcn_mfma_f32_32x32x16_bf16(b1,qr[d0],p1,0,0,0);}}
}
typedef __attribute__((address_space(3))) const char* lds_cptr;
typedef short v4i16_t __attribute__((ext_vector_type(4)));
__device__ __forceinline__ void kload8(bf16x8*kf,lds_cptr kp){
  kf[0]=*(const __attribute__((address_space(3))) bf16x8*)(kp);      kf[1]=*(const __attribute__((address_space(3))) bf16x8*)(kp+512);
  kf[2]=*(const __attribute__((address_space(3))) bf16x8*)(kp+2048); kf[3]=*(const __attribute__((address_space(3))) bf16x8*)(kp+2560);
  kf[4]=*(const __attribute__((address_space(3))) bf16x8*)(kp+4096); kf[5]=*(const __attribute__((address_space(3))) bf16x8*)(kp+4608);
  kf[6]=*(const __attribute__((address_space(3))) bf16x8*)(kp+6144); kf[7]=*(const __attribute__((address_space(3))) bf16x8*)(kp+6656);
}
__device__ __forceinline__ void kload2(bf16x8*kf,lds_cptr kp,int j){ kf[2*j]=*(const __attribute__((address_space(3))) bf16x8*)(kp+j*2048); kf[2*j+1]=*(const __attribute__((address_space(3))) bf16x8*)(kp+j*2048+512); }
__device__ __forceinline__ s16x4 vtr(lds_cptr p){ return __builtin_bit_cast(s16x4,__builtin_amdgcn_ds_read_tr16_b64_v4i16((__attribute__((address_space(3))) v4i16_t*)p)); }
__device__ __forceinline__ float rowmax(const f32x16&p0,const f32x16&p1){
  float a=max3f(p0[0],p0[1],p1[0]),b=max3f(p0[2],p0[3],p1[1]);a=max3f(a,p1[2],p1[3]);
  #pragma unroll
  for(int r=4;r<16;r+=4){a=max3f(a,p0[r],p0[r+1]);b=max3f(b,p0[r+2],p0[r+3]);a=max3f(a,p1[r],p1[r+1]);b=max3f(b,p1[r+2],p1[r+3]);}
  const float m=max2f(a,b);
  auto rr=__builtin_amdgcn_permlane32_swap(__float_as_uint(m),__float_as_uint(m),false,false);
  return max2f(__uint_as_float(rr[0]),__uint_as_float(rr[1]));
}
__device__ __forceinline__ void pv(f32x16*o,int vb,bf16x8 pa0,bf16x8 pa1,bf16x8 pa2,bf16x8 pa3){
  #pragma unroll
  for(int d0=0;d0<2;++d0){s16x4 lo[4],hi[4];
    #pragma unroll
    for(int ks=0;ks<4;++ks){
      asm volatile("ds_read_b64_tr_b16 %0,%1 offset:%c2":"=&v"(lo[ks]):"v"(vb),"i"(d0*4096+ks*1024):"memory");
      asm volatile("ds_read_b64_tr_b16 %0,%1 offset:%c2":"=&v"(hi[ks]):"v"(vb),"i"(d0*4096+ks*1024+512):"memory");}
    asm volatile("s_waitcnt lgkmcnt(0)":::"memory");SBAR();
    #define PK(k) (bf16x8){lo[k][0],lo[k][1],lo[k][2],lo[k][3],hi[k][0],hi[k][1],hi[k][2],hi[k][3]}
    o[d0]=__builtin_amdgcn_mfma_f32_32x32x16_bf16(pa0,PK(0),o[d0],0,0,0);
    o[d0]=__builtin_amdgcn_mfma_f32_32x32x16_bf16(pa1,PK(1),o[d0],0,0,0);
    o[d0]=__builtin_amdgcn_mfma_f32_32x32x16_bf16(pa2,PK(2),o[d0],0,0,0);
    o[d0]=__builtin_amdgcn_mfma_f32_32x32x16_bf16(pa3,PK(3),o[d0],0,0,0);
    #undef PK
  }
}

#ifndef ATTN_STORE16
#define ATTN_STORE16(p,v) (*(u32x4*)(p)=(v))
#endif
template<int THRL> __device__ __forceinline__ void attn_unit(int qb,const bf16*Q,const bf16*__restrict__ K,const bf16*__restrict__ V,bf16*O,char*shm){
  int tid_=threadIdx.x; asm volatile("":"+v"(tid_)); const int tid=tid_,lane=tid&63,r32=lane&31,hi=lane>>5; const int wid=__builtin_amdgcn_readfirstlane(tid>>6);
  const int q0=qb*QB;
  const bf16*Qw=Q+(long)(q0+wid*QBLK)*PQ;
  const bf16*Kh=K,*Vh=V;
  const unsigned lds0=(unsigned)(uintptr_t)shm;
  float*wsf=(float*)(shm+LDS_WS)+wid*64;
  const bf16*ksrc=Kh+(long)lane*PQ+wid*8;
  const bf16*vsrc=Vh+(long)(16*(wid&3)+(lane>>2))*PQ+(wid>>2)*32+(lane&3)*8;
  const unsigned kdst=lds0+LDS_K+wid*1024, vdst=lds0+LDS_V+wid*1024;
  #define DMA_K(t,slot) glds16(ksrc+(long)(t)*KVBLK*PQ,(unsigned)__builtin_amdgcn_readfirstlane(kdst+(slot)))
  #define DMA_V(t,slot) glds16(vsrc+(long)(t)*KVBLK*PQ,(unsigned)__builtin_amdgcn_readfirstlane(vdst+(slot)))
  const int vb0=(int)(lds0+LDS_V)+((lane>>4)&1)*32+(lane&3)*8+(4*hi+((lane&15)>>2))*64;
  const char*Kbase=shm+LDS_K; bf16x8 kf[8];
  const lds_cptr shm3=(lds_cptr)shm; const lds_cptr kp0=shm3+LDS_K+hi*1024+r32*16; const lds_cptr vp0=shm3+LDS_V+((lane>>4)&1)*32+(lane&3)*8+(4*hi+((lane&15)>>2))*64;
  const int NT=(q0+QB)/KVBLK;
  DMA_K(0,0);DMA_V(0,0);DMA_K(1,SLOTB);
  bf16x8 qr[4];
  #pragma unroll
  for(int d0=0;d0<4;++d0)qr[d0]=*reinterpret_cast<const bf16x8*>(&Qw[(long)r32*PQ+d0*16+hi*8]);
  float mhat=0.f,l_reg=0.f;f32x16 o[2];o[0]=f32x16{};o[1]=f32x16{};asm volatile("":"+v"(o[0]));asm volatile("":"+v"(o[1]));f32x16 negm=f32x16{};asm volatile("":"+v"(negm));
  const int qrel=wid*QBLK+r32;
  #define CMASK(P0,P1,t) do{int jb_=(t)-(NT-4); if(jb_>=0)cmask(P0,P1,jb_,qrel,hi);}while(0)
  bool resc=false;
  #define START(P0,P1) do{ const float rm=rowmax(P0,P1); resc=false; \
    { const float dl=rm; mhat=fadd_s(mhat,dl); \
      _Pragma("unroll") for(int r=0;r<16;++r){P0[r]=fsub_s(P0[r],dl);P1[r]=fsub_s(P1[r],dl);} \
      _Pragma("unroll") for(int r=0;r<16;++r)negm[r]=-mhat; asm volatile("":"+v"(negm)); } \
    _Pragma("unroll") for(int r=0;r<16;++r)P0[r]=__builtin_amdgcn_exp2f(P0[r]); }while(0)
  #define RESC() do{ if(resc){ asm volatile("s_waitcnt lgkmcnt(0)":::"memory"); \
      _Pragma("unroll") for(int d_=0;d_<2;++d_) _Pragma("unroll") for(int r=0;r<16;++r)o[d_][r]*=wsf[crow(r,hi)]; } }while(0)
  f32x16 pA0,pA1,pB0,pB1;
  int sl_prev=0,sl_cur=0,sl_next=SLOTB;
  #define ROT() do{sl_prev=sl_cur;sl_cur=sl_next;sl_next=(sl_next==(NSLOT-1)*SLOTB)?0:sl_next+SLOTB;}while(0)
  DMA_K(2,2*SLOTB);
  WAIT_BAR(3);
  qkt(pA0,pA1,Kbase,qr,negm,r32,hi);asm volatile("s_nop 15\n\ts_nop 7":"+v"(pA0),"+v"(pA1));CMASK(pA0,pA1,0);
  START(pA0,pA1);
  _Pragma("unroll") for(int r=0;r<16;++r)pA1[r]=__builtin_amdgcn_exp2f(pA1[r]);
  WAIT_BAR(0);
  DMA_K(3,0);DMA_V(1,SLOTB);
  ROT();
  kload8(kf,kp0+sl_cur);
  WAIT_BAR(2);
  s16x4 vlo[8],vhi[8]; u32x4 pw0,pw1,pw2,pw3;
  #define PKW(P,B) cvtpk_s(P[B],P[B+1])
  #define PAF(k) __builtin_bit_cast(bf16x8,pw##k)
  #define VFR(i) (bf16x8){vlo[i][0],vlo[i][1],vlo[i][2],vlo[i][3],vhi[i][0],vhi[i][1],vhi[i][2],vhi[i][3]}
  #define PIN(x) asm volatile("":"+v"(x))
  #define MX3(a,b,c) __builtin_fmaxf(__builtin_fmaxf((a),(b)),(c))
  #define GAPA(MF,A0,A1,A2,A3,W0,W1,PW) do{ MF; sacc+=A0; sacc+=A1; sacc+=A2; sacc+=A3; PIN(sacc); W0; W1; PIN(PW); SBAR(); }while(0)
  #define EX(v) __builtin_amdgcn_exp2f(v)
  #define GAPB(MF,X,B) do{ MF; X[B]=EX(X[B]); X[B+1]=EX(X[B+1]); X[B+2]=EX(X[B+2]); X[B+3]=EX(X[B+3]); PIN(X); SBAR(); }while(0)
  #define VRD(i) do{ vlo[i]=vtr(vp_+(((i)>>2)*4096+((i)&3)*1024)); vhi[i]=vtr(vp_+(((i)>>2)*4096+((i)&3)*1024+512)); }while(0)
  #define KRD(G,j) do{ if(G){ kload2(kf,kp0+sl_next,j); SBAR(); } }while(0)
  #define STEP(C0,C1,P0,P1,t,GK,GV,GL) do{ SBAR(); \
    const lds_cptr vp_=vp0+sl_prev; \
    VRD(0); SBAR(); float sacc=(P0[0]+P0[1]); \
    GAPA(C0=__builtin_amdgcn_mfma_f32_32x32x16_bf16(kf[0],qr[0],negm,0,0,0), P0[2],P0[3],P0[4],P0[5],     pw0[0]=PKW(P0,0), pw0[1]=PKW(P0,2), pw0); \
    VRD(4); SBAR(); GAPA(C1=__builtin_amdgcn_mfma_f32_32x32x16_bf16(kf[1],qr[0],negm,0,0,0), P0[6],P0[7],P0[8],P0[9],     pw0[2]=PKW(P0,4), pw0[3]=PKW(P0,6), pw0); \
    VRD(1); SBAR(); GAPA(C0=__builtin_amdgcn_mfma_f32_32x32x16_bf16(kf[2],qr[1],C0,0,0,0),   P0[10],P0[11],P0[12],P0[13], pw1[0]=PKW(P0,8), pw1[1]=PKW(P0,10), pw1); \
    VRD(5); SBAR(); GAPA(C1=__builtin_amdgcn_mfma_f32_32x32x16_bf16(kf[3],qr[1],C1,0,0,0),   P0[14],P0[15],P1[0],P1[1],   pw1[2]=PKW(P0,12),pw1[3]=PKW(P0,14), pw1); \
    VRD(2); SBAR(); GAPA(C0=__builtin_amdgcn_mfma_f32_32x32x16_bf16(kf[4],qr[2],C0,0,0,0),   P1[2],P1[3],P1[4],P1[5],     pw2[0]=PKW(P1,0), pw2[1]=PKW(P1,2), pw2); \
    VRD(6); SBAR(); GAPA(C1=__builtin_amdgcn_mfma_f32_32x32x16_bf16(kf[5],qr[2],C1,0,0,0),   P1[6],P1[7],P1[8],P1[9],     pw2[2]=PKW(P1,4), pw2[3]=PKW(P1,6), pw2); \
    VRD(3); SBAR(); GAPA(C0=__builtin_amdgcn_mfma_f32_32x32x16_bf16(kf[6],qr[3],C0,0,0,0),   P1[10],P1[11],P1[12],P1[13], pw3[0]=PKW(P1,8), pw3[1]=PKW(P1,10), pw3); \
    VRD(7); SBAR(); GAPA(C1=__builtin_amdgcn_mfma_f32_32x32x16_bf16(kf[7],qr[3],C1,0,0,0),   P1[14],P1[15],0.f,0.f,       pw3[2]=PKW(P1,12),pw3[3]=PKW(P1,14), pw3); \
    l_reg+=sacc; \
    if(GK){DMA_K((t)+3,sl_cur);} if(GV){DMA_V((t)+1,sl_next);} \
    CMASK(C0,C1,t); \
    { float a=MX3(C0[0],C0[1],C1[0]),b=MX3(C0[2],C0[3],C1[1]); a=MX3(a,C1[2],C1[3]); \
      _Pragma("unroll") for(int r=4;r<16;r+=4){a=MX3(a,C0[r],C0[r+1]);b=MX3(b,C0[r+2],C0[r+3]);a=MX3(a,C1[r],C1[r+1]);b=MX3(b,C1[r+2],C1[r+3]);} \
      float rm=__builtin_fmaxf(a,b); { auto rr=__builtin_amdgcn_permlane32_swap(__float_as_uint(rm),__float_as_uint(rm),false,false); rm=__builtin_fmaxf(__uint_as_float(rr[0]),__uint_as_float(rr[1])); } \
      resc=false; \
      if(__builtin_expect(__any(rm>(float)THRL),0)){ const float dl=__builtin_fmaxf(rm,0.f); mhat+=dl; \
        _Pragma("unroll") for(int r=0;r<16;++r){C0[r]-=dl;C1[r]-=dl;} \
        _Pragma("unroll") for(int r=0;r<16;++r)negm[r]=-mhat; asm volatile("":"+v"(negm)); \
        const float f=__builtin_amdgcn_exp2f(-dl); l_reg*=f; if(hi==0)wsf[r32]=f; resc=true; } } \
    SBAR(); \
    GAPB(o[0]=__builtin_amdgcn_mfma_f32_32x32x16_bf16(PAF(0),VFR(0),o[0],0,0,0), C0,0); \
    GAPB(o[1]=__builtin_amdgcn_mfma_f32_32x32x16_bf16(PAF(0),VFR(4),o[1],0,0,0), C0,4); \
    KRD(GL,0); GAPB(o[0]=__builtin_amdgcn_mfma_f32_32x32x16_bf16(PAF(1),VFR(1),o[0],0,0,0), C0,8); \
    KRD(GL,1); GAPB(o[1]=__builtin_amdgcn_mfma_f32_32x32x16_bf16(PAF(1),VFR(5),o[1],0,0,0), C0,12); \
    KRD(GL,2); GAPB(o[0]=__builtin_amdgcn_mfma_f32_32x32x16_bf16(PAF(2),VFR(2),o[0],0,0,0), C1,0); \
    KRD(GL,3); GAPB(o[1]=__builtin_amdgcn_mfma_f32_32x32x16_bf16(PAF(2),VFR(6),o[1],0,0,0), C1,4); \
    GAPB(o[0]=__builtin_amdgcn_mfma_f32_32x32x16_bf16(PAF(3),VFR(3),o[0],0,0,0), C1,8); \
    GAPB(o[1]=__builtin_amdgcn_mfma_f32_32x32x16_bf16(PAF(3),VFR(7),o[1],0,0,0), C1,12); \
    }while(0)
  int t=1;
  #undef CMASK
  #define CMASK(P0,P1,t) do{}while(0)
  for(;t+5<NT;t+=2){
    STEP(pB0,pB1,pA0,pA1,t,true,true,true);     WAIT_BAR(2); RESC(); ROT();
    STEP(pA0,pA1,pB0,pB1,t+1,true,true,true);   WAIT_BAR(2); RESC(); ROT();
  }
  #undef CMASK
  #define CMASK(P0,P1,t) do{int jb_=(t)-(NT-4); if(jb_>=0)cmask(P0,P1,jb_,qrel,hi);}while(0)
  #define ENDW(tt) do{ if((tt)+3<NT){WAIT_BAR(2);} else if((tt)+2<NT){WAIT_BAR(1);} else {WAIT_BAR(0);} }while(0)
  for(;t+1<NT;t+=2){
    STEP(pB0,pB1,pA0,pA1,t,(t+3<NT),(t+1<NT),(t+1<NT));       ENDW(t);   RESC(); ROT();
    STEP(pA0,pA1,pB0,pB1,t+1,(t+4<NT),(t+2<NT),(t+2<NT));     ENDW(t+1); RESC(); ROT();
  }
  STEP(pB0,pB1,pA0,pA1,NT-1,false,false,false); RESC();
  { float sacc=pB0[0]+pB0[1]; _Pragma("unroll") for(int r=2;r<16;++r)sacc+=pB0[r]; _Pragma("unroll") for(int r=0;r<16;++r)sacc+=pB1[r]; l_reg+=sacc;
    pw0=(u32x4){PKW(pB0,0),PKW(pB0,2),PKW(pB0,4),PKW(pB0,6)};pw1=(u32x4){PKW(pB0,8),PKW(pB0,10),PKW(pB0,12),PKW(pB0,14)};pw2=(u32x4){PKW(pB1,0),PKW(pB1,2),PKW(pB1,4),PKW(pB1,6)};pw3=(u32x4){PKW(pB1,8),PKW(pB1,10),PKW(pB1,12),PKW(pB1,14)};
    SBAR(); pv(o,vb0+sl_cur,PAF(0),PAF(1),PAF(2),PAF(3)); }
  #undef PKW
  #undef PAF
  #undef VFR
  #undef PIN
  #undef MX3
  #undef GAPA
  #undef GAPB
  #undef EX
  #undef VRD
  #undef KRD
  #undef STEP
  #undef ENDW
  {auto rr=__builtin_amdgcn_permlane32_swap(__float_as_uint(l_reg),__float_as_uint(l_reg),false,false);l_reg=__uint_as_float(rr[0])+__uint_as_float(rr[1]);}
  if(hi==0)wsf[32+r32]=l_reg;asm volatile("s_waitcnt lgkmcnt(0)":::"memory");
  float rli[16];
  #pragma unroll
  for(int r=0;r<16;++r)rli[r]=__builtin_amdgcn_rcpf(wsf[32+crow(r,hi)]);
  bf16*Ow=O+(long)(q0+wid*QBLK)*PO;
  { bf16*stg=(bf16*)(shm+LDS_OST)+wid*2048;
    #pragma unroll
    for(int r=0;r<16;++r){const int orow=crow(r,hi);
      #pragma unroll
      for(int d0=0;d0<2;++d0)stg[orow*64+d0*32+r32]=__float2bfloat16(o[d0][r]*rli[r]);}
    asm volatile("s_waitcnt lgkmcnt(0)":::"memory");
    #pragma unroll
    for(int i=0;i<4;++i){const int row=i*8+(lane>>3),ch=lane&7; const u32x4 v=*(const u32x4*)(stg+row*64+ch*8); ATTN_STORE16(Ow+(long)row*PO+ch*8,v);} }
  asm volatile("s_waitcnt lgkmcnt(0)\n\ts_barrier":::"memory");
  #undef DMA_K
  #undef DMA_V
  #undef CMASK
  #undef START
  #undef RESC
  #undef ROT
}
constexpr int ATTN_LDS_BYTES=LDS_BYTES;
template<int THRL=8> __device__ __forceinline__ void attn_phase(char*lds,const bf16*PD,bf16*O,int vcu){
  const int pr=vcu>>3,s=vcu&7,h=pr>>2,m=(pr>>1)&1,vh=pr&1;
  const bf16*Q=PD+h*128+m*64,*K=PD+1024+h*128+m*64,*V=PD+2048+h*128+vh*64; bf16*Op=O+m*1024+h*128+vh*64;
  _Pragma("unroll 1") for(int i=0;i<8;++i){ const int qb=(i>>1)*16+((i&1)?15-s:s); attn_unit<THRL>(qb,Q,K,V,Op,lds); }
}
#undef SBAR
#undef WAIT_BAR
}
#define GAS __attribute__((address_space(1)))
#define LAS __attribute__((address_space(3)))
typedef unsigned short bf16;
typedef unsigned v4u __attribute__((ext_vector_type(4)));
typedef float f32x4 __attribute__((ext_vector_type(4)));
typedef short bf16x8 __attribute__((ext_vector_type(8)));
typedef GAS unsigned gu32;
typedef GAS unsigned long long gu64;
#define RLX_AGENT __ATOMIC_RELAXED, __HIP_MEMORY_SCOPE_AGENT
#define LDS_WAIT() asm volatile("s_waitcnt lgkmcnt(0)" ::: "memory")
#define VM_WAIT() asm volatile("s_waitcnt vmcnt(0)" ::: "memory")
__device__ __forceinline__ unsigned long long rt() { return __builtin_amdgcn_s_memrealtime(); }
__device__ __forceinline__ unsigned f2bf(float f) { unsigned u = __builtin_bit_cast(unsigned, f); return (u + 0x7fffu + ((u >> 16) & 1u)) >> 16; }
__device__ __forceinline__ unsigned pk2(float lo, float hi) { return f2bf(lo) | (f2bf(hi) << 16); }

#define XB_TMO      128
#define XB_XCNT(j)  (256  + 64 * (j))
#define XB_XSUB(j)  (1280 + 64 * (j))
#define XB_XGEN(j)  (2304 + 64 * (j))
#define XB_TOP      3328
#define XB_TOPGEN   3392
#define XCD_BAR_WORDS 3456
#define XB_SPIN_CAP (1u << 18)

__device__ __forceinline__ unsigned xb_ld(unsigned* p)              { return __hip_atomic_load(p, __ATOMIC_RELAXED, __HIP_MEMORY_SCOPE_AGENT); }
__device__ __forceinline__ unsigned xb_add(unsigned* p, unsigned v) { return __hip_atomic_fetch_add(p, v, __ATOMIC_RELAXED, __HIP_MEMORY_SCOPE_AGENT); }
__device__ __forceinline__ unsigned xb_xcc_id() { return (unsigned)__builtin_amdgcn_s_getreg((3 << 11) | 20) & 0xFu; }
#define XB_SPIN(cond, bar) do { unsigned _sp = 0; while (cond) { __builtin_amdgcn_s_sleep(1); \
    if ((++_sp & 255u) == 0u) { if (xb_ld(&(bar)[XB_TMO])) break; if (_sp > XB_SPIN_CAP) { atomicAdd(&(bar)[XB_TMO], 1u); break; } } } } while (0)

struct XcdBarrier {
    unsigned* bar; unsigned x;
    volatile LAS unsigned* st;
};

__device__ __forceinline__ XcdBarrier xcd_barrier_post(unsigned* bar, volatile LAS unsigned* st) {
    XcdBarrier b; b.bar = bar; b.x = xb_xcc_id(); b.st = st;
    if (threadIdx.x == 0) (void)xb_add(&bar[XB_XCNT(b.x)], 1u);
    return b;
}
__device__ __forceinline__ void xcd_barrier_complete(unsigned* bar, unsigned x, unsigned& nloc, unsigned& nx) {
    const unsigned G = gridDim.x * gridDim.y * gridDim.z;
    unsigned sum, cnt, mine, sp = 0u;
    for (;;) {
        sum = 0u; cnt = 0u; mine = 0u;
#pragma unroll
        for (unsigned j = 0; j < 16; ++j) { const unsigned c = xb_ld(&bar[XB_XCNT(j)]); sum += c; cnt += (c > 0u) ? 1u : 0u; mine = (j == x) ? c : mine; }
        if (sum == G) break;
        __builtin_amdgcn_s_sleep(1);
        if ((++sp & 255u) == 0u) { if (xb_ld(&bar[XB_TMO])) break; if (sp > XB_SPIN_CAP) { atomicAdd(&bar[XB_TMO], 1u); break; } }
    }
    nloc = mine > 0u ? mine : 1u; nx = cnt > 0u ? cnt : 1u;
}

__device__ __forceinline__ void xcd_barrier(const XcdBarrier& b) {
    asm volatile("s_waitcnt vmcnt(0)" ::: "memory");
    __syncthreads();
    if (threadIdx.x == 0) {
        unsigned* bar = b.bar;
        __builtin_amdgcn_s_waitcnt(0);
        unsigned nloc = b.st[0], nx = b.st[1];
        if (nloc == 0u) { xcd_barrier_complete(bar, b.x, nloc, nx); b.st[0] = nloc; b.st[1] = nx; }
        const unsigned old = xb_add(&bar[XB_XSUB(b.x)], 1u);
        const unsigned gen = old / nloc;
        if (old + 1u == (gen + 1u) * nloc) {
            __builtin_amdgcn_fence(__ATOMIC_RELEASE, "agent");
            asm volatile("s_waitcnt vmcnt(0)" ::: "memory");
            const unsigned og = xb_add(&bar[XB_TOP], 1u);
            const unsigned tg = og / nx;
            if (og + 1u == (tg + 1u) * nx) xb_add(&bar[XB_TOPGEN], 1u);
            else XB_SPIN(xb_ld(&bar[XB_TOPGEN]) == tg, bar);
            __builtin_amdgcn_fence(__ATOMIC_ACQUIRE, "agent");
            xb_add(&bar[XB_XGEN(b.x)], 1u);
            asm volatile("s_waitcnt vmcnt(0)" ::: "memory");
        } else {
            XB_SPIN(xb_ld(&bar[XB_XGEN(b.x)]) == gen, bar);
            __builtin_amdgcn_fence(__ATOMIC_ACQUIRE, "agent");
            asm volatile("s_waitcnt vmcnt(0)" ::: "memory");
        }
    }
    __syncthreads();
}
constexpr int NWAVES = 8;
constexpr int S_ = 16384, DM = 2048;
constexpr int NPH = 16;
#ifndef MK_PER_PHASE
#define MK_PER_PHASE 0
#endif
constexpr size_t MiB = 1u << 20;
constexpr size_t WS_CTL = 0, CTL_ZERO_BYTES = 1 * MiB;
constexpr size_t WS_WA = 1 * MiB, WS_WB = 5 * MiB, WS_WOUT = 9 * MiB, WS_WS = 17 * MiB, WS_LORA = 25 * MiB;
constexpr size_t WS_WIN = 27 * MiB, WS_PR = 69 * MiB, WS_PD = 181 * MiB, WS_PG = 277 * MiB;
constexpr size_t WS_A = 405 * MiB, WS_E = 437 * MiB, WS_G = 469 * MiB, WS_END = 501 * MiB;
constexpr size_t WS_SCN = 27 * MiB, WS_SCAL = 123 * MiB, WS_SLOC = 127 * MiB, WS_ASEG = 143 * MiB, WS_SIN = 159 * MiB;
constexpr size_t WS_YA = 405 * MiB, WS_OATT = 27 * MiB, WS_YB = 91 * MiB, WS_T1 = 123 * MiB, WS_MERGED = 27 * MiB;
constexpr size_t WS_XN2 = 91 * MiB, WS_UTAB = 155 * MiB, WS_VTAB = 219 * MiB, WS_SCORES = 283 * MiB;
constexpr size_t OUT_XN = 0, OUT_RKV = 0, OUT_LIN = 96 * MiB;
constexpr int CW_BAR = 4096;
constexpr int RING_OFF = 0, RING_BYTES = 131072;
constexpr int LDSCTL_OFF = RING_BYTES, MISC_OFF = LDSCTL_OFF + 320;
constexpr int LDS_BYTES = 147456;
constexpr int NSEG = 64, SEGLEN = S_ / NSEG;

struct Args { const float* in[28]; float* out; unsigned char* ws; int ph_lo, ph_hi; };

struct Frame {
    LAS unsigned char* lds; volatile LAS unsigned* MISC; gu32* ctl;
    int tid, lane, wave, vcu, G;
};

__device__ __forceinline__ float bf2f(unsigned short b) { return __uint_as_float((unsigned)b << 16); }
__device__ __forceinline__ float wave_sum(float v) {
#pragma unroll
    for (int o = 1; o < 64; o <<= 1) v += __shfl_xor(v, o);
    return v;
}
__device__ __forceinline__ float wave_max(float v) {
#pragma unroll
    for (int o = 1; o < 64; o <<= 1) v = fmaxf(v, __shfl_xor(v, o));
    return v;
}
__device__ __forceinline__ float sigmf(float x) { return __builtin_amdgcn_rcpf(1.0f + __expf(-x)); }

__device__ __forceinline__ void transpose_block(const float* W, int ldw, int k0, int n0, int kvalid, bf16* WT, int ldt, int drow0, LAS float* scr, int lane) {
#pragma unroll 8
    for (int i = 0; i < 32; ++i) { const int kk = 2 * i + (lane >> 5); const int k = k0 + kk; scr[kk * 33 + (lane & 31)] = (k < kvalid) ? W[(size_t)k * ldw + n0 + (lane & 31)] : 0.f; }
    LDS_WAIT(); asm volatile("" ::: "memory");
    const int c = lane & 7;
#pragma unroll
    for (int j = 0; j < 4; ++j) { const int n = (lane >> 3) + 8 * j; const LAS float* s = scr + (8 * c) * 33 + n;
        v4u o; o.x = pk2(s[0 * 33], s[1 * 33]); o.y = pk2(s[2 * 33], s[3 * 33]); o.z = pk2(s[4 * 33], s[5 * 33]); o.w = pk2(s[6 * 33], s[7 * 33]);
        *(GAS v4u*)(WT + (size_t)(drow0 + n) * ldt + k0 + 8 * c) = o; }
    LDS_WAIT(); asm volatile("" ::: "memory");
}
__device__ __forceinline__ void rms_row_to_bf16(const float* xrow, const float* g, bf16* orow, int lane) {
    const GAS f32x4* xr = (const GAS f32x4*)xrow + lane; const f32x4* gr = (const f32x4*)g + lane;
    f32x4 v[8]; float s = 0.f;
#pragma unroll
    for (int j = 0; j < 8; ++j) { v[j] = xr[64 * j]; s += (v[j].x * v[j].x + v[j].y * v[j].y) + (v[j].z * v[j].z + v[j].w * v[j].w); }
    const float rstd = rsqrtf(wave_sum(s) * (1.f / 2048.f) + 1e-6f);
    GAS unsigned long long* o8 = (GAS unsigned long long*)orow + lane;
#pragma unroll
    for (int j = 0; j < 8; ++j) { const f32x4 gg = gr[64 * j];
        o8[64 * j] = (unsigned long long)pk2(v[j].x * rstd * gg.x, v[j].y * rstd * gg.y) | ((unsigned long long)pk2(v[j].z * rstd * gg.z, v[j].w * rstd * gg.w) << 32); }
}

template <int K> __device__ __forceinline__ void fmac_dpp(float& acc, float op, float s) {
    asm("v_fmac_f32_dpp %0, %1, %2 quad_perm:[%c3,%c3,%c3,%c3] row_mask:0xf bank_mask:0xf" : "+v"(acc) : "v"(op), "v"(s), "i"(K)); }
template <int K> __device__ __forceinline__ void mulip_dpp(float& s, float op) {
    asm("v_mul_f32_dpp %0, %1, %0 quad_perm:[%c2,%c2,%c2,%c2] row_mask:0xf bank_mask:0xf" : "+v"(s) : "v"(op), "i"(K)); }
#define SCAN_FOR_C(BODY) _Pragma("unroll") for (int j = 0; j < 4; ++j) { \
    { constexpr int k = 0; _Pragma("unroll") for (int i = 0; i < 4; ++i) { const int c = 16 * j + 4 * k + i; BODY } } \
    { constexpr int k = 1; _Pragma("unroll") for (int i = 0; i < 4; ++i) { const int c = 16 * j + 4 * k + i; BODY } } \
    { constexpr int k = 2; _Pragma("unroll") for (int i = 0; i < 4; ++i) { const int c = 16 * j + 4 * k + i; BODY } } \
    { constexpr int k = 3; _Pragma("unroll") for (int i = 0; i < 4; ++i) { const int c = 16 * j + 4 * k + i; BODY } } }

constexpr int SCAN_CH = 4, SCAN_STEP_F = 448, SCAN_WAVE_BYTES = (SCAN_CH * SCAN_STEP_F + SCAN_CH * 4) * 4;
template <int KIND> __device__ __forceinline__ void scan_task(const int lane, unsigned char* ws, const float* const* in, const bf16* RKV, int h, int seg, LAS float* wl) {
    const int t0 = seg * SEGLEN;
    const bf16* SCN = (const bf16*)(ws + WS_SCN) + ((size_t)h * S_) * 192;
    const float* SCAL = (const float*)(ws + WS_SCAL) + ((size_t)h * S_) * 4;
    const bf16* Eb = (const bf16*)(ws + WS_E); const bf16* Gb = (const bf16*)(ws + WS_G);
    float S[64];
    if (KIND == 0) {
#pragma unroll
        for (int c = 0; c < 64; ++c) S[c] = 0.f;
    } else if (KIND == 1) {
#pragma unroll
        for (int c = 0; c < 64; ++c) S[c] = (c == lane) ? 1.f : 0.f;
    } else {
        const f32x4* sp = (const f32x4*)((const float*)(ws + WS_SIN) + (((size_t)h * NSEG + seg) * 64 + lane) * 64);
#pragma unroll
        for (int q = 0; q < 16; ++q) { const f32x4 x = sp[q]; S[4 * q] = x.x; S[4 * q + 1] = x.y; S[4 * q + 2] = x.z; S[4 * q + 3] = x.w; }
    }
    float lg = 0.f, lb = 0.f;
    if (KIND == 2) { lg = in[12][h * 64 + lane]; lb = in[13][h * 64 + lane]; }
    constexpr int CH = SCAN_CH;
    unsigned short pk[CH], pb[CH], pt[CH], pr[CH], pe[CH], pv[CH], pg[CH]; f32x4 psc = (f32x4){0.f, 0.f, 0.f, 0.f};
#define SCAN_PREFETCH(tc) do { _Pragma("unroll") for (int s = 0; s < CH; ++s) { const size_t t = (size_t)((tc) + s); \
        pk[s] = SCN[t * 192 + lane]; pb[s] = SCN[t * 192 + 64 + lane]; pt[s] = SCN[t * 192 + 128 + lane]; \
        pr[s] = RKV[t * 3072 + h * 64 + lane]; pe[s] = Eb[t * 1024 + h * 64 + lane]; \
        if (KIND != 1) pv[s] = RKV[t * 3072 + 2048 + h * 64 + lane]; if (KIND == 2) pg[s] = Gb[t * 1024 + h * 64 + lane]; } \
        if (KIND != 1) { if (lane < CH) psc = *(const f32x4*)(SCAL + (size_t)((tc) + lane) * 4); } } while (0)
    SCAN_PREFETCH(t0);
    bf16* YA = (bf16*)(ws + WS_YA) + h * 64 + lane;
#pragma unroll 1
    for (int tc = t0; tc < t0 + SEGLEN; tc += CH) {
#pragma unroll
        for (int s = 0; s < CH; ++s) { const float w = __expf(-bf2f(pe[s])); LAS float* q = wl + s * SCAN_STEP_F;
            q[lane] = bf2f(pk[s]); q[64 + lane] = w * bf2f(pr[s]); q[128 + lane] = w; q[192 + lane] = bf2f(pb[s]); q[256 + lane] = bf2f(pt[s]);
            if (KIND != 1) q[320 + lane] = bf2f(pv[s]); if (KIND == 2) q[384 + lane] = bf2f(pg[s]); }
        if (KIND != 1) { if (lane < CH) *(LAS f32x4*)(wl + CH * SCAN_STEP_F + lane * 4) = psc; }
        if (tc + CH < t0 + SEGLEN) SCAN_PREFETCH(tc + CH);
        LDS_WAIT(); asm volatile("" ::: "memory");
        f32x4 KK[4], WR[4];
        { const LAS f32x4* q4 = (const LAS f32x4*)wl + (lane & 3);
#pragma unroll
          for (int j = 0; j < 4; ++j) { KK[j] = q4[j * 4]; if (KIND == 2) WR[j] = q4[16 + j * 4]; } }
#pragma unroll 1
        for (int s = 0; s < CH; ++s) {
            const LAS float* qs = wl + s * SCAN_STEP_F;
            const LAS f32x4* q4 = (const LAS f32x4*)qs + (lane & 3);
            f32x4 WW[4], BB[4], KT[4];
#pragma unroll
            for (int j = 0; j < 4; ++j) { WW[j] = q4[32 + j * 4]; BB[j] = q4[48 + j * 4]; if (KIND != 1) KT[j] = q4[64 + j * 4]; }
            float vt = 0.f, gt_ = 0.f; f32x4 sc = (f32x4){0.f, 0.f, 0.f, 0.f};
            if (KIND != 1) { vt = qs[320 + lane]; sc = *(const LAS f32x4*)(wl + CH * SCAN_STEP_F + s * 4); }
            if (KIND == 2) gt_ = qs[384 + lane];
            float sa0 = 0.f, sa1 = 0.f, yp0 = 0.f, yp1 = 0.f;
            SCAN_FOR_C( if (i & 1) { fmac_dpp<k>(sa1, KK[j][i], S[c]); if (KIND == 2) fmac_dpp<k>(yp1, WR[j][i], S[c]); }
                        else       { fmac_dpp<k>(sa0, KK[j][i], S[c]); if (KIND == 2) fmac_dpp<k>(yp0, WR[j][i], S[c]); } )
            const float sa = sa0 + sa1;
            { const LAS f32x4* qn = (const LAS f32x4*)(wl + ((s + 1) & (CH - 1)) * SCAN_STEP_F) + (lane & 3);
#pragma unroll
              for (int j = 0; j < 4; ++j) { KK[j] = qn[j * 4]; if (KIND == 2) WR[j] = qn[16 + j * 4]; } }
            SCAN_FOR_C( mulip_dpp<k>(S[c], WW[j][i]); )
            SCAN_FOR_C( fmac_dpp<k>(S[c], BB[j][i], sa); )
            if (KIND != 1) { SCAN_FOR_C( fmac_dpp<k>(S[c], KT[j][i], vt); ) }
            if (KIND == 2) {
                const float y = (yp0 + yp1) + sa * sc.x + vt * sc.y;
                const float mean = wave_sum(y) * (1.f / 64.f); const float d = y - mean;
                const float var = wave_sum(d * d) * (1.f / 64.f);
                const float o = (d * rsqrtf(var + 64e-5f) * lg + lb + sc.z * vt) * gt_;
                YA[(size_t)(tc + s) * 1024] = (unsigned short)f2bf(o);
            }
        }
        LDS_WAIT(); asm volatile("" ::: "memory");
    }
#undef SCAN_PREFETCH
    if (KIND != 2) {
        f32x4* op = (f32x4*)((float*)(ws + (KIND == 0 ? WS_SLOC : WS_ASEG)) + (((size_t)h * NSEG + seg) * 64 + lane) * 64);
#pragma unroll
        for (int q = 0; q < 16; ++q) op[q] = (f32x4){S[4 * q], S[4 * q + 1], S[4 * q + 2], S[4 * q + 3]};
    }
}

__global__ void __launch_bounds__(NWAVES * 64, 2) mk_fwd(Args args) {
    extern __shared__ __attribute__((aligned(16))) unsigned char lds[];
    Frame F;
    F.lds = (LAS unsigned char*)lds; F.MISC = (volatile LAS unsigned*)(F.lds + MISC_OFF);
    F.tid = threadIdx.x; F.wave = __builtin_amdgcn_readfirstlane(F.tid >> 6);
    F.G = gridDim.x; { const int bx = blockIdx.x; F.vcu = (F.G % 8 == 0) ? (bx % 8) * (F.G / 8) + bx / 8 : bx; }
    unsigned char* ws = args.ws; F.ctl = (gu32*)(ws + WS_CTL);
    const float* const* in = args.in;
    unsigned char* ob = (unsigned char*)args.out;
    for (int u = threadIdx.x; u < (LDS_BYTES - LDSCTL_OFF) / 4; u += NWAVES * 64) ((LAS unsigned*)(F.lds + LDSCTL_OFF))[u] = 0u;
    __syncthreads();
    XcdBarrier bar; bar.bar = (unsigned*)(F.ctl + CW_BAR); bar.x = 0; bar.st = nullptr;
    if (!MK_PER_PHASE) bar = xcd_barrier_post((unsigned*)(F.ctl + CW_BAR), F.MISC + 8);
    const int lo = args.ph_lo, hi = args.ph_hi;
#ifndef PH_MASK
#define PH_MASK 0xFFFF
#endif
#define IN(k) ((((PH_MASK) >> (k)) & 1) && lo <= (k) && (k) < hi)
#define SEAM(k) do { if (IN(k) && IN((k) + 1)) xcd_barrier(bar); } while (0)
    const int gw = F.vcu * NWAVES + F.wave, NGW = F.G * NWAVES; const int NGT = F.G * NWAVES * 64;
#define PHASE_IDS int tid__ = threadIdx.x; asm volatile("" : "+v"(tid__)); const int tid = tid__, lane = tid & 63, gt = F.vcu * (NWAVES * 64) + tid; (void)gt; (void)lane;

    bf16* WIN_T = (bf16*)(ws + WS_WIN); bf16* WA_T = (bf16*)(ws + WS_WA); bf16* WB_T = (bf16*)(ws + WS_WB); bf16* WOUT_T = (bf16*)(ws + WS_WOUT);
    bf16* WS_T = (bf16*)(ws + WS_WS); bf16* LORA_T = (bf16*)(ws + WS_LORA);
    bf16* XN = (bf16*)(ob + OUT_XN); bf16* RKV = (bf16*)(ob + OUT_RKV); bf16* LIN = (bf16*)(ob + OUT_LIN);
    bf16* PR = (bf16*)(ws + WS_PR); bf16* PD = (bf16*)(ws + WS_PD); bf16* PG = (bf16*)(ws + WS_PG);

    if (IN(0)) { PHASE_IDS
        LAS float* scr = (LAS float*)(F.lds + RING_OFF + F.wave * 16384);
        constexpr int I_IN = 32 * 334, I_A = 16 * 64, I_B = 16 * 64, I_O = 32 * 64, I_L = 4 * 32;
        constexpr int NIT = I_IN + I_A + I_B + I_O + 3 * I_L;
        for (int it = gw; it < NIT; it += NGW) {
            int r = it;
            if (r < I_IN) { const int kb = r / 334, nb = r % 334, n0 = nb * 32; transpose_block(in[2], 10688, kb * 64, n0, 2048, WIN_T, 2048, n0 + (n0 >= 3520 ? 64 : 0), scr, lane); continue; } r -= I_IN;
            if (r < I_A) { const int kb = r / 64, nb = r % 64; transpose_block(in[19], 2048, kb * 64, nb * 32, 1024, WA_T, 1024, nb * 32, scr, lane); continue; } r -= I_A;
            if (r < I_B) { const int kb = r / 64, nb = r % 64; transpose_block(in[20], 2048, kb * 64, nb * 32, 1024, WB_T, 1024, nb * 32, scr, lane); continue; } r -= I_B;
            if (r < I_O) { const int kb = r / 64, nb = r % 64; transpose_block(in[21], 2048, kb * 64, nb * 32, 2048, WOUT_T, 2048, nb * 32, scr, lane); continue; } r -= I_O;
            { const int which = r / I_L, rr = r % I_L, kb = rr / 32, nb = rr % 32; const float* W = which == 0 ? in[5] : (which == 1 ? in[7] : in[8]);
              transpose_block(W, 1024, kb * 64, nb * 32, which == 2 ? 256 : 96, LORA_T + (size_t)which * 1024 * 256, 256, nb * 32, scr, lane); }
        }
        for (int i = gt; i < 16384; i += NGT) *(GAS v4u*)(WIN_T + (size_t)3520 * 2048 + (size_t)i * 8) = (v4u){0u, 0u, 0u, 0u};
        for (int task = gw; task < 16 * 32 * 4; task += NGW) {
            const int hp = task >> 7, kb = (task >> 2) & 31, ng = task & 3; const int k = kb * 64 + lane;
            const f32x4* wq = (const f32x4*)(in[23] + (size_t)k * 2048 + hp * 128);
            f32x4 q[32];
#pragma unroll
            for (int d = 0; d < 32; ++d) q[d] = wq[d];
            const float* sk = in[24] + ((size_t)hp * 128 + ng * 32) * 128;
            for (int n = 0; n < 32; ++n) { const f32x4* s4 = (const f32x4*)(sk + (size_t)n * 128); float a0 = 0.f, a1 = 0.f;
#pragma unroll
                for (int d = 0; d < 32; ++d) { const f32x4 s = s4[d]; a0 = fmaf(q[d].x, s.x, a0); a1 = fmaf(q[d].y, s.y, a1); a0 = fmaf(q[d].z, s.z, a0); a1 = fmaf(q[d].w, s.w, a1); }
                WS_T[(size_t)(hp * 128 + ng * 32 + n) * 2048 + k] = (bf16)f2bf(a0 + a1); }
        }
        for (int m = gw; m < S_; m += NGW) rms_row_to_bf16(in[0] + (size_t)m * DM, in[1], XN + (size_t)m * DM, lane);
    }
    SEAM(0);
    if (IN(1)) { PHASE_IDS
        pg8::Gemm g{XN, WIN_T, S_, 10752, 2048, 2048, 2048}; pg8::StaticOrder S; S.init(S_, 10752, F.G, (int)blockIdx.x);
        pg8::Epi<pg8::EM_G1> E{PR, PD, PG, nullptr, nullptr, nullptr, attn_body::C2};
        pg8::gemm_phase<pg8::Epi<pg8::EM_G1>, pg8::StaticOrder, true, true>(F.lds + RING_OFF, g, S, E);
    }
    SEAM(1);
    if (IN(2)) { PHASE_IDS
        const float* mu = in[3];
        for (int t = gw; t < S_; t += NGW) {
            const bf16* cur = PR + (size_t)t * 3584; const bf16* prv = cur - 3584;
#pragma unroll 1
            for (int j = 0; j < 7; ++j) { const int ch = lane + 64 * j; if (ch >= 440) break;
                const v4u c4 = *(const GAS v4u*)(cur + ch * 8); v4u p4 = (v4u){0u, 0u, 0u, 0u}; if (t > 0) p4 = *(const GAS v4u*)(prv + ch * 8);
                const f32x4 m0 = *(const f32x4*)(mu + ch * 8), m1 = *(const f32x4*)(mu + ch * 8 + 4);
                float c[8] = {pg8::bflo(c4.x), pg8::bfhi(c4.x), pg8::bflo(c4.y), pg8::bfhi(c4.y), pg8::bflo(c4.z), pg8::bfhi(c4.z), pg8::bflo(c4.w), pg8::bfhi(c4.w)};
                const float p[8] = {pg8::bflo(p4.x), pg8::bfhi(p4.x), pg8::bflo(p4.y), pg8::bfhi(p4.y), pg8::bflo(p4.z), pg8::bfhi(p4.z), pg8::bflo(p4.w), pg8::bfhi(p4.w)};
                const float mm[8] = {m0.x, m0.y, m0.z, m0.w, m1.x, m1.y, m1.z, m1.w};
#pragma unroll
                for (int e = 0; e < 8; ++e) c[e] = c[e] + (p[e] - c[e]) * mm[e];
                bf16* dst;
                if (ch < 384) dst = RKV + (size_t)t * 3072 + ch * 8;
                else { const int col = ch * 8 - 3072;
                    if (col < 96) { dst = LIN + (size_t)t * 768 + col;
#pragma unroll
                        for (int e = 0; e < 8; ++e) c[e] = tanhf(c[e]); }
                    else if (col < 192) dst = LIN + (size_t)t * 768 + 256 + (col - 96);
                    else { dst = LIN + (size_t)t * 768 + 512 + (col - 192);
#pragma unroll
                        for (int e = 0; e < 8; ++e) c[e] = sigmf(c[e]); } }
                *(GAS v4u*)dst = (v4u){pk2(c[0], c[1]), pk2(c[2], c[3]), pk2(c[4], c[5]), pk2(c[6], c[7])};
            }
            if (lane < 40) { const int z = lane < 20 ? 96 + lane * 8 : 352 + (lane - 20) * 8; *(GAS v4u*)(LIN + (size_t)t * 768 + z) = (v4u){0u, 0u, 0u, 0u}; }
        }
    }
    SEAM(2);
    if (IN(3)) { PHASE_IDS
        { pg8::Gemm g{LIN, LORA_T, S_, 1024, 256, 768, 256}; pg8::StaticOrder S; S.init(S_, 1024, F.G, (int)blockIdx.x);
          pg8::Epi<pg8::EM_LORA_W> E{ws + WS_E, nullptr, nullptr, nullptr, nullptr, in[4], 1.f};
          pg8::gemm_phase<pg8::Epi<pg8::EM_LORA_W>, pg8::StaticOrder, true, true>(F.lds + RING_OFF, g, S, E); }
        { pg8::Gemm g{LIN + 256, LORA_T + 1024 * 256, S_, 1024, 256, 768, 256}; pg8::StaticOrder S; S.init(S_, 1024, F.G, (int)blockIdx.x);
          pg8::Epi<pg8::EM_LORA_A> E{ws + WS_A, nullptr, nullptr, nullptr, nullptr, in[6], 1.f};
          pg8::gemm_phase<pg8::Epi<pg8::EM_LORA_A>, pg8::StaticOrder, true, true>(F.lds + RING_OFF, g, S, E); }
        { pg8::Gemm g{LIN + 512, LORA_T + 2 * 1024 * 256, S_, 1024, 256, 768, 256}; pg8::StaticOrder S; S.init(S_, 1024, F.G, (int)blockIdx.x);
          pg8::Epi<pg8::EM_LORA_G> E{ws + WS_G, nullptr, nullptr, nullptr, nullptr, nullptr, 1.f};
          pg8::gemm_phase<pg8::Epi<pg8::EM_LORA_G>, pg8::StaticOrder, true, true>(F.lds + RING_OFF, g, S, E); }
    }
    SEAM(3);
    if (IN(4)) { PHASE_IDS
        bf16* SCN = (bf16*)(ws + WS_SCN); float* SCAL = (float*)(ws + WS_SCAL); const bf16* Ab = (const bf16*)(ws + WS_A);
        for (int t = gw; t < S_; t += NGW) {
#pragma unroll 2
            for (int h = 0; h < 16; ++h) { const int cc = h * 64 + lane;
                const float r = bf2f(RKV[(size_t)t * 3072 + cc]), k = bf2f(RKV[(size_t)t * 3072 + 1024 + cc]), a = bf2f(Ab[(size_t)t * 1024 + cc]);
                float kk = k * in[9][cc]; const float nrm = sqrtf(wave_sum(kk * kk)); kk = kk / fmaxf(nrm, 1e-12f);
                const float kt = k * (1.f + (a - 1.f) * in[10][cc]); const float b = kk * a;
                const unsigned short kkb = (unsigned short)f2bf(-kk), bb = (unsigned short)f2bf(b), ktb = (unsigned short)f2bf(kt);
                bf16* q = SCN + ((size_t)h * S_ + t) * 192; q[lane] = kkb; q[64 + lane] = bb; q[128 + lane] = ktb;
                const float br = wave_sum(bf2f(bb) * r), kr = wave_sum(bf2f(ktb) * r), bon = wave_sum(r * kt * in[11][cc]);
                if (lane == 0) *(f32x4*)(SCAL + ((size_t)h * S_ + t) * 4) = (f32x4){br, kr, bon, 0.f}; }
        }
    }
    SEAM(4);
    if (IN(5)) { PHASE_IDS
        for (int task = gw; task < 16 * NSEG * 2; task += NGW) { const int pair = task >> 1, kind = task & 1, h = pair / NSEG, seg = pair % NSEG;
            LAS float* wl = (LAS float*)(F.lds + RING_OFF + F.wave * SCAN_WAVE_BYTES);
            if (kind == 0) scan_task<0>(lane, ws, in, RKV, h, seg, wl); else scan_task<1>(lane, ws, in, RKV, h, seg, wl); }
    }
    SEAM(5);
    if (IN(6)) { PHASE_IDS
        if (F.vcu < 16) { const int h = F.vcu; const int v = tid >> 3, cg = tid & 7;
            LAS float* Sb = (LAS float*)(F.lds + RING_OFF); LAS float* Ab = Sb + 2 * 64 * 65;
            const float* SL = (const float*)(ws + WS_SLOC) + (size_t)h * NSEG * 4096; const float* AS = (const float*)(ws + WS_ASEG) + (size_t)h * NSEG * 4096; float* SI = (float*)(ws + WS_SIN) + (size_t)h * NSEG * 4096;
            f32x4 s0 = (f32x4){0.f, 0.f, 0.f, 0.f}, s1 = s0; int cur = 0;
            f32x4 na0 = *(const f32x4*)(AS + (size_t)v * 64 + cg * 8), na1 = *(const f32x4*)(AS + (size_t)v * 64 + cg * 8 + 4);
            f32x4 nl0 = *(const f32x4*)(SL + (size_t)v * 64 + cg * 8), nl1 = *(const f32x4*)(SL + (size_t)v * 64 + cg * 8 + 4);
            for (int p = 0; p < NSEG; ++p) {
                *(f32x4*)(SI + (size_t)p * 4096 + v * 64 + cg * 8) = s0; *(f32x4*)(SI + (size_t)p * 4096 + v * 64 + cg * 8 + 4) = s1;
                if (p == NSEG - 1) break;
                LAS float* sw = Sb + cur * 64 * 65 + v * 65 + cg * 8; sw[0] = s0.x; sw[1] = s0.y; sw[2] = s0.z; sw[3] = s0.w; sw[4] = s1.x; sw[5] = s1.y; sw[6] = s1.z; sw[7] = s1.w;
                *(LAS f32x4*)(Ab + v * 64 + cg * 8) = na0; *(LAS f32x4*)(Ab + v * 64 + cg * 8 + 4) = na1;
                f32x4 a0 = nl0, a1 = nl1;
                if (p + 1 < NSEG - 1) { const size_t o = (size_t)(p + 1) * 4096 + v * 64 + cg * 8; na0 = *(const f32x4*)(AS + o); na1 = *(const f32x4*)(AS + o + 4); nl0 = *(const f32x4*)(SL + o); nl1 = *(const f32x4*)(SL + o + 4); }
                __syncthreads();
                const LAS float* sr = Sb + cur * 64 * 65 + v * 65;
#pragma unroll 8
                for (int c = 0; c < 64; ++c) { const float s = sr[c]; const f32x4 x0 = *(const LAS f32x4*)(Ab + c * 64 + cg * 8), x1 = *(const LAS f32x4*)(Ab + c * 64 + cg * 8 + 4); a0 = a0 + x0 * s; a1 = a1 + x1 * s; }
                s0 = a0; s1 = a1; cur ^= 1;
                __syncthreads();
            }
        }
    }
    SEAM(6);
    if (IN(7)) { PHASE_IDS
        for (int task = gw; task < 16 * NSEG; task += NGW) { const int h = task / NSEG, seg = task % NSEG;
            LAS float* wl = (LAS float*)(F.lds + RING_OFF + F.wave * SCAN_WAVE_BYTES);
            scan_task<2>(lane, ws, in, RKV, h, seg, wl); }
    }
    SEAM(7);
    if (IN(8)) { PHASE_IDS
        __syncthreads();
        attn_body::attn_phase<8>((char*)lds + RING_OFF, (const attn_body::bf16*)PD, (attn_body::bf16*)(ws + WS_OATT), F.vcu);
    }
    SEAM(8);
    if (IN(9)) { PHASE_IDS
        float d1 = 0.f, d2 = 0.f; d1 = in[14][lane] * in[15][lane]; d2 = in[16][lane] * in[17][lane];
        const float lam = __expf(wave_sum(d1)) - __expf(wave_sum(d2)) + 0.2f;
        const bf16* OA = (const bf16*)(ws + WS_OATT); bf16* YB = (bf16*)(ws + WS_YB);
        f32x4 sg[4];
#pragma unroll
        for (int q = 0; q < 4; ++q) sg[q] = *(const f32x4*)(in[18] + (lane & 7) * 16 + q * 4);
        for (int t = gw; t < S_; t += NGW) {
            const v4u a0 = *(const GAS v4u*)(OA + (size_t)t * 2048 + lane * 16), a1 = *(const GAS v4u*)(OA + (size_t)t * 2048 + lane * 16 + 8);
            const v4u b0 = *(const GAS v4u*)(OA + (size_t)t * 2048 + 1024 + lane * 16), b1 = *(const GAS v4u*)(OA + (size_t)t * 2048 + 1024 + lane * 16 + 8);
            const unsigned aw[8] = {a0.x, a0.y, a0.z, a0.w, a1.x, a1.y, a1.z, a1.w}, bw[8] = {b0.x, b0.y, b0.z, b0.w, b1.x, b1.y, b1.z, b1.w};
            float o[16]; float ss = 0.f;
#pragma unroll
            for (int e = 0; e < 8; ++e) { o[2 * e] = pg8::bflo(aw[e]) - lam * pg8::bflo(bw[e]); o[2 * e + 1] = pg8::bfhi(aw[e]) - lam * pg8::bfhi(bw[e]); ss += o[2 * e] * o[2 * e] + o[2 * e + 1] * o[2 * e + 1]; }
            ss += __shfl_xor(ss, 1); ss += __shfl_xor(ss, 2); ss += __shfl_xor(ss, 4);
            const float rs = rsqrtf(ss * (1.f / 128.f) + 1e-5f) * 0.8f;
            const float gg[16] = {sg[0].x, sg[0].y, sg[0].z, sg[0].w, sg[1].x, sg[1].y, sg[1].z, sg[1].w, sg[2].x, sg[2].y, sg[2].z, sg[2].w, sg[3].x, sg[3].y, sg[3].z, sg[3].w};
#pragma unroll
            for (int e = 0; e < 16; ++e) o[e] = o[e] * rs * gg[e];
            *(GAS v4u*)(YB + (size_t)t * 1024 + lane * 16) = (v4u){pk2(o[0], o[1]), pk2(o[2], o[3]), pk2(o[4], o[5]), pk2(o[6], o[7])};
            *(GAS v4u*)(YB + (size_t)t * 1024 + lane * 16 + 8) = (v4u){pk2(o[8], o[9]), pk2(o[10], o[11]), pk2(o[12], o[13]), pk2(o[14], o[15])};
        }
    }
    SEAM(9);
    if (IN(10)) { PHASE_IDS
        pg8::Gemm g{(const bf16*)(ws + WS_YA), WA_T, S_, 2048, 1024, 1024, 1024}; pg8::StaticOrder S; S.init(S_, 2048, F.G, (int)blockIdx.x);
        pg8::Epi<pg8::EM_PROJA> E{ws + WS_T1, nullptr, nullptr, PG, nullptr, nullptr, 1.f};
        pg8::gemm_phase<pg8::Epi<pg8::EM_PROJA>, pg8::StaticOrder, true, true>(F.lds + RING_OFF, g, S, E);
    }
    SEAM(10);
    if (IN(11)) { PHASE_IDS
        pg8::Gemm g{(const bf16*)(ws + WS_YB), WB_T, S_, 2048, 1024, 1024, 1024}; pg8::StaticOrder S; S.init(S_, 2048, F.G, (int)blockIdx.x);
        pg8::Epi<pg8::EM_PROJB> E{ws + WS_MERGED, nullptr, nullptr, PG, ws + WS_T1, nullptr, 1.f};
        pg8::gemm_phase<pg8::Epi<pg8::EM_PROJB>, pg8::StaticOrder, true, true>(F.lds + RING_OFF, g, S, E);
    }
    SEAM(11);
    if (IN(12)) { PHASE_IDS
        pg8::Gemm g{(const bf16*)(ws + WS_MERGED), WOUT_T, S_, 2048, 2048, 2048, 2048}; pg8::StaticOrder S; S.init(S_, 2048, F.G, (int)blockIdx.x);
        pg8::Epi<pg8::EM_WOUT> E{args.out, nullptr, nullptr, nullptr, in[0], nullptr, 1.f};
        pg8::gemm_phase<pg8::Epi<pg8::EM_WOUT>, pg8::StaticOrder, true, true>(F.lds + RING_OFF, g, S, E);
    }
    SEAM(12);
    if (IN(13)) { PHASE_IDS
        for (int m = gw; m < S_; m += NGW) rms_row_to_bf16(args.out + (size_t)m * DM, in[22], (bf16*)(ws + WS_XN2) + (size_t)m * DM, lane);
        const size_t n8 = (size_t)16384 * 2048 / 8;
        for (int which = 0; which < 2; ++which) { const float* src = in[25 + which]; bf16* dst = (bf16*)(ws + (which ? WS_VTAB : WS_UTAB));
            for (size_t i = gt; i < n8; i += NGT) { const f32x4 a = __builtin_nontemporal_load((const f32x4*)(src + i * 8)), b = __builtin_nontemporal_load((const f32x4*)(src + i * 8 + 4));
                *(GAS v4u*)(dst + i * 8) = (v4u){pk2(a.x, a.y), pk2(a.z, a.w), pk2(b.x, b.y), pk2(b.z, b.w)}; } }
    }
    SEAM(13);
    if (IN(14)) { PHASE_IDS
        pg8::Gemm g{(const bf16*)(ws + WS_XN2), WS_T, S_, 2048, 2048, 2048, 2048}; pg8::StaticOrder S; S.init(S_, 2048, F.G, (int)blockIdx.x);
        pg8::Epi<pg8::EM_SCORES> E{ws + WS_SCORES, nullptr, nullptr, nullptr, nullptr, nullptr, 1.f};
        pg8::gemm_phase<pg8::Epi<pg8::EM_SCORES>, pg8::StaticOrder, true, true>(F.lds + RING_OFF, g, S, E);
    }
    SEAM(14);
    if (IN(15)) { PHASE_IDS
        const float* SC = (const float*)(ws + WS_SCORES); const bf16* XN2 = (const bf16*)(ws + WS_XN2);
        const bf16* UT = (const bf16*)(ws + WS_UTAB); const bf16* VT = (const bf16*)(ws + WS_VTAB);
        LAS unsigned* lst = (LAS unsigned*)(F.lds + RING_OFF + F.wave * 2048);
        int ci, cj;
        { const int L = lane;
          if (L < 16) { ci = 0; cj = L; } else if (L < 24) { ci = 1; cj = L - 16; } else if (L < 29) { ci = 2; cj = L - 24; } else if (L < 33) { ci = 3; cj = L - 29; }
          else if (L < 36) { ci = 4; cj = L - 33; } else if (L < 38) { ci = 5; cj = L - 36; } else if (L < 40) { ci = 6; cj = L - 38; } else if (L < 42) { ci = 7; cj = L - 40; }
          else if (L < 50) { ci = L - 34; cj = 0; } else { ci = 0; cj = 0; } }
        for (int t = gw; t < S_; t += NGW) {
            const float* srow = SC + (size_t)t * 2048;
            for (int h = 0; h < 8; ++h) {
                float tv[2]; int ti[2];
#pragma unroll
                for (int p = 0; p < 2; ++p) {
                    float v0 = srow[(h * 2 + p) * 128 + lane], v1 = srow[(h * 2 + p) * 128 + 64 + lane]; float mv = -INFINITY; int mi = 0;
                    for (int it = 0; it < 16; ++it) {
                        const float wm = wave_max(fmaxf(v0, v1));
                        const unsigned long long m0 = __ballot(v0 == wm), m1 = __ballot(v1 == wm);
                        int idx;
                        if (m0) { const int src = __ffsll((long long)m0) - 1; idx = src; if (lane == src) v0 = -INFINITY; }
                        else { const int src = __ffsll((long long)m1) - 1; idx = 64 + src; if (lane == src) v1 = -INFINITY; }
                        if (lane == it) { mv = wm; mi = idx; }
                    }
                    tv[p] = mv; ti[p] = mi;
                }
                float cv = __shfl(tv[0], ci) + __shfl(tv[1], cj); const int cidx = __shfl(ti[0], ci) * 128 + __shfl(ti[1], cj);
                if (lane >= 50) cv = -INFINITY;
                int rank = 0;
                for (int L2 = 0; L2 < 50; ++L2) { const float o = __shfl(cv, L2); rank += (o > cv || (o == cv && L2 < lane)) ? 1 : 0; }
                const bool sel = (lane < 50) && (rank < 16);
                const float mx = wave_max(cv); const float e = sel ? __expf(cv - mx) : 0.f; const float gsum = wave_sum(e);
                if (sel) { lst[(h * 16 + rank) * 2] = (unsigned)cidx; lst[(h * 16 + rank) * 2 + 1] = __float_as_uint(e / gsum); }
            }
            LDS_WAIT(); asm volatile("" ::: "memory");
            v4u xq[4];
#pragma unroll
            for (int j = 0; j < 4; ++j) xq[j] = *(const GAS v4u*)(XN2 + (size_t)t * 2048 + j * 512 + lane * 8);
            float acc[32];
#pragma unroll
            for (int e = 0; e < 32; ++e) acc[e] = 0.f;
#pragma unroll 1
            for (int e0 = 0; e0 < 128; e0 += 4) {
                v4u ur[4][4], vr[4][4]; float gate[4];
#pragma unroll
                for (int q = 0; q < 4; ++q) { const unsigned idx = __builtin_amdgcn_readfirstlane(lst[(e0 + q) * 2]); gate[q] = __uint_as_float(__builtin_amdgcn_readfirstlane(lst[(e0 + q) * 2 + 1]));
                    const bf16* up = UT + (size_t)idx * 2048 + lane * 8; const bf16* vp = VT + (size_t)idx * 2048 + lane * 8;
#pragma unroll
                    for (int j = 0; j < 4; ++j) { ur[q][j] = *(const GAS v4u*)(up + j * 512); vr[q][j] = *(const GAS v4u*)(vp + j * 512); } }
#pragma unroll
                for (int q = 0; q < 4; ++q) { float d = 0.f;
#pragma unroll
                    for (int j = 0; j < 4; ++j) { const unsigned xw[4] = {xq[j].x, xq[j].y, xq[j].z, xq[j].w}, uw[4] = {ur[q][j].x, ur[q][j].y, ur[q][j].z, ur[q][j].w};
#pragma unroll
                        for (int w = 0; w < 4; ++w) { d = fmaf(pg8::bflo(xw[w]), pg8::bflo(uw[w]), d); d = fmaf(pg8::bfhi(xw[w]), pg8::bfhi(uw[w]), d); } }
                    d = wave_sum(d);
                    const float act = 0.5f * d * (1.f + erff(d * 0.70710678118f)); const float cf = gate[q] * act;
#pragma unroll
                    for (int j = 0; j < 4; ++j) { const unsigned vw[4] = {vr[q][j].x, vr[q][j].y, vr[q][j].z, vr[q][j].w};
#pragma unroll
                        for (int w = 0; w < 4; ++w) { acc[j * 8 + 2 * w] = fmaf(cf, pg8::bflo(vw[w]), acc[j * 8 + 2 * w]); acc[j * 8 + 2 * w + 1] = fmaf(cf, pg8::bfhi(vw[w]), acc[j * 8 + 2 * w + 1]); } }
                }
            }
            float* orow = args.out + (size_t)t * 2048; float ss = 0.f;
#pragma unroll
            for (int j = 0; j < 4; ++j) { const f32x4 a = *(const f32x4*)(orow + j * 512 + lane * 8), b = *(const f32x4*)(orow + j * 512 + lane * 8 + 4);
                acc[j * 8 + 0] += a.x; acc[j * 8 + 1] += a.y; acc[j * 8 + 2] += a.z; acc[j * 8 + 3] += a.w; acc[j * 8 + 4] += b.x; acc[j * 8 + 5] += b.y; acc[j * 8 + 6] += b.z; acc[j * 8 + 7] += b.w; }
#pragma unroll
            for (int e = 0; e < 32; ++e) ss += acc[e] * acc[e];
            const float rstd = rsqrtf(wave_sum(ss) * (1.f / 2048.f) + 1e-6f);
#pragma unroll
            for (int j = 0; j < 4; ++j) { const f32x4 g0 = *(const f32x4*)(in[27] + j * 512 + lane * 8), g1 = *(const f32x4*)(in[27] + j * 512 + lane * 8 + 4);
                *(f32x4*)(orow + j * 512 + lane * 8) = (f32x4){acc[j * 8 + 0] * rstd * g0.x, acc[j * 8 + 1] * rstd * g0.y, acc[j * 8 + 2] * rstd * g0.z, acc[j * 8 + 3] * rstd * g0.w};
                *(f32x4*)(orow + j * 512 + lane * 8 + 4) = (f32x4){acc[j * 8 + 4] * rstd * g1.x, acc[j * 8 + 5] * rstd * g1.y, acc[j * 8 + 6] * rstd * g1.z, acc[j * 8 + 7] * rstd * g1.w}; }
            LDS_WAIT(); asm volatile("" ::: "memory");
        }
    }
#undef IN
#undef SEAM
}

extern "C" void kernel_launch(void* const* d_in, const int* in_sizes, int n_in, void* d_out, int out_size, void* d_ws, size_t ws_size, hipStream_t stream) {
    static int grid = 0;
    if (grid == 0) {
        if (n_in != 28 || in_sizes[0] != S_ * DM || out_size != S_ * DM || ws_size < WS_END) { fprintf(stderr, "kernel_launch: unexpected shapes: n_in %d in0 %d out %d ws %zu (need >= %zu)\n", n_in, n_in > 0 ? in_sizes[0] : -1, out_size, ws_size, (size_t)WS_END); grid = -1; return; }
        if (hipFuncSetAttribute((const void*)mk_fwd, hipFuncAttributeMaxDynamicSharedMemorySize, LDS_BYTES) != hipSuccess) { fprintf(stderr, "kernel_launch: hipFuncSetAttribute failed\n"); grid = -1; return; }
        int per_cu = 0;
        if (hipOccupancyMaxActiveBlocksPerMultiprocessor(&per_cu, (const void*)mk_fwd, NWAVES * 64, LDS_BYTES) != hipSuccess || per_cu < 1) fprintf(stderr, "kernel_launch: note: occupancy query reports %d\n", per_cu);
        (void)hipGetLastError();
        grid = 256;
    }
    if (grid < 0) return;
    (void)hipMemsetAsync((char*)d_ws + WS_CTL, 0, CTL_ZERO_BYTES, stream);
    Args a{};
    for (int i = 0; i < 28; ++i) a.in[i] = (const float*)d_in[i];
    a.out = (float*)d_out; a.ws = (unsigned char*)d_ws;
#if MK_PER_PHASE
    for (int p = 0; p < NPH; ++p) { a.ph_lo = p; a.ph_hi = p + 1; hipLaunchKernelGGL(mk_fwd, dim3(grid), dim3(NWAVES * 64), LDS_BYTES, stream, a); }
#else
    a.ph_lo = 0; a.ph_hi = NPH; hipLaunchKernelGGL(mk_fwd, dim3(grid), dim3(NWAVES * 64), LDS_BYTES, stream, a);
#endif
    const hipError_t le = hipPeekAtLastError();
    if (le != hipSuccess) fprintf(stderr, "kernel_launch: launch failed: %s\n", hipGetErrorName(le));
}
```

```cpp
#include <hip/hip_runtime.h>
#include <cstdio>
#include <cstdint>
namespace pg8 {
#define PG8_LAS __attribute__((address_space(3)))
typedef unsigned short bf16_t;
typedef short bf16x8 __attribute__((ext_vector_type(8)));
typedef float f32x4 __attribute__((ext_vector_type(4)));
typedef unsigned u32x4 __attribute__((ext_vector_type(4)));
constexpr int BM = 256, BK = 64, HALF = 128, HTB = HALF * BK * 2  , STAGE_BYTES = 8 * HTB, NXCD = 8, WGM = 8;

__host__ __device__ __forceinline__ int lds_byte(int r, int c) { const int st = (r >> 4) * 2 + (c >> 5), rr = r & 15, cc = c & 31, ob = rr * 64 + cc * 2; return st * 1024 + (ob ^ (((ob >> 9) & 1) << 5)); }
__host__ __device__ __forceinline__ void stage_rc(int b, int& R, int& C) { const int st = b / 1024, sb = b % 1024, swz = sb ^ (((sb >> 9) & 1) << 5); R = (st >> 1) * 16 + swz / 64; C = (st & 1) * 32 + (swz % 64) / 2; }
__host__ __device__ __forceinline__ int perm32(int rho) { const int n = rho >> 4, i = rho & 15; return 8 * (i >> 2) + 4 * n + (i & 3); }

struct Unit { int pm, pn; };
struct Gemm { const bf16_t* A; const bf16_t* Bt; int M, N, K, lda, ldb; };

struct StaticOrder {
    int nM, nN, nwg, G, c;
    __host__ __device__ void init(int M, int N, int G_, int c_) { nM = M / BM; nN = N / BM; nwg = nM * nN; G = G_; c = c_; }
    __host__ __device__ bool next(int i, Unit& u) const {
        const long L = (long)i * G + c; if (L >= nwg) return false;
        int wgid = (int)L; { const int q = nwg / NXCD, r = nwg % NXCD, xcd = wgid % NXCD, off = wgid / NXCD; wgid = (xcd < r ? xcd * (q + 1) : r * (q + 1) + (xcd - r) * q) + off; }
        const int nig = WGM * nN, gid = wgid / nig, fm = gid * WGM, gsz = (nM - fm) < WGM ? (nM - fm) : WGM;
        u.pm = fm + ((wgid % nig) % gsz); u.pn = (wgid % nig) / gsz; return true;
    }
    __device__ __forceinline__ void a_ready(const Unit&) const {}
    __device__ __forceinline__ void done(const Unit&) const {}
};

__device__ __forceinline__ unsigned cvt_pk_bf16(float lo, float hi) { unsigned r; asm volatile("v_cvt_pk_bf16_f32 %0, %1, %2" : "=v"(r) : "v"(lo), "v"(hi)); return r; }
__device__ __forceinline__ float sigm(float x) { return __builtin_amdgcn_rcpf(1.0f + __expf(-x)); }
__device__ __forceinline__ float bflo(unsigned w) { return __uint_as_float(w << 16); }
__device__ __forceinline__ float bfhi(unsigned w) { return __uint_as_float(w & 0xffff0000u); }
enum { EM_G1 = 0, EM_LORA_W = 1, EM_LORA_A = 2, EM_LORA_G = 3, EM_PROJA = 4, EM_PROJB = 5, EM_WOUT = 6, EM_SCORES = 7 };
template <int MODE> struct Epi {
    static constexpr bool PERM = true, AFTER_DRAIN = false;
    void* o0; void* o1; void* o2; const void* i0; const void* i1; const float* vec; float sc;
    __device__ __forceinline__ void operator()(const f32x4 (&acc)[2][2][4][2], const Unit& u, int wr, int wc, int fr, int fq) const {
        const int row0 = u.pm * BM + wr * 64 + fr;
        int colt = u.pn * BM; int ldc = 2048; int sub = 0;
        bf16_t* ob = (bf16_t*)o0; float scl = 1.f;
        if (MODE == EM_G1) {
            if (u.pn < 14) { ldc = 3584; }
            else if (u.pn < 26) { ob = (bf16_t*)o1; ldc = 3072; colt -= 14 * BM; if (u.pn < 18) scl = sc; }
            else { ob = (bf16_t*)o2; ldc = 4096; colt -= 26 * BM; sub = 1; }
        }
        if (MODE == EM_LORA_W || MODE == EM_LORA_A || MODE == EM_LORA_G) ldc = 1024;
        const int col0 = colt + wc * 32 + 8 * fq;
#pragma unroll
        for (int ai = 0; ai < 2; ++ai)
#pragma unroll
            for (int m = 0; m < 4; ++m) { const size_t row = (size_t)(row0 + ai * HALF + m * 16);
#pragma unroll
                for (int bj = 0; bj < 2; ++bj) { f32x4 v0 = acc[ai][bj][m][0], v1 = acc[ai][bj][m][1]; const int col = col0 + bj * HALF;
                    if (MODE == EM_G1) {
                        if (sub) { v0 = (f32x4){sigm(v0[0]), sigm(v0[1]), sigm(v0[2]), sigm(v0[3])}; v1 = (f32x4){sigm(v1[0]), sigm(v1[1]), sigm(v1[2]), sigm(v1[3])}; }
                        else { v0 = v0 * scl; v1 = v1 * scl; }
                        u32x4 w; w.x = cvt_pk_bf16(v0[0], v0[1]); w.y = cvt_pk_bf16(v0[2], v0[3]); w.z = cvt_pk_bf16(v1[0], v1[1]); w.w = cvt_pk_bf16(v1[2], v1[3]);
                        *(u32x4*)(ob + row * ldc + col) = w;
                    } else if (MODE == EM_LORA_W || MODE == EM_LORA_A) {
                        const f32x4 b0 = *(const f32x4*)(vec + col), b1 = *(const f32x4*)(vec + col + 4);
                        v0 = v0 + b0; v1 = v1 + b1;
                        v0 = (f32x4){sigm(v0[0]), sigm(v0[1]), sigm(v0[2]), sigm(v0[3])}; v1 = (f32x4){sigm(v1[0]), sigm(v1[1]), sigm(v1[2]), sigm(v1[3])};
                        if (MODE == EM_LORA_W) { v0 = v0 * 0.60653065971f; v1 = v1 * 0.60653065971f; }
                        u32x4 w; w.x = cvt_pk_bf16(v0[0], v0[1]); w.y = cvt_pk_bf16(v0[2], v0[3]); w.z = cvt_pk_bf16(v1[0], v1[1]); w.w = cvt_pk_bf16(v1[2], v1[3]);
                        *(u32x4*)(ob + row * ldc + col) = w;
                    } else if (MODE == EM_LORA_G) {
                        u32x4 w; w.x = cvt_pk_bf16(v0[0], v0[1]); w.y = cvt_pk_bf16(v0[2], v0[3]); w.z = cvt_pk_bf16(v1[0], v1[1]); w.w = cvt_pk_bf16(v1[2], v1[3]);
                        *(u32x4*)(ob + row * ldc + col) = w;
                    } else if (MODE == EM_PROJA) {
                        const u32x4 g = *(const u32x4*)((const bf16_t*)i0 + row * 4096 + col);
                        float* op = (float*)o0 + row * 2048 + col;
                        *(f32x4*)op = (f32x4){v0[0] * bflo(g.x), v0[1] * bfhi(g.x), v0[2] * bflo(g.y), v0[3] * bfhi(g.y)};
                        *(f32x4*)(op + 4) = (f32x4){v1[0] * bflo(g.z), v1[1] * bfhi(g.z), v1[2] * bflo(g.w), v1[3] * bfhi(g.w)};
                    } else if (MODE == EM_PROJB) {
                        const u32x4 g = *(const u32x4*)((const bf16_t*)i0 + row * 4096 + 2048 + col);
                        const float* tp = (const float*)i1 + row * 2048 + col; const f32x4 t0 = *(const f32x4*)tp, t1 = *(const f32x4*)(tp + 4);
                        v0 = (f32x4){t0[0] + v0[0] * bflo(g.x), t0[1] + v0[1] * bfhi(g.x), t0[2] + v0[2] * bflo(g.y), t0[3] + v0[3] * bfhi(g.y)};
                        v1 = (f32x4){t1[0] + v1[0] * bflo(g.z), t1[1] + v1[1] * bfhi(g.z), t1[2] + v1[2] * bflo(g.w), t1[3] + v1[3] * bfhi(g.w)};
                        u32x4 w; w.x = cvt_pk_bf16(v0[0], v0[1]); w.y = cvt_pk_bf16(v0[2], v0[3]); w.z = cvt_pk_bf16(v1[0], v1[1]); w.w = cvt_pk_bf16(v1[2], v1[3]);
                        *(u32x4*)(ob + row * 2048 + col) = w;
                    } else if (MODE == EM_WOUT) {
                        const float* xp = (const float*)i1 + row * 2048 + col; const f32x4 t0 = *(const f32x4*)xp, t1 = *(const f32x4*)(xp + 4);
                        float* op = (float*)o0 + row * 2048 + col; *(f32x4*)op = t0 + v0; *(f32x4*)(op + 4) = t1 + v1;
                    } else {
                        float* op = (float*)o0 + row * 2048 + col; *(f32x4*)op = v0; *(f32x4*)(op + 4) = v1;
                    }
                } }
    }
};

template <class Epi, class Sched, bool ALIGN_EPI = false, bool SP2 = false>
__device__ __forceinline__ void gemm_phase(PG8_LAS unsigned char* lds, const Gemm g, const Sched& S, const Epi& E) {
    int tid_ = threadIdx.x; asm volatile("" : "+v"(tid_)); const int tid = tid_, wid = __builtin_amdgcn_readfirstlane(tid >> 6), lane = tid & 63, wr = wid >> 2, wc = wid & 3, fr = lane & 15, fq = lane >> 4;
    const int K = g.K, nt = K / BK;
    unsigned voffA[2], voffB[2];
#pragma unroll
    for (int i = 0; i < 2; ++i) { int R, C; stage_rc(tid * 16 + i * 8192, R, C); const int Rb = Epi::PERM ? ((R & ~31) + perm32(R & 31)) : R;
        voffA[i] = (unsigned)(R * g.lda + C) * 2u; voffB[i] = (unsigned)(Rb * g.ldb + C) * 2u; }
    const size_t kstep = (size_t)(BK * 2);
    const size_t hstepA = (size_t)HALF * g.lda * 2, hstepB = (size_t)HALF * g.ldb * 2;
    const size_t tstepA = 2 * hstepA, tstepB = 2 * hstepB;
    const unsigned ldsw = (unsigned)wid * 1024u;
    const int aoff = lds_byte(wr * 64 + fr, fq * 8), boff = lds_byte(wc * 32 + fr, fq * 8);
#define PG8_SA(b, h) (((b) * 2 + (h)) * HTB)
#define PG8_SB(b, h) ((4 + (b) * 2 + (h)) * HTB)
#define PG8_STAGE(bufoff, gbase, voff) do { _Pragma("unroll") for (int _i = 0; _i < 2; ++_i) \
        __builtin_amdgcn_global_load_lds((const unsigned*)((const char*)(gbase) + (voff)[_i]), (PG8_LAS unsigned*)(lds + (bufoff) + ldsw + _i * 8192), 16, 0, 0); } while (0)
#define PG8_LDA(dst, b, h) do { _Pragma("unroll") for (int m = 0; m < 4; ++m) _Pragma("unroll") for (int k = 0; k < 2; ++k) dst[m][k] = *(const PG8_LAS bf16x8*)(lds + PG8_SA(b, h) + aoff + m * 2048 + k * 1024); } while (0)
#define PG8_LDB(dst, b, h) do { _Pragma("unroll") for (int n = 0; n < 2; ++n) _Pragma("unroll") for (int k = 0; k < 2; ++k) dst[n][k] = *(const PG8_LAS bf16x8*)(lds + PG8_SB(b, h) + boff + n * 2048 + k * 1024); } while (0)
#define PG8_MMA(ai, bj, At, Bt) do { __builtin_amdgcn_s_setprio(1); _Pragma("unroll") for (int m = 0; m < 4; ++m) _Pragma("unroll") for (int n = 0; n < 2; ++n) _Pragma("unroll") for (int k = 0; k < 2; ++k) \
        acc[ai][bj][m][n] = __builtin_amdgcn_mfma_f32_16x16x32_bf16(Bt[n][k], At[m][k], acc[ai][bj][m][n], 0, 0, 0); __builtin_amdgcn_s_setprio(0); } while (0)
#define PG8_WAIT_V(n) asm volatile("s_waitcnt vmcnt(" #n ")" ::: "memory")
#define PG8_WAIT_L(n) asm volatile("s_waitcnt lgkmcnt(" #n ")" ::: "memory")
#define PG8_BAR __builtin_amdgcn_s_barrier()
#define PG8_SCHED __builtin_amdgcn_sched_barrier(0)
    Unit cur, nxt; int ui = 0;
    if (!S.next(0, cur)) return;
    f32x4 acc[2][2][4][2];
#pragma unroll
    for (int a = 0; a < 2; ++a)
#pragma unroll
        for (int b = 0; b < 2; ++b)
#pragma unroll
            for (int m = 0; m < 4; ++m)
#pragma unroll
                for (int n = 0; n < 2; ++n) acc[a][b][m][n] = (f32x4){0.f, 0.f, 0.f, 0.f};
    bf16x8 At[4][2], B0[2][2], B1[2][2];
    const char* cA = (const char*)g.A + (size_t)cur.pm * tstepA; const char* cB = (const char*)g.Bt + (size_t)cur.pn * tstepB;
    S.a_ready(cur);
    if constexpr (SP2) {
        PG8_STAGE(PG8_SB(0, 0), cB, voffB); PG8_STAGE(PG8_SB(0, 1), cB + hstepB, voffB); PG8_STAGE(PG8_SA(0, 0), cA, voffA); PG8_STAGE(PG8_SA(0, 1), cA + hstepA, voffA);
        if (wr == 1) PG8_BAR;
        PG8_WAIT_V(2); PG8_BAR;
        PG8_STAGE(PG8_SB(1, 0), cB + kstep, voffB); PG8_STAGE(PG8_SA(1, 0), cA + kstep, voffA); PG8_STAGE(PG8_SB(1, 1), cB + hstepB + kstep, voffB);
        PG8_WAIT_V(6); PG8_BAR;
    } else {
        PG8_STAGE(PG8_SB(0, 0), cB, voffB); PG8_STAGE(PG8_SA(0, 0), cA, voffA); PG8_STAGE(PG8_SB(0, 1), cB + hstepB, voffB); PG8_STAGE(PG8_SA(0, 1), cA + hstepA, voffA);
        if (wr == 1) PG8_BAR;
        PG8_WAIT_V(4); PG8_BAR;
        PG8_STAGE(PG8_SB(1, 0), cB + kstep, voffB); PG8_STAGE(PG8_SA(1, 0), cA + kstep, voffA); PG8_STAGE(PG8_SB(1, 1), cB + hstepB + kstep, voffB);
        PG8_WAIT_V(6); PG8_BAR;
    }
    for (;;) {
        const bool has_next = S.next(ui + 1, nxt);
        const char* nA = has_next ? (const char*)g.A + (size_t)nxt.pm * tstepA : cA; const char* nB = has_next ? (const char*)g.Bt + (size_t)nxt.pn * tstepB : cB;
        for (int t = 0; t < nt; t += 2) {
            const bool last = (t == nt - 2);
            const char* a1 = cA + (size_t)(t + 1) * kstep;
            const char* a2 = last ? nA : cA + (size_t)(t + 2) * kstep; const char* b2 = last ? nB : cB + (size_t)(t + 2) * kstep;
            const char* a3 = a2 + kstep; const char* b3 = b2 + kstep;
            if (last && has_next) S.a_ready(nxt);
            if constexpr (SP2) {
            PG8_LDB(B0, 0, 0); PG8_LDB(B1, 0, 1); PG8_SCHED; PG8_LDA(At, 0, 0); PG8_STAGE(PG8_SA(1, 1), a1 + hstepA, voffA);
            PG8_WAIT_V(8); PG8_WAIT_L(0); PG8_BAR; PG8_MMA(0, 0, At, B0); PG8_MMA(0, 1, At, B1); PG8_BAR; PG8_SCHED;
            PG8_LDA(At, 0, 1); PG8_STAGE(PG8_SB(0, 0), b2, voffB); PG8_STAGE(PG8_SB(0, 1), b2 + hstepB, voffB); PG8_STAGE(PG8_SA(0, 0), a2, voffA);
            PG8_WAIT_V(8); PG8_WAIT_L(0); PG8_BAR; PG8_MMA(1, 0, At, B0); PG8_MMA(1, 1, At, B1); PG8_BAR; PG8_SCHED;
            PG8_LDB(B0, 1, 0); PG8_LDB(B1, 1, 1); PG8_SCHED; PG8_LDA(At, 1, 0); PG8_STAGE(PG8_SA(0, 1), a2 + hstepA, voffA);
            PG8_WAIT_V(8); PG8_WAIT_L(0); PG8_BAR; PG8_MMA(0, 0, At, B0); PG8_MMA(0, 1, At, B1); PG8_BAR; PG8_SCHED;
            PG8_LDA(At, 1, 1); PG8_STAGE(PG8_SB(1, 0), b3, voffB); PG8_STAGE(PG8_SB(1, 1), b3 + hstepB, voffB); PG8_STAGE(PG8_SA(1, 0), a3, voffA);
            PG8_WAIT_V(8); PG8_WAIT_L(0); PG8_BAR; PG8_MMA(1, 0, At, B0); PG8_MMA(1, 1, At, B1); PG8_BAR; PG8_SCHED;
            } else {
            PG8_LDB(B0, 0, 0); PG8_SCHED; PG8_LDA(At, 0, 0); PG8_STAGE(PG8_SA(1, 1), a1 + hstepA, voffA);
            PG8_WAIT_L(8); PG8_BAR; PG8_WAIT_L(0); PG8_MMA(0, 0, At, B0); PG8_BAR; PG8_SCHED;
            PG8_LDB(B1, 0, 1); PG8_STAGE(PG8_SB(0, 0), b2, voffB);
            PG8_BAR; PG8_WAIT_L(0); PG8_MMA(0, 1, At, B1); PG8_BAR;
            PG8_LDA(At, 0, 1); PG8_STAGE(PG8_SA(0, 0), a2, voffA);
            PG8_BAR; PG8_WAIT_L(0); PG8_MMA(1, 0, At, B0); PG8_BAR; PG8_SCHED;
            PG8_STAGE(PG8_SB(0, 1), b2 + hstepB, voffB);
            PG8_WAIT_V(6); PG8_BAR; PG8_MMA(1, 1, At, B1); PG8_BAR;
            PG8_LDB(B0, 1, 0); PG8_SCHED; PG8_LDA(At, 1, 0); PG8_STAGE(PG8_SA(0, 1), a2 + hstepA, voffA);
            PG8_WAIT_L(8); PG8_BAR; PG8_WAIT_L(0); PG8_MMA(0, 0, At, B0); PG8_BAR; PG8_SCHED;
            PG8_LDB(B1, 1, 1); PG8_STAGE(PG8_SB(1, 0), b3, voffB);
            PG8_BAR; PG8_WAIT_L(0); PG8_MMA(0, 1, At, B1); PG8_BAR;
            PG8_LDA(At, 1, 1); PG8_STAGE(PG8_SA(1, 0), a3, voffA);
            PG8_BAR; PG8_WAIT_L(0); PG8_MMA(1, 0, At, B0); PG8_BAR; PG8_SCHED;
            PG8_STAGE(PG8_SB(1, 1), b3 + hstepB, voffB);
            PG8_WAIT_V(6); PG8_BAR; PG8_MMA(1, 1, At, B1); PG8_BAR;
            }
        }
        if constexpr (ALIGN_EPI) { if (wr == 0) PG8_BAR; }
        if constexpr (!Epi::AFTER_DRAIN) { E(acc, cur, wr, wc, fr, fq); S.done(cur); }
        if (!has_next) break;
#pragma unroll
        for (int a = 0; a < 2; ++a)
#pragma unroll
            for (int b = 0; b < 2; ++b)
#pragma unroll
                for (int m = 0; m < 4; ++m)
#pragma unroll
                    for (int n = 0; n < 2; ++n) acc[a][b][m][n] = (f32x4){0.f, 0.f, 0.f, 0.f};
        cur = nxt; cA = nA; cB = nB; ++ui;
        if constexpr (ALIGN_EPI) { if (wr == 1) PG8_BAR; }
    }
    PG8_WAIT_V(0);
    if constexpr (!ALIGN_EPI) { if (wr == 0) PG8_BAR; }
    PG8_BAR;
    if constexpr (Epi::AFTER_DRAIN) { E.fused(acc, cur, wr, wc, fr, fq, lds, wid, lane); S.done(cur); }
#undef PG8_SA
#undef PG8_SB
#undef PG8_STAGE
#undef PG8_LDA
#undef PG8_LDB
#undef PG8_MMA
#undef PG8_WAIT_V
#undef PG8_WAIT_L
#undef PG8_BAR
#undef PG8_SCHED
}
}
#include <hip/hip_bf16.h>
#include <cmath>
namespace attn_body {
using bf16=__hip_bfloat16;
using bf16x8=__attribute__((ext_vector_type(8)))short;
using s16x4=__attribute__((ext_vector_type(4)))short;
using f32x16=__attribute__((ext_vector_type(16)))float;
using u32x4=__attribute__((ext_vector_type(4)))unsigned;
constexpr int SEQ=16384,D=64,PQ=3072,PO=2048;
constexpr int NW=8,QBLK=32,QB=QBLK*NW,KVBLK=64,NQB=SEQ/QB;
constexpr int ATTN_UNIT_ROWS=QB;
__device__ __forceinline__ int crow(int r,int hi){return (r&3)+8*(r>>2)+4*hi;}
#define SBAR() __builtin_amdgcn_sched_barrier(0)
__device__ __forceinline__ void cmask(f32x16&p0,f32x16&p1,int jb,int qrel,int hi){
  const float NEG=-INFINITY; int kb=64*jb+4*hi;
  #pragma unroll
  for(int r=0;r<16;++r){int kv=kb+(r&3)+8*(r>>2); if(kv>qrel)p0[r]=NEG; if(kv+32>qrel)p1[r]=NEG;}
}

constexpr int NSLOT=3, SLOTB=8192;
constexpr int LDS_K=0, LDS_V=NSLOT*SLOTB, LDS_WS=2*NSLOT*SLOTB, LDS_OST=LDS_WS+NW*64*4, LDS_BYTES=LDS_OST+NW*4096;
constexpr float C2=0.125f*1.4426950408889634f;
__device__ __forceinline__ void glds16(const void*gsrc,unsigned lds_dst){unsigned keep;
  asm volatile("s_mov_b32 %0, m0\n\ts_mov_b32 m0, %2\n\ts_nop 0\n\tglobal_load_lds_dwordx4 %1, off\n\ts_mov_b32 m0, %0":"=&s"(keep):"v"(gsrc),"s"(lds_dst):"memory");}
__device__ __forceinline__ float max3f(float a,float b,float c){float r;asm("v_max3_f32 %0, %1, %2, %3":"=v"(r):"v"(a),"v"(b),"v"(c));return r;}
__device__ __forceinline__ float max2f(float a,float b){float r;asm("v_max_f32_e32 %0, %1, %2":"=v"(r):"v"(a),"v"(b));return r;}
__device__ __forceinline__ float fadd_s(float a,float b){float r;asm("v_add_f32_e32 %0, %1, %2":"=v"(r):"v"(a),"v"(b));return r;}
__device__ __forceinline__ float fsub_s(float a,float b){float r;asm("v_sub_f32_e32 %0, %1, %2":"=v"(r):"v"(a),"v"(b));return r;}
typedef float f32x2_t __attribute__((ext_vector_type(2))); typedef __bf16 bf16x2_t __attribute__((ext_vector_type(2)));
__device__ __forceinline__ unsigned cvtpk_s(float lo,float hi){f32x2_t v={lo,hi};bf16x2_t b=__builtin_convertvector(v,bf16x2_t);return __builtin_bit_cast(unsigned,b);}
#define WAIT_BAR(N) asm volatile("s_waitcnt vmcnt(" #N ") lgkmcnt(0)\n\ts_barrier":::"memory")

__device__ __forceinline__ void qkt(f32x16&p0,f32x16&p1,const char*Kslot,const bf16x8*qr,const f32x16&negm,int r32,int hi){
  const char*kb=Kslot+hi*1024+r32*16;
  #pragma unroll
  for(int d0=0;d0<4;++d0){
    const bf16x8 b0=*reinterpret_cast<const bf16x8*>(kb+d0*2048);
    const bf16x8 b1=*reinterpret_cast<const bf16x8*>(kb+d0*2048+512);
    if(d0==0){p0=__builtin_amdgcn_mfma_f32_32x32x16_bf16(b0,qr[0],negm,0,0,0);p1=__builtin_amdgcn_mfma_f32_32x32x16_bf16(b1,qr[0],negm,0,0,0);}
    else{p0=__builtin_amdgcn_mfma_f32_32x32x16_bf16(b0,qr[d0],p0,0,0,0);p1=__builtin_amdgcn_mfma_f32_32x32x16_bf16(b1,qr[d0],p1,0,0,0);}}
}
typedef __attribute__((address_space(3))) const char* lds_cptr;
typedef short v4i16_t __attribute__((ext_vector_type(4)));
__device__ __forceinline__ void kload8(bf16x8*kf,lds_cptr kp){
  kf[0]=*(const __attribute__((address_space(3))) bf16x8*)(kp);      kf[1]=*(const __attribute__((address_space(3))) bf16x8*)(kp+512);
  kf[2]=*(const __attribute__((address_space(3))) bf16x8*)(kp+2048); kf[3]=*(const __attribute__((address_space(3))) bf16x8*)(kp+2560);
  kf[4]=*(const __attribute__((address_space(3))) bf16x8*)(kp+4096); kf[5]=*(const __attribute__((address_space(3))) bf16x8*)(kp+4608);
  kf[6]=*(const __attribute__((address_space(3))) bf16x8*)(kp+6144); kf[7]=*(const __attribute__((address_space(3))) bf16x8*)(kp+6656);
}
__device__ __forceinline__ void kload2(bf16x8*kf,lds_cptr kp,int j){ kf[2*j]=*(const __attribute__((address_space(3))) bf16x8*)(kp+j*2048); kf[2*j+1]=*(const __attribute__((address_space(3))) bf16x8*)(kp+j*2048+512); }
__device__ __forceinline__ s16x4 vtr(lds_cptr p){ return __builtin_bit_cast(s16x4,__builtin_amdgcn_ds_read_tr16_b64_v4i16((__attribute__((address_space(3))) v4i16_t*)p)); }
__device__ __forceinline__ float rowmax(const f32x16&p0,const f32x16&p1){
  float a=max3f(p0[0],p0[1],p1[0]),b=max3f(p0[2],p0[3],p1[1]);a=max3f(a,p1[2],p1[3]);
  #pragma unroll
  for(int r=4;r<16;r+=4){a=max3f(a,p0[r],p0[r+1]);b=max3f(b,p0[r+2],p0[r+3]);a=max3f(a,p1[r],p1[r+1]);b=max3f(b,p1[r+2],p1[r+3]);}
  const float m=max2f(a,b);
  auto rr=__builtin_amdgcn_permlane32_swap(__float_as_uint(m),__float_as_uint(m),false,false);
  return max2f(__uint_as_float(rr[0]),__uint_as_float(rr[1]));
}
__device__ __forceinline__ void pv(f32x16*o,int vb,bf16x8 pa0,bf16x8 pa1,bf16x8 pa2,bf16x8 pa3){
  #pragma unroll
  for(int d0=0;d0<2;++d0){s16x4 lo[4],hi[4];
    #pragma unroll
    for(int ks=0;ks<4;++ks){
      asm volatile("ds_read_b64_tr_b16 %0,%1 offset:%c2":"=&v"(lo[ks]):"v"(vb),"i"(d0*4096+ks*1024):"memory");
      asm volatile("ds_read_b64_tr_b16 %0,%1 offset:%c2":"=&v"(hi[ks]):"v"(vb),"i"(d0*4096+ks*1024+512):"memory");}
    asm volatile("s_waitcnt lgkmcnt(0)":::"memory");SBAR();
    #define PK(k) (bf16x8){lo[k][0],lo[k][1],lo[k][2],lo[k][3],hi[k][0],hi[k][1],hi[k][2],hi[k][3]}
    o[d0]=__builtin_amdgcn_mfma_f32_32x32x16_bf16(pa0,PK(0),o[d0],0,0,0);
    o[d0]=__builtin_amdgcn_mfma_f32_32x32x16_bf16(pa1,PK(1),o[d0],0,0,0);
    o[d0]=__builtin_amdgcn_mfma_f32_32x32x16_bf16(pa2,PK(2),o[d0],0,0,0);
    o[d0]=__builtin_amdgcn_mfma_f32_32x32x16_bf16(pa3,PK(3),o[d0],0,0,0);
    #undef PK
  }
}

#ifndef ATTN_STORE16
#define ATTN_STORE16(p,v) (*(u32x4*)(p)=(v))
#endif
template<int THRL> __device__ __forceinline__ void attn_unit(int qb,const bf16*Q,const bf16*__restrict__ K,const bf16*__restrict__ V,bf16*O,char*shm){
  int tid_=threadIdx.x; asm volatile("":"+v"(tid_)); const int tid=tid_,lane=tid&63,r32=lane&31,hi=lane>>5; const int wid=__builtin_amdgcn_readfirstlane(tid>>6);
  const int q0=qb*QB;
  const bf16*Qw=Q+(long)(q0+wid*QBLK)*PQ;
  const bf16*Kh=K,*Vh=V;
  const unsigned lds0=(unsigned)(uintptr_t)shm;
  float*wsf=(float*)(shm+LDS_WS)+wid*64;
  const bf16*ksrc=Kh+(long)lane*PQ+wid*8;
  const bf16*vsrc=Vh+(long)(16*(wid&3)+(lane>>2))*PQ+(wid>>2)*32+(lane&3)*8;
  const unsigned kdst=lds0+LDS_K+wid*1024, vdst=lds0+LDS_V+wid*1024;
  #define DMA_K(t,slot) glds16(ksrc+(long)(t)*KVBLK*PQ,(unsigned)__builtin_amdgcn_readfirstlane(kdst+(slot)))
  #define DMA_V(t,slot) glds16(vsrc+(long)(t)*KVBLK*PQ,(unsigned)__builtin_amdgcn_readfirstlane(vdst+(slot)))
  const int vb0=(int)(lds0+LDS_V)+((lane>>4)&1)*32+(lane&3)*8+(4*hi+((lane&15)>>2))*64;
  const char*Kbase=shm+LDS_K; bf16x8 kf[8];
  const lds_cptr shm3=(lds_cptr)shm; const lds_cptr kp0=shm3+LDS_K+hi*1024+r32*16; const lds_cptr vp0=shm3+LDS_V+((lane>>4)&1)*32+(lane&3)*8+(4*hi+((lane&15)>>2))*64;
  const int NT=(q0+QB)/KVBLK;
  DMA_K(0,0);DMA_V(0,0);DMA_K(1,SLOTB);
  bf16x8 qr[4];
  #pragma unroll
  for(int d0=0;d0<4;++d0)qr[d0]=*reinterpret_cast<const bf16x8*>(&Qw[(long)r32*PQ+d0*16+hi*8]);
  float mhat=0.f,l_reg=0.f;f32x16 o[2];o[0]=f32x16{};o[1]=f32x16{};asm volatile("":"+v"(o[0]));asm volatile("":"+v"(o[1]));f32x16 negm=f32x16{};asm volatile("":"+v"(negm));
  const int qrel=wid*QBLK+r32;
  #define CMASK(P0,P1,t) do{int jb_=(t)-(NT-4); if(jb_>=0)cmask(P0,P1,jb_,qrel,hi);}while(0)
  bool resc=false;
  #define START(P0,P1) do{ const float rm=rowmax(P0,P1); resc=false; \
    { const float dl=rm; mhat=fadd_s(mhat,dl); \
      _Pragma("unroll") for(int r=0;r<16;++r){P0[r]=fsub_s(P0[r],dl);P1[r]=fsub_s(P1[r],dl);} \
      _Pragma("unroll") for(int r=0;r<16;++r)negm[r]=-mhat; asm volatile("":"+v"(negm)); } \
    _Pragma("unroll") for(int r=0;r<16;++r)P0[r]=__builtin_amdgcn_exp2f(P0[r]); }while(0)
  #define RESC() do{ if(resc){ asm volatile("s_waitcnt lgkmcnt(0)":::"memory"); \
      _Pragma("unroll") for(int d_=0;d_<2;++d_) _Pragma("unroll") for(int r=0;r<16;++r)o[d_][r]*=wsf[crow(r,hi)]; } }while(0)
  f32x16 pA0,pA1,pB0,pB1;
  int sl_prev=0,sl_cur=0,sl_next=SLOTB;
  #define ROT() do{sl_prev=sl_cur;sl_cur=sl_next;sl_next=(sl_next==(NSLOT-1)*SLOTB)?0:sl_next+SLOTB;}while(0)
  DMA_K(2,2*SLOTB);
  WAIT_BAR(3);
  qkt(pA0,pA1,Kbase,qr,negm,r32,hi);asm volatile("s_nop 15\n\ts_nop 7":"+v"(pA0),"+v"(pA1));CMASK(pA0,pA1,0);
  START(pA0,pA1);
  _Pragma("unroll") for(int r=0;r<16;++r)pA1[r]=__builtin_amdgcn_exp2f(pA1[r]);
  WAIT_BAR(0);
  DMA_K(3,0);DMA_V(1,SLOTB);
  ROT();
  kload8(kf,kp0+sl_cur);
  WAIT_BAR(2);
  s16x4 vlo[8],vhi[8]; u32x4 pw0,pw1,pw2,pw3;
  #define PKW(P,B) cvtpk_s(P[B],P[B+1])
  #define PAF(k) __builtin_bit_cast(bf16x8,pw##k)
  #define VFR(i) (bf16x8){vlo[i][0],vlo[i][1],vlo[i][2],vlo[i][3],vhi[i][0],vhi[i][1],vhi[i][2],vhi[i][3]}
  #define PIN(x) asm volatile("":"+v"(x))
  #define MX3(a,b,c) __builtin_fmaxf(__builtin_fmaxf((a),(b)),(c))
  #define GAPA(MF,A0,A1,A2,A3,W0,W1,PW) do{ MF; sacc+=A0; sacc+=A1; sacc+=A2; sacc+=A3; PIN(sacc); W0; W1; PIN(PW); SBAR(); }while(0)
  #define EX(v) __builtin_amdgcn_exp2f(v)
  #define GAPB(MF,X,B) do{ MF; X[B]=EX(X[B]); X[B+1]=EX(X[B+1]); X[B+2]=EX(X[B+2]); X[B+3]=EX(X[B+3]); PIN(X); SBAR(); }while(0)
  #define VRD(i) do{ vlo[i]=vtr(vp_+(((i)>>2)*4096+((i)&3)*1024)); vhi[i]=vtr(vp_+(((i)>>2)*4096+((i)&3)*1024+512)); }while(0)
  #define KRD(G,j) do{ if(G){ kload2(kf,kp0+sl_next,j); SBAR(); } }while(0)
  #define STEP(C0,C1,P0,P1,t,GK,GV,GL) do{ SBAR(); \
    const lds_cptr vp_=vp0+sl_prev; \
    VRD(0); SBAR(); float sacc=(P0[0]+P0[1]); \
    GAPA(C0=__builtin_amdgcn_mfma_f32_32x32x16_bf16(kf[0],qr[0],negm,0,0,0), P0[2],P0[3],P0[4],P0[5],     pw0[0]=PKW(P0,0), pw0[1]=PKW(P0,2), pw0); \
    VRD(4); SBAR(); GAPA(C1=__builtin_amdgcn_mfma_f32_32x32x16_bf16(kf[1],qr[0],negm,0,0,0), P0[6],P0[7],P0[8],P0[9],     pw0[2]=PKW(P0,4), pw0[3]=PKW(P0,6), pw0); \
    VRD(1); SBAR(); GAPA(C0=__builtin_amdgcn_mfma_f32_32x32x16_bf16(kf[2],qr[1],C0,0,0,0),   P0[10],P0[11],P0[12],P0[13], pw1[0]=PKW(P0,8), pw1[1]=PKW(P0,10), pw1); \
    VRD(5); SBAR(); GAPA(C1=__builtin_amdgcn_mfma_f32_32x32x16_bf16(kf[3],qr[1],C1,0,0,0),   P0[14],P0[15],P1[0],P1[1],   pw1[2]=PKW(P0,12),pw1[3]=PKW(P0,14), pw1); \
    VRD(2); SBAR(); GAPA(C0=__builtin_amdgcn_mfma_f32_32x32x16_bf16(kf[4],qr[2],C0,0,0,0),   P1[2],P1[3],P1[4],P1[5],     pw2[0]=PKW(P1,0), pw2[1]=PKW(P1,2), pw2); \
    VRD(6); SBAR(); GAPA(C1=__builtin_amdgcn_mfma_f32_32x32x16_bf16(kf[5],qr[2],C1,0,0,0),   P1[6],P1[7],P1[8],P1[9],     pw2[2]=PKW(P1,4), pw2[3]=PKW(P1,6), pw2); \
    VRD(3); SBAR(); GAPA(C0=__builtin_amdgcn_mfma_f32_32x32x16_bf16(kf[6],qr[3],C0,0,0,0),   P1[10],P1[11],P1[12],P1[13], pw3[0]=PKW(P1,8), pw3[1]=PKW(P1,10), pw3); \
    VRD(7); SBAR(); GAPA(C1=__builtin_amdgcn_mfma_f32_32x32x16_bf16(kf[7],qr[3],C1,0,0,0),   P1[14],P1[15],0.f,0.f,       pw3[2]=PKW(P1,12),pw3[3]=PKW(P1,14), pw3); \
    l_reg+=sacc; \
    if(GK){DMA_K((t)+3,sl_cur);} if(GV){DMA_V((t)+1,sl_next);} \
    CMASK(C0,C1,t); \
    { float a=MX3(C0[0],C0[1],C1[0]),b=MX3(C0[2],C0[3],C1[1]); a=MX3(a,C1[2],C1[3]); \
      _Pragma("unroll") for(int r=4;r<16;r+=4){a=MX3(a,C0[r],C0[r+1]);b=MX3(b,C0[r+2],C0[r+3]);a=MX3(a,C1[r],C1[r+1]);b=MX3(b,C1[r+2],C1[r+3]);} \
      float rm=__builtin_fmaxf(a,b); { auto rr=__builtin_amdgcn_permlane32_swap(__float_as_uint(rm),__float_as_uint(rm),false,false); rm=__builtin_fmaxf(__uint_as_float(rr[0]),__uint_as_float(rr[1])); } \
      resc=false; \
      if(__builtin_expect(__any(rm>(float)THRL),0)){ const float dl=__builtin_fmaxf(rm,0.f); mhat+=dl; \
        _Pragma("unroll") for(int r=0;r<16;++r){C0[r]-=dl;C1[r]-=dl;} \
        _Pragma("unroll") for(int r=0;r<16;++r)negm[r]=-mhat; asm volatile("":"+v"(negm)); \
        const float f=__builtin_amdgcn_exp2f(-dl); l_reg*=f; if(hi==0)wsf[r32]=f; resc=true; } } \
    SBAR(); \
    GAPB(o[0]=__builtin_amdgcn_mfma_f32_32x32x16_bf16(PAF(0),VFR(0),o[0],0,0,0), C0,0); \
    GAPB(o[1]=__builtin_amdgcn_mfma_f32_32x32x16_bf16(PAF(0),VFR(4),o[1],0,0,0), C0,4); \
    KRD(GL,0); GAPB(o[0]=__builtin_amdgcn_mfma_f32_32x32x16_bf16(PAF(1),VFR(1),o[0],0,0,0), C0,8); \
    KRD(GL,1); GAPB(o[1]=__builtin_amdgcn_mfma_f32_32x32x16_bf16(PAF(1),VFR(5),o[1],0,0,0), C0,12); \
    KRD(GL,2); GAPB(o[0]=__builtin_amdgcn_mfma_f32_32x32x16_bf16(PAF(2),VFR(2),o[0],0,0,0), C1,0); \
    KRD(GL,3); GAPB(o[1]=__builtin_amdgcn_mfma_f32_32x32x16_bf16(PAF(2),VFR(6),o[1],0,0,0), C1,4); \
    GAPB(o[0]=__builtin_amdgcn_mfma_f32_32x32x16_bf16(PAF(3),VFR(3),o[0],0,0,0), C1,8); \
    GAPB(o[1]=__builtin_amdgcn_mfma_f32_32x32x16_bf16(PAF(3),VFR(7),o[1],0,0,0), C1,12); \
    }while(0)
  int t=1;
  #undef CMASK
  #define CMASK(P0,P1,t) do{}while(0)
  for(;t+5<NT;t+=2){
    STEP(pB0,pB1,pA0,pA1,t,true,true,true);     WAIT_BAR(2); RESC(); ROT();
    STEP(pA0,pA1,pB0,pB1,t+1,true,true,true);   WAIT_BAR(2); RESC(); ROT();
  }
  #undef CMASK
  #define CMASK(P0,P1,t) do{int jb_=(t)-(NT-4); if(jb_>=0)cmask(P0,P1,jb_,qrel,hi);}while(0)
  #define ENDW(tt) do{ if((tt)+3<NT){WAIT_BAR(2);} else if((tt)+2<NT){WAIT_BAR(1);} else {WAIT_BAR(0);} }while(0)
  for(;t+1<NT;t+=2){
    STEP(pB0,pB1,pA0,pA1,t,(t+3<NT),(t+1<NT),(t+1<NT));       ENDW(t);   RESC(); ROT();
    STEP(pA0,pA1,pB0,pB1,t+1,(t+4<NT),(t+2<NT),(t+2<NT));     ENDW(t+1); RESC(); ROT();
  }
  STEP(pB0,pB1,pA0,pA1,NT-1,false,false,false); RESC();
  { float sacc=pB0[0]+pB0[1]; _Pragma("unroll") for(int r=2;r<16;++r)sacc+=pB0[r]; _Pragma("unroll") for(int r=0;r<16;++r)sacc+=pB1[r]; l_reg+=sacc;
    pw0=(u32x4){PKW(pB0,0),PKW(pB0,2),PKW(pB0,4),PKW(pB0,6)};pw1=(u32x4){PKW(pB0,8),PKW(pB0,10),PKW(pB0,12),PKW(pB0,14)};pw2=(u32x4){PKW(pB1,0),PKW(pB1,2),PKW(pB1,4),PKW(pB1,6)};pw3=(u32x4){PKW(pB1,8),PKW(pB1,10),PKW(pB1,12),PKW(pB1,14)};
    SBAR(); pv(o,vb0+sl_cur,PAF(0),PAF(1),PAF(2),PAF(3)); }
  #undef PKW
  #undef PAF
  #undef VFR
  #undef PIN
  #undef MX3
  #undef GAPA
  #undef GAPB
  #undef EX
  #undef VRD
  #undef KRD
  #undef STEP
  #undef ENDW
  {auto rr=__builtin_amdgcn_permlane32_swap(__float_as_uint(l_reg),__float_as_uint(l_reg),false,false);l_reg=__uint_as_float(rr[0])+__uint_as_float(rr[1]);}
  if(hi==0)wsf[32+r32]=l_reg;asm volatile("s_waitcnt lgkmcnt(0)":::"memory");
  float rli[16];
  #pragma unroll
  for(int r=0;r<16;++r)rli[r]=__builtin_amdgcn_rcpf(wsf[32+crow(r,hi)]);
  bf16*Ow=O+(long)(q0+wid*QBLK)*PO;
  { bf16*stg=(bf16*)(shm+LDS_OST)+wid*2048;
    #pragma unroll
    for(int r=0;r<16;++r){const int orow=crow(r,hi);
      #pragma unroll
      for(int d0=0;d0<2;++d0)stg[orow*64+d0*32+r32]=__float2bfloat16(o[d0][r]*rli[r]);}
    asm volatile("s_waitcnt lgkmcnt(0)":::"memory");
    #pragma unroll
    for(int i=0;i<4;++i){const int row=i*8+(lane>>3),ch=lane&7; const u32x4 v=*(const u32x4*)(stg+row*64+ch*8); ATTN_STORE16(Ow+(long)row*PO+ch*8,v);} }
  asm volatile("s_waitcnt lgkmcnt(0)\n\ts_barrier":::"memory");
  #undef DMA_K
  #undef DMA_V
  #undef CMASK
  #undef START
  #undef RESC
  #undef ROT
}
constexpr int ATTN_LDS_BYTES=LDS_BYTES;
template<int THRL=8> __device__ __forceinline__ void attn_phase(char*lds,const bf16*PD,bf16*O,int vcu){
  const int pr=vcu>>3,s=vcu&7,h=pr>>2,m=(pr>>1)&1,vh=pr&1;
  const bf16*Q=PD+h*128+m*64,*K=PD+1024+h*128+m*64,*V=PD+2048+h*128+vh*64; bf16*Op=O+m*1024+h*128+vh*64;
  _Pragma("unroll 1") for(int i=0;i<8;++i){ const int qb=(i>>1)*16+((i&1)?15-s:s); attn_unit<THRL>(qb,Q,K,V,Op,lds); }
}
#undef SBAR
#undef WAIT_BAR
}
#define GAS __attribute__((address_space(1)))
#define LAS __attribute__((address_space(3)))
typedef unsigned short bf16;
typedef unsigned v4u __attribute__((ext_vector_type(4)));
typedef float f32x4 __attribute__((ext_vector_type(4)));
typedef short bf16x8 __attribute__((ext_vector_type(8)));
typedef GAS unsigned gu32;
typedef GAS unsigned long long gu64;
#define RLX_AGENT __ATOMIC_RELAXED, __HIP_MEMORY_SCOPE_AGENT
#define LDS_WAIT() asm volatile("s_waitcnt lgkmcnt(0)" ::: "memory")
#define VM_WAIT() asm volatile("s_waitcnt vmcnt(0)" ::: "memory")
__device__ __forceinline__ unsigned long long rt() { return __builtin_amdgcn_s_memrealtime(); }
__device__ __forceinline__ unsigned f2bf(float f) { unsigned u = __builtin_bit_cast(unsigned, f); return (u + 0x7fffu + ((u >> 16) & 1u)) >> 16; }
__device__ __forceinline__ unsigned pk2(float lo, float hi) { return f2bf(lo) | (f2bf(hi) << 16); }

#define XB_TMO      128
#define XB_XCNT(j)  (256  + 64 * (j))
#define XB_XSUB(j)  (1280 + 64 * (j))
#define XB_XGEN(j)  (2304 + 64 * (j))
#define XB_TOP      3328
#define XB_TOPGEN   3392
#define XCD_BAR_WORDS 3456
#define XB_SPIN_CAP (1u << 18)

__device__ __forceinline__ unsigned xb_ld(unsigned* p)              { return __hip_atomic_load(p, __ATOMIC_RELAXED, __HIP_MEMORY_SCOPE_AGENT); }
__device__ __forceinline__ unsigned xb_add(unsigned* p, unsigned v) { return __hip_atomic_fetch_add(p, v, __ATOMIC_RELAXED, __HIP_MEMORY_SCOPE_AGENT); }
__device__ __forceinline__ unsigned xb_xcc_id() { return (unsigned)__builtin_amdgcn_s_getreg((3 << 11) | 20) & 0xFu; }
#define XB_SPIN(cond, bar) do { unsigned _sp = 0; while (cond) { __builtin_amdgcn_s_sleep(1); \
    if ((++_sp & 255u) == 0u) { if (xb_ld(&(bar)[XB_TMO])) break; if (_sp > XB_SPIN_CAP) { atomicAdd(&(bar)[XB_TMO], 1u); break; } } } } while (0)

struct XcdBarrier {
    unsigned* bar; unsigned x;
    volatile LAS unsigned* st;
};

__device__ __forceinline__ XcdBarrier xcd_barrier_post(unsigned* bar, volatile LAS unsigned* st) {
    XcdBarrier b; b.bar = bar; b.x = xb_xcc_id(); b.st = st;
    if (threadIdx.x == 0) (void)xb_add(&bar[XB_XCNT(b.x)], 1u);
    return b;
}
__device__ __forceinline__ void xcd_barrier_complete(unsigned* bar, unsigned x, unsigned& nloc, unsigned& nx) {
    const unsigned G = gridDim.x * gridDim.y * gridDim.z;
    unsigned sum, cnt, mine, sp = 0u;
    for (;;) {
        sum = 0u; cnt = 0u; mine = 0u;
#pragma unroll
        for (unsigned j = 0; j < 16; ++j) { const unsigned c = xb_ld(&bar[XB_XCNT(j)]); sum += c; cnt += (c > 0u) ? 1u : 0u; mine = (j == x) ? c : mine; }
        if (sum == G) break;
        __builtin_amdgcn_s_sleep(1);
        if ((++sp & 255u) == 0u) { if (xb_ld(&bar[XB_TMO])) break; if (sp > XB_SPIN_CAP) { atomicAdd(&bar[XB_TMO], 1u); break; } }
    }
    nloc = mine > 0u ? mine : 1u; nx = cnt > 0u ? cnt : 1u;
}

__device__ __forceinline__ void xcd_barrier(const XcdBarrier& b) {
    asm volatile("s_waitcnt vmcnt(0)" ::: "memory");
    __syncthreads();
    if (threadIdx.x == 0) {
        unsigned* bar = b.bar;
        __builtin_amdgcn_s_waitcnt(0);
        unsigned nloc = b.st[0], nx = b.st[1];
        if (nloc == 0u) { xcd_barrier_complete(bar, b.x, nloc, nx); b.st[0] = nloc; b.st[1] = nx; }
        const unsigned old = xb_add(&bar[XB_XSUB(b.x)], 1u);
        const unsigned gen = old / nloc;
        if (old + 1u == (gen + 1u) * nloc) {
            __builtin_amdgcn_fence(__ATOMIC_RELEASE, "agent");
            asm volatile("s_waitcnt vmcnt(0)" ::: "memory");
            const unsigned og = xb_add(&bar[XB_TOP], 1u);
            const unsigned tg = og / nx;
            if (og + 1u == (tg + 1u) * nx) xb_add(&bar[XB_TOPGEN], 1u);
            else XB_SPIN(xb_ld(&bar[XB_TOPGEN]) == tg, bar);
            __builtin_amdgcn_fence(__ATOMIC_ACQUIRE, "agent");
            xb_add(&bar[XB_XGEN(b.x)], 1u);
            asm volatile("s_waitcnt vmcnt(0)" ::: "memory");
        } else {
            XB_SPIN(xb_ld(&bar[XB_XGEN(b.x)]) == gen, bar);
            __builtin_amdgcn_fence(__ATOMIC_ACQUIRE, "agent");
            asm volatile("s_waitcnt vmcnt(0)" ::: "memory");
        }
    }
    __syncthreads();
}
constexpr int NWAVES = 8;
constexpr int S_ = 16384, DM = 2048;
constexpr int NPH = 16;
#ifndef MK_PER_PHASE
#define MK_PER_PHASE 0
#endif
constexpr size_t MiB = 1u << 20;
constexpr size_t WS_CTL = 0, CTL_ZERO_BYTES = 1 * MiB;
constexpr size_t WS_WA = 1 * MiB, WS_WB = 5 * MiB, WS_WOUT = 9 * MiB, WS_WS = 17 * MiB, WS_LORA = 25 * MiB;
constexpr size_t WS_WIN = 27 * MiB, WS_PR = 69 * MiB, WS_PD = 181 * MiB, WS_PG = 277 * MiB;
constexpr size_t WS_A = 405 * MiB, WS_E = 437 * MiB, WS_G = 469 * MiB, WS_END = 507 * MiB;
constexpr size_t WS_SCN = 27 * MiB, WS_SCAL = 123 * MiB, WS_SLOC = 127 * MiB, WS_ASEG = 143 * MiB, WS_SIN = 159 * MiB;
constexpr size_t WS_YA = 405 * MiB, WS_OATT = 27 * MiB, WS_YB = 91 * MiB, WS_T1 = 123 * MiB, WS_MERGED = 27 * MiB;
constexpr size_t WS_H2 = 123 * MiB, WS_XN2 = 27 * MiB, WS_UTAB = 251 * MiB, WS_VTAB = 315 * MiB, WS_SCORES = 379 * MiB;
constexpr size_t WS_USCL = 26 * MiB + 512 * 1024, WS_VSCL = WS_USCL + 65536;
constexpr size_t OUT_XN = 0, OUT_RKV = 0, OUT_LIN = 96 * MiB;
constexpr int CW_BAR = 4096;
constexpr int RING_OFF = 0, RING_BYTES = 131072;
constexpr int LDSCTL_OFF = RING_BYTES, MISC_OFF = LDSCTL_OFF + 320;
constexpr int LDS_BYTES = 147456;
constexpr int NSEG = 64, SEGLEN = S_ / NSEG;

struct Args { const float* in[28]; float* out; unsigned char* ws; int ph_lo, ph_hi; };

struct Frame {
    LAS unsigned char* lds; volatile LAS unsigned* MISC; gu32* ctl;
    int tid, lane, wave, vcu, G;
};

__device__ __forceinline__ float bf2f(unsigned short b) { return __uint_as_float((unsigned)b << 16); }
__device__ __forceinline__ float wave_sum(float v) {
#pragma unroll
    for (int o = 1; o < 64; o <<= 1) v += __shfl_xor(v, o);
    return v;
}
__device__ __forceinline__ float wave_max(float v) {
#pragma unroll
    for (int o = 1; o < 64; o <<= 1) v = fmaxf(v, __shfl_xor(v, o));
    return v;
}
template <int CTRL, int RM> __device__ __forceinline__ float dppf(float oldv, float x) { return __builtin_bit_cast(float, __builtin_amdgcn_update_dpp(__builtin_bit_cast(int, oldv), __builtin_bit_cast(int, x), CTRL, RM, 0xf, false)); }
__device__ __forceinline__ float wsum(float v) {
    v += dppf<0xB1, 0xf>(v, v); v += dppf<0x4E, 0xf>(v, v); v += dppf<0x141, 0xf>(v, v); v += dppf<0x140, 0xf>(v, v);
    v += dppf<0x142, 0xa>(0.f, v); v += dppf<0x143, 0xc>(0.f, v);
    return __builtin_bit_cast(float, __builtin_amdgcn_readlane(__builtin_bit_cast(int, v), 63));
}
__device__ __forceinline__ float wmax(float v) {
    v = fmaxf(v, dppf<0xB1, 0xf>(v, v)); v = fmaxf(v, dppf<0x4E, 0xf>(v, v)); v = fmaxf(v, dppf<0x141, 0xf>(v, v)); v = fmaxf(v, dppf<0x140, 0xf>(v, v));
    v = fmaxf(v, dppf<0x142, 0xa>(0.f, v)); v = fmaxf(v, dppf<0x143, 0xc>(0.f, v));
    return __builtin_bit_cast(float, __builtin_amdgcn_readlane(__builtin_bit_cast(int, v), 63));
}
__device__ __forceinline__ float sigmf(float x) { return __builtin_amdgcn_rcpf(1.0f + __expf(-x)); }

__device__ __forceinline__ void transpose_block(const float* W, int ldw, int k0, int n0, int kvalid, bf16* WT, int ldt, int drow0, LAS float* scr, int lane) {
#pragma unroll 8
    for (int i = 0; i < 32; ++i) { const int kk = 2 * i + (lane >> 5); const int k = k0 + kk; scr[kk * 33 + (lane & 31)] = (k < kvalid) ? W[(size_t)k * ldw + n0 + (lane & 31)] : 0.f; }
    LDS_WAIT(); asm volatile("" ::: "memory");
    const int c = lane & 7;
#pragma unroll
    for (int j = 0; j < 4; ++j) { const int n = (lane >> 3) + 8 * j; const LAS float* s = scr + (8 * c) * 33 + n;
        v4u o; o.x = pk2(s[0 * 33], s[1 * 33]); o.y = pk2(s[2 * 33], s[3 * 33]); o.z = pk2(s[4 * 33], s[5 * 33]); o.w = pk2(s[6 * 33], s[7 * 33]);
        *(GAS v4u*)(WT + (size_t)(drow0 + n) * ldt + k0 + 8 * c) = o; }
    LDS_WAIT(); asm volatile("" ::: "memory");
}
__device__ __forceinline__ void rms_row_to_bf16(const float* xrow, const float* g, bf16* orow, int lane) {
    const GAS f32x4* xr = (const GAS f32x4*)xrow + lane; const f32x4* gr = (const f32x4*)g + lane;
    f32x4 v[8]; float s = 0.f;
#pragma unroll
    for (int j = 0; j < 8; ++j) { v[j] = xr[64 * j]; s += (v[j].x * v[j].x + v[j].y * v[j].y) + (v[j].z * v[j].z + v[j].w * v[j].w); }
    const float rstd = rsqrtf(wave_sum(s) * (1.f / 2048.f) + 1e-6f);
    GAS unsigned long long* o8 = (GAS unsigned long long*)orow + lane;
#pragma unroll
    for (int j = 0; j < 8; ++j) { const f32x4 gg = gr[64 * j];
        o8[64 * j] = (unsigned long long)pk2(v[j].x * rstd * gg.x, v[j].y * rstd * gg.y) | ((unsigned long long)pk2(v[j].z * rstd * gg.z, v[j].w * rstd * gg.w) << 32); }
}

template <int K> __device__ __forceinline__ void fmac_dpp(float& acc, float op, float s) {
    asm("v_fmac_f32_dpp %0, %1, %2 quad_perm:[%c3,%c3,%c3,%c3] row_mask:0xf bank_mask:0xf" : "+v"(acc) : "v"(op), "v"(s), "i"(K)); }
template <int K> __device__ __forceinline__ void mulip_dpp(float& s, float op) {
    asm("v_mul_f32_dpp %0, %1, %0 quad_perm:[%c2,%c2,%c2,%c2] row_mask:0xf bank_mask:0xf" : "+v"(s) : "v"(op), "i"(K)); }
#define SCAN_FOR_C(BODY) _Pragma("unroll") for (int j = 0; j < 4; ++j) { \
    { constexpr int k = 0; _Pragma("unroll") for (int i = 0; i < 4; ++i) { const int c = 16 * j + 4 * k + i; BODY } } \
    { constexpr int k = 1; _Pragma("unroll") for (int i = 0; i < 4; ++i) { const int c = 16 * j + 4 * k + i; BODY } } \
    { constexpr int k = 2; _Pragma("unroll") for (int i = 0; i < 4; ++i) { const int c = 16 * j + 4 * k + i; BODY } } \
    { constexpr int k = 3; _Pragma("unroll") for (int i = 0; i < 4; ++i) { const int c = 16 * j + 4 * k + i; BODY } } }

constexpr int SCAN_CH = 4, SCAN_STEP_F = 448, SCAN_WAVE_BYTES = (SCAN_CH * SCAN_STEP_F + SCAN_CH * 4) * 4;
template <int KIND> __device__ __forceinline__ void scan_task(const int lane, unsigned char* ws, const float* const* in, const bf16* RKV, int h, int seg, LAS float* wl) {
    const int t0 = seg * SEGLEN;
    const bf16* SCN = (const bf16*)(ws + WS_SCN) + ((size_t)h * S_) * 192;
    const float* SCAL = (const float*)(ws + WS_SCAL) + ((size_t)h * S_) * 4;
    const bf16* Eb = (const bf16*)(ws + WS_E); const bf16* Gb = (const bf16*)(ws + WS_G);
    float S[64];
    if (KIND == 0) {
#pragma unroll
        for (int c = 0; c < 64; ++c) S[c] = 0.f;
    } else if (KIND == 1) {
#pragma unroll
        for (int c = 0; c < 64; ++c) S[c] = (c == lane) ? 1.f : 0.f;
    } else {
        const f32x4* sp = (const f32x4*)((const float*)(ws + WS_SIN) + (((size_t)h * NSEG + seg) * 64 + lane) * 64);
#pragma unroll
        for (int q = 0; q < 16; ++q) { const f32x4 x = sp[q]; S[4 * q] = x.x; S[4 * q + 1] = x.y; S[4 * q + 2] = x.z; S[4 * q + 3] = x.w; }
    }
    float lg = 0.f, lb = 0.f;
    if (KIND == 2) { lg = in[12][h * 64 + lane]; lb = in[13][h * 64 + lane]; }
    constexpr int CH = SCAN_CH;
    unsigned short pk[CH], pb[CH], pt[CH], pr[CH], pe[CH], pv[CH], pg[CH]; f32x4 psc = (f32x4){0.f, 0.f, 0.f, 0.f};
#define SCAN_PREFETCH(tc) do { _Pragma("unroll") for (int s = 0; s < CH; ++s) { const size_t t = (size_t)((tc) + s); \
        pk[s] = SCN[t * 192 + lane]; pb[s] = SCN[t * 192 + 64 + lane]; pt[s] = SCN[t * 192 + 128 + lane]; \
        pr[s] = RKV[t * 3072 + h * 64 + lane]; pe[s] = Eb[t * 1024 + h * 64 + lane]; \
        if (KIND != 1) pv[s] = RKV[t * 3072 + 2048 + h * 64 + lane]; if (KIND == 2) pg[s] = Gb[t * 1024 + h * 64 + lane]; } \
        if (KIND != 1) { if (lane < CH) psc = *(const f32x4*)(SCAL + (size_t)((tc) + lane) * 4); } } while (0)
    SCAN_PREFETCH(t0);
    bf16* YA = (bf16*)(ws + WS_YA) + h * 64 + lane;
#pragma unroll 1
    for (int tc = t0; tc < t0 + SEGLEN; tc += CH) {
#pragma unroll
        for (int s = 0; s < CH; ++s) { const float w = __expf(-bf2f(pe[s])); LAS float* q = wl + s * SCAN_STEP_F;
            q[lane] = bf2f(pk[s]); q[64 + lane] = w * bf2f(pr[s]); q[128 + lane] = w; q[192 + lane] = bf2f(pb[s]); q[256 + lane] = bf2f(pt[s]);
            if (KIND != 1) q[320 + lane] = bf2f(pv[s]); if (KIND == 2) q[384 + lane] = bf2f(pg[s]); }
        if (KIND != 1) { if (lane < CH) *(LAS f32x4*)(wl + CH * SCAN_STEP_F + lane * 4) = psc; }
        if (tc + CH < t0 + SEGLEN) SCAN_PREFETCH(tc + CH);
        LDS_WAIT(); asm volatile("" ::: "memory");
        f32x4 KK[4], WR[4];
        { const LAS f32x4* q4 = (const LAS f32x4*)wl + (lane & 3);
#pragma unroll
          for (int j = 0; j < 4; ++j) { KK[j] = q4[j * 4]; if (KIND == 2) WR[j] = q4[16 + j * 4]; } }
#pragma unroll 1
        for (int s = 0; s < CH; ++s) {
            const LAS float* qs = wl + s * SCAN_STEP_F;
            const LAS f32x4* q4 = (const LAS f32x4*)qs + (lane & 3);
            f32x4 WW[4], BB[4], KT[4];
#pragma unroll
            for (int j = 0; j < 4; ++j) { WW[j] = q4[32 + j * 4]; BB[j] = q4[48 + j * 4]; if (KIND != 1) KT[j] = q4[64 + j * 4]; }
            float vt = 0.f, gt_ = 0.f; f32x4 sc = (f32x4){0.f, 0.f, 0.f, 0.f};
            if (KIND != 1) { vt = qs[320 + lane]; sc = *(const LAS f32x4*)(wl + CH * SCAN_STEP_F + s * 4); }
            if (KIND == 2) gt_ = qs[384 + lane];
            float sa0 = 0.f, sa1 = 0.f, yp0 = 0.f, yp1 = 0.f;
            SCAN_FOR_C( if (i & 1) { fmac_dpp<k>(sa1, KK[j][i], S[c]); if (KIND == 2) fmac_dpp<k>(yp1, WR[j][i], S[c]); }
                        else       { fmac_dpp<k>(sa0, KK[j][i], S[c]); if (KIND == 2) fmac_dpp<k>(yp0, WR[j][i], S[c]); } )
            const float sa = sa0 + sa1;
            { const LAS f32x4* qn = (const LAS f32x4*)(wl + ((s + 1) & (CH - 1)) * SCAN_STEP_F) + (lane & 3);
#pragma unroll
              for (int j = 0; j < 4; ++j) { KK[j] = qn[j * 4]; if (KIND == 2) WR[j] = qn[16 + j * 4]; } }
            SCAN_FOR_C( mulip_dpp<k>(S[c], WW[j][i]); )
            SCAN_FOR_C( fmac_dpp<k>(S[c], BB[j][i], sa); )
            if (KIND != 1) { SCAN_FOR_C( fmac_dpp<k>(S[c], KT[j][i], vt); ) }
            if (KIND == 2) {
                const float y = (yp0 + yp1) + sa * sc.x + vt * sc.y;
                const float mean = wave_sum(y) * (1.f / 64.f); const float d = y - mean;
                const float var = wave_sum(d * d) * (1.f / 64.f);
                const float o = (d * rsqrtf(var + 64e-5f) * lg + lb + sc.z * vt) * gt_;
                YA[(size_t)(tc + s) * 1024] = (unsigned short)f2bf(o);
            }
        }
        LDS_WAIT(); asm volatile("" ::: "memory");
    }
#undef SCAN_PREFETCH
    if (KIND != 2) {
        f32x4* op = (f32x4*)((float*)(ws + (KIND == 0 ? WS_SLOC : WS_ASEG)) + (((size_t)h * NSEG + seg) * 64 + lane) * 64);
#pragma unroll
        for (int q = 0; q < 16; ++q) op[q] = (f32x4){S[4 * q], S[4 * q + 1], S[4 * q + 2], S[4 * q + 3]};
    }
}

__global__ void __launch_bounds__(NWAVES * 64, 2) mk_fwd(Args args) {
    extern __shared__ __attribute__((aligned(16))) unsigned char lds[];
    Frame F;
    F.lds = (LAS unsigned char*)lds; F.MISC = (volatile LAS unsigned*)(F.lds + MISC_OFF);
    F.tid = threadIdx.x; F.wave = __builtin_amdgcn_readfirstlane(F.tid >> 6);
    F.G = gridDim.x; { const int bx = blockIdx.x; F.vcu = (F.G % 8 == 0) ? (bx % 8) * (F.G / 8) + bx / 8 : bx; }
    unsigned char* ws = args.ws; F.ctl = (gu32*)(ws + WS_CTL);
    const float* const* in = args.in;
    unsigned char* ob = (unsigned char*)args.out;
    for (int u = threadIdx.x; u < (LDS_BYTES - LDSCTL_OFF) / 4; u += NWAVES * 64) ((LAS unsigned*)(F.lds + LDSCTL_OFF))[u] = 0u;
    __syncthreads();
    XcdBarrier bar; bar.bar = (unsigned*)(F.ctl + CW_BAR); bar.x = 0; bar.st = nullptr;
    if (!MK_PER_PHASE) bar = xcd_barrier_post((unsigned*)(F.ctl + CW_BAR), F.MISC + 8);
    const int lo = args.ph_lo, hi = args.ph_hi;
#ifndef PH_MASK
#define PH_MASK 0xFFFF
#endif
#define IN(k) ((((PH_MASK) >> (k)) & 1) && lo <= (k) && (k) < hi)
#ifndef PROBE_MASK
#define PROBE_MASK 0
#endif
#ifndef PROBE_N
#define PROBE_N 1
#endif
#define PHASE_BEGIN(k) if (IN(k)) { for (int rep_ = 0; rep_ < 1 + ((((PROBE_MASK) >> (k)) & 1) ? (PROBE_N) : 0); ++rep_) { if (rep_) xcd_barrier(bar); PHASE_IDS
#define PHASE_END } }
#define SEAM(k) do { if (IN(k) && IN((k) + 1)) xcd_barrier(bar); } while (0)
    const int gw = F.vcu * NWAVES + F.wave, NGW = F.G * NWAVES; const int NGT = F.G * NWAVES * 64;
#define PHASE_IDS int tid__ = threadIdx.x; asm volatile("" : "+v"(tid__)); const int tid = tid__, lane = tid & 63, gt = F.vcu * (NWAVES * 64) + tid; (void)gt; (void)lane;

    bf16* WIN_T = (bf16*)(ws + WS_WIN); bf16* WA_T = (bf16*)(ws + WS_WA); bf16* WB_T = (bf16*)(ws + WS_WB); bf16* WOUT_T = (bf16*)(ws + WS_WOUT);
    bf16* WS_T = (bf16*)(ws + WS_WS); bf16* LORA_T = (bf16*)(ws + WS_LORA);
    bf16* XN = (bf16*)(ob + OUT_XN); bf16* RKV = (bf16*)(ob + OUT_RKV); bf16* LIN = (bf16*)(ob + OUT_LIN);
    bf16* PR = (bf16*)(ws + WS_PR); bf16* PD = (bf16*)(ws + WS_PD); bf16* PG = (bf16*)(ws + WS_PG);

    PHASE_BEGIN(0)
        LAS float* scr = (LAS float*)(F.lds + RING_OFF + F.wave * 16384);
        constexpr int I_IN = 32 * 334, I_A = 16 * 64, I_B = 16 * 64, I_O = 32 * 64, I_L = 4 * 32;
        constexpr int NIT = I_IN + I_A + I_B + I_O + 3 * I_L;
        for (int it = gw; it < NIT; it += NGW) {
            int r = it;
            if (r < I_IN) { const int kb = r / 334, nb = r % 334, n0 = nb * 32; transpose_block(in[2], 10688, kb * 64, n0, 2048, WIN_T, 2048, n0 + (n0 >= 3520 ? 64 : 0), scr, lane); continue; } r -= I_IN;
            if (r < I_A) { const int kb = r / 64, nb = r % 64; transpose_block(in[19], 2048, kb * 64, nb * 32, 1024, WA_T, 1024, nb * 32, scr, lane); continue; } r -= I_A;
            if (r < I_B) { const int kb = r / 64, nb = r % 64; transpose_block(in[20], 2048, kb * 64, nb * 32, 1024, WB_T, 1024, nb * 32, scr, lane); continue; } r -= I_B;
            if (r < I_O) { const int kb = r / 64, nb = r % 64; transpose_block(in[21], 2048, kb * 64, nb * 32, 2048, WOUT_T, 2048, nb * 32, scr, lane); continue; } r -= I_O;
            { const int which = r / I_L, rr = r % I_L, kb = rr / 32, nb = rr % 32; const float* W = which == 0 ? in[5] : (which == 1 ? in[7] : in[8]);
              transpose_block(W, 1024, kb * 64, nb * 32, which == 2 ? 256 : 96, LORA_T + (size_t)which * 1024 * 256, 256, nb * 32, scr, lane); }
        }
        for (int i = gt; i < 16384; i += NGT) *(GAS v4u*)(WIN_T + (size_t)3520 * 2048 + (size_t)i * 8) = (v4u){0u, 0u, 0u, 0u};
        for (int task = gw; task < 16 * 32 * 4; task += NGW) {
            const int hp = task >> 7, kb = (task >> 2) & 31, ng = task & 3; const int k = kb * 64 + lane;
            const f32x4* wq = (const f32x4*)(in[23] + (size_t)k * 2048 + hp * 128);
            f32x4 q[32];
#pragma unroll
            for (int d = 0; d < 32; ++d) q[d] = wq[d];
            const float* sk = in[24] + ((size_t)hp * 128 + ng * 32) * 128;
            for (int n = 0; n < 32; ++n) { const f32x4* s4 = (const f32x4*)(sk + (size_t)n * 128); float a0 = 0.f, a1 = 0.f;
#pragma unroll
                for (int d = 0; d < 32; ++d) { const f32x4 s = s4[d]; a0 = fmaf(q[d].x, s.x, a0); a1 = fmaf(q[d].y, s.y, a1); a0 = fmaf(q[d].z, s.z, a0); a1 = fmaf(q[d].w, s.w, a1); }
                WS_T[(size_t)(hp * 128 + ng * 32 + n) * 2048 + k] = (bf16)f2bf(a0 + a1); }
        }
        for (int m = gw; m < S_; m += NGW) rms_row_to_bf16(in[0] + (size_t)m * DM, in[1], XN + (size_t)m * DM, lane);
    PHASE_END
    SEAM(0);
    PHASE_BEGIN(1)
        pg8::Gemm g{XN, WIN_T, S_, 10752, 2048, 2048, 2048}; pg8::StaticOrder S; S.init(S_, 10752, F.G, (int)blockIdx.x);
        pg8::Epi<pg8::EM_G1> E{PR, PD, PG, nullptr, nullptr, nullptr, attn_body::C2};
        pg8::gemm_phase<pg8::Epi<pg8::EM_G1>, pg8::StaticOrder, true, true>(F.lds + RING_OFF, g, S, E);
    PHASE_END
    SEAM(1);
    PHASE_BEGIN(2)
        const float* mu = in[3];
        for (int t = gw; t < S_; t += NGW) {
            const bf16* cur = PR + (size_t)t * 3584; const bf16* prv = cur - 3584;
#pragma unroll 1
            for (int j = 0; j < 7; ++j) { const int ch = lane + 64 * j; if (ch >= 440) break;
                const v4u c4 = *(const GAS v4u*)(cur + ch * 8); v4u p4 = (v4u){0u, 0u, 0u, 0u}; if (t > 0) p4 = *(const GAS v4u*)(prv + ch * 8);
                const f32x4 m0 = *(const f32x4*)(mu + ch * 8), m1 = *(const f32x4*)(mu + ch * 8 + 4);
                float c[8] = {pg8::bflo(c4.x), pg8::bfhi(c4.x), pg8::bflo(c4.y), pg8::bfhi(c4.y), pg8::bflo(c4.z), pg8::bfhi(c4.z), pg8::bflo(c4.w), pg8::bfhi(c4.w)};
                const float p[8] = {pg8::bflo(p4.x), pg8::bfhi(p4.x), pg8::bflo(p4.y), pg8::bfhi(p4.y), pg8::bflo(p4.z), pg8::bfhi(p4.z), pg8::bflo(p4.w), pg8::bfhi(p4.w)};
                const float mm[8] = {m0.x, m0.y, m0.z, m0.w, m1.x, m1.y, m1.z, m1.w};
#pragma unroll
                for (int e = 0; e < 8; ++e) c[e] = c[e] + (p[e] - c[e]) * mm[e];
                bf16* dst;
                if (ch < 384) dst = RKV + (size_t)t * 3072 + ch * 8;
                else { const int col = ch * 8 - 3072;
                    if (col < 96) { dst = LIN + (size_t)t * 768 + col;
#pragma unroll
                        for (int e = 0; e < 8; ++e) c[e] = tanhf(c[e]); }
                    else if (col < 192) dst = LIN + (size_t)t * 768 + 256 + (col - 96);
                    else { dst = LIN + (size_t)t * 768 + 512 + (col - 192);
#pragma unroll
                        for (int e = 0; e < 8; ++e) c[e] = sigmf(c[e]); } }
                *(GAS v4u*)dst = (v4u){pk2(c[0], c[1]), pk2(c[2], c[3]), pk2(c[4], c[5]), pk2(c[6], c[7])};
            }
            if (lane < 40) { const int z = lane < 20 ? 96 + lane * 8 : 352 + (lane - 20) * 8; *(GAS v4u*)(LIN + (size_t)t * 768 + z) = (v4u){0u, 0u, 0u, 0u}; }
        }
    PHASE_END
    SEAM(2);
    PHASE_BEGIN(3)
        { pg8::Gemm g{LIN, LORA_T, S_, 1024, 256, 768, 256}; pg8::StaticOrder S; S.init(S_, 1024, F.G, (int)blockIdx.x);
          pg8::Epi<pg8::EM_LORA_W> E{ws + WS_E, nullptr, nullptr, nullptr, nullptr, in[4], 1.f};
          pg8::gemm_phase<pg8::Epi<pg8::EM_LORA_W>, pg8::StaticOrder, true, true>(F.lds + RING_OFF, g, S, E); }
        { pg8::Gemm g{LIN + 256, LORA_T + 1024 * 256, S_, 1024, 256, 768, 256}; pg8::StaticOrder S; S.init(S_, 1024, F.G, (int)blockIdx.x);
          pg8::Epi<pg8::EM_LORA_A> E{ws + WS_A, nullptr, nullptr, nullptr, nullptr, in[6], 1.f};
          pg8::gemm_phase<pg8::Epi<pg8::EM_LORA_A>, pg8::StaticOrder, true, true>(F.lds + RING_OFF, g, S, E); }
        { pg8::Gemm g{LIN + 512, LORA_T + 2 * 1024 * 256, S_, 1024, 256, 768, 256}; pg8::StaticOrder S; S.init(S_, 1024, F.G, (int)blockIdx.x);
          pg8::Epi<pg8::EM_LORA_G> E{ws + WS_G, nullptr, nullptr, nullptr, nullptr, nullptr, 1.f};
          pg8::gemm_phase<pg8::Epi<pg8::EM_LORA_G>, pg8::StaticOrder, true, true>(F.lds + RING_OFF, g, S, E); }
    PHASE_END
    SEAM(3);
    PHASE_BEGIN(4)
        bf16* SCN = (bf16*)(ws + WS_SCN); float* SCAL = (float*)(ws + WS_SCAL); const bf16* Ab = (const bf16*)(ws + WS_A);
        for (int t = gw; t < S_; t += NGW) {
#pragma unroll 2
            for (int h = 0; h < 16; ++h) { const int cc = h * 64 + lane;
                const float r = bf2f(RKV[(size_t)t * 3072 + cc]), k = bf2f(RKV[(size_t)t * 3072 + 1024 + cc]), a = bf2f(Ab[(size_t)t * 1024 + cc]);
                float kk = k * in[9][cc]; const float nrm = sqrtf(wave_sum(kk * kk)); kk = kk / fmaxf(nrm, 1e-12f);
                const float kt = k * (1.f + (a - 1.f) * in[10][cc]); const float b = kk * a;
                const unsigned short kkb = (unsigned short)f2bf(-kk), bb = (unsigned short)f2bf(b), ktb = (unsigned short)f2bf(kt);
                bf16* q = SCN + ((size_t)h * S_ + t) * 192; q[lane] = kkb; q[64 + lane] = bb; q[128 + lane] = ktb;
                const float br = wave_sum(bf2f(bb) * r), kr = wave_sum(bf2f(ktb) * r), bon = wave_sum(r * kt * in[11][cc]);
                if (lane == 0) *(f32x4*)(SCAL + ((size_t)h * S_ + t) * 4) = (f32x4){br, kr, bon, 0.f}; }
        }
    PHASE_END
    SEAM(4);
    PHASE_BEGIN(5)
        for (int task = gw; task < 16 * NSEG * 2; task += NGW) { const int pair = task >> 1, kind = task & 1, h = pair / NSEG, seg = pair % NSEG;
            LAS float* wl = (LAS float*)(F.lds + RING_OFF + F.wave * SCAN_WAVE_BYTES);
            if (kind == 0) scan_task<0>(lane, ws, in, RKV, h, seg, wl); else scan_task<1>(lane, ws, in, RKV, h, seg, wl); }
    PHASE_END
    SEAM(5);
    PHASE_BEGIN(6)
        if (F.vcu < 16) { const int h = F.vcu; const int v = tid >> 3, cg = tid & 7;
            LAS float* Sb = (LAS float*)(F.lds + RING_OFF); LAS float* Ab = Sb + 2 * 64 * 65;
            const float* SL = (const float*)(ws + WS_SLOC) + (size_t)h * NSEG * 4096; const float* AS = (const float*)(ws + WS_ASEG) + (size_t)h * NSEG * 4096; float* SI = (float*)(ws + WS_SIN) + (size_t)h * NSEG * 4096;
            f32x4 s0 = (f32x4){0.f, 0.f, 0.f, 0.f}, s1 = s0; int cur = 0;
            f32x4 na0 = *(const f32x4*)(AS + (size_t)v * 64 + cg * 8), na1 = *(const f32x4*)(AS + (size_t)v * 64 + cg * 8 + 4);
            f32x4 nl0 = *(const f32x4*)(SL + (size_t)v * 64 + cg * 8), nl1 = *(const f32x4*)(SL + (size_t)v * 64 + cg * 8 + 4);
            for (int p = 0; p < NSEG; ++p) {
                *(f32x4*)(SI + (size_t)p * 4096 + v * 64 + cg * 8) = s0; *(f32x4*)(SI + (size_t)p * 4096 + v * 64 + cg * 8 + 4) = s1;
                if (p == NSEG - 1) break;
                LAS float* sw = Sb + cur * 64 * 65 + v * 65 + cg * 8; sw[0] = s0.x; sw[1] = s0.y; sw[2] = s0.z; sw[3] = s0.w; sw[4] = s1.x; sw[5] = s1.y; sw[6] = s1.z; sw[7] = s1.w;
                *(LAS f32x4*)(Ab + v * 64 + cg * 8) = na0; *(LAS f32x4*)(Ab + v * 64 + cg * 8 + 4) = na1;
                f32x4 a0 = nl0, a1 = nl1;
                if (p + 1 < NSEG - 1) { const size_t o = (size_t)(p + 1) * 4096 + v * 64 + cg * 8; na0 = *(const f32x4*)(AS + o); na1 = *(const f32x4*)(AS + o + 4); nl0 = *(const f32x4*)(SL + o); nl1 = *(const f32x4*)(SL + o + 4); }
                __syncthreads();
                const LAS float* sr = Sb + cur * 64 * 65 + v * 65;
#pragma unroll 8
                for (int c = 0; c < 64; ++c) { const float s = sr[c]; const f32x4 x0 = *(const LAS f32x4*)(Ab + c * 64 + cg * 8), x1 = *(const LAS f32x4*)(Ab + c * 64 + cg * 8 + 4); a0 = a0 + x0 * s; a1 = a1 + x1 * s; }
                s0 = a0; s1 = a1; cur ^= 1;
                __syncthreads();
            }
        }
    PHASE_END
    SEAM(6);
    PHASE_BEGIN(7)
        for (int task = gw; task < 16 * NSEG; task += NGW) { const int h = task / NSEG, seg = task % NSEG;
            LAS float* wl = (LAS float*)(F.lds + RING_OFF + F.wave * SCAN_WAVE_BYTES);
            scan_task<2>(lane, ws, in, RKV, h, seg, wl); }
    PHASE_END
    SEAM(7);
    PHASE_BEGIN(8)
        __syncthreads();
        attn_body::attn_phase<8>((char*)lds + RING_OFF, (const attn_body::bf16*)PD, (attn_body::bf16*)(ws + WS_OATT), F.vcu);
    PHASE_END
    SEAM(8);
    PHASE_BEGIN(9)
        float d1 = 0.f, d2 = 0.f; d1 = in[14][lane] * in[15][lane]; d2 = in[16][lane] * in[17][lane];
        const float lam = __expf(wave_sum(d1)) - __expf(wave_sum(d2)) + 0.2f;
        const bf16* OA = (const bf16*)(ws + WS_OATT); bf16* YB = (bf16*)(ws + WS_YB);
        f32x4 sg[4];
#pragma unroll
        for (int q = 0; q < 4; ++q) sg[q] = *(const f32x4*)(in[18] + (lane & 7) * 16 + q * 4);
        for (int t = gw; t < S_; t += NGW) {
            const v4u a0 = *(const GAS v4u*)(OA + (size_t)t * 2048 + lane * 16), a1 = *(const GAS v4u*)(OA + (size_t)t * 2048 + lane * 16 + 8);
            const v4u b0 = *(const GAS v4u*)(OA + (size_t)t * 2048 + 1024 + lane * 16), b1 = *(const GAS v4u*)(OA + (size_t)t * 2048 + 1024 + lane * 16 + 8);
            const unsigned aw[8] = {a0.x, a0.y, a0.z, a0.w, a1.x, a1.y, a1.z, a1.w}, bw[8] = {b0.x, b0.y, b0.z, b0.w, b1.x, b1.y, b1.z, b1.w};
            float o[16]; float ss = 0.f;
#pragma unroll
            for (int e = 0; e < 8; ++e) { o[2 * e] = pg8::bflo(aw[e]) - lam * pg8::bflo(bw[e]); o[2 * e + 1] = pg8::bfhi(aw[e]) - lam * pg8::bfhi(bw[e]); ss += o[2 * e] * o[2 * e] + o[2 * e + 1] * o[2 * e + 1]; }
            ss += __shfl_xor(ss, 1); ss += __shfl_xor(ss, 2); ss += __shfl_xor(ss, 4);
            const float rs = rsqrtf(ss * (1.f / 128.f) + 1e-5f) * 0.8f;
            const float gg[16] = {sg[0].x, sg[0].y, sg[0].z, sg[0].w, sg[1].x, sg[1].y, sg[1].z, sg[1].w, sg[2].x, sg[2].y, sg[2].z, sg[2].w, sg[3].x, sg[3].y, sg[3].z, sg[3].w};
#pragma unroll
            for (int e = 0; e < 16; ++e) o[e] = o[e] * rs * gg[e];
            *(GAS v4u*)(YB + (size_t)t * 1024 + lane * 16) = (v4u){pk2(o[0], o[1]), pk2(o[2], o[3]), pk2(o[4], o[5]), pk2(o[6], o[7])};
            *(GAS v4u*)(YB + (size_t)t * 1024 + lane * 16 + 8) = (v4u){pk2(o[8], o[9]), pk2(o[10], o[11]), pk2(o[12], o[13]), pk2(o[14], o[15])};
        }
    PHASE_END
    SEAM(9);
    PHASE_BEGIN(10)
        pg8::Gemm g{(const bf16*)(ws + WS_YA), WA_T, S_, 2048, 1024, 1024, 1024}; pg8::StaticOrder S; S.init(S_, 2048, F.G, (int)blockIdx.x);
        pg8::Epi<pg8::EM_PROJA> E{ws + WS_T1, nullptr, nullptr, PG, nullptr, nullptr, 1.f};
        pg8::gemm_phase<pg8::Epi<pg8::EM_PROJA>, pg8::StaticOrder, true, true>(F.lds + RING_OFF, g, S, E);
    PHASE_END
    SEAM(10);
    PHASE_BEGIN(11)
        pg8::Gemm g{(const bf16*)(ws + WS_YB), WB_T, S_, 2048, 1024, 1024, 1024}; pg8::StaticOrder S; S.init(S_, 2048, F.G, (int)blockIdx.x);
        pg8::Epi<pg8::EM_PROJB> E{ws + WS_MERGED, nullptr, nullptr, PG, ws + WS_T1, nullptr, 1.f};
        pg8::gemm_phase<pg8::Epi<pg8::EM_PROJB>, pg8::StaticOrder, true, true>(F.lds + RING_OFF, g, S, E);
    PHASE_END
    SEAM(11);
    PHASE_BEGIN(12)
        pg8::Gemm g{(const bf16*)(ws + WS_MERGED), WOUT_T, S_, 2048, 2048, 2048, 2048}; pg8::StaticOrder S; S.init(S_, 2048, F.G, (int)blockIdx.x);
        pg8::Epi<pg8::EM_WOUT> E{ws + WS_H2, nullptr, nullptr, nullptr, in[0], nullptr, 1.f};
        pg8::gemm_phase<pg8::Epi<pg8::EM_WOUT>, pg8::StaticOrder, true, true>(F.lds + RING_OFF, g, S, E);
    PHASE_END
    SEAM(12);
    PHASE_BEGIN(13)
        for (int m = gw; m < S_; m += NGW) rms_row_to_bf16((const float*)(ws + WS_H2) + (size_t)m * DM, in[22], (bf16*)(ws + WS_XN2) + (size_t)m * DM, lane);
        for (int row = gw; row < 32768; row += NGW) { const int which = row >> 14, r = row & 16383;
            const f32x4* src = (const f32x4*)(in[25 + which] + (size_t)r * 2048) + lane; f32x4 v[8]; float am = 0.f;
#pragma unroll
            for (int j = 0; j < 8; ++j) { v[j] = __builtin_nontemporal_load(src + 64 * j); am = fmaxf(am, fmaxf(fmaxf(fabsf(v[j].x), fabsf(v[j].y)), fmaxf(fabsf(v[j].z), fabsf(v[j].w)))); }
            am = wmax(am); const float sc = am > 0.f ? 416.f / am : 1.f, inv = am > 0.f ? am * (1.f / 416.f) : 1.f;
            unsigned* dst = (unsigned*)(ws + (which ? WS_VTAB : WS_UTAB) + (size_t)r * 2048) + lane;
#pragma unroll
            for (int j = 0; j < 8; ++j) { int w = __builtin_amdgcn_cvt_pk_fp8_f32(v[j].x * sc, v[j].y * sc, 0, false); w = __builtin_amdgcn_cvt_pk_fp8_f32(v[j].z * sc, v[j].w * sc, w, true); dst[64 * j] = (unsigned)w; }
            if (lane == 0) ((float*)(ws + (which ? WS_VSCL : WS_USCL)))[r] = inv; }
    PHASE_END
    SEAM(13);
    PHASE_BEGIN(14)
        pg8::Gemm g{(const bf16*)(ws + WS_XN2), WS_T, S_, 2048, 2048, 2048, 2048}; pg8::StaticOrder S; S.init(S_, 2048, F.G, (int)blockIdx.x);
        pg8::Epi<pg8::EM_SCORES> E{ws + WS_SCORES, nullptr, nullptr, nullptr, nullptr, nullptr, 1.f};
        pg8::gemm_phase<pg8::Epi<pg8::EM_SCORES>, pg8::StaticOrder, true, true>(F.lds + RING_OFF, g, S, E);
    PHASE_END
    SEAM(14);
    PHASE_BEGIN(15)
        const float* SC = (const float*)(ws + WS_SCORES); const bf16* XN2 = (const bf16*)(ws + WS_XN2);
        const unsigned char* UT = (const unsigned char*)(ws + WS_UTAB); const unsigned char* VT = (const unsigned char*)(ws + WS_VTAB);
        const float* USC = (const float*)(ws + WS_USCL); const float* VSC = (const float*)(ws + WS_VSCL);
        LAS unsigned* lst = (LAS unsigned*)(F.lds + RING_OFF + F.wave * 8192);
        for (int tb = gw; tb < S_ / 8; tb += NGW) {
            { const int tl = lane >> 3, h = lane & 7; const float* srow = SC + (size_t)(tb * 8 + tl) * 2048 + h * 256;
              float A[16], B[16];
#pragma unroll
              for (int p = 0; p < 2; ++p) { float top[16];
#pragma unroll
                  for (int k = 0; k < 16; ++k) top[k] = -INFINITY;
#pragma unroll 2
                  for (int i4 = 0; i4 < 32; ++i4) { const f32x4 v = *(const f32x4*)(srow + p * 128 + i4 * 4); const float ve[4] = {v.x, v.y, v.z, v.w};
#pragma unroll
                      for (int e = 0; e < 4; ++e) { float x = __uint_as_float((__float_as_uint(ve[e]) & 0xffffff80u) | (unsigned)(i4 * 4 + e));
#pragma unroll
                          for (int k = 0; k < 16; ++k) { const float hi = fmaxf(top[k], x); x = fminf(top[k], x); top[k] = hi; } } }
#pragma unroll
                  for (int k = 0; k < 16; ++k) { if (p == 0) A[k] = top[k]; else B[k] = top[k]; } }
              float cs[16]; unsigned cx[16];
#pragma unroll
              for (int k = 0; k < 16; ++k) { cs[k] = -INFINITY; cx[k] = 0u; }
#pragma unroll
              for (int i = 0; i < 16; ++i)
#pragma unroll
                  for (int j = 0; j < 16; ++j) if ((i + 1) * (j + 1) <= 16) {
                      float x = A[i] + B[j]; unsigned xi = ((__float_as_uint(A[i]) & 127u) << 7) | (__float_as_uint(B[j]) & 127u);
#pragma unroll
                      for (int k = 0; k < 16; ++k) { const bool c = x > cs[k]; const float ns = c ? x : cs[k]; const unsigned ni = c ? xi : cx[k]; x = c ? cs[k] : x; xi = c ? cx[k] : xi; cs[k] = ns; cx[k] = ni; } }
              float gsum = 0.f; const float cmax = cs[0];
#pragma unroll
              for (int k = 0; k < 16; ++k) { cs[k] = __expf(cs[k] - cmax); }
#pragma unroll
              for (int k = 0; k < 16; ++k) gsum += cs[k];
              const float ginv = 1.f / gsum; LAS unsigned* lp = lst + (tl * 128 + h * 16) * 2;
#pragma unroll
              for (int k = 0; k < 16; k += 2) *(LAS v4u*)(lp + k * 2) = (v4u){cx[k], __float_as_uint(cs[k] * ginv), cx[k + 1], __float_as_uint(cs[k + 1] * ginv)}; }
            LDS_WAIT(); asm volatile("" ::: "memory");
#pragma unroll 1
            for (int tl = 0; tl < 8; ++tl) { const int t = tb * 8 + tl;
                float xf[32];
#pragma unroll
                for (int j = 0; j < 2; ++j) { const v4u a = *(const GAS v4u*)(XN2 + (size_t)t * 2048 + j * 1024 + lane * 16), b = *(const GAS v4u*)(XN2 + (size_t)t * 2048 + j * 1024 + lane * 16 + 8);
                    const unsigned w[8] = {a.x, a.y, a.z, a.w, b.x, b.y, b.z, b.w};
#pragma unroll
                    for (int e = 0; e < 8; ++e) { xf[j * 16 + 2 * e] = pg8::bflo(w[e]); xf[j * 16 + 2 * e + 1] = pg8::bfhi(w[e]); } }
                float acc[32];
#pragma unroll
                for (int e = 0; e < 32; ++e) acc[e] = 0.f;
                constexpr int EG = 4;
#pragma unroll 1
                for (int e0 = 0; e0 < 128; e0 += EG) {
                    v4u ur[EG][2], vr[EG][2]; float gate[EG], su[EG], sv[EG];
#pragma unroll
                    for (int q = 0; q < EG; ++q) { const unsigned idx = __builtin_amdgcn_readfirstlane(lst[(tl * 128 + e0 + q) * 2]); gate[q] = __uint_as_float(__builtin_amdgcn_readfirstlane(lst[(tl * 128 + e0 + q) * 2 + 1]));
                        const unsigned char* up = UT + (size_t)idx * 2048 + lane * 16; const unsigned char* vp = VT + (size_t)idx * 2048 + lane * 16;
                        ur[q][0] = *(const GAS v4u*)up; ur[q][1] = *(const GAS v4u*)(up + 1024); vr[q][0] = *(const GAS v4u*)vp; vr[q][1] = *(const GAS v4u*)(vp + 1024);
                        su[q] = USC[idx]; sv[q] = VSC[idx]; }
#pragma unroll
                    for (int q = 0; q < EG; ++q) { float d0 = 0.f, d1 = 0.f;
#pragma unroll
                        for (int j = 0; j < 2; ++j) { const unsigned uw[4] = {ur[q][j].x, ur[q][j].y, ur[q][j].z, ur[q][j].w};
#pragma unroll
                            for (int w = 0; w < 4; ++w) { const auto lo = __builtin_amdgcn_cvt_pk_f32_fp8((int)uw[w], false), hi = __builtin_amdgcn_cvt_pk_f32_fp8((int)uw[w], true);
                                d0 = fmaf(xf[j * 16 + 4 * w], lo[0], d0); d1 = fmaf(xf[j * 16 + 4 * w + 1], lo[1], d1); d0 = fmaf(xf[j * 16 + 4 * w + 2], hi[0], d0); d1 = fmaf(xf[j * 16 + 4 * w + 3], hi[1], d1); } }
                        const float d = wsum(d0 + d1) * su[q];
                        const float act = 0.5f * d * (1.f + erff(d * 0.70710678118f)); const float cf = gate[q] * act * sv[q];
#pragma unroll
                        for (int j = 0; j < 2; ++j) { const unsigned vw[4] = {vr[q][j].x, vr[q][j].y, vr[q][j].z, vr[q][j].w};
#pragma unroll
                            for (int w = 0; w < 4; ++w) { const auto lo = __builtin_amdgcn_cvt_pk_f32_fp8((int)vw[w], false), hi = __builtin_amdgcn_cvt_pk_f32_fp8((int)vw[w], true);
                                acc[j * 16 + 4 * w] = fmaf(cf, lo[0], acc[j * 16 + 4 * w]); acc[j * 16 + 4 * w + 1] = fmaf(cf, lo[1], acc[j * 16 + 4 * w + 1]);
                                acc[j * 16 + 4 * w + 2] = fmaf(cf, hi[0], acc[j * 16 + 4 * w + 2]); acc[j * 16 + 4 * w + 3] = fmaf(cf, hi[1], acc[j * 16 + 4 * w + 3]); } }
                    }
                }
                float* orow = args.out + (size_t)t * 2048; const float* hrow = (const float*)(ws + WS_H2) + (size_t)t * 2048; float ss = 0.f;
#pragma unroll
                for (int j = 0; j < 2; ++j)
#pragma unroll
                    for (int q = 0; q < 4; ++q) { const f32x4 a = *(const f32x4*)(hrow + j * 1024 + lane * 16 + q * 4);
                        acc[j * 16 + q * 4] += a.x; acc[j * 16 + q * 4 + 1] += a.y; acc[j * 16 + q * 4 + 2] += a.z; acc[j * 16 + q * 4 + 3] += a.w; }
#pragma unroll
                for (int e = 0; e < 32; ++e) ss += acc[e] * acc[e];
                const float rstd = rsqrtf(wsum(ss) * (1.f / 2048.f) + 1e-6f);
#pragma unroll
                for (int j = 0; j < 2; ++j)
#pragma unroll
                    for (int q = 0; q < 4; ++q) { const f32x4 g0 = *(const f32x4*)(in[27] + j * 1024 + lane * 16 + q * 4);
                        *(f32x4*)(orow + j * 1024 + lane * 16 + q * 4) = (f32x4){acc[j * 16 + q * 4] * rstd * g0.x, acc[j * 16 + q * 4 + 1] * rstd * g0.y, acc[j * 16 + q * 4 + 2] * rstd * g0.z, acc[j * 16 + q * 4 + 3] * rstd * g0.w}; }
            }
            LDS_WAIT(); asm volatile("" ::: "memory");
        }
    PHASE_END
#undef IN
#undef SEAM
}

extern "C" void kernel_launch(void* const* d_in, const int* in_sizes, int n_in, void* d_out, int out_size, void* d_ws, size_t ws_size, hipStream_t stream) {
    static int grid = 0;
    if (grid == 0) {
        if (n_in != 28 || in_sizes[0] != S_ * DM || out_size != S_ * DM || ws_size < WS_END) { fprintf(stderr, "kernel_launch: unexpected shapes: n_in %d in0 %d out %d ws %zu (need >= %zu)\n", n_in, n_in > 0 ? in_sizes[0] : -1, out_size, ws_size, (size_t)WS_END); grid = -1; return; }
        if (hipFuncSetAttribute((const void*)mk_fwd, hipFuncAttributeMaxDynamicSharedMemorySize, LDS_BYTES) != hipSuccess) { fprintf(stderr, "kernel_launch: hipFuncSetAttribute failed\n"); grid = -1; return; }
        int per_cu = 0;
        if (hipOccupancyMaxActiveBlocksPerMultiprocessor(&per_cu, (const void*)mk_fwd, NWAVES * 64, LDS_BYTES) != hipSuccess || per_cu < 1) fprintf(stderr, "kernel_launch: note: occupancy query reports %d\n", per_cu);
        (void)hipGetLastError();
        grid = 256;
    }
    if (grid < 0) return;
    (void)hipMemsetAsync((char*)d_ws + WS_CTL, 0, CTL_ZERO_BYTES, stream);
    Args a{};
    for (int i = 0; i < 28; ++i) a.in[i] = (const float*)d_in[i];
    a.out = (float*)d_out; a.ws = (unsigned char*)d_ws;
#if MK_PER_PHASE
    for (int p = 0; p < NPH; ++p) { a.ph_lo = p; a.ph_hi = p + 1; hipLaunchKernelGGL(mk_fwd, dim3(grid), dim3(NWAVES * 64), LDS_BYTES, stream, a); }
#else
    a.ph_lo = 0; a.ph_hi = NPH; hipLaunchKernelGGL(mk_fwd, dim3(grid), dim3(NWAVES * 64), LDS_BYTES, stream, a);
#endif
    const hipError_t le = hipPeekAtLastError();
    if (le != hipSuccess) fprintf(stderr, "kernel_launch: launch failed: %s\n", hipGetErrorName(le));
}
```

```cpp
#include <hip/hip_runtime.h>
#include <cstdio>
#include <cstdint>
namespace pg8 {
#define PG8_LAS __attribute__((address_space(3)))
typedef unsigned short bf16_t;
typedef short bf16x8 __attribute__((ext_vector_type(8)));
typedef float f32x4 __attribute__((ext_vector_type(4)));
typedef unsigned u32x4 __attribute__((ext_vector_type(4)));
constexpr int BM = 256, BK = 64, HALF = 128, HTB = HALF * BK * 2  , STAGE_BYTES = 8 * HTB, NXCD = 8, WGM = 8;

__host__ __device__ __forceinline__ int lds_byte(int r, int c) { const int st = (r >> 4) * 2 + (c >> 5), rr = r & 15, cc = c & 31, ob = rr * 64 + cc * 2; return st * 1024 + (ob ^ (((ob >> 9) & 1) << 5)); }
__host__ __device__ __forceinline__ void stage_rc(int b, int& R, int& C) { const int st = b / 1024, sb = b % 1024, swz = sb ^ (((sb >> 9) & 1) << 5); R = (st >> 1) * 16 + swz / 64; C = (st & 1) * 32 + (swz % 64) / 2; }
__host__ __device__ __forceinline__ int perm32(int rho) { const int n = rho >> 4, i = rho & 15; return 8 * (i >> 2) + 4 * n + (i & 3); }

struct Unit { int pm, pn; };
struct Gemm { const bf16_t* A; const bf16_t* Bt; int M, N, K, lda, ldb; };

struct StaticOrder {
    int nM, nN, nwg, G, c;
    __host__ __device__ void init(int M, int N, int G_, int c_) { nM = M / BM; nN = N / BM; nwg = nM * nN; G = G_; c = c_; }
    __host__ __device__ bool next(int i, Unit& u) const {
        const long L = (long)i * G + c; if (L >= nwg) return false;
        int wgid = (int)L; { const int q = nwg / NXCD, r = nwg % NXCD, xcd = wgid % NXCD, off = wgid / NXCD; wgid = (xcd < r ? xcd * (q + 1) : r * (q + 1) + (xcd - r) * q) + off; }
        const int nig = WGM * nN, gid = wgid / nig, fm = gid * WGM, gsz = (nM - fm) < WGM ? (nM - fm) : WGM;
        u.pm = fm + ((wgid % nig) % gsz); u.pn = (wgid % nig) / gsz; return true;
    }
    __device__ __forceinline__ void a_ready(const Unit&) const {}
    __device__ __forceinline__ void done(const Unit&) const {}
};

__device__ __forceinline__ unsigned cvt_pk_bf16(float lo, float hi) { unsigned r; asm volatile("v_cvt_pk_bf16_f32 %0, %1, %2" : "=v"(r) : "v"(lo), "v"(hi)); return r; }
__device__ __forceinline__ float sigm(float x) { return __builtin_amdgcn_rcpf(1.0f + __expf(-x)); }
__device__ __forceinline__ float bflo(unsigned w) { return __uint_as_float(w << 16); }
__device__ __forceinline__ float bfhi(unsigned w) { return __uint_as_float(w & 0xffff0000u); }
enum { EM_G1 = 0, EM_LORA_W = 1, EM_LORA_A = 2, EM_LORA_G = 3, EM_PROJA = 4, EM_PROJB = 5, EM_WOUT = 6, EM_SCORES = 7 };
template <int MODE> struct Epi {
    static constexpr bool PERM = true, AFTER_DRAIN = false;
    void* o0; void* o1; void* o2; const void* i0; const void* i1; const float* vec; float sc;
    __device__ __forceinline__ void operator()(const f32x4 (&acc)[2][2][4][2], const Unit& u, int wr, int wc, int fr, int fq) const {
        asm volatile("" ::: "memory");
        const int row0 = u.pm * BM + wr * 64 + fr;
        int colt = u.pn * BM; int ldc = 2048; int sub = 0;
        bf16_t* ob = (bf16_t*)o0; float scl = 1.f;
        if (MODE == EM_G1) {
            if (u.pn < 14) { ldc = 3584; }
            else if (u.pn < 26) { ob = (bf16_t*)o1; ldc = 3072; colt -= 14 * BM; if (u.pn < 18) scl = sc; }
            else { ob = (bf16_t*)o2; ldc = 4096; colt -= 26 * BM; sub = 1; }
        }
        if (MODE == EM_LORA_W || MODE == EM_LORA_A || MODE == EM_LORA_G) ldc = 1024;
        const int col0 = colt + wc * 32 + 8 * fq;
#pragma unroll
        for (int ai = 0; ai < 2; ++ai)
#pragma unroll
            for (int m = 0; m < 4; ++m) { const size_t row = (size_t)(row0 + ai * HALF + m * 16);
#pragma unroll
                for (int bj = 0; bj < 2; ++bj) { f32x4 v0 = acc[ai][bj][m][0], v1 = acc[ai][bj][m][1]; const int col = col0 + bj * HALF;
                    if (MODE == EM_G1) {
                        if (sub) { v0 = (f32x4){sigm(v0[0]), sigm(v0[1]), sigm(v0[2]), sigm(v0[3])}; v1 = (f32x4){sigm(v1[0]), sigm(v1[1]), sigm(v1[2]), sigm(v1[3])}; }
                        else { v0 = v0 * scl; v1 = v1 * scl; }
                        u32x4 w; w.x = cvt_pk_bf16(v0[0], v0[1]); w.y = cvt_pk_bf16(v0[2], v0[3]); w.z = cvt_pk_bf16(v1[0], v1[1]); w.w = cvt_pk_bf16(v1[2], v1[3]);
                        *(u32x4*)(ob + row * ldc + col) = w;
                    } else if (MODE == EM_LORA_W) {
                        if (vec) { const f32x4 b0 = *(const f32x4*)(vec + col), b1 = *(const f32x4*)(vec + col + 4);
                            v0 = v0 + b0; v1 = v1 + b1;
                            v0 = (f32x4){sigm(v0[0]), sigm(v0[1]), sigm(v0[2]), sigm(v0[3])}; v1 = (f32x4){sigm(v1[0]), sigm(v1[1]), sigm(v1[2]), sigm(v1[3])};
                            v0 = v0 * sc; v1 = v1 * sc; }
                        u32x4 w; w.x = cvt_pk_bf16(v0[0], v0[1]); w.y = cvt_pk_bf16(v0[2], v0[3]); w.z = cvt_pk_bf16(v1[0], v1[1]); w.w = cvt_pk_bf16(v1[2], v1[3]);
                        *(u32x4*)(ob + row * ldc + col) = w;
                    } else if (MODE == EM_PROJA) {
                        const u32x4 g = *(const u32x4*)((const bf16_t*)i0 + row * 4096 + col);
                        float* op = (float*)o0 + row * 2048 + col;
                        *(f32x4*)op = (f32x4){v0[0] * bflo(g.x), v0[1] * bfhi(g.x), v0[2] * bflo(g.y), v0[3] * bfhi(g.y)};
                        *(f32x4*)(op + 4) = (f32x4){v1[0] * bflo(g.z), v1[1] * bfhi(g.z), v1[2] * bflo(g.w), v1[3] * bfhi(g.w)};
                    } else if (MODE == EM_PROJB) {
                        const u32x4 g = *(const u32x4*)((const bf16_t*)i0 + row * 4096 + 2048 + col);
                        const float* tp = (const float*)i1 + row * 2048 + col; const f32x4 t0 = *(const f32x4*)tp, t1 = *(const f32x4*)(tp + 4);
                        v0 = (f32x4){t0[0] + v0[0] * bflo(g.x), t0[1] + v0[1] * bfhi(g.x), t0[2] + v0[2] * bflo(g.y), t0[3] + v0[3] * bfhi(g.y)};
                        v1 = (f32x4){t1[0] + v1[0] * bflo(g.z), t1[1] + v1[1] * bfhi(g.z), t1[2] + v1[2] * bflo(g.w), t1[3] + v1[3] * bfhi(g.w)};
                        u32x4 w; w.x = cvt_pk_bf16(v0[0], v0[1]); w.y = cvt_pk_bf16(v0[2], v0[3]); w.z = cvt_pk_bf16(v1[0], v1[1]); w.w = cvt_pk_bf16(v1[2], v1[3]);
                        *(u32x4*)(ob + row * 2048 + col) = w;
                    } else if (MODE == EM_WOUT) {
                        const float* xp = (const float*)i1 + row * 2048 + col; const f32x4 t0 = *(const f32x4*)xp, t1 = *(const f32x4*)(xp + 4);
                        float* op = (float*)o0 + row * 2048 + col; *(f32x4*)op = t0 + v0; *(f32x4*)(op + 4) = t1 + v1;
                    } else {
                        float* op = (float*)o0 + row * 2048 + col; *(f32x4*)op = v0; *(f32x4*)(op + 4) = v1;
                    }
                } }
    }
};

template <class Epi, class Sched, bool ALIGN_EPI = false, bool SP2 = false>
__device__ __forceinline__ void gemm_phase(PG8_LAS unsigned char* lds, const Gemm g, const Sched& S, const Epi& E) {
    int tid_ = threadIdx.x; asm volatile("" : "+v"(tid_)); const int tid = tid_, wid = __builtin_amdgcn_readfirstlane(tid >> 6), lane = tid & 63, wr = wid >> 2, wc = wid & 3, fr = lane & 15, fq = lane >> 4;
    const int K = g.K, nt = K / BK;
    unsigned voffA[2], voffB[2];
#pragma unroll
    for (int i = 0; i < 2; ++i) { int R, C; stage_rc(tid * 16 + i * 8192, R, C); const int Rb = Epi::PERM ? ((R & ~31) + perm32(R & 31)) : R;
        voffA[i] = (unsigned)(R * g.lda + C) * 2u; voffB[i] = (unsigned)(Rb * g.ldb + C) * 2u; }
    const size_t kstep = (size_t)(BK * 2);
    const size_t hstepA = (size_t)HALF * g.lda * 2, hstepB = (size_t)HALF * g.ldb * 2;
    const size_t tstepA = 2 * hstepA, tstepB = 2 * hstepB;
    const unsigned ldsw = (unsigned)wid * 1024u;
    const int aoff = lds_byte(wr * 64 + fr, fq * 8), boff = lds_byte(wc * 32 + fr, fq * 8);
#define PG8_SA(b, h) (((b) * 2 + (h)) * HTB)
#define PG8_SB(b, h) ((4 + (b) * 2 + (h)) * HTB)
#define PG8_STAGE(bufoff, gbase, voff) do { _Pragma("unroll") for (int _i = 0; _i < 2; ++_i) \
        __builtin_amdgcn_global_load_lds((const unsigned*)((const char*)(gbase) + (voff)[_i]), (PG8_LAS unsigned*)(lds + (bufoff) + ldsw + _i * 8192), 16, 0, 0); } while (0)
#define PG8_LDA(dst, b, h) do { _Pragma("unroll") for (int m = 0; m < 4; ++m) _Pragma("unroll") for (int k = 0; k < 2; ++k) dst[m][k] = *(const PG8_LAS bf16x8*)(lds + PG8_SA(b, h) + aoff + m * 2048 + k * 1024); } while (0)
#define PG8_LDB(dst, b, h) do { _Pragma("unroll") for (int n = 0; n < 2; ++n) _Pragma("unroll") for (int k = 0; k < 2; ++k) dst[n][k] = *(const PG8_LAS bf16x8*)(lds + PG8_SB(b, h) + boff + n * 2048 + k * 1024); } while (0)
#define PG8_MMA(ai, bj, At, Bt) do { __builtin_amdgcn_s_setprio(1); _Pragma("unroll") for (int m = 0; m < 4; ++m) _Pragma("unroll") for (int n = 0; n < 2; ++n) _Pragma("unroll") for (int k = 0; k < 2; ++k) \
        acc[ai][bj][m][n] = __builtin_amdgcn_mfma_f32_16x16x32_bf16(Bt[n][k], At[m][k], acc[ai][bj][m][n], 0, 0, 0); __builtin_amdgcn_s_setprio(0); } while (0)
#define PG8_WAIT_V(n) asm volatile("s_waitcnt vmcnt(" #n ")" ::: "memory")
#define PG8_WAIT_L(n) asm volatile("s_waitcnt lgkmcnt(" #n ")" ::: "memory")
#define PG8_BAR __builtin_amdgcn_s_barrier()
#define PG8_SCHED __builtin_amdgcn_sched_barrier(0)
    Unit cur, nxt; int ui = 0;
    if (!S.next(0, cur)) return;
    f32x4 acc[2][2][4][2];
#pragma unroll
    for (int a = 0; a < 2; ++a)
#pragma unroll
        for (int b = 0; b < 2; ++b)
#pragma unroll
            for (int m = 0; m < 4; ++m)
#pragma unroll
                for (int n = 0; n < 2; ++n) acc[a][b][m][n] = (f32x4){0.f, 0.f, 0.f, 0.f};
    bf16x8 At[4][2], B0[2][2], B1[2][2];
    const char* cA = (const char*)g.A + (size_t)cur.pm * tstepA; const char* cB = (const char*)g.Bt + (size_t)cur.pn * tstepB;
    S.a_ready(cur);
    if constexpr (SP2) {
        PG8_STAGE(PG8_SB(0, 0), cB, voffB); PG8_STAGE(PG8_SB(0, 1), cB + hstepB, voffB); PG8_STAGE(PG8_SA(0, 0), cA, voffA); PG8_STAGE(PG8_SA(0, 1), cA + hstepA, voffA);
        if (wr == 1) PG8_BAR;
        PG8_WAIT_V(2); PG8_BAR;
        PG8_STAGE(PG8_SB(1, 0), cB + kstep, voffB); PG8_STAGE(PG8_SA(1, 0), cA + kstep, voffA); PG8_STAGE(PG8_SB(1, 1), cB + hstepB + kstep, voffB);
        PG8_WAIT_V(6); PG8_BAR;
    } else {
        PG8_STAGE(PG8_SB(0, 0), cB, voffB); PG8_STAGE(PG8_SA(0, 0), cA, voffA); PG8_STAGE(PG8_SB(0, 1), cB + hstepB, voffB); PG8_STAGE(PG8_SA(0, 1), cA + hstepA, voffA);
        if (wr == 1) PG8_BAR;
        PG8_WAIT_V(4); PG8_BAR;
        PG8_STAGE(PG8_SB(1, 0), cB + kstep, voffB); PG8_STAGE(PG8_SA(1, 0), cA + kstep, voffA); PG8_STAGE(PG8_SB(1, 1), cB + hstepB + kstep, voffB);
        PG8_WAIT_V(6); PG8_BAR;
    }
    for (;;) {
        const bool has_next = S.next(ui + 1, nxt);
        const char* nA = has_next ? (const char*)g.A + (size_t)nxt.pm * tstepA : cA; const char* nB = has_next ? (const char*)g.Bt + (size_t)nxt.pn * tstepB : cB;
        for (int t = 0; t < nt; t += 2) {
            const bool last = (t == nt - 2);
            const char* a1 = cA + (size_t)(t + 1) * kstep;
            const char* a2 = last ? nA : cA + (size_t)(t + 2) * kstep; const char* b2 = last ? nB : cB + (size_t)(t + 2) * kstep;
            const char* a3 = a2 + kstep; const char* b3 = b2 + kstep;
            if (last && has_next) S.a_ready(nxt);
            if constexpr (SP2) {
            PG8_LDB(B0, 0, 0); PG8_LDB(B1, 0, 1); PG8_SCHED; PG8_LDA(At, 0, 0); PG8_STAGE(PG8_SA(1, 1), a1 + hstepA, voffA);
            PG8_WAIT_V(8); PG8_WAIT_L(0); PG8_BAR; PG8_MMA(0, 0, At, B0); PG8_MMA(0, 1, At, B1); PG8_BAR; PG8_SCHED;
            PG8_LDA(At, 0, 1); PG8_STAGE(PG8_SB(0, 0), b2, voffB); PG8_STAGE(PG8_SB(0, 1), b2 + hstepB, voffB); PG8_STAGE(PG8_SA(0, 0), a2, voffA);
            PG8_WAIT_V(8); PG8_WAIT_L(0); PG8_BAR; PG8_MMA(1, 0, At, B0); PG8_MMA(1, 1, At, B1); PG8_BAR; PG8_SCHED;
            PG8_LDB(B0, 1, 0); PG8_LDB(B1, 1, 1); PG8_SCHED; PG8_LDA(At, 1, 0); PG8_STAGE(PG8_SA(0, 1), a2 + hstepA, voffA);
            PG8_WAIT_V(8); PG8_WAIT_L(0); PG8_BAR; PG8_MMA(0, 0, At, B0); PG8_MMA(0, 1, At, B1); PG8_BAR; PG8_SCHED;
            PG8_LDA(At, 1, 1); PG8_STAGE(PG8_SB(1, 0), b3, voffB); PG8_STAGE(PG8_SB(1, 1), b3 + hstepB, voffB); PG8_STAGE(PG8_SA(1, 0), a3, voffA);
            PG8_WAIT_V(8); PG8_WAIT_L(0); PG8_BAR; PG8_MMA(1, 0, At, B0); PG8_MMA(1, 1, At, B1); PG8_BAR; PG8_SCHED;
            } else {
            PG8_LDB(B0, 0, 0); PG8_SCHED; PG8_LDA(At, 0, 0); PG8_STAGE(PG8_SA(1, 1), a1 + hstepA, voffA);
            PG8_WAIT_L(8); PG8_BAR; PG8_WAIT_L(0); PG8_MMA(0, 0, At, B0); PG8_BAR; PG8_SCHED;
            PG8_LDB(B1, 0, 1); PG8_STAGE(PG8_SB(0, 0), b2, voffB);
            PG8_BAR; PG8_WAIT_L(0); PG8_MMA(0, 1, At, B1); PG8_BAR;
            PG8_LDA(At, 0, 1); PG8_STAGE(PG8_SA(0, 0), a2, voffA);
            PG8_BAR; PG8_WAIT_L(0); PG8_MMA(1, 0, At, B0); PG8_BAR; PG8_SCHED;
            PG8_STAGE(PG8_SB(0, 1), b2 + hstepB, voffB);
            PG8_WAIT_V(6); PG8_BAR; PG8_MMA(1, 1, At, B1); PG8_BAR;
            PG8_LDB(B0, 1, 0); PG8_SCHED; PG8_LDA(At, 1, 0); PG8_STAGE(PG8_SA(0, 1), a2 + hstepA, voffA);
            PG8_WAIT_L(8); PG8_BAR; PG8_WAIT_L(0); PG8_MMA(0, 0, At, B0); PG8_BAR; PG8_SCHED;
            PG8_LDB(B1, 1, 1); PG8_STAGE(PG8_SB(1, 0), b3, voffB);
            PG8_BAR; PG8_WAIT_L(0); PG8_MMA(0, 1, At, B1); PG8_BAR;
            PG8_LDA(At, 1, 1); PG8_STAGE(PG8_SA(1, 0), a3, voffA);
            PG8_BAR; PG8_WAIT_L(0); PG8_MMA(1, 0, At, B0); PG8_BAR; PG8_SCHED;
            PG8_STAGE(PG8_SB(1, 1), b3 + hstepB, voffB);
            PG8_WAIT_V(6); PG8_BAR; PG8_MMA(1, 1, At, B1); PG8_BAR;
            }
        }
        if constexpr (ALIGN_EPI) { if (wr == 0) PG8_BAR; }
        if constexpr (!Epi::AFTER_DRAIN) { E(acc, cur, wr, wc, fr, fq); S.done(cur); }
        if (!has_next) break;
#pragma unroll
        for (int a = 0; a < 2; ++a)
#pragma unroll
            for (int b = 0; b < 2; ++b)
#pragma unroll
                for (int m = 0; m < 4; ++m)
#pragma unroll
                    for (int n = 0; n < 2; ++n) acc[a][b][m][n] = (f32x4){0.f, 0.f, 0.f, 0.f};
        cur = nxt; cA = nA; cB = nB; ++ui;
        if constexpr (ALIGN_EPI) { if (wr == 1) PG8_BAR; }
    }
    PG8_WAIT_V(0);
    if constexpr (!ALIGN_EPI) { if (wr == 0) PG8_BAR; }
    PG8_BAR;
    if constexpr (Epi::AFTER_DRAIN) { E.fused(acc, cur, wr, wc, fr, fq, lds, wid, lane); S.done(cur); }
#undef PG8_SA
#undef PG8_SB
#undef PG8_STAGE
#undef PG8_LDA
#undef PG8_LDB
#undef PG8_MMA
#undef PG8_WAIT_V
#undef PG8_WAIT_L
#undef PG8_BAR
#undef PG8_SCHED
}
}
#include <hip/hip_bf16.h>
#include <cmath>
namespace attn_body {
using bf16=__hip_bfloat16;
using bf16x8=__attribute__((ext_vector_type(8)))short;
using s16x4=__attribute__((ext_vector_type(4)))short;
using f32x16=__attribute__((ext_vector_type(16)))float;
using u32x4=__attribute__((ext_vector_type(4)))unsigned;
constexpr int SEQ=16384,D=64,PQ=3072,PO=2048;
constexpr int NW=8,QBLK=32,QB=QBLK*NW,KVBLK=64,NQB=SEQ/QB;
constexpr int ATTN_UNIT_ROWS=QB;
__device__ __forceinline__ int crow(int r,int hi){return (r&3)+8*(r>>2)+4*hi;}
#define SBAR() __builtin_amdgcn_sched_barrier(0)
__device__ __forceinline__ void cmask(f32x16&p0,f32x16&p1,int jb,int qrel,int hi){
  const float NEG=-INFINITY; int kb=64*jb+4*hi;
  #pragma unroll
  for(int r=0;r<16;++r){int kv=kb+(r&3)+8*(r>>2); if(kv>qrel)p0[r]=NEG; if(kv+32>qrel)p1[r]=NEG;}
}

constexpr int NSLOT=3, SLOTB=8192;
constexpr int LDS_K=0, LDS_V=NSLOT*SLOTB, LDS_WS=2*NSLOT*SLOTB, LDS_OST=LDS_WS+NW*64*4, LDS_BYTES=LDS_OST+NW*4096;
constexpr float C2=0.125f*1.4426950408889634f;
__device__ __forceinline__ void glds16(const void*gsrc,unsigned lds_dst){unsigned keep;
  asm volatile("s_mov_b32 %0, m0\n\ts_mov_b32 m0, %2\n\ts_nop 0\n\tglobal_load_lds_dwordx4 %1, off\n\ts_mov_b32 m0, %0":"=&s"(keep):"v"(gsrc),"s"(lds_dst):"memory");}
__device__ __forceinline__ float max3f(float a,float b,float c){float r;asm("v_max3_f32 %0, %1, %2, %3":"=v"(r):"v"(a),"v"(b),"v"(c));return r;}
__device__ __forceinline__ float max2f(float a,float b){float r;asm("v_max_f32_e32 %0, %1, %2":"=v"(r):"v"(a),"v"(b));return r;}
__device__ __forceinline__ float fadd_s(float a,float b){float r;asm("v_add_f32_e32 %0, %1, %2":"=v"(r):"v"(a),"v"(b));return r;}
__device__ __forceinline__ float fsub_s(float a,float b){float r;asm("v_sub_f32_e32 %0, %1, %2":"=v"(r):"v"(a),"v"(b));return r;}
typedef float f32x2_t __attribute__((ext_vector_type(2))); typedef __bf16 bf16x2_t __attribute__((ext_vector_type(2)));
__device__ __forceinline__ unsigned cvtpk_s(float lo,float hi){f32x2_t v={lo,hi};bf16x2_t b=__builtin_convertvector(v,bf16x2_t);return __builtin_bit_cast(unsigned,b);}
#define WAIT_BAR(N) asm volatile("s_waitcnt vmcnt(" #N ") lgkmcnt(0)\n\ts_barrier":::"memory")

__device__ __forceinline__ void qkt(f32x16&p0,f32x16&p1,const char*Kslot,const bf16x8*qr,const f32x16&negm,int r32,int hi){
  const char*kb=Kslot+hi*1024+r32*16;
  #pragma unroll
  for(int d0=0;d0<4;++d0){
    const bf16x8 b0=*reinterpret_cast<const bf16x8*>(kb+d0*2048);
    const bf16x8 b1=*reinterpret_cast<const bf16x8*>(kb+d0*2048+512);
    if(d0==0){p0=__builtin_amdgcn_mfma_f32_32x32x16_bf16(b0,qr[0],negm,0,0,0);p1=__builtin_amdgcn_mfma_f32_32x32x16_bf16(b1,qr[0],negm,0,0,0);}
    else{p0=__builtin_amdgcn_mfma_f32_32x32x16_bf16(b0,qr[d0],p0,0,0,0);p1=__builtin_amdgcn_mfma_f32_32x32x16_bf16(b1,qr[d0],p1,0,0,0);}}
}
typedef __attribute__((address_space(3))) const char* lds_cptr;
typedef short v4i16_t __attribute__((ext_vector_type(4)));
__device__ __forceinline__ void kload8(bf16x8*kf,lds_cptr kp){
  kf[0]=*(const __attribute__((address_space(3))) bf16x8*)(kp);      kf[1]=*(const __attribute__((address_space(3))) bf16x8*)(kp+512);
  kf[2]=*(const __attribute__((address_space(3))) bf16x8*)(kp+2048); kf[3]=*(const __attribute__((address_space(3))) bf16x8*)(kp+2560);
  kf[4]=*(const __attribute__((address_space(3))) bf16x8*)(kp+4096); kf[5]=*(const __attribute__((address_space(3))) bf16x8*)(kp+4608);
  kf[6]=*(const __attribute__((address_space(3))) bf16x8*)(kp+6144); kf[7]=*(const __attribute__((address_space(3))) bf16x8*)(kp+6656);
}
__device__ __forceinline__ void kload2(bf16x8*kf,lds_cptr kp,int j){ kf[2*j]=*(const __attribute__((address_space(3))) bf16x8*)(kp+j*2048); kf[2*j+1]=*(const __attribute__((address_space(3))) bf16x8*)(kp+j*2048+512); }
__device__ __forceinline__ s16x4 vtr(lds_cptr p){ return __builtin_bit_cast(s16x4,__builtin_amdgcn_ds_read_tr16_b64_v4i16((__attribute__((address_space(3))) v4i16_t*)p)); }
__device__ __forceinline__ float rowmax(const f32x16&p0,const f32x16&p1){
  float a=max3f(p0[0],p0[1],p1[0]),b=max3f(p0[2],p0[3],p1[1]);a=max3f(a,p1[2],p1[3]);
  #pragma unroll
  for(int r=4;r<16;r+=4){a=max3f(a,p0[r],p0[r+1]);b=max3f(b,p0[r+2],p0[r+3]);a=max3f(a,p1[r],p1[r+1]);b=max3f(b,p1[r+2],p1[r+3]);}
  const float m=max2f(a,b);
  auto rr=__builtin_amdgcn_permlane32_swap(__float_as_uint(m),__float_as_uint(m),false,false);
  return max2f(__uint_as_float(rr[0]),__uint_as_float(rr[1]));
}
__device__ __forceinline__ void pv(f32x16*o,int vb,bf16x8 pa0,bf16x8 pa1,bf16x8 pa2,bf16x8 pa3){
  #pragma unroll
  for(int d0=0;d0<2;++d0){s16x4 lo[4],hi[4];
    #pragma unroll
    for(int ks=0;ks<4;++ks){
      asm volatile("ds_read_b64_tr_b16 %0,%1 offset:%c2":"=&v"(lo[ks]):"v"(vb),"i"(d0*4096+ks*1024):"memory");
      asm volatile("ds_read_b64_tr_b16 %0,%1 offset:%c2":"=&v"(hi[ks]):"v"(vb),"i"(d0*4096+ks*1024+512):"memory");}
    asm volatile("s_waitcnt lgkmcnt(0)":::"memory");SBAR();
    #define PK(k) (bf16x8){lo[k][0],lo[k][1],lo[k][2],lo[k][3],hi[k][0],hi[k][1],hi[k][2],hi[k][3]}
    o[d0]=__builtin_amdgcn_mfma_f32_32x32x16_bf16(pa0,PK(0),o[d0],0,0,0);
    o[d0]=__builtin_amdgcn_mfma_f32_32x32x16_bf16(pa1,PK(1),o[d0],0,0,0);
    o[d0]=__builtin_amdgcn_mfma_f32_32x32x16_bf16(pa2,PK(2),o[d0],0,0,0);
    o[d0]=__builtin_amdgcn_mfma_f32_32x32x16_bf16(pa3,PK(3),o[d0],0,0,0);
    #undef PK
  }
}

#ifndef ATTN_STORE16
#define ATTN_STORE16(p,v) (*(u32x4*)(p)=(v))
#endif
template<int THRL> __device__ __forceinline__ void attn_unit(int qb,const bf16*Q,const bf16*__restrict__ K,const bf16*__restrict__ V,bf16*O,char*shm){
  int tid_=threadIdx.x; asm volatile("":"+v"(tid_)); const int tid=tid_,lane=tid&63,r32=lane&31,hi=lane>>5; const int wid=__builtin_amdgcn_readfirstlane(tid>>6);
  const int q0=qb*QB;
  const bf16*Qw=Q+(long)(q0+wid*QBLK)*PQ;
  const bf16*Kh=K,*Vh=V;
  const unsigned lds0=(unsigned)(uintptr_t)shm;
  float*wsf=(float*)(shm+LDS_WS)+wid*64;
  const bf16*ksrc=Kh+(long)lane*PQ+wid*8;
  const bf16*vsrc=Vh+(long)(16*(wid&3)+(lane>>2))*PQ+(wid>>2)*32+(lane&3)*8;
  const unsigned kdst=lds0+LDS_K+wid*1024, vdst=lds0+LDS_V+wid*1024;
  #define DMA_K(t,slot) glds16(ksrc+(long)(t)*KVBLK*PQ,(unsigned)__builtin_amdgcn_readfirstlane(kdst+(slot)))
  #define DMA_V(t,slot) glds16(vsrc+(long)(t)*KVBLK*PQ,(unsigned)__builtin_amdgcn_readfirstlane(vdst+(slot)))
  const int vb0=(int)(lds0+LDS_V)+((lane>>4)&1)*32+(lane&3)*8+(4*hi+((lane&15)>>2))*64;
  const char*Kbase=shm+LDS_K; bf16x8 kf[8];
  const lds_cptr shm3=(lds_cptr)shm; const lds_cptr kp0=shm3+LDS_K+hi*1024+r32*16; const lds_cptr vp0=shm3+LDS_V+((lane>>4)&1)*32+(lane&3)*8+(4*hi+((lane&15)>>2))*64;
  const int NT=(q0+QB)/KVBLK;
  DMA_K(0,0);DMA_V(0,0);DMA_K(1,SLOTB);
  bf16x8 qr[4];
  #pragma unroll
  for(int d0=0;d0<4;++d0)qr[d0]=*reinterpret_cast<const bf16x8*>(&Qw[(long)r32*PQ+d0*16+hi*8]);
  float mhat=0.f,l_reg=0.f;f32x16 o[2];o[0]=f32x16{};o[1]=f32x16{};asm volatile("":"+v"(o[0]));asm volatile("":"+v"(o[1]));f32x16 negm=f32x16{};asm volatile("":"+v"(negm));
  const int qrel=wid*QBLK+r32;
  #define CMASK(P0,P1,t) do{int jb_=(t)-(NT-4); if(jb_>=0)cmask(P0,P1,jb_,qrel,hi);}while(0)
  bool resc=false;
  #define START(P0,P1) do{ const float rm=rowmax(P0,P1); resc=false; \
    { const float dl=rm; mhat=fadd_s(mhat,dl); \
      _Pragma("unroll") for(int r=0;r<16;++r){P0[r]=fsub_s(P0[r],dl);P1[r]=fsub_s(P1[r],dl);} \
      _Pragma("unroll") for(int r=0;r<16;++r)negm[r]=-mhat; asm volatile("":"+v"(negm)); } \
    _Pragma("unroll") for(int r=0;r<16;++r)P0[r]=__builtin_amdgcn_exp2f(P0[r]); }while(0)
  #define RESC() do{ if(resc){ asm volatile("s_waitcnt lgkmcnt(0)":::"memory"); \
      _Pragma("unroll") for(int d_=0;d_<2;++d_) _Pragma("unroll") for(int r=0;r<16;++r)o[d_][r]*=wsf[crow(r,hi)]; } }while(0)
  f32x16 pA0,pA1,pB0,pB1;
  int sl_prev=0,sl_cur=0,sl_next=SLOTB;
  #define ROT() do{sl_prev=sl_cur;sl_cur=sl_next;sl_next=(sl_next==(NSLOT-1)*SLOTB)?0:sl_next+SLOTB;}while(0)
  DMA_K(2,2*SLOTB);
  WAIT_BAR(3);
  qkt(pA0,pA1,Kbase,qr,negm,r32,hi);asm volatile("s_nop 15\n\ts_nop 7":"+v"(pA0),"+v"(pA1));CMASK(pA0,pA1,0);
  START(pA0,pA1);
  _Pragma("unroll") for(int r=0;r<16;++r)pA1[r]=__builtin_amdgcn_exp2f(pA1[r]);
  WAIT_BAR(0);
  DMA_K(3,0);DMA_V(1,SLOTB);
  ROT();
  kload8(kf,kp0+sl_cur);
  WAIT_BAR(2);
  s16x4 vlo[8],vhi[8]; u32x4 pw0,pw1,pw2,pw3;
  #define PKW(P,B) cvtpk_s(P[B],P[B+1])
  #define PAF(k) __builtin_bit_cast(bf16x8,pw##k)
  #define VFR(i) (bf16x8){vlo[i][0],vlo[i][1],vlo[i][2],vlo[i][3],vhi[i][0],vhi[i][1],vhi[i][2],vhi[i][3]}
  #define PIN(x) asm volatile("":"+v"(x))
  #define MX3(a,b,c) __builtin_fmaxf(__builtin_fmaxf((a),(b)),(c))
  #define GAPA(MF,A0,A1,A2,A3,W0,W1,PW) do{ MF; sacc+=A0; sacc+=A1; sacc+=A2; sacc+=A3; PIN(sacc); W0; W1; PIN(PW); SBAR(); }while(0)
  #define EX(v) __builtin_amdgcn_exp2f(v)
  #define GAPB(MF,X,B) do{ MF; X[B]=EX(X[B]); X[B+1]=EX(X[B+1]); X[B+2]=EX(X[B+2]); X[B+3]=EX(X[B+3]); PIN(X); SBAR(); }while(0)
  #define VRD(i) do{ vlo[i]=vtr(vp_+(((i)>>2)*4096+((i)&3)*1024)); vhi[i]=vtr(vp_+(((i)>>2)*4096+((i)&3)*1024+512)); }while(0)
  #define KRD(G,j) do{ if(G){ kload2(kf,kp0+sl_next,j); SBAR(); } }while(0)
  #define STEP(C0,C1,P0,P1,t,GK,GV,GL) do{ SBAR(); \
    const lds_cptr vp_=vp0+sl_prev; \
    VRD(0); SBAR(); float sacc=(P0[0]+P0[1]); \
    GAPA(C0=__builtin_amdgcn_mfma_f32_32x32x16_bf16(kf[0],qr[0],negm,0,0,0), P0[2],P0[3],P0[4],P0[5],     pw0[0]=PKW(P0,0), pw0[1]=PKW(P0,2), pw0); \
    VRD(4); SBAR(); GAPA(C1=__builtin_amdgcn_mfma_f32_32x32x16_bf16(kf[1],qr[0],negm,0,0,0), P0[6],P0[7],P0[8],P0[9],     pw0[2]=PKW(P0,4), pw0[3]=PKW(P0,6), pw0); \
    VRD(1); SBAR(); GAPA(C0=__builtin_amdgcn_mfma_f32_32x32x16_bf16(kf[2],qr[1],C0,0,0,0),   P0[10],P0[11],P0[12],P0[13], pw1[0]=PKW(P0,8), pw1[1]=PKW(P0,10), pw1); \
    VRD(5); SBAR(); GAPA(C1=__builtin_amdgcn_mfma_f32_32x32x16_bf16(kf[3],qr[1],C1,0,0,0),   P0[14],P0[15],P1[0],P1[1],   pw1[2]=PKW(P0,12),pw1[3]=PKW(P0,14), pw1); \
    VRD(2); SBAR(); GAPA(C0=__builtin_amdgcn_mfma_f32_32x32x16_bf16(kf[4],qr[2],C0,0,0,0),   P1[2],P1[3],P1[4],P1[5],     pw2[0]=PKW(P1,0), pw2[1]=PKW(P1,2), pw2); \
    VRD(6); SBAR(); GAPA(C1=__builtin_amdgcn_mfma_f32_32x32x16_bf16(kf[5],qr[2],C1,0,0,0),   P1[6],P1[7],P1[8],P1[9],     pw2[2]=PKW(P1,4), pw2[3]=PKW(P1,6), pw2); \
    VRD(3); SBAR(); GAPA(C0=__builtin_amdgcn_mfma_f32_32x32x16_bf16(kf[6],qr[3],C0,0,0,0),   P1[10],P1[11],P1[12],P1[13], pw3[0]=PKW(P1,8), pw3[1]=PKW(P1,10), pw3); \
    VRD(7); SBAR(); GAPA(C1=__builtin_amdgcn_mfma_f32_32x32x16_bf16(kf[7],qr[3],C1,0,0,0),   P1[14],P1[15],0.f,0.f,       pw3[2]=PKW(P1,12),pw3[3]=PKW(P1,14), pw3); \
    l_reg+=sacc; \
    if(GK){DMA_K((t)+3,sl_cur);} if(GV){DMA_V((t)+1,sl_next);} \
    CMASK(C0,C1,t); \
    { float a=MX3(C0[0],C0[1],C1[0]),b=MX3(C0[2],C0[3],C1[1]); a=MX3(a,C1[2],C1[3]); \
      _Pragma("unroll") for(int r=4;r<16;r+=4){a=MX3(a,C0[r],C0[r+1]);b=MX3(b,C0[r+2],C0[r+3]);a=MX3(a,C1[r],C1[r+1]);b=MX3(b,C1[r+2],C1[r+3]);} \
      float rm=__builtin_fmaxf(a,b); { auto rr=__builtin_amdgcn_permlane32_swap(__float_as_uint(rm),__float_as_uint(rm),false,false); rm=__builtin_fmaxf(__uint_as_float(rr[0]),__uint_as_float(rr[1])); } \
      resc=false; \
      if(__builtin_expect(__any(rm>(float)THRL),0)){ const float dl=__builtin_fmaxf(rm,0.f); mhat+=dl; \
        _Pragma("unroll") for(int r=0;r<16;++r){C0[r]-=dl;C1[r]-=dl;} \
        _Pragma("unroll") for(int r=0;r<16;++r)negm[r]=-mhat; asm volatile("":"+v"(negm)); \
        const float f=__builtin_amdgcn_exp2f(-dl); l_reg*=f; if(hi==0)wsf[r32]=f; resc=true; } } \
    SBAR(); \
    GAPB(o[0]=__builtin_amdgcn_mfma_f32_32x32x16_bf16(PAF(0),VFR(0),o[0],0,0,0), C0,0); \
    GAPB(o[1]=__builtin_amdgcn_mfma_f32_32x32x16_bf16(PAF(0),VFR(4),o[1],0,0,0), C0,4); \
    KRD(GL,0); GAPB(o[0]=__builtin_amdgcn_mfma_f32_32x32x16_bf16(PAF(1),VFR(1),o[0],0,0,0), C0,8); \
    KRD(GL,1); GAPB(o[1]=__builtin_amdgcn_mfma_f32_32x32x16_bf16(PAF(1),VFR(5),o[1],0,0,0), C0,12); \
    KRD(GL,2); GAPB(o[0]=__builtin_amdgcn_mfma_f32_32x32x16_bf16(PAF(2),VFR(2),o[0],0,0,0), C1,0); \
    KRD(GL,3); GAPB(o[1]=__builtin_amdgcn_mfma_f32_32x32x16_bf16(PAF(2),VFR(6),o[1],0,0,0), C1,4); \
    GAPB(o[0]=__builtin_amdgcn_mfma_f32_32x32x16_bf16(PAF(3),VFR(3),o[0],0,0,0), C1,8); \
    GAPB(o[1]=__builtin_amdgcn_mfma_f32_32x32x16_bf16(PAF(3),VFR(7),o[1],0,0,0), C1,12); \
    }while(0)
  int t=1;
  #undef CMASK
  #define CMASK(P0,P1,t) do{}while(0)
  for(;t+5<NT;t+=2){
    STEP(pB0,pB1,pA0,pA1,t,true,true,true);     WAIT_BAR(2); RESC(); ROT();
    STEP(pA0,pA1,pB0,pB1,t+1,true,true,true);   WAIT_BAR(2); RESC(); ROT();
  }
  #undef CMASK
  #define CMASK(P0,P1,t) do{int jb_=(t)-(NT-4); if(jb_>=0)cmask(P0,P1,jb_,qrel,hi);}while(0)
  #define ENDW(tt) do{ if((tt)+3<NT){WAIT_BAR(2);} else if((tt)+2<NT){WAIT_BAR(1);} else {WAIT_BAR(0);} }while(0)
  for(;t+1<NT;t+=2){
    STEP(pB0,pB1,pA0,pA1,t,(t+3<NT),(t+1<NT),(t+1<NT));       ENDW(t);   RESC(); ROT();
    STEP(pA0,pA1,pB0,pB1,t+1,(t+4<NT),(t+2<NT),(t+2<NT));     ENDW(t+1); RESC(); ROT();
  }
  STEP(pB0,pB1,pA0,pA1,NT-1,false,false,false); RESC();
  { float sacc=pB0[0]+pB0[1]; _Pragma("unroll") for(int r=2;r<16;++r)sacc+=pB0[r]; _Pragma("unroll") for(int r=0;r<16;++r)sacc+=pB1[r]; l_reg+=sacc;
    pw0=(u32x4){PKW(pB0,0),PKW(pB0,2),PKW(pB0,4),PKW(pB0,6)};pw1=(u32x4){PKW(pB0,8),PKW(pB0,10),PKW(pB0,12),PKW(pB0,14)};pw2=(u32x4){PKW(pB1,0),PKW(pB1,2),PKW(pB1,4),PKW(pB1,6)};pw3=(u32x4){PKW(pB1,8),PKW(pB1,10),PKW(pB1,12),PKW(pB1,14)};
    SBAR(); pv(o,vb0+sl_cur,PAF(0),PAF(1),PAF(2),PAF(3)); }
  #undef PKW
  #undef PAF
  #undef VFR
  #undef PIN
  #undef MX3
  #undef GAPA
  #undef GAPB
  #undef EX
  #undef VRD
  #undef KRD
  #undef STEP
  #undef ENDW
  {auto rr=__builtin_amdgcn_permlane32_swap(__float_as_uint(l_reg),__float_as_uint(l_reg),false,false);l_reg=__uint_as_float(rr[0])+__uint_as_float(rr[1]);}
  if(hi==0)wsf[32+r32]=l_reg;asm volatile("s_waitcnt lgkmcnt(0)":::"memory");
  float rli[16];
  #pragma unroll
  for(int r=0;r<16;++r)rli[r]=__builtin_amdgcn_rcpf(wsf[32+crow(r,hi)]);
  bf16*Ow=O+(long)(q0+wid*QBLK)*PO;
  { bf16*stg=(bf16*)(shm+LDS_OST)+wid*2048;
    #pragma unroll
    for(int r=0;r<16;++r){const int orow=crow(r,hi);
      #pragma unroll
      for(int d0=0;d0<2;++d0)stg[orow*64+d0*32+r32]=__float2bfloat16(o[d0][r]*rli[r]);}
    asm volatile("s_waitcnt lgkmcnt(0)":::"memory");
    #pragma unroll
    for(int i=0;i<4;++i){const int row=i*8+(lane>>3),ch=lane&7; const u32x4 v=*(const u32x4*)(stg+row*64+ch*8); ATTN_STORE16(Ow+(long)row*PO+ch*8,v);} }
  asm volatile("s_waitcnt lgkmcnt(0)\n\ts_barrier":::"memory");
  #undef DMA_K
  #undef DMA_V
  #undef CMASK
  #undef START
  #undef RESC
  #undef ROT
}
constexpr int ATTN_LDS_BYTES=LDS_BYTES;
template<int THRL=8> __device__ __forceinline__ void attn_phase(char*lds,const bf16*PD,bf16*O,int vcu){
  const int pr=vcu>>3,s=vcu&7,h=pr>>2,m=(pr>>1)&1,vh=pr&1;
  const bf16*Q=PD+h*128+m*64,*K=PD+1024+h*128+m*64,*V=PD+2048+h*128+vh*64; bf16*Op=O+m*1024+h*128+vh*64;
  _Pragma("unroll 1") for(int i=0;i<8;++i){ const int qb=(i>>1)*16+((i&1)?15-s:s); attn_unit<THRL>(qb,Q,K,V,Op,lds); }
}
#undef SBAR
#undef WAIT_BAR
}
#define GAS __attribute__((address_space(1)))
#define LAS __attribute__((address_space(3)))
typedef unsigned short bf16;
typedef unsigned v4u __attribute__((ext_vector_type(4)));
typedef float f32x4 __attribute__((ext_vector_type(4)));
typedef short bf16x8 __attribute__((ext_vector_type(8)));
typedef GAS unsigned gu32;
typedef GAS unsigned long long gu64;
#define RLX_AGENT __ATOMIC_RELAXED, __HIP_MEMORY_SCOPE_AGENT
#define LDS_WAIT() asm volatile("s_waitcnt lgkmcnt(0)" ::: "memory")
#define VM_WAIT() asm volatile("s_waitcnt vmcnt(0)" ::: "memory")
__device__ __forceinline__ unsigned long long rt() { return __builtin_amdgcn_s_memrealtime(); }
__device__ __forceinline__ unsigned f2bf(float f) { unsigned u = __builtin_bit_cast(unsigned, f); return (u + 0x7fffu + ((u >> 16) & 1u)) >> 16; }
__device__ __forceinline__ unsigned pk2(float lo, float hi) { return f2bf(lo) | (f2bf(hi) << 16); }

#define XB_TMO      128
#define XB_XCNT(j)  (256  + 64 * (j))
#define XB_XSUB(j)  (1280 + 64 * (j))
#define XB_XGEN(j)  (2304 + 64 * (j))
#define XB_TOP      3328
#define XB_TOPGEN   3392
#define XCD_BAR_WORDS 3456
#define XB_SPIN_CAP (1u << 18)

__device__ __forceinline__ unsigned xb_ld(unsigned* p)              { return __hip_atomic_load(p, __ATOMIC_RELAXED, __HIP_MEMORY_SCOPE_AGENT); }
__device__ __forceinline__ unsigned xb_add(unsigned* p, unsigned v) { return __hip_atomic_fetch_add(p, v, __ATOMIC_RELAXED, __HIP_MEMORY_SCOPE_AGENT); }
__device__ __forceinline__ unsigned xb_xcc_id() { return (unsigned)__builtin_amdgcn_s_getreg((3 << 11) | 20) & 0xFu; }
#define XB_SPIN(cond, bar) do { unsigned _sp = 0; while (cond) { __builtin_amdgcn_s_sleep(1); \
    if ((++_sp & 255u) == 0u) { if (xb_ld(&(bar)[XB_TMO])) break; if (_sp > XB_SPIN_CAP) { atomicAdd(&(bar)[XB_TMO], 1u); break; } } } } while (0)

struct XcdBarrier {
    unsigned* bar; unsigned x;
    volatile LAS unsigned* st;
};

__device__ __forceinline__ XcdBarrier xcd_barrier_post(unsigned* bar, volatile LAS unsigned* st) {
    XcdBarrier b; b.bar = bar; b.x = xb_xcc_id(); b.st = st;
    if (threadIdx.x == 0) (void)xb_add(&bar[XB_XCNT(b.x)], 1u);
    return b;
}
__device__ __forceinline__ void xcd_barrier_complete(unsigned* bar, unsigned x, unsigned& nloc, unsigned& nx) {
    const unsigned G = gridDim.x * gridDim.y * gridDim.z;
    unsigned sum, cnt, mine, sp = 0u;
    for (;;) {
        sum = 0u; cnt = 0u; mine = 0u;
#pragma unroll
        for (unsigned j = 0; j < 16; ++j) { const unsigned c = xb_ld(&bar[XB_XCNT(j)]); sum += c; cnt += (c > 0u) ? 1u : 0u; mine = (j == x) ? c : mine; }
        if (sum == G) break;
        __builtin_amdgcn_s_sleep(1);
        if ((++sp & 255u) == 0u) { if (xb_ld(&bar[XB_TMO])) break; if (sp > XB_SPIN_CAP) { atomicAdd(&bar[XB_TMO], 1u); break; } }
    }
    nloc = mine > 0u ? mine : 1u; nx = cnt > 0u ? cnt : 1u;
}

__device__ __forceinline__ void xcd_barrier(const XcdBarrier& b) {
    asm volatile("s_waitcnt vmcnt(0)" ::: "memory");
    __syncthreads();
    if (threadIdx.x == 0) {
        unsigned* bar = b.bar;
        __builtin_amdgcn_s_waitcnt(0);
        unsigned nloc = b.st[0], nx = b.st[1];
        if (nloc == 0u) { xcd_barrier_complete(bar, b.x, nloc, nx); b.st[0] = nloc; b.st[1] = nx; }
        const unsigned old = xb_add(&bar[XB_XSUB(b.x)], 1u);
        const unsigned gen = old / nloc;
        if (old + 1u == (gen + 1u) * nloc) {
            __builtin_amdgcn_fence(__ATOMIC_RELEASE, "agent");
            asm volatile("s_waitcnt vmcnt(0)" ::: "memory");
            const unsigned og = xb_add(&bar[XB_TOP], 1u);
            const unsigned tg = og / nx;
            if (og + 1u == (tg + 1u) * nx) xb_add(&bar[XB_TOPGEN], 1u);
            else XB_SPIN(xb_ld(&bar[XB_TOPGEN]) == tg, bar);
            __builtin_amdgcn_fence(__ATOMIC_ACQUIRE, "agent");
            xb_add(&bar[XB_XGEN(b.x)], 1u);
            asm volatile("s_waitcnt vmcnt(0)" ::: "memory");
        } else {
            XB_SPIN(xb_ld(&bar[XB_XGEN(b.x)]) == gen, bar);
            __builtin_amdgcn_fence(__ATOMIC_ACQUIRE, "agent");
            asm volatile("s_waitcnt vmcnt(0)" ::: "memory");
        }
    }
    __syncthreads();
}
constexpr int NWAVES = 8;
constexpr int S_ = 16384, DM = 2048;
constexpr int NPH = 16;
#ifndef MK_PER_PHASE
#define MK_PER_PHASE 0
#endif
constexpr size_t MiB = 1u << 20;
constexpr size_t WS_CTL = 0, CTL_ZERO_BYTES = 1 * MiB;
constexpr size_t WS_WA = 1 * MiB, WS_WB = 5 * MiB, WS_WOUT = 9 * MiB, WS_WS = 17 * MiB, WS_LORA = 25 * MiB;
constexpr size_t WS_WIN = 27 * MiB, WS_PR = 69 * MiB, WS_PD = 181 * MiB, WS_PG = 277 * MiB;
constexpr size_t WS_A = 405 * MiB, WS_E = 437 * MiB, WS_G = 469 * MiB, WS_END = 507 * MiB;
constexpr size_t WS_SCN = 27 * MiB, WS_SCAL = 123 * MiB, WS_SLOC = 127 * MiB, WS_ASEG = 143 * MiB, WS_SIN = 159 * MiB;
constexpr size_t WS_YA = 405 * MiB, WS_OATT = 27 * MiB, WS_YB = 91 * MiB, WS_T1 = 123 * MiB, WS_MERGED = 27 * MiB;
constexpr size_t WS_H2 = 123 * MiB, WS_XN2 = 27 * MiB, WS_UTAB = 251 * MiB, WS_VTAB = 315 * MiB, WS_SCORES = 379 * MiB;
constexpr size_t WS_USCL = 26 * MiB + 512 * 1024, WS_VSCL = WS_USCL + 65536;
constexpr size_t OUT_XN = 0, OUT_RKV = 0, OUT_LIN = 96 * MiB;
constexpr int CW_BAR = 4096;
constexpr int RING_OFF = 0, RING_BYTES = 131072;
constexpr int LDSCTL_OFF = RING_BYTES, MISC_OFF = LDSCTL_OFF + 320;
constexpr int LDS_BYTES = 147456;
constexpr int NSEG = 64, SEGLEN = S_ / NSEG;

struct Args { const float* in[28]; float* out; unsigned char* ws; int ph_lo, ph_hi; };

struct Frame {
    LAS unsigned char* lds; volatile LAS unsigned* MISC; gu32* ctl;
    int tid, lane, wave, vcu, G;
};

__device__ __forceinline__ float bf2f(unsigned short b) { return __uint_as_float((unsigned)b << 16); }
__device__ __forceinline__ float wave_sum(float v) {
#pragma unroll
    for (int o = 1; o < 64; o <<= 1) v += __shfl_xor(v, o);
    return v;
}
__device__ __forceinline__ float wave_max(float v) {
#pragma unroll
    for (int o = 1; o < 64; o <<= 1) v = fmaxf(v, __shfl_xor(v, o));
    return v;
}
template <int CTRL, int RM> __device__ __forceinline__ float dppf(float oldv, float x) { return __builtin_bit_cast(float, __builtin_amdgcn_update_dpp(__builtin_bit_cast(int, oldv), __builtin_bit_cast(int, x), CTRL, RM, 0xf, false)); }
__device__ __forceinline__ float wsum(float v) {
    v += dppf<0xB1, 0xf>(v, v); v += dppf<0x4E, 0xf>(v, v); v += dppf<0x141, 0xf>(v, v); v += dppf<0x140, 0xf>(v, v);
    v += dppf<0x142, 0xa>(0.f, v); v += dppf<0x143, 0xc>(0.f, v);
    return __builtin_bit_cast(float, __builtin_amdgcn_readlane(__builtin_bit_cast(int, v), 63));
}
__device__ __forceinline__ float wmax(float v) {
    v = fmaxf(v, dppf<0xB1, 0xf>(v, v)); v = fmaxf(v, dppf<0x4E, 0xf>(v, v)); v = fmaxf(v, dppf<0x141, 0xf>(v, v)); v = fmaxf(v, dppf<0x140, 0xf>(v, v));
    v = fmaxf(v, dppf<0x142, 0xa>(0.f, v)); v = fmaxf(v, dppf<0x143, 0xc>(0.f, v));
    return __builtin_bit_cast(float, __builtin_amdgcn_readlane(__builtin_bit_cast(int, v), 63));
}
__device__ __forceinline__ float sigmf(float x) { return __builtin_amdgcn_rcpf(1.0f + __expf(-x)); }

__device__ __forceinline__ void transpose_block(const float* W, int ldw, int k0, int n0, int kvalid, bf16* WT, int ldt, int drow0, LAS float* scr, int lane) {
#pragma unroll 8
    for (int i = 0; i < 32; ++i) { const int kk = 2 * i + (lane >> 5); const int k = k0 + kk; scr[kk * 33 + (lane & 31)] = (k < kvalid) ? W[(size_t)k * ldw + n0 + (lane & 31)] : 0.f; }
    LDS_WAIT(); asm volatile("" ::: "memory");
    const int c = lane & 7;
#pragma unroll
    for (int j = 0; j < 4; ++j) { const int n = (lane >> 3) + 8 * j; const LAS float* s = scr + (8 * c) * 33 + n;
        v4u o; o.x = pk2(s[0 * 33], s[1 * 33]); o.y = pk2(s[2 * 33], s[3 * 33]); o.z = pk2(s[4 * 33], s[5 * 33]); o.w = pk2(s[6 * 33], s[7 * 33]);
        *(GAS v4u*)(WT + (size_t)(drow0 + n) * ldt + k0 + 8 * c) = o; }
    LDS_WAIT(); asm volatile("" ::: "memory");
}
__device__ __forceinline__ void rms_row_to_bf16(const float* xrow, const float* g, bf16* orow, int lane) {
    const GAS f32x4* xr = (const GAS f32x4*)xrow + lane; const f32x4* gr = (const f32x4*)g + lane;
    f32x4 v[8]; float s = 0.f;
#pragma unroll
    for (int j = 0; j < 8; ++j) { v[j] = xr[64 * j]; s += (v[j].x * v[j].x + v[j].y * v[j].y) + (v[j].z * v[j].z + v[j].w * v[j].w); }
    const float rstd = rsqrtf(wave_sum(s) * (1.f / 2048.f) + 1e-6f);
    GAS unsigned long long* o8 = (GAS unsigned long long*)orow + lane;
#pragma unroll
    for (int j = 0; j < 8; ++j) { const f32x4 gg = gr[64 * j];
        o8[64 * j] = (unsigned long long)pk2(v[j].x * rstd * gg.x, v[j].y * rstd * gg.y) | ((unsigned long long)pk2(v[j].z * rstd * gg.z, v[j].w * rstd * gg.w) << 32); }
}

template <int K, int VAR = 0> __device__ __forceinline__ void fmac_dpp(float& acc, float op, float s) {
    if (VAR == 0) asm("v_fmac_f32_dpp %0, %1, %2 quad_perm:[%c3,%c3,%c3,%c3] row_mask:0xf bank_mask:0xf" : "+v"(acc) : "v"(op), "v"(s), "i"(K));
    else asm("v_fmac_f32_e32 %0, %1, %2" : "+v"(acc) : "v"(op), "v"(s)); }
template <int K, int VAR = 0> __device__ __forceinline__ void mulip_dpp(float& s, float op) {
    if (VAR == 0) asm("v_mul_f32_dpp %0, %1, %0 quad_perm:[%c2,%c2,%c2,%c2] row_mask:0xf bank_mask:0xf" : "+v"(s) : "v"(op), "i"(K));
    else asm("v_mul_f32_e32 %0, %1, %0" : "+v"(s) : "v"(op)); }
#define SCAN_FOR_C(...) _Pragma("unroll") for (int j = 0; j < 4; ++j) { \
    { constexpr int k = 0; _Pragma("unroll") for (int i = 0; i < 4; ++i) { const int c = 16 * j + 4 * k + i; __VA_ARGS__ } } \
    { constexpr int k = 1; _Pragma("unroll") for (int i = 0; i < 4; ++i) { const int c = 16 * j + 4 * k + i; __VA_ARGS__ } } \
    { constexpr int k = 2; _Pragma("unroll") for (int i = 0; i < 4; ++i) { const int c = 16 * j + 4 * k + i; __VA_ARGS__ } } \
    { constexpr int k = 3; _Pragma("unroll") for (int i = 0; i < 4; ++i) { const int c = 16 * j + 4 * k + i; __VA_ARGS__ } } }

constexpr int SCAN_CH = 4, SCAN_STEP_F = 448, SCAN_WAVE_BYTES = (SCAN_CH * SCAN_STEP_F + SCAN_CH * 4) * 4;
template <int KIND, int VAR = 0> __device__ __forceinline__ void scan_task(bf16* yabase, const int lane, unsigned char* ws, const float* const* in, const bf16* RKV, int h, int seg, LAS float* wl) {
    const int t0 = seg * SEGLEN;
    const bf16* SCN = (const bf16*)(ws + WS_SCN) + ((size_t)h * S_) * 192;
    const float* SCAL = (const float*)(ws + WS_SCAL) + ((size_t)h * S_) * 4;
    const bf16* Eb = (const bf16*)(ws + WS_E); const bf16* Gb = (const bf16*)(ws + WS_G);
    float S[64];
    if (KIND == 0) {
#pragma unroll
        for (int c = 0; c < 64; ++c) S[c] = 0.f;
    } else if (KIND == 1) {
#pragma unroll
        for (int c = 0; c < 64; ++c) S[c] = (c == lane) ? 1.f : 0.f;
    } else {
        const f32x4* sp = (const f32x4*)((const float*)(ws + WS_SIN) + (((size_t)h * NSEG + seg) * 64 + lane) * 64);
#pragma unroll
        for (int q = 0; q < 16; ++q) { const f32x4 x = sp[q]; S[4 * q] = x.x; S[4 * q + 1] = x.y; S[4 * q + 2] = x.z; S[4 * q + 3] = x.w; }
    }
    float lg = 0.f, lb = 0.f;
    if (KIND == 2) { lg = in[12][h * 64 + lane]; lb = in[13][h * 64 + lane]; }
    constexpr int CH = SCAN_CH;
    unsigned short pk[CH], pb[CH], pt[CH], pr[CH], pe[CH], pv[CH], pg[CH]; f32x4 psc = (f32x4){0.f, 0.f, 0.f, 0.f};
#define SCAN_PREFETCH(tc) do { _Pragma("unroll") for (int s = 0; s < CH; ++s) { const size_t t = (size_t)((tc) + s); \
        pk[s] = SCN[t * 192 + lane]; pb[s] = SCN[t * 192 + 64 + lane]; pt[s] = SCN[t * 192 + 128 + lane]; \
        pr[s] = RKV[t * 3072 + h * 64 + lane]; pe[s] = Eb[t * 1024 + h * 64 + lane]; \
        if (KIND != 1) pv[s] = RKV[t * 3072 + 2048 + h * 64 + lane]; if (KIND == 2) pg[s] = Gb[t * 1024 + h * 64 + lane]; } \
        if (KIND != 1) { if (lane < CH) psc = *(const f32x4*)(SCAL + (size_t)((tc) + lane) * 4); } } while (0)
    SCAN_PREFETCH(t0);
    bf16* YA = yabase + h * 64 + lane;
#pragma unroll 1
    for (int tc = t0; tc < t0 + SEGLEN; tc += CH) {
#pragma unroll
        for (int s = 0; s < CH; ++s) { const float w = __expf(-bf2f(pe[s])); LAS float* q = wl + s * SCAN_STEP_F;
            q[lane] = bf2f(pk[s]); q[64 + lane] = w * bf2f(pr[s]); q[128 + lane] = w; q[192 + lane] = bf2f(pb[s]); q[256 + lane] = bf2f(pt[s]);
            if (KIND != 1) q[320 + lane] = bf2f(pv[s]); if (KIND == 2) q[384 + lane] = bf2f(pg[s]); }
        if (KIND != 1) { if (lane < CH) *(LAS f32x4*)(wl + CH * SCAN_STEP_F + lane * 4) = psc; }
        if (tc + CH < t0 + SEGLEN) SCAN_PREFETCH(tc + CH);
        LDS_WAIT(); asm volatile("" ::: "memory");
        f32x4 KK[4], WR[4];
        { const LAS f32x4* q4 = (const LAS f32x4*)wl + (lane & 3);
#pragma unroll
          for (int j = 0; j < 4; ++j) { KK[j] = q4[j * 4]; if (KIND == 2) WR[j] = q4[16 + j * 4]; } }
#pragma unroll 1
        for (int s = 0; s < CH; ++s) {
            const LAS float* qs = wl + s * SCAN_STEP_F;
            const LAS f32x4* q4 = (const LAS f32x4*)qs + (lane & 3);
            f32x4 WW[4], BB[4], KT[4];
#pragma unroll
            for (int j = 0; j < 4; ++j) { WW[j] = q4[32 + j * 4]; BB[j] = q4[48 + j * 4]; if (KIND != 1) KT[j] = q4[64 + j * 4]; }
            float vt = 0.f, gt_ = 0.f; f32x4 sc = (f32x4){0.f, 0.f, 0.f, 0.f};
            if (KIND != 1) { vt = qs[320 + lane]; sc = *(const LAS f32x4*)(wl + CH * SCAN_STEP_F + s * 4); }
            if (KIND == 2) gt_ = qs[384 + lane];
            float sa0 = 0.f, sa1 = 0.f, yp0 = 0.f, yp1 = 0.f;
            SCAN_FOR_C( if (i & 1) { fmac_dpp<k, VAR>(sa1, KK[j][i], S[c]); if (KIND == 2) fmac_dpp<k, VAR>(yp1, WR[j][i], S[c]); }
                        else       { fmac_dpp<k, VAR>(sa0, KK[j][i], S[c]); if (KIND == 2) fmac_dpp<k, VAR>(yp0, WR[j][i], S[c]); } )
            const float sa = sa0 + sa1;
            { const LAS f32x4* qn = (const LAS f32x4*)(wl + ((s + 1) & (CH - 1)) * SCAN_STEP_F) + (lane & 3);
#pragma unroll
              for (int j = 0; j < 4; ++j) { KK[j] = qn[j * 4]; if (KIND == 2) WR[j] = qn[16 + j * 4]; } }
            SCAN_FOR_C( mulip_dpp<k, VAR>(S[c], WW[j][i]); )
            SCAN_FOR_C( fmac_dpp<k, VAR>(S[c], BB[j][i], sa); )
            if (KIND != 1) { SCAN_FOR_C( fmac_dpp<k, VAR>(S[c], KT[j][i], vt); ) }
            if (KIND == 2) {
                const float y = (yp0 + yp1) + sa * sc.x + vt * sc.y;
                const float mean = wsum(y) * (1.f / 64.f); const float d = y - mean;
                const float var = wsum(d * d) * (1.f / 64.f);
                const float o = (d * rsqrtf(var + 64e-5f) * lg + lb + sc.z * vt) * gt_;
                YA[(size_t)(tc + s) * 1024] = (unsigned short)f2bf(o);
            }
        }
        LDS_WAIT(); asm volatile("" ::: "memory");
    }
#undef SCAN_PREFETCH
    if (KIND != 2) {
        f32x4* op = (f32x4*)((float*)(ws + (KIND == 0 ? WS_SLOC : WS_ASEG)) + (((size_t)h * NSEG + seg) * 64 + lane) * 64);
#pragma unroll
        for (int q = 0; q < 16; ++q) op[q] = (f32x4){S[4 * q], S[4 * q + 1], S[4 * q + 2], S[4 * q + 3]};
    }
}

__global__ void __launch_bounds__(NWAVES * 64, 2) mk_fwd(Args args) {
    extern __shared__ __attribute__((aligned(16))) unsigned char lds[];
    Frame F;
    F.lds = (LAS unsigned char*)lds; F.MISC = (volatile LAS unsigned*)(F.lds + MISC_OFF);
    F.tid = threadIdx.x; F.wave = __builtin_amdgcn_readfirstlane(F.tid >> 6);
    F.G = gridDim.x; { const int bx = blockIdx.x; F.vcu = (F.G % 8 == 0) ? (bx % 8) * (F.G / 8) + bx / 8 : bx; }
    unsigned char* ws = args.ws; F.ctl = (gu32*)(ws + WS_CTL);
    const float* const* in = args.in;
    unsigned char* ob = (unsigned char*)args.out;
    for (int u = threadIdx.x; u < (LDS_BYTES - LDSCTL_OFF) / 4; u += NWAVES * 64) ((LAS unsigned*)(F.lds + LDSCTL_OFF))[u] = 0u;
    __syncthreads();
    XcdBarrier bar; bar.bar = (unsigned*)(F.ctl + CW_BAR); bar.x = 0; bar.st = nullptr;
    if (!MK_PER_PHASE) bar = xcd_barrier_post((unsigned*)(F.ctl + CW_BAR), F.MISC + 8);
    const int lo = args.ph_lo, hi = args.ph_hi;
#ifndef PH_MASK
#define PH_MASK 0xFFFF
#endif
#define IN(k) ((((PH_MASK) >> (k)) & 1) && lo <= (k) && (k) < hi)
#ifndef PROBE_MASK
#define PROBE_MASK 0
#endif
#ifndef PROBE_VARIANT
#define PROBE_VARIANT 0
#endif
#ifndef PROBE_N
#define PROBE_N 1
#endif
#define PHASE_BEGIN(k) if (IN(k)) { for (int rep_ = 0; rep_ < 1 + ((((PROBE_MASK) >> (k)) & 1) ? (PROBE_N) : 0); ++rep_) { if (rep_) xcd_barrier(bar); PHASE_IDS
#define PHASE_END } }
#define SEAM(k) do { if (IN(k) && IN((k) + 1)) xcd_barrier(bar); } while (0)
    const int gw = F.vcu * NWAVES + F.wave, NGW = F.G * NWAVES; const int NGT = F.G * NWAVES * 64;
#define PHASE_IDS int tid__ = threadIdx.x; asm volatile("" : "+v"(tid__)); const int tid = tid__, lane = tid & 63, gt = F.vcu * (NWAVES * 64) + tid; (void)gt; (void)lane;

    bf16* WIN_T = (bf16*)(ws + WS_WIN); bf16* WA_T = (bf16*)(ws + WS_WA); bf16* WB_T = (bf16*)(ws + WS_WB); bf16* WOUT_T = (bf16*)(ws + WS_WOUT);
    bf16* WS_T = (bf16*)(ws + WS_WS); bf16* LORA_T = (bf16*)(ws + WS_LORA);
    bf16* XN = (bf16*)(ob + OUT_XN); bf16* RKV = (bf16*)(ob + OUT_RKV); bf16* LIN = (bf16*)(ob + OUT_LIN);
    bf16* PR = (bf16*)(ws + WS_PR); bf16* PD = (bf16*)(ws + WS_PD); bf16* PG = (bf16*)(ws + WS_PG);

    PHASE_BEGIN(0)
        LAS float* scr = (LAS float*)(F.lds + RING_OFF + F.wave * 16384);
        constexpr int I_IN = 32 * 334, I_A = 16 * 64, I_B = 16 * 64, I_O = 32 * 64, I_L = 4 * 32;
        constexpr int NIT = I_IN + I_A + I_B + I_O + 3 * I_L;
        for (int it = gw; it < NIT; it += NGW) {
            int r = it;
            if (r < I_IN) { const int kb = r / 334, nb = r % 334, n0 = nb * 32; transpose_block(in[2], 10688, kb * 64, n0, 2048, WIN_T, 2048, n0 + (n0 >= 3520 ? 64 : 0), scr, lane); continue; } r -= I_IN;
            if (r < I_A) { const int kb = r / 64, nb = r % 64; transpose_block(in[19], 2048, kb * 64, nb * 32, 1024, WA_T, 1024, nb * 32, scr, lane); continue; } r -= I_A;
            if (r < I_B) { const int kb = r / 64, nb = r % 64; transpose_block(in[20], 2048, kb * 64, nb * 32, 1024, WB_T, 1024, nb * 32, scr, lane); continue; } r -= I_B;
            if (r < I_O) { const int kb = r / 64, nb = r % 64; transpose_block(in[21], 2048, kb * 64, nb * 32, 2048, WOUT_T, 2048, nb * 32, scr, lane); continue; } r -= I_O;
            { const int which = r / I_L, rr = r % I_L, kb = rr / 32, nb = rr % 32; const float* W = which == 0 ? in[5] : (which == 1 ? in[7] : in[8]);
              transpose_block(W, 1024, kb * 64, nb * 32, which == 2 ? 256 : 96, LORA_T + (size_t)which * 1024 * 256, 256, nb * 32, scr, lane); }
        }
        for (int i = gt; i < 16384; i += NGT) *(GAS v4u*)(WIN_T + (size_t)3520 * 2048 + (size_t)i * 8) = (v4u){0u, 0u, 0u, 0u};
        for (int task = gw; task < 16 * 32 * 4; task += NGW) {
            const int hp = task >> 7, kb = (task >> 2) & 31, ng = task & 3; const int k = kb * 64 + lane;
            const f32x4* wq = (const f32x4*)(in[23] + (size_t)k * 2048 + hp * 128);
            f32x4 q[32];
#pragma unroll
            for (int d = 0; d < 32; ++d) q[d] = wq[d];
            const float* sk = in[24] + ((size_t)hp * 128 + ng * 32) * 128;
            for (int n = 0; n < 32; ++n) { const f32x4* s4 = (const f32x4*)(sk + (size_t)n * 128); float a0 = 0.f, a1 = 0.f;
#pragma unroll
                for (int d = 0; d < 32; ++d) { const f32x4 s = s4[d]; a0 = fmaf(q[d].x, s.x, a0); a1 = fmaf(q[d].y, s.y, a1); a0 = fmaf(q[d].z, s.z, a0); a1 = fmaf(q[d].w, s.w, a1); }
                WS_T[(size_t)(hp * 128 + ng * 32 + n) * 2048 + k] = (bf16)f2bf(a0 + a1); }
        }
        for (int m = gw; m < S_; m += NGW) rms_row_to_bf16(in[0] + (size_t)m * DM, in[1], XN + (size_t)m * DM, lane);
    PHASE_END
    SEAM(0);
    PHASE_BEGIN(1)
        pg8::Gemm g{XN, WIN_T, S_, 10752, 2048, 2048, 2048}; pg8::StaticOrder S; S.init(S_, 10752, F.G, (int)blockIdx.x);
        pg8::Epi<pg8::EM_G1> E{PR, PD, PG, nullptr, nullptr, nullptr, attn_body::C2};
        pg8::gemm_phase<pg8::Epi<pg8::EM_G1>, pg8::StaticOrder, true, true>(F.lds + RING_OFF, g, S, E);
    PHASE_END
    SEAM(1);
    PHASE_BEGIN(2)
        const float* mu = in[3];
        for (int t = gw; t < S_; t += NGW) {
            const bf16* cur = PR + (size_t)t * 3584; const bf16* prv = cur - 3584;
#pragma unroll 1
            for (int j = 0; j < 7; ++j) { const int ch = lane + 64 * j; if (ch >= 440) break;
                const v4u c4 = *(const GAS v4u*)(cur + ch * 8); v4u p4 = (v4u){0u, 0u, 0u, 0u}; if (t > 0) p4 = *(const GAS v4u*)(prv + ch * 8);
                const f32x4 m0 = *(const f32x4*)(mu + ch * 8), m1 = *(const f32x4*)(mu + ch * 8 + 4);
                float c[8] = {pg8::bflo(c4.x), pg8::bfhi(c4.x), pg8::bflo(c4.y), pg8::bfhi(c4.y), pg8::bflo(c4.z), pg8::bfhi(c4.z), pg8::bflo(c4.w), pg8::bfhi(c4.w)};
                const float p[8] = {pg8::bflo(p4.x), pg8::bfhi(p4.x), pg8::bflo(p4.y), pg8::bfhi(p4.y), pg8::bflo(p4.z), pg8::bfhi(p4.z), pg8::bflo(p4.w), pg8::bfhi(p4.w)};
                const float mm[8] = {m0.x, m0.y, m0.z, m0.w, m1.x, m1.y, m1.z, m1.w};
#pragma unroll
                for (int e = 0; e < 8; ++e) c[e] = c[e] + (p[e] - c[e]) * mm[e];
                bf16* dst;
                if (ch < 384) dst = RKV + (size_t)t * 3072 + ch * 8;
                else { const int col = ch * 8 - 3072;
                    if (col < 96) { dst = LIN + (size_t)t * 768 + col;
#pragma unroll
                        for (int e = 0; e < 8; ++e) c[e] = tanhf(c[e]); }
                    else if (col < 192) dst = LIN + (size_t)t * 768 + 256 + (col - 96);
                    else { dst = LIN + (size_t)t * 768 + 512 + (col - 192);
#pragma unroll
                        for (int e = 0; e < 8; ++e) c[e] = sigmf(c[e]); } }
                *(GAS v4u*)dst = (v4u){pk2(c[0], c[1]), pk2(c[2], c[3]), pk2(c[4], c[5]), pk2(c[6], c[7])};
            }
            if (lane < 40) { const int z = lane < 20 ? 96 + lane * 8 : 352 + (lane - 20) * 8; *(GAS v4u*)(LIN + (size_t)t * 768 + z) = (v4u){0u, 0u, 0u, 0u}; }
        }
    PHASE_END
    SEAM(2);
    PHASE_BEGIN(3)
#pragma unroll 1
        for (int which = 0; which < 3; ++which) {
            int kd = 256; asm volatile("" : "+s"(kd));
            pg8::Gemm g{LIN + which * 256, LORA_T + (size_t)which * 1024 * 256, S_, 1024, kd, 768, 256}; pg8::StaticOrder S; S.init(S_, 1024, F.G, (int)blockIdx.x);
            pg8::Epi<pg8::EM_LORA_W> E{ws + (which == 0 ? WS_E : (which == 1 ? WS_A : WS_G)), nullptr, nullptr, nullptr, nullptr, which == 0 ? in[4] : (which == 1 ? in[6] : nullptr), which == 0 ? 0.60653065971f : 1.f};
            pg8::gemm_phase<pg8::Epi<pg8::EM_LORA_W>, pg8::StaticOrder, true, true>(F.lds + RING_OFF, g, S, E); }
    PHASE_END
    SEAM(3);
    PHASE_BEGIN(4)
        bf16* SCN = (bf16*)(ws + WS_SCN); float* SCAL = (float*)(ws + WS_SCAL); const bf16* Ab = (const bf16*)(ws + WS_A);
        for (int t = gw; t < S_; t += NGW) {
#pragma unroll 2
            for (int h = 0; h < 16; ++h) { const int cc = h * 64 + lane;
                const float r = bf2f(RKV[(size_t)t * 3072 + cc]), k = bf2f(RKV[(size_t)t * 3072 + 1024 + cc]), a = bf2f(Ab[(size_t)t * 1024 + cc]);
                float kk = k * in[9][cc]; const float nrm = sqrtf(wsum(kk * kk)); kk = kk / fmaxf(nrm, 1e-12f);
                const float kt = k * (1.f + (a - 1.f) * in[10][cc]); const float b = kk * a;
                const unsigned short kkb = (unsigned short)f2bf(-kk), bb = (unsigned short)f2bf(b), ktb = (unsigned short)f2bf(kt);
                bf16* q = SCN + ((size_t)h * S_ + t) * 192; q[lane] = kkb; q[64 + lane] = bb; q[128 + lane] = ktb;
                const float br = wsum(bf2f(bb) * r), kr = wsum(bf2f(ktb) * r), bon = wsum(r * kt * in[11][cc]);
                if (lane == 0) *(f32x4*)(SCAL + ((size_t)h * S_ + t) * 4) = (f32x4){br, kr, bon, 0.f}; }
        }
    PHASE_END
    SEAM(4);
    PHASE_BEGIN(5)
        for (int task = gw; task < 16 * NSEG * 2; task += NGW) { const int pair = task >> 1, kind = task & 1, h = pair / NSEG, seg = pair % NSEG;
            LAS float* wl = (LAS float*)(F.lds + RING_OFF + F.wave * SCAN_WAVE_BYTES);
            if (kind == 0) scan_task<0>(nullptr, lane, ws, in, RKV, h, seg, wl); else scan_task<1>(nullptr, lane, ws, in, RKV, h, seg, wl); }
    PHASE_END
    SEAM(5);
    PHASE_BEGIN(6)
        if (F.vcu < 16) { const int h = F.vcu; const int v = tid >> 3, cg = tid & 7;
            LAS float* Sb = (LAS float*)(F.lds + RING_OFF); LAS float* Ab = Sb + 2 * 64 * 65;
            const float* SL = (const float*)(ws + WS_SLOC) + (size_t)h * NSEG * 4096; const float* AS = (const float*)(ws + WS_ASEG) + (size_t)h * NSEG * 4096; float* SI = (float*)(ws + WS_SIN) + (size_t)h * NSEG * 4096;
            f32x4 s0 = (f32x4){0.f, 0.f, 0.f, 0.f}, s1 = s0; int cur = 0;
            f32x4 na0 = *(const f32x4*)(AS + (size_t)v * 64 + cg * 8), na1 = *(const f32x4*)(AS + (size_t)v * 64 + cg * 8 + 4);
            f32x4 nl0 = *(const f32x4*)(SL + (size_t)v * 64 + cg * 8), nl1 = *(const f32x4*)(SL + (size_t)v * 64 + cg * 8 + 4);
            for (int p = 0; p < NSEG; ++p) {
                *(f32x4*)(SI + (size_t)p * 4096 + v * 64 + cg * 8) = s0; *(f32x4*)(SI + (size_t)p * 4096 + v * 64 + cg * 8 + 4) = s1;
                if (p == NSEG - 1) break;
                LAS float* sw = Sb + cur * 64 * 65 + v * 65 + cg * 8; sw[0] = s0.x; sw[1] = s0.y; sw[2] = s0.z; sw[3] = s0.w; sw[4] = s1.x; sw[5] = s1.y; sw[6] = s1.z; sw[7] = s1.w;
                *(LAS f32x4*)(Ab + v * 64 + cg * 8) = na0; *(LAS f32x4*)(Ab + v * 64 + cg * 8 + 4) = na1;
                f32x4 a0 = nl0, a1 = nl1;
                if (p + 1 < NSEG - 1) { const size_t o = (size_t)(p + 1) * 4096 + v * 64 + cg * 8; na0 = *(const f32x4*)(AS + o); na1 = *(const f32x4*)(AS + o + 4); nl0 = *(const f32x4*)(SL + o); nl1 = *(const f32x4*)(SL + o + 4); }
                __syncthreads();
                const LAS float* sr = Sb + cur * 64 * 65 + v * 65;
#pragma unroll 8
                for (int c = 0; c < 64; ++c) { const float s = sr[c]; const f32x4 x0 = *(const LAS f32x4*)(Ab + c * 64 + cg * 8), x1 = *(const LAS f32x4*)(Ab + c * 64 + cg * 8 + 4); a0 = a0 + x0 * s; a1 = a1 + x1 * s; }
                s0 = a0; s1 = a1; cur ^= 1;
                __syncthreads();
            }
        }
    PHASE_END
    SEAM(6);
    PHASE_BEGIN(7)
#if PROBE_VARIANT
        if (rep_) { for (int task = gw; task < 16 * NSEG; task += NGW) { const int h = task / NSEG, seg = task % NSEG;
            LAS float* wl = (LAS float*)(F.lds + RING_OFF + F.wave * SCAN_WAVE_BYTES);
            scan_task<2, 1>((bf16*)(ob + OUT_LIN), lane, ws, in, RKV, h, seg, wl); } } else
#endif
        if (F.wave < 4)
        for (int task = F.vcu * 4 + F.wave; task < 16 * NSEG; task += F.G * 4) { const int h = task / NSEG, seg = task % NSEG;
            LAS float* wl = (LAS float*)(F.lds + RING_OFF + F.wave * SCAN_WAVE_BYTES);
            scan_task<2>((bf16*)(ws + WS_YA), lane, ws, in, RKV, h, seg, wl); }
    PHASE_END
    SEAM(7);
    PHASE_BEGIN(8)
        __syncthreads();
        attn_body::attn_phase<8>((char*)lds + RING_OFF, (const attn_body::bf16*)PD, (attn_body::bf16*)(ws + WS_OATT), F.vcu);
    PHASE_END
    SEAM(8);
    PHASE_BEGIN(9)
        float d1 = 0.f, d2 = 0.f; d1 = in[14][lane] * in[15][lane]; d2 = in[16][lane] * in[17][lane];
        const float lam = __expf(wave_sum(d1)) - __expf(wave_sum(d2)) + 0.2f;
        const bf16* OA = (const bf16*)(ws + WS_OATT); bf16* YB = (bf16*)(ws + WS_YB);
        f32x4 sg[4];
#pragma unroll
        for (int q = 0; q < 4; ++q) sg[q] = *(const f32x4*)(in[18] + (lane & 7) * 16 + q * 4);
        for (int t = gw; t < S_; t += NGW) {
            const v4u a0 = *(const GAS v4u*)(OA + (size_t)t * 2048 + lane * 16), a1 = *(const GAS v4u*)(OA + (size_t)t * 2048 + lane * 16 + 8);
            const v4u b0 = *(const GAS v4u*)(OA + (size_t)t * 2048 + 1024 + lane * 16), b1 = *(const GAS v4u*)(OA + (size_t)t * 2048 + 1024 + lane * 16 + 8);
            const unsigned aw[8] = {a0.x, a0.y, a0.z, a0.w, a1.x, a1.y, a1.z, a1.w}, bw[8] = {b0.x, b0.y, b0.z, b0.w, b1.x, b1.y, b1.z, b1.w};
            float o[16]; float ss = 0.f;
#pragma unroll
            for (int e = 0; e < 8; ++e) { o[2 * e] = pg8::bflo(aw[e]) - lam * pg8::bflo(bw[e]); o[2 * e + 1] = pg8::bfhi(aw[e]) - lam * pg8::bfhi(bw[e]); ss += o[2 * e] * o[2 * e] + o[2 * e + 1] * o[2 * e + 1]; }
            ss += __shfl_xor(ss, 1); ss += __shfl_xor(ss, 2); ss += __shfl_xor(ss, 4);
            const float rs = rsqrtf(ss * (1.f / 128.f) + 1e-5f) * 0.8f;
            const float gg[16] = {sg[0].x, sg[0].y, sg[0].z, sg[0].w, sg[1].x, sg[1].y, sg[1].z, sg[1].w, sg[2].x, sg[2].y, sg[2].z, sg[2].w, sg[3].x, sg[3].y, sg[3].z, sg[3].w};
#pragma unroll
            for (int e = 0; e < 16; ++e) o[e] = o[e] * rs * gg[e];
            *(GAS v4u*)(YB + (size_t)t * 1024 + lane * 16) = (v4u){pk2(o[0], o[1]), pk2(o[2], o[3]), pk2(o[4], o[5]), pk2(o[6], o[7])};
            *(GAS v4u*)(YB + (size_t)t * 1024 + lane * 16 + 8) = (v4u){pk2(o[8], o[9]), pk2(o[10], o[11]), pk2(o[12], o[13]), pk2(o[14], o[15])};
        }
    PHASE_END
    SEAM(9);
    PHASE_BEGIN(10)
        pg8::Gemm g{(const bf16*)(ws + WS_YA), WA_T, S_, 2048, 1024, 1024, 1024}; pg8::StaticOrder S; S.init(S_, 2048, F.G, (int)blockIdx.x);
        pg8::Epi<pg8::EM_PROJA> E{ws + WS_T1, nullptr, nullptr, PG, nullptr, nullptr, 1.f};
        pg8::gemm_phase<pg8::Epi<pg8::EM_PROJA>, pg8::StaticOrder, true, true>(F.lds + RING_OFF, g, S, E);
    PHASE_END
    SEAM(10);
    PHASE_BEGIN(11)
        pg8::Gemm g{(const bf16*)(ws + WS_YB), WB_T, S_, 2048, 1024, 1024, 1024}; pg8::StaticOrder S; S.init(S_, 2048, F.G, (int)blockIdx.x);
        pg8::Epi<pg8::EM_PROJB> E{ws + WS_MERGED, nullptr, nullptr, PG, ws + WS_T1, nullptr, 1.f};
        pg8::gemm_phase<pg8::Epi<pg8::EM_PROJB>, pg8::StaticOrder, true, true>(F.lds + RING_OFF, g, S, E);
    PHASE_END
    SEAM(11);
    PHASE_BEGIN(12)
        pg8::Gemm g{(const bf16*)(ws + WS_MERGED), WOUT_T, S_, 2048, 2048, 2048, 2048}; pg8::StaticOrder S; S.init(S_, 2048, F.G, (int)blockIdx.x);
        pg8::Epi<pg8::EM_WOUT> E{ws + WS_H2, nullptr, nullptr, nullptr, in[0], nullptr, 1.f};
        pg8::gemm_phase<pg8::Epi<pg8::EM_WOUT>, pg8::StaticOrder, true, true>(F.lds + RING_OFF, g, S, E);
    PHASE_END
    SEAM(12);
    PHASE_BEGIN(13)
        for (int m = gw; m < S_; m += NGW) rms_row_to_bf16((const float*)(ws + WS_H2) + (size_t)m * DM, in[22], (bf16*)(ws + WS_XN2) + (size_t)m * DM, lane);
        for (int row = gw; row < 32768; row += NGW) { const int which = row >> 14, r = row & 16383;
            const f32x4* src = (const f32x4*)(in[25 + which] + (size_t)r * 2048) + lane; f32x4 v[8]; float am = 0.f;
#pragma unroll
            for (int j = 0; j < 8; ++j) { v[j] = __builtin_nontemporal_load(src + 64 * j); am = fmaxf(am, fmaxf(fmaxf(fabsf(v[j].x), fabsf(v[j].y)), fmaxf(fabsf(v[j].z), fabsf(v[j].w)))); }
            am = wmax(am); const float sc = am > 0.f ? 416.f / am : 1.f, inv = am > 0.f ? am * (1.f / 416.f) : 1.f;
            unsigned* dst = (unsigned*)(ws + (which ? WS_VTAB : WS_UTAB) + (size_t)r * 2048) + lane;
#pragma unroll
            for (int j = 0; j < 8; ++j) { int w = __builtin_amdgcn_cvt_pk_fp8_f32(v[j].x * sc, v[j].y * sc, 0, false); w = __builtin_amdgcn_cvt_pk_fp8_f32(v[j].z * sc, v[j].w * sc, w, true); dst[64 * j] = (unsigned)w; }
            if (lane == 0) ((float*)(ws + (which ? WS_VSCL : WS_USCL)))[r] = inv; }
    PHASE_END
    SEAM(13);
    PHASE_BEGIN(14)
        pg8::Gemm g{(const bf16*)(ws + WS_XN2), WS_T, S_, 2048, 2048, 2048, 2048}; pg8::StaticOrder S; S.init(S_, 2048, F.G, (int)blockIdx.x);
        pg8::Epi<pg8::EM_SCORES> E{ws + WS_SCORES, nullptr, nullptr, nullptr, nullptr, nullptr, 1.f};
        pg8::gemm_phase<pg8::Epi<pg8::EM_SCORES>, pg8::StaticOrder, true, true>(F.lds + RING_OFF, g, S, E);
    PHASE_END
    SEAM(14);
    PHASE_BEGIN(15)
        const float* SC = (const float*)(ws + WS_SCORES); const bf16* XN2 = (const bf16*)(ws + WS_XN2);
        const unsigned char* UT = (const unsigned char*)(ws + WS_UTAB); const unsigned char* VT = (const unsigned char*)(ws + WS_VTAB);
        const float* USC = (const float*)(ws + WS_USCL); const float* VSC = (const float*)(ws + WS_VSCL);
        LAS unsigned* lst = (LAS unsigned*)(F.lds + RING_OFF + F.wave * 10240);
        for (int tb = gw; tb < S_ / 8; tb += NGW) {
            { const int tl = lane >> 3, h = lane & 7; const float* srow = SC + (size_t)(tb * 8 + tl) * 2048 + h * 256;
              float A[16], B[16];
#pragma unroll
              for (int p = 0; p < 2; ++p) { float top[16];
#pragma unroll
                  for (int k = 0; k < 16; ++k) top[k] = -INFINITY;
#pragma unroll 2
                  for (int i4 = 0; i4 < 32; ++i4) { const f32x4 v = *(const f32x4*)(srow + p * 128 + i4 * 4); const float ve[4] = {v.x, v.y, v.z, v.w};
#pragma unroll
                      for (int e = 0; e < 4; ++e) { float x = __uint_as_float((__float_as_uint(ve[e]) & 0xffffff80u) | (unsigned)(i4 * 4 + e));
#pragma unroll
                          for (int k = 0; k < 16; ++k) { const float hi = fmaxf(top[k], x); x = fminf(top[k], x); top[k] = hi; } } }
#pragma unroll
                  for (int k = 0; k < 16; ++k) { if (p == 0) A[k] = top[k]; else B[k] = top[k]; } }
              LAS unsigned* ixl = (LAS unsigned*)(F.lds + RING_OFF + F.wave * 10240 + 8192) + lane * 8;
              { unsigned wa[4], wb[4];
#pragma unroll
                for (int q = 0; q < 4; ++q) { wa[q] = 0u; wb[q] = 0u;
#pragma unroll
                    for (int e = 0; e < 4; ++e) { wa[q] |= (__float_as_uint(A[q * 4 + e]) & 127u) << (8 * e); wb[q] |= (__float_as_uint(B[q * 4 + e]) & 127u) << (8 * e); } }
                *(LAS v4u*)ixl = (v4u){wa[0], wa[1], wa[2], wa[3]}; *(LAS v4u*)(ixl + 4) = (v4u){wb[0], wb[1], wb[2], wb[3]}; }
              float cs[16];
#pragma unroll
              for (int k = 0; k < 16; ++k) cs[k] = -INFINITY;
#pragma unroll
              for (int i = 0; i < 16; ++i)
#pragma unroll
                  for (int j = 0; j < 16; ++j) if ((i + 1) * (j + 1) <= 16) {
                      float x = __uint_as_float((__float_as_uint(A[i] + B[j]) & 0xffffff00u) | (unsigned)(i * 16 + j));
#pragma unroll
                      for (int k = 0; k < 16; ++k) { const float hi = fmaxf(cs[k], x); x = fminf(cs[k], x); cs[k] = hi; } }
              LDS_WAIT(); asm volatile("" ::: "memory");
              const LAS unsigned char* ixb = (const LAS unsigned char*)ixl;
              unsigned cx[16]; float gsum = 0.f; const float cmax = cs[0];
#pragma unroll
              for (int k = 0; k < 16; ++k) { const unsigned ij = __float_as_uint(cs[k]) & 255u; cx[k] = ((unsigned)ixb[ij >> 4] << 7) | (unsigned)ixb[16 + (ij & 15u)]; cs[k] = __expf(cs[k] - cmax); gsum += cs[k]; }
              const float ginv = 1.f / gsum; LAS unsigned* lp = lst + (tl * 128 + h * 16) * 2;
#pragma unroll
              for (int k = 0; k < 16; k += 2) *(LAS v4u*)(lp + k * 2) = (v4u){cx[k], __float_as_uint(cs[k] * ginv), cx[k + 1], __float_as_uint(cs[k + 1] * ginv)}; }
            LDS_WAIT(); asm volatile("" ::: "memory");
#pragma unroll 1
            for (int tl = 0; tl < 8; ++tl) { const int t = tb * 8 + tl;
                float xf[32];
#pragma unroll
                for (int j = 0; j < 2; ++j) { const v4u a = *(const GAS v4u*)(XN2 + (size_t)t * 2048 + j * 1024 + lane * 16), b = *(const GAS v4u*)(XN2 + (size_t)t * 2048 + j * 1024 + lane * 16 + 8);
                    const unsigned w[8] = {a.x, a.y, a.z, a.w, b.x, b.y, b.z, b.w};
#pragma unroll
                    for (int e = 0; e < 8; ++e) { xf[j * 16 + 2 * e] = pg8::bflo(w[e]); xf[j * 16 + 2 * e + 1] = pg8::bfhi(w[e]); } }
                float acc[32];
#pragma unroll
                for (int e = 0; e < 32; ++e) acc[e] = 0.f;
                constexpr int EG = 4;
#pragma unroll 1
                for (int e0 = 0; e0 < 128; e0 += EG) {
                    v4u ur[EG][2], vr[EG][2]; float gate[EG], su[EG], sv[EG];
#pragma unroll
                    for (int q = 0; q < EG; ++q) { const unsigned idx = __builtin_amdgcn_readfirstlane(lst[(tl * 128 + e0 + q) * 2]); gate[q] = __uint_as_float(__builtin_amdgcn_readfirstlane(lst[(tl * 128 + e0 + q) * 2 + 1]));
                        const unsigned char* up = UT + (size_t)idx * 2048 + lane * 16; const unsigned char* vp = VT + (size_t)idx * 2048 + lane * 16;
                        ur[q][0] = *(const GAS v4u*)up; ur[q][1] = *(const GAS v4u*)(up + 1024); vr[q][0] = *(const GAS v4u*)vp; vr[q][1] = *(const GAS v4u*)(vp + 1024);
                        su[q] = USC[idx]; sv[q] = VSC[idx]; }
#pragma unroll
                    for (int q = 0; q < EG; ++q) { float d0 = 0.f, d1 = 0.f;
#pragma unroll
                        for (int j = 0; j < 2; ++j) { const unsigned uw[4] = {ur[q][j].x, ur[q][j].y, ur[q][j].z, ur[q][j].w};
#pragma unroll
                            for (int w = 0; w < 4; ++w) { const auto lo = __builtin_amdgcn_cvt_pk_f32_fp8((int)uw[w], false), hi = __builtin_amdgcn_cvt_pk_f32_fp8((int)uw[w], true);
                                d0 = fmaf(xf[j * 16 + 4 * w], lo[0], d0); d1 = fmaf(xf[j * 16 + 4 * w + 1], lo[1], d1); d0 = fmaf(xf[j * 16 + 4 * w + 2], hi[0], d0); d1 = fmaf(xf[j * 16 + 4 * w + 3], hi[1], d1); } }
                        const float d = wsum(d0 + d1) * su[q];
                        const float act = 0.5f * d * (1.f + erff(d * 0.70710678118f)); const float cf = gate[q] * act * sv[q];
#pragma unroll
                        for (int j = 0; j < 2; ++j) { const unsigned vw[4] = {vr[q][j].x, vr[q][j].y, vr[q][j].z, vr[q][j].w};
#pragma unroll
                            for (int w = 0; w < 4; ++w) { const auto lo = __builtin_amdgcn_cvt_pk_f32_fp8((int)vw[w], false), hi = __builtin_amdgcn_cvt_pk_f32_fp8((int)vw[w], true);
                                acc[j * 16 + 4 * w] = fmaf(cf, lo[0], acc[j * 16 + 4 * w]); acc[j * 16 + 4 * w + 1] = fmaf(cf, lo[1], acc[j * 16 + 4 * w + 1]);
                                acc[j * 16 + 4 * w + 2] = fmaf(cf, hi[0], acc[j * 16 + 4 * w + 2]); acc[j * 16 + 4 * w + 3] = fmaf(cf, hi[1], acc[j * 16 + 4 * w + 3]); } }
                    }
                }
                float* orow = args.out + (size_t)t * 2048; const float* hrow = (const float*)(ws + WS_H2) + (size_t)t * 2048; float ss = 0.f;
#pragma unroll
                for (int j = 0; j < 2; ++j)
#pragma unroll
                    for (int q = 0; q < 4; ++q) { const f32x4 a = *(const f32x4*)(hrow + j * 1024 + lane * 16 + q * 4);
                        acc[j * 16 + q * 4] += a.x; acc[j * 16 + q * 4 + 1] += a.y; acc[j * 16 + q * 4 + 2] += a.z; acc[j * 16 + q * 4 + 3] += a.w; }
#pragma unroll
                for (int e = 0; e < 32; ++e) ss += acc[e] * acc[e];
                const float rstd = rsqrtf(wsum(ss) * (1.f / 2048.f) + 1e-6f);
#pragma unroll
                for (int j = 0; j < 2; ++j)
#pragma unroll
                    for (int q = 0; q < 4; ++q) { const f32x4 g0 = *(const f32x4*)(in[27] + j * 1024 + lane * 16 + q * 4);
                        *(f32x4*)(orow + j * 1024 + lane * 16 + q * 4) = (f32x4){acc[j * 16 + q * 4] * rstd * g0.x, acc[j * 16 + q * 4 + 1] * rstd * g0.y, acc[j * 16 + q * 4 + 2] * rstd * g0.z, acc[j * 16 + q * 4 + 3] * rstd * g0.w}; }
            }
            LDS_WAIT(); asm volatile("" ::: "memory");
        }
    PHASE_END
#undef IN
#undef SEAM
}

extern "C" void kernel_launch(void* const* d_in, const int* in_sizes, int n_in, void* d_out, int out_size, void* d_ws, size_t ws_size, hipStream_t stream) {
    static int grid = 0;
    if (grid == 0) {
        if (n_in != 28 || in_sizes[0] != S_ * DM || out_size != S_ * DM || ws_size < WS_END) { fprintf(stderr, "kernel_launch: unexpected shapes: n_in %d in0 %d out %d ws %zu (need >= %zu)\n", n_in, n_in > 0 ? in_sizes[0] : -1, out_size, ws_size, (size_t)WS_END); grid = -1; return; }
        if (hipFuncSetAttribute((const void*)mk_fwd, hipFuncAttributeMaxDynamicSharedMemorySize, LDS_BYTES) != hipSuccess) { fprintf(stderr, "kernel_launch: hipFuncSetAttribute failed\n"); grid = -1; return; }
        int per_cu = 0;
        if (hipOccupancyMaxActiveBlocksPerMultiprocessor(&per_cu, (const void*)mk_fwd, NWAVES * 64, LDS_BYTES) != hipSuccess || per_cu < 1) fprintf(stderr, "kernel_launch: note: occupancy query reports %d\n", per_cu);
        (void)hipGetLastError();
        grid = 256;
    }
    if (grid < 0) return;
    (void)hipMemsetAsync((char*)d_ws + WS_CTL, 0, CTL_ZERO_BYTES, stream);
    Args a{};
    for (int i = 0; i < 28; ++i) a.in[i] = (const float*)d_in[i];
    a.out = (float*)d_out; a.ws = (unsigned char*)d_ws;
#if MK_PER_PHASE
    for (int p = 0; p < NPH; ++p) { a.ph_lo = p; a.ph_hi = p + 1; hipLaunchKernelGGL(mk_fwd, dim3(grid), dim3(NWAVES * 64), LDS_BYTES, stream, a); }
#else
    a.ph_lo = 0; a.ph_hi = NPH; hipLaunchKernelGGL(mk_fwd, dim3(grid), dim3(NWAVES * 64), LDS_BYTES, stream, a);
#endif
    const hipError_t le = hipPeekAtLastError();
    if (le != hipSuccess) fprintf(stderr, "kernel_launch: launch failed: %s\n", hipGetErrorName(le));
}
```

```cpp
#include <hip/hip_runtime.h>
#include <cstdio>
#include <cstdint>
namespace pg8 {
#define PG8_LAS __attribute__((address_space(3)))
typedef unsigned short bf16_t;
typedef short bf16x8 __attribute__((ext_vector_type(8)));
typedef float f32x4 __attribute__((ext_vector_type(4)));
typedef unsigned u32x4 __attribute__((ext_vector_type(4)));
constexpr int BM = 256, BK = 64, HALF = 128, HTB = HALF * BK * 2  , STAGE_BYTES = 8 * HTB, NXCD = 8, WGM = 8;

__host__ __device__ __forceinline__ int lds_byte(int r, int c) { const int st = (r >> 4) * 2 + (c >> 5), rr = r & 15, cc = c & 31, ob = rr * 64 + cc * 2; return st * 1024 + (ob ^ (((ob >> 9) & 1) << 5)); }
__host__ __device__ __forceinline__ void stage_rc(int b, int& R, int& C) { const int st = b / 1024, sb = b % 1024, swz = sb ^ (((sb >> 9) & 1) << 5); R = (st >> 1) * 16 + swz / 64; C = (st & 1) * 32 + (swz % 64) / 2; }
__host__ __device__ __forceinline__ int perm32(int rho) { const int n = rho >> 4, i = rho & 15; return 8 * (i >> 2) + 4 * n + (i & 3); }

struct Unit { int pm, pn; };
struct Gemm { const bf16_t* A; const bf16_t* Bt; int M, N, K, lda, ldb; };

struct StaticOrder {
    int nM, nN, nwg, G, c;
    __host__ __device__ void init(int M, int N, int G_, int c_) { nM = M / BM; nN = N / BM; nwg = nM * nN; G = G_; c = c_; }
    __host__ __device__ bool next(int i, Unit& u) const {
        const long L = (long)i * G + c; if (L >= nwg) return false;
        int wgid = (int)L; { const int q = nwg / NXCD, r = nwg % NXCD, xcd = wgid % NXCD, off = wgid / NXCD; wgid = (xcd < r ? xcd * (q + 1) : r * (q + 1) + (xcd - r) * q) + off; }
        const int nig = WGM * nN, gid = wgid / nig, fm = gid * WGM, gsz = (nM - fm) < WGM ? (nM - fm) : WGM;
        u.pm = fm + ((wgid % nig) % gsz); u.pn = (wgid % nig) / gsz; return true;
    }
    __device__ __forceinline__ void a_ready(const Unit&) const {}
    __device__ __forceinline__ void done(const Unit&) const {}
};

__device__ __forceinline__ unsigned cvt_pk_bf16(float lo, float hi) { unsigned r; asm volatile("v_cvt_pk_bf16_f32 %0, %1, %2" : "=v"(r) : "v"(lo), "v"(hi)); return r; }
__device__ __forceinline__ float sigm(float x) { return __builtin_amdgcn_rcpf(1.0f + __expf(-x)); }
__device__ __forceinline__ float bflo(unsigned w) { return __uint_as_float(w << 16); }
__device__ __forceinline__ float bfhi(unsigned w) { return __uint_as_float(w & 0xffff0000u); }
enum { EM_G1 = 0, EM_LORA_W = 1, EM_LORA_A = 2, EM_LORA_G = 3, EM_PROJA = 4, EM_PROJB = 5, EM_WOUT = 6, EM_SCORES = 7 };
template <int MODE> struct Epi {
    static constexpr bool PERM = true, AFTER_DRAIN = false;
    void* o0; void* o1; void* o2; const void* i0; const void* i1; const float* vec; float sc;
    __device__ __forceinline__ void operator()(const f32x4 (&acc)[2][2][4][2], const Unit& u, int wr, int wc, int fr, int fq) const {
        asm volatile("" ::: "memory");
        const int row0 = u.pm * BM + wr * 64 + fr;
        int colt = u.pn * BM; int ldc = 2048; int sub = 0;
        bf16_t* ob = (bf16_t*)o0; float scl = 1.f;
        if (MODE == EM_G1) {
            if (u.pn < 14) { ldc = 3584; }
            else if (u.pn < 26) { ob = (bf16_t*)o1; ldc = 3072; colt -= 14 * BM; if (u.pn < 18) scl = sc; }
            else { ob = (bf16_t*)o2; ldc = 4096; colt -= 26 * BM; sub = 1; }
        }
        if (MODE == EM_LORA_W || MODE == EM_LORA_A || MODE == EM_LORA_G) ldc = 1024;
        const int col0 = colt + wc * 32 + 8 * fq;
#pragma unroll
        for (int ai = 0; ai < 2; ++ai)
#pragma unroll
            for (int m = 0; m < 4; ++m) { const size_t row = (size_t)(row0 + ai * HALF + m * 16);
#pragma unroll
                for (int bj = 0; bj < 2; ++bj) { f32x4 v0 = acc[ai][bj][m][0], v1 = acc[ai][bj][m][1]; const int col = col0 + bj * HALF;
                    if (MODE == EM_G1) {
                        if (sub) { v0 = (f32x4){sigm(v0[0]), sigm(v0[1]), sigm(v0[2]), sigm(v0[3])}; v1 = (f32x4){sigm(v1[0]), sigm(v1[1]), sigm(v1[2]), sigm(v1[3])}; }
                        else { v0 = v0 * scl; v1 = v1 * scl; }
                        u32x4 w; w.x = cvt_pk_bf16(v0[0], v0[1]); w.y = cvt_pk_bf16(v0[2], v0[3]); w.z = cvt_pk_bf16(v1[0], v1[1]); w.w = cvt_pk_bf16(v1[2], v1[3]);
                        *(u32x4*)(ob + row * ldc + col) = w;
                    } else if (MODE == EM_LORA_W) {
                        if (vec) { const f32x4 b0 = *(const f32x4*)(vec + col), b1 = *(const f32x4*)(vec + col + 4);
                            v0 = v0 + b0; v1 = v1 + b1;
                            v0 = (f32x4){sigm(v0[0]), sigm(v0[1]), sigm(v0[2]), sigm(v0[3])}; v1 = (f32x4){sigm(v1[0]), sigm(v1[1]), sigm(v1[2]), sigm(v1[3])};
                            v0 = v0 * sc; v1 = v1 * sc; }
                        u32x4 w; w.x = cvt_pk_bf16(v0[0], v0[1]); w.y = cvt_pk_bf16(v0[2], v0[3]); w.z = cvt_pk_bf16(v1[0], v1[1]); w.w = cvt_pk_bf16(v1[2], v1[3]);
                        *(u32x4*)(ob + row * ldc + col) = w;
                    } else if (MODE == EM_PROJA) {
                        const u32x4 g = *(const u32x4*)((const bf16_t*)i0 + row * 4096 + col);
                        float* op = (float*)o0 + row * 2048 + col;
                        *(f32x4*)op = (f32x4){v0[0] * bflo(g.x), v0[1] * bfhi(g.x), v0[2] * bflo(g.y), v0[3] * bfhi(g.y)};
                        *(f32x4*)(op + 4) = (f32x4){v1[0] * bflo(g.z), v1[1] * bfhi(g.z), v1[2] * bflo(g.w), v1[3] * bfhi(g.w)};
                    } else if (MODE == EM_PROJB) {
                        const u32x4 g = *(const u32x4*)((const bf16_t*)i0 + row * 4096 + 2048 + col);
                        const float* tp = (const float*)i1 + row * 2048 + col; const f32x4 t0 = *(const f32x4*)tp, t1 = *(const f32x4*)(tp + 4);
                        v0 = (f32x4){t0[0] + v0[0] * bflo(g.x), t0[1] + v0[1] * bfhi(g.x), t0[2] + v0[2] * bflo(g.y), t0[3] + v0[3] * bfhi(g.y)};
                        v1 = (f32x4){t1[0] + v1[0] * bflo(g.z), t1[1] + v1[1] * bfhi(g.z), t1[2] + v1[2] * bflo(g.w), t1[3] + v1[3] * bfhi(g.w)};
                        u32x4 w; w.x = cvt_pk_bf16(v0[0], v0[1]); w.y = cvt_pk_bf16(v0[2], v0[3]); w.z = cvt_pk_bf16(v1[0], v1[1]); w.w = cvt_pk_bf16(v1[2], v1[3]);
                        *(u32x4*)(ob + row * 2048 + col) = w;
                    } else if (MODE == EM_WOUT) {
                        const float* xp = (const float*)i1 + row * 2048 + col; const f32x4 t0 = *(const f32x4*)xp, t1 = *(const f32x4*)(xp + 4);
                        float* op = (float*)o0 + row * 2048 + col; *(f32x4*)op = t0 + v0; *(f32x4*)(op + 4) = t1 + v1;
                    } else {
                        float* op = (float*)o0 + row * 2048 + col; *(f32x4*)op = v0; *(f32x4*)(op + 4) = v1;
                    }
                } }
    }
};

template <class Epi, class Sched, bool ALIGN_EPI = false, bool SP2 = false>
__device__ __forceinline__ void gemm_phase(PG8_LAS unsigned char* lds, const Gemm g, const Sched& S, const Epi& E) {
    int tid_ = threadIdx.x; asm volatile("" : "+v"(tid_)); const int tid = tid_, wid = __builtin_amdgcn_readfirstlane(tid >> 6), lane = tid & 63, wr = wid >> 2, wc = wid & 3, fr = lane & 15, fq = lane >> 4;
    const int K = g.K, nt = K / BK;
    unsigned voffA[2], voffB[2];
#pragma unroll
    for (int i = 0; i < 2; ++i) { int R, C; stage_rc(tid * 16 + i * 8192, R, C); const int Rb = Epi::PERM ? ((R & ~31) + perm32(R & 31)) : R;
        voffA[i] = (unsigned)(R * g.lda + C) * 2u; voffB[i] = (unsigned)(Rb * g.ldb + C) * 2u; }
    const size_t kstep = (size_t)(BK * 2);
    const size_t hstepA = (size_t)HALF * g.lda * 2, hstepB = (size_t)HALF * g.ldb * 2;
    const size_t tstepA = 2 * hstepA, tstepB = 2 * hstepB;
    const unsigned ldsw = (unsigned)wid * 1024u;
    const int aoff = lds_byte(wr * 64 + fr, fq * 8), boff = lds_byte(wc * 32 + fr, fq * 8);
#define PG8_SA(b, h) (((b) * 2 + (h)) * HTB)
#define PG8_SB(b, h) ((4 + (b) * 2 + (h)) * HTB)
#define PG8_STAGE(bufoff, gbase, voff) do { _Pragma("unroll") for (int _i = 0; _i < 2; ++_i) \
        __builtin_amdgcn_global_load_lds((const unsigned*)((const char*)(gbase) + (voff)[_i]), (PG8_LAS unsigned*)(lds + (bufoff) + ldsw + _i * 8192), 16, 0, 0); } while (0)
#define PG8_LDA(dst, b, h) do { _Pragma("unroll") for (int m = 0; m < 4; ++m) _Pragma("unroll") for (int k = 0; k < 2; ++k) dst[m][k] = *(const PG8_LAS bf16x8*)(lds + PG8_SA(b, h) + aoff + m * 2048 + k * 1024); } while (0)
#define PG8_LDB(dst, b, h) do { _Pragma("unroll") for (int n = 0; n < 2; ++n) _Pragma("unroll") for (int k = 0; k < 2; ++k) dst[n][k] = *(const PG8_LAS bf16x8*)(lds + PG8_SB(b, h) + boff + n * 2048 + k * 1024); } while (0)
#define PG8_MMA(ai, bj, At, Bt) do { __builtin_amdgcn_s_setprio(1); _Pragma("unroll") for (int m = 0; m < 4; ++m) _Pragma("unroll") for (int n = 0; n < 2; ++n) _Pragma("unroll") for (int k = 0; k < 2; ++k) \
        acc[ai][bj][m][n] = __builtin_amdgcn_mfma_f32_16x16x32_bf16(Bt[n][k], At[m][k], acc[ai][bj][m][n], 0, 0, 0); __builtin_amdgcn_s_setprio(0); } while (0)
#define PG8_WAIT_V(n) asm volatile("s_waitcnt vmcnt(" #n ")" ::: "memory")
#define PG8_WAIT_L(n) asm volatile("s_waitcnt lgkmcnt(" #n ")" ::: "memory")
#define PG8_BAR __builtin_amdgcn_s_barrier()
#define PG8_SCHED __builtin_amdgcn_sched_barrier(0)
    Unit cur, nxt; int ui = 0;
    if (!S.next(0, cur)) return;
    f32x4 acc[2][2][4][2];
#pragma unroll
    for (int a = 0; a < 2; ++a)
#pragma unroll
        for (int b = 0; b < 2; ++b)
#pragma unroll
            for (int m = 0; m < 4; ++m)
#pragma unroll
                for (int n = 0; n < 2; ++n) acc[a][b][m][n] = (f32x4){0.f, 0.f, 0.f, 0.f};
    bf16x8 At[4][2], B0[2][2], B1[2][2];
    const char* cA = (const char*)g.A + (size_t)cur.pm * tstepA; const char* cB = (const char*)g.Bt + (size_t)cur.pn * tstepB;
    S.a_ready(cur);
    if constexpr (SP2) {
        PG8_STAGE(PG8_SB(0, 0), cB, voffB); PG8_STAGE(PG8_SB(0, 1), cB + hstepB, voffB); PG8_STAGE(PG8_SA(0, 0), cA, voffA); PG8_STAGE(PG8_SA(0, 1), cA + hstepA, voffA);
        if (wr == 1) PG8_BAR;
        PG8_WAIT_V(2); PG8_BAR;
        PG8_STAGE(PG8_SB(1, 0), cB + kstep, voffB); PG8_STAGE(PG8_SA(1, 0), cA + kstep, voffA); PG8_STAGE(PG8_SB(1, 1), cB + hstepB + kstep, voffB);
        PG8_WAIT_V(6); PG8_BAR;
    } else {
        PG8_STAGE(PG8_SB(0, 0), cB, voffB); PG8_STAGE(PG8_SA(0, 0), cA, voffA); PG8_STAGE(PG8_SB(0, 1), cB + hstepB, voffB); PG8_STAGE(PG8_SA(0, 1), cA + hstepA, voffA);
        if (wr == 1) PG8_BAR;
        PG8_WAIT_V(4); PG8_BAR;
        PG8_STAGE(PG8_SB(1, 0), cB + kstep, voffB); PG8_STAGE(PG8_SA(1, 0), cA + kstep, voffA); PG8_STAGE(PG8_SB(1, 1), cB + hstepB + kstep, voffB);
        PG8_WAIT_V(6); PG8_BAR;
    }
    for (;;) {
        const bool has_next = S.next(ui + 1, nxt);
        const char* nA = has_next ? (const char*)g.A + (size_t)nxt.pm * tstepA : cA; const char* nB = has_next ? (const char*)g.Bt + (size_t)nxt.pn * tstepB : cB;
        for (int t = 0; t < nt; t += 2) {
            const bool last = (t == nt - 2);
            const char* a1 = cA + (size_t)(t + 1) * kstep;
            const char* a2 = last ? nA : cA + (size_t)(t + 2) * kstep; const char* b2 = last ? nB : cB + (size_t)(t + 2) * kstep;
            const char* a3 = a2 + kstep; const char* b3 = b2 + kstep;
            if (last && has_next) S.a_ready(nxt);
            if constexpr (SP2) {
            PG8_LDB(B0, 0, 0); PG8_LDB(B1, 0, 1); PG8_SCHED; PG8_LDA(At, 0, 0); PG8_STAGE(PG8_SA(1, 1), a1 + hstepA, voffA);
            PG8_WAIT_V(8); PG8_WAIT_L(0); PG8_BAR; PG8_MMA(0, 0, At, B0); PG8_MMA(0, 1, At, B1); PG8_BAR; PG8_SCHED;
            PG8_LDA(At, 0, 1); PG8_STAGE(PG8_SB(0, 0), b2, voffB); PG8_STAGE(PG8_SB(0, 1), b2 + hstepB, voffB); PG8_STAGE(PG8_SA(0, 0), a2, voffA);
            PG8_WAIT_V(8); PG8_WAIT_L(0); PG8_BAR; PG8_MMA(1, 0, At, B0); PG8_MMA(1, 1, At, B1); PG8_BAR; PG8_SCHED;
            PG8_LDB(B0, 1, 0); PG8_LDB(B1, 1, 1); PG8_SCHED; PG8_LDA(At, 1, 0); PG8_STAGE(PG8_SA(0, 1), a2 + hstepA, voffA);
            PG8_WAIT_V(8); PG8_WAIT_L(0); PG8_BAR; PG8_MMA(0, 0, At, B0); PG8_MMA(0, 1, At, B1); PG8_BAR; PG8_SCHED;
            PG8_LDA(At, 1, 1); PG8_STAGE(PG8_SB(1, 0), b3, voffB); PG8_STAGE(PG8_SB(1, 1), b3 + hstepB, voffB); PG8_STAGE(PG8_SA(1, 0), a3, voffA);
            PG8_WAIT_V(8); PG8_WAIT_L(0); PG8_BAR; PG8_MMA(1, 0, At, B0); PG8_MMA(1, 1, At, B1); PG8_BAR; PG8_SCHED;
            } else {
            PG8_LDB(B0, 0, 0); PG8_SCHED; PG8_LDA(At, 0, 0); PG8_STAGE(PG8_SA(1, 1), a1 + hstepA, voffA);
            PG8_WAIT_L(8); PG8_BAR; PG8_WAIT_L(0); PG8_MMA(0, 0, At, B0); PG8_BAR; PG8_SCHED;
            PG8_LDB(B1, 0, 1); PG8_STAGE(PG8_SB(0, 0), b2, voffB);
            PG8_BAR; PG8_WAIT_L(0); PG8_MMA(0, 1, At, B1); PG8_BAR;
            PG8_LDA(At, 0, 1); PG8_STAGE(PG8_SA(0, 0), a2, voffA);
            PG8_BAR; PG8_WAIT_L(0); PG8_MMA(1, 0, At, B0); PG8_BAR; PG8_SCHED;
            PG8_STAGE(PG8_SB(0, 1), b2 + hstepB, voffB);
            PG8_WAIT_V(6); PG8_BAR; PG8_MMA(1, 1, At, B1); PG8_BAR;
            PG8_LDB(B0, 1, 0); PG8_SCHED; PG8_LDA(At, 1, 0); PG8_STAGE(PG8_SA(0, 1), a2 + hstepA, voffA);
            PG8_WAIT_L(8); PG8_BAR; PG8_WAIT_L(0); PG8_MMA(0, 0, At, B0); PG8_BAR; PG8_SCHED;
            PG8_LDB(B1, 1, 1); PG8_STAGE(PG8_SB(1, 0), b3, voffB);
            PG8_BAR; PG8_WAIT_L(0); PG8_MMA(0, 1, At, B1); PG8_BAR;
            PG8_LDA(At, 1, 1); PG8_STAGE(PG8_SA(1, 0), a3, voffA);
            PG8_BAR; PG8_WAIT_L(0); PG8_MMA(1, 0, At, B0); PG8_BAR; PG8_SCHED;
            PG8_STAGE(PG8_SB(1, 1), b3 + hstepB, voffB);
            PG8_WAIT_V(6); PG8_BAR; PG8_MMA(1, 1, At, B1); PG8_BAR;
            }
        }
        if constexpr (ALIGN_EPI) { if (wr == 0) PG8_BAR; }
        if constexpr (!Epi::AFTER_DRAIN) { E(acc, cur, wr, wc, fr, fq); S.done(cur); }
        if (!has_next) break;
#pragma unroll
        for (int a = 0; a < 2; ++a)
#pragma unroll
            for (int b = 0; b < 2; ++b)
#pragma unroll
                for (int m = 0; m < 4; ++m)
#pragma unroll
                    for (int n = 0; n < 2; ++n) acc[a][b][m][n] = (f32x4){0.f, 0.f, 0.f, 0.f};
        cur = nxt; cA = nA; cB = nB; ++ui;
        if constexpr (ALIGN_EPI) { if (wr == 1) PG8_BAR; }
    }
    PG8_WAIT_V(0);
    if constexpr (!ALIGN_EPI) { if (wr == 0) PG8_BAR; }
    PG8_BAR;
    if constexpr (Epi::AFTER_DRAIN) { E.fused(acc, cur, wr, wc, fr, fq, lds, wid, lane); S.done(cur); }
#undef PG8_SA
#undef PG8_SB
#undef PG8_STAGE
#undef PG8_LDA
#undef PG8_LDB
#undef PG8_MMA
#undef PG8_WAIT_V
#undef PG8_WAIT_L
#undef PG8_BAR
#undef PG8_SCHED
}
}
#include <hip/hip_bf16.h>
#include <cmath>
namespace attn_body {
using bf16=__hip_bfloat16;
using bf16x8=__attribute__((ext_vector_type(8)))short;
using s16x4=__attribute__((ext_vector_type(4)))short;
using f32x16=__attribute__((ext_vector_type(16)))float;
using u32x4=__attribute__((ext_vector_type(4)))unsigned;
constexpr int SEQ=16384,D=64,PQ=3072,PO=2048;
constexpr int NW=8,QBLK=32,QB=QBLK*NW,KVBLK=64,NQB=SEQ/QB;
constexpr int ATTN_UNIT_ROWS=QB;
__device__ __forceinline__ int crow(int r,int hi){return (r&3)+8*(r>>2)+4*hi;}
#define SBAR() __builtin_amdgcn_sched_barrier(0)
__device__ __forceinline__ void cmask(f32x16&p0,f32x16&p1,int jb,int qrel,int hi){
  const float NEG=-INFINITY; int kb=64*jb+4*hi;
  #pragma unroll
  for(int r=0;r<16;++r){int kv=kb+(r&3)+8*(r>>2); if(kv>qrel)p0[r]=NEG; if(kv+32>qrel)p1[r]=NEG;}
}

constexpr int NSLOT=3, SLOTB=8192;
constexpr int LDS_K=0, LDS_V=NSLOT*SLOTB, LDS_WS=2*NSLOT*SLOTB, LDS_OST=LDS_WS+NW*64*4, LDS_BYTES=LDS_OST+NW*4096;
constexpr float C2=0.125f*1.4426950408889634f;
__device__ __forceinline__ void glds16(const void*gsrc,unsigned lds_dst){unsigned keep;
  asm volatile("s_mov_b32 %0, m0\n\ts_mov_b32 m0, %2\n\ts_nop 0\n\tglobal_load_lds_dwordx4 %1, off\n\ts_mov_b32 m0, %0":"=&s"(keep):"v"(gsrc),"s"(lds_dst):"memory");}
__device__ __forceinline__ float max3f(float a,float b,float c){float r;asm("v_max3_f32 %0, %1, %2, %3":"=v"(r):"v"(a),"v"(b),"v"(c));return r;}
__device__ __forceinline__ float max2f(float a,float b){float r;asm("v_max_f32_e32 %0, %1, %2":"=v"(r):"v"(a),"v"(b));return r;}
__device__ __forceinline__ float fadd_s(float a,float b){float r;asm("v_add_f32_e32 %0, %1, %2":"=v"(r):"v"(a),"v"(b));return r;}
__device__ __forceinline__ float fsub_s(float a,float b){float r;asm("v_sub_f32_e32 %0, %1, %2":"=v"(r):"v"(a),"v"(b));return r;}
typedef float f32x2_t __attribute__((ext_vector_type(2))); typedef __bf16 bf16x2_t __attribute__((ext_vector_type(2)));
__device__ __forceinline__ unsigned cvtpk_s(float lo,float hi){f32x2_t v={lo,hi};bf16x2_t b=__builtin_convertvector(v,bf16x2_t);return __builtin_bit_cast(unsigned,b);}
#define WAIT_BAR(N) asm volatile("s_waitcnt vmcnt(" #N ") lgkmcnt(0)\n\ts_barrier":::"memory")

__device__ __forceinline__ void qkt(f32x16&p0,f32x16&p1,const char*Kslot,const bf16x8*qr,const f32x16&negm,int r32,int hi){
  const char*kb=Kslot+hi*1024+r32*16;
  #pragma unroll
  for(int d0=0;d0<4;++d0){
    const bf16x8 b0=*reinterpret_cast<const bf16x8*>(kb+d0*2048);
    const bf16x8 b1=*reinterpret_cast<const bf16x8*>(kb+d0*2048+512);
    if(d0==0){p0=__builtin_amdgcn_mfma_f32_32x32x16_bf16(b0,qr[0],negm,0,0,0);p1=__builtin_amdgcn_mfma_f32_32x32x16_bf16(b1,qr[0],negm,0,0,0);}
    else{p0=__builtin_amdgcn_mfma_f32_32x32x16_bf16(b0,qr[d0],p0,0,0,0);p1=__builtin_amdgcn_mfma_f32_32x32x16_bf16(b1,qr[d0],p1,0,0,0);}}
}
typedef __attribute__((address_space(3))) const char* lds_cptr;
typedef short v4i16_t __attribute__((ext_vector_type(4)));
__device__ __forceinline__ void kload8(bf16x8*kf,lds_cptr kp){
  kf[0]=*(const __attribute__((address_space(3))) bf16x8*)(kp);      kf[1]=*(const __attribute__((address_space(3))) bf16x8*)(kp+512);
  kf[2]=*(const __attribute__((address_space(3))) bf16x8*)(kp+2048); kf[3]=*(const __attribute__((address_space(3))) bf16x8*)(kp+2560);
  kf[4]=*(const __attribute__((address_space(3))) bf16x8*)(kp+4096); kf[5]=*(const __attribute__((address_space(3))) bf16x8*)(kp+4608);
  kf[6]=*(const __attribute__((address_space(3))) bf16x8*)(kp+6144); kf[7]=*(const __attribute__((address_space(3))) bf16x8*)(kp+6656);
}
__device__ __forceinline__ void kload2(bf16x8*kf,lds_cptr kp,int j){ kf[2*j]=*(const __attribute__((address_space(3))) bf16x8*)(kp+j*2048); kf[2*j+1]=*(const __attribute__((address_space(3))) bf16x8*)(kp+j*2048+512); }
__device__ __forceinline__ s16x4 vtr(lds_cptr p){ return __builtin_bit_cast(s16x4,__builtin_amdgcn_ds_read_tr16_b64_v4i16((__attribute__((address_space(3))) v4i16_t*)p)); }
__device__ __forceinline__ float rowmax(const f32x16&p0,const f32x16&p1){
  float a=max3f(p0[0],p0[1],p1[0]),b=max3f(p0[2],p0[3],p1[1]);a=max3f(a,p1[2],p1[3]);
  #pragma unroll
  for(int r=4;r<16;r+=4){a=max3f(a,p0[r],p0[r+1]);b=max3f(b,p0[r+2],p0[r+3]);a=max3f(a,p1[r],p1[r+1]);b=max3f(b,p1[r+2],p1[r+3]);}
  const float m=max2f(a,b);
  auto rr=__builtin_amdgcn_permlane32_swap(__float_as_uint(m),__float_as_uint(m),false,false);
  return max2f(__uint_as_float(rr[0]),__uint_as_float(rr[1]));
}
__device__ __forceinline__ void pv(f32x16*o,int vb,bf16x8 pa0,bf16x8 pa1,bf16x8 pa2,bf16x8 pa3){
  #pragma unroll
  for(int d0=0;d0<2;++d0){s16x4 lo[4],hi[4];
    #pragma unroll
    for(int ks=0;ks<4;++ks){
      asm volatile("ds_read_b64_tr_b16 %0,%1 offset:%c2":"=&v"(lo[ks]):"v"(vb),"i"(d0*4096+ks*1024):"memory");
      asm volatile("ds_read_b64_tr_b16 %0,%1 offset:%c2":"=&v"(hi[ks]):"v"(vb),"i"(d0*4096+ks*1024+512):"memory");}
    asm volatile("s_waitcnt lgkmcnt(0)":::"memory");SBAR();
    #define PK(k) (bf16x8){lo[k][0],lo[k][1],lo[k][2],lo[k][3],hi[k][0],hi[k][1],hi[k][2],hi[k][3]}
    o[d0]=__builtin_amdgcn_mfma_f32_32x32x16_bf16(pa0,PK(0),o[d0],0,0,0);
    o[d0]=__builtin_amdgcn_mfma_f32_32x32x16_bf16(pa1,PK(1),o[d0],0,0,0);
    o[d0]=__builtin_amdgcn_mfma_f32_32x32x16_bf16(pa2,PK(2),o[d0],0,0,0);
    o[d0]=__builtin_amdgcn_mfma_f32_32x32x16_bf16(pa3,PK(3),o[d0],0,0,0);
    #undef PK
  }
}

#ifndef ATTN_STORE16
#define ATTN_STORE16(p,v) (*(u32x4*)(p)=(v))
#endif
template<int THRL> __device__ __forceinline__ void attn_unit(int qb,const bf16*Q,const bf16*__restrict__ K,const bf16*__restrict__ V,bf16*O,char*shm){
  int tid_=threadIdx.x; asm volatile("":"+v"(tid_)); const int tid=tid_,lane=tid&63,r32=lane&31,hi=lane>>5; const int wid=__builtin_amdgcn_readfirstlane(tid>>6);
  const int q0=qb*QB;
  const bf16*Qw=Q+(long)(q0+wid*QBLK)*PQ;
  const bf16*Kh=K,*Vh=V;
  const unsigned lds0=(unsigned)(uintptr_t)shm;
  float*wsf=(float*)(shm+LDS_WS)+wid*64;
  const bf16*ksrc=Kh+(long)lane*PQ+wid*8;
  const bf16*vsrc=Vh+(long)(16*(wid&3)+(lane>>2))*PQ+(wid>>2)*32+(lane&3)*8;
  const unsigned kdst=lds0+LDS_K+wid*1024, vdst=lds0+LDS_V+wid*1024;
  #define DMA_K(t,slot) glds16(ksrc+(long)(t)*KVBLK*PQ,(unsigned)__builtin_amdgcn_readfirstlane(kdst+(slot)))
  #define DMA_V(t,slot) glds16(vsrc+(long)(t)*KVBLK*PQ,(unsigned)__builtin_amdgcn_readfirstlane(vdst+(slot)))
  const int vb0=(int)(lds0+LDS_V)+((lane>>4)&1)*32+(lane&3)*8+(4*hi+((lane&15)>>2))*64;
  const char*Kbase=shm+LDS_K; bf16x8 kf[8];
  const lds_cptr shm3=(lds_cptr)shm; const lds_cptr kp0=shm3+LDS_K+hi*1024+r32*16; const lds_cptr vp0=shm3+LDS_V+((lane>>4)&1)*32+(lane&3)*8+(4*hi+((lane&15)>>2))*64;
  const int NT=(q0+QB)/KVBLK;
  DMA_K(0,0);DMA_V(0,0);DMA_K(1,SLOTB);
  bf16x8 qr[4];
  #pragma unroll
  for(int d0=0;d0<4;++d0)qr[d0]=*reinterpret_cast<const bf16x8*>(&Qw[(long)r32*PQ+d0*16+hi*8]);
  float mhat=0.f,l_reg=0.f;f32x16 o[2];o[0]=f32x16{};o[1]=f32x16{};asm volatile("":"+v"(o[0]));asm volatile("":"+v"(o[1]));f32x16 negm=f32x16{};asm volatile("":"+v"(negm));
  const int qrel=wid*QBLK+r32;
  #define CMASK(P0,P1,t) do{int jb_=(t)-(NT-4); if(jb_>=0)cmask(P0,P1,jb_,qrel,hi);}while(0)
  bool resc=false;
  #define START(P0,P1) do{ const float rm=rowmax(P0,P1); resc=false; \
    { const float dl=rm; mhat=fadd_s(mhat,dl); \
      _Pragma("unroll") for(int r=0;r<16;++r){P0[r]=fsub_s(P0[r],dl);P1[r]=fsub_s(P1[r],dl);} \
      _Pragma("unroll") for(int r=0;r<16;++r)negm[r]=-mhat; asm volatile("":"+v"(negm)); } \
    _Pragma("unroll") for(int r=0;r<16;++r)P0[r]=__builtin_amdgcn_exp2f(P0[r]); }while(0)
  #define RESC() do{ if(resc){ asm volatile("s_waitcnt lgkmcnt(0)":::"memory"); \
      _Pragma("unroll") for(int d_=0;d_<2;++d_) _Pragma("unroll") for(int r=0;r<16;++r)o[d_][r]*=wsf[crow(r,hi)]; } }while(0)
  f32x16 pA0,pA1,pB0,pB1;
  int sl_prev=0,sl_cur=0,sl_next=SLOTB;
  #define ROT() do{sl_prev=sl_cur;sl_cur=sl_next;sl_next=(sl_next==(NSLOT-1)*SLOTB)?0:sl_next+SLOTB;}while(0)
  DMA_K(2,2*SLOTB);
  WAIT_BAR(3);
  qkt(pA0,pA1,Kbase,qr,negm,r32,hi);asm volatile("s_nop 15\n\ts_nop 7":"+v"(pA0),"+v"(pA1));CMASK(pA0,pA1,0);
  START(pA0,pA1);
  _Pragma("unroll") for(int r=0;r<16;++r)pA1[r]=__builtin_amdgcn_exp2f(pA1[r]);
  WAIT_BAR(0);
  DMA_K(3,0);DMA_V(1,SLOTB);
  ROT();
  kload8(kf,kp0+sl_cur);
  WAIT_BAR(2);
  s16x4 vlo[8],vhi[8]; u32x4 pw0,pw1,pw2,pw3;
  #define PKW(P,B) cvtpk_s(P[B],P[B+1])
  #define PAF(k) __builtin_bit_cast(bf16x8,pw##k)
  #define VFR(i) (bf16x8){vlo[i][0],vlo[i][1],vlo[i][2],vlo[i][3],vhi[i][0],vhi[i][1],vhi[i][2],vhi[i][3]}
  #define PIN(x) asm volatile("":"+v"(x))
  #define MX3(a,b,c) __builtin_fmaxf(__builtin_fmaxf((a),(b)),(c))
  #define GAPA(MF,A0,A1,A2,A3,W0,W1,PW) do{ MF; sacc+=A0; sacc+=A1; sacc+=A2; sacc+=A3; PIN(sacc); W0; W1; PIN(PW); SBAR(); }while(0)
  #define EX(v) __builtin_amdgcn_exp2f(v)
  #define GAPB(MF,X,B) do{ MF; X[B]=EX(X[B]); X[B+1]=EX(X[B+1]); X[B+2]=EX(X[B+2]); X[B+3]=EX(X[B+3]); PIN(X); SBAR(); }while(0)
  #define VRD(i) do{ vlo[i]=vtr(vp_+(((i)>>2)*4096+((i)&3)*1024)); vhi[i]=vtr(vp_+(((i)>>2)*4096+((i)&3)*1024+512)); }while(0)
  #define KRD(G,j) do{ if(G){ kload2(kf,kp0+sl_next,j); SBAR(); } }while(0)
  #define STEP(C0,C1,P0,P1,t,GK,GV,GL) do{ SBAR(); \
    const lds_cptr vp_=vp0+sl_prev; \
    VRD(0); SBAR(); float sacc=(P0[0]+P0[1]); \
    GAPA(C0=__builtin_amdgcn_mfma_f32_32x32x16_bf16(kf[0],qr[0],negm,0,0,0), P0[2],P0[3],P0[4],P0[5],     pw0[0]=PKW(P0,0), pw0[1]=PKW(P0,2), pw0); \
    VRD(4); SBAR(); GAPA(C1=__builtin_amdgcn_mfma_f32_32x32x16_bf16(kf[1],qr[0],negm,0,0,0), P0[6],P0[7],P0[8],P0[9],     pw0[2]=PKW(P0,4), pw0[3]=PKW(P0,6), pw0); \
    VRD(1); SBAR(); GAPA(C0=__builtin_amdgcn_mfma_f32_32x32x16_bf16(kf[2],qr[1],C0,0,0,0),   P0[10],P0[11],P0[12],P0[13], pw1[0]=PKW(P0,8), pw1[1]=PKW(P0,10), pw1); \
    VRD(5); SBAR(); GAPA(C1=__builtin_amdgcn_mfma_f32_32x32x16_bf16(kf[3],qr[1],C1,0,0,0),   P0[14],P0[15],P1[0],P1[1],   pw1[2]=PKW(P0,12),pw1[3]=PKW(P0,14), pw1); \
    VRD(2); SBAR(); GAPA(C0=__builtin_amdgcn_mfma_f32_32x32x16_bf16(kf[4],qr[2],C0,0,0,0),   P1[2],P1[3],P1[4],P1[5],     pw2[0]=PKW(P1,0), pw2[1]=PKW(P1,2), pw2); \
    VRD(6); SBAR(); GAPA(C1=__builtin_amdgcn_mfma_f32_32x32x16_bf16(kf[5],qr[2],C1,0,0,0),   P1[6],P1[7],P1[8],P1[9],     pw2[2]=PKW(P1,4), pw2[3]=PKW(P1,6), pw2); \
    VRD(3); SBAR(); GAPA(C0=__builtin_amdgcn_mfma_f32_32x32x16_bf16(kf[6],qr[3],C0,0,0,0),   P1[10],P1[11],P1[12],P1[13], pw3[0]=PKW(P1,8), pw3[1]=PKW(P1,10), pw3); \
    VRD(7); SBAR(); GAPA(C1=__builtin_amdgcn_mfma_f32_32x32x16_bf16(kf[7],qr[3],C1,0,0,0),   P1[14],P1[15],0.f,0.f,       pw3[2]=PKW(P1,12),pw3[3]=PKW(P1,14), pw3); \
    l_reg+=sacc; \
    if(GK){DMA_K((t)+3,sl_cur);} if(GV){DMA_V((t)+1,sl_next);} \
    CMASK(C0,C1,t); \
    { float a=MX3(C0[0],C0[1],C1[0]),b=MX3(C0[2],C0[3],C1[1]); a=MX3(a,C1[2],C1[3]); \
      _Pragma("unroll") for(int r=4;r<16;r+=4){a=MX3(a,C0[r],C0[r+1]);b=MX3(b,C0[r+2],C0[r+3]);a=MX3(a,C1[r],C1[r+1]);b=MX3(b,C1[r+2],C1[r+3]);} \
      float rm=__builtin_fmaxf(a,b); { auto rr=__builtin_amdgcn_permlane32_swap(__float_as_uint(rm),__float_as_uint(rm),false,false); rm=__builtin_fmaxf(__uint_as_float(rr[0]),__uint_as_float(rr[1])); } \
      resc=false; \
      if(__builtin_expect(__any(rm>(float)THRL),0)){ const float dl=__builtin_fmaxf(rm,0.f); mhat+=dl; \
        _Pragma("unroll") for(int r=0;r<16;++r){C0[r]-=dl;C1[r]-=dl;} \
        _Pragma("unroll") for(int r=0;r<16;++r)negm[r]=-mhat; asm volatile("":"+v"(negm)); \
        const float f=__builtin_amdgcn_exp2f(-dl); l_reg*=f; if(hi==0)wsf[r32]=f; resc=true; } } \
    SBAR(); \
    GAPB(o[0]=__builtin_amdgcn_mfma_f32_32x32x16_bf16(PAF(0),VFR(0),o[0],0,0,0), C0,0); \
    GAPB(o[1]=__builtin_amdgcn_mfma_f32_32x32x16_bf16(PAF(0),VFR(4),o[1],0,0,0), C0,4); \
    KRD(GL,0); GAPB(o[0]=__builtin_amdgcn_mfma_f32_32x32x16_bf16(PAF(1),VFR(1),o[0],0,0,0), C0,8); \
    KRD(GL,1); GAPB(o[1]=__builtin_amdgcn_mfma_f32_32x32x16_bf16(PAF(1),VFR(5),o[1],0,0,0), C0,12); \
    KRD(GL,2); GAPB(o[0]=__builtin_amdgcn_mfma_f32_32x32x16_bf16(PAF(2),VFR(2),o[0],0,0,0), C1,0); \
    KRD(GL,3); GAPB(o[1]=__builtin_amdgcn_mfma_f32_32x32x16_bf16(PAF(2),VFR(6),o[1],0,0,0), C1,4); \
    GAPB(o[0]=__builtin_amdgcn_mfma_f32_32x32x16_bf16(PAF(3),VFR(3),o[0],0,0,0), C1,8); \
    GAPB(o[1]=__builtin_amdgcn_mfma_f32_32x32x16_bf16(PAF(3),VFR(7),o[1],0,0,0), C1,12); \
    }while(0)
  int t=1;
  #undef CMASK
  #define CMASK(P0,P1,t) do{}while(0)
  for(;t+5<NT;t+=2){
    STEP(pB0,pB1,pA0,pA1,t,true,true,true);     WAIT_BAR(2); RESC(); ROT();
    STEP(pA0,pA1,pB0,pB1,t+1,true,true,true);   WAIT_BAR(2); RESC(); ROT();
  }
  #undef CMASK
  #define CMASK(P0,P1,t) do{int jb_=(t)-(NT-4); if(jb_>=0)cmask(P0,P1,jb_,qrel,hi);}while(0)
  #define ENDW(tt) do{ if((tt)+3<NT){WAIT_BAR(2);} else if((tt)+2<NT){WAIT_BAR(1);} else {WAIT_BAR(0);} }while(0)
  for(;t+1<NT;t+=2){
    STEP(pB0,pB1,pA0,pA1,t,(t+3<NT),(t+1<NT),(t+1<NT));       ENDW(t);   RESC(); ROT();
    STEP(pA0,pA1,pB0,pB1,t+1,(t+4<NT),(t+2<NT),(t+2<NT));     ENDW(t+1); RESC(); ROT();
  }
  STEP(pB0,pB1,pA0,pA1,NT-1,false,false,false); RESC();
  { float sacc=pB0[0]+pB0[1]; _Pragma("unroll") for(int r=2;r<16;++r)sacc+=pB0[r]; _Pragma("unroll") for(int r=0;r<16;++r)sacc+=pB1[r]; l_reg+=sacc;
    pw0=(u32x4){PKW(pB0,0),PKW(pB0,2),PKW(pB0,4),PKW(pB0,6)};pw1=(u32x4){PKW(pB0,8),PKW(pB0,10),PKW(pB0,12),PKW(pB0,14)};pw2=(u32x4){PKW(pB1,0),PKW(pB1,2),PKW(pB1,4),PKW(pB1,6)};pw3=(u32x4){PKW(pB1,8),PKW(pB1,10),PKW(pB1,12),PKW(pB1,14)};
    SBAR(); pv(o,vb0+sl_cur,PAF(0),PAF(1),PAF(2),PAF(3)); }
  #undef PKW
  #undef PAF
  #undef VFR
  #undef PIN
  #undef MX3
  #undef GAPA
  #undef GAPB
  #undef EX
  #undef VRD
  #undef KRD
  #undef STEP
  #undef ENDW
  {auto rr=__builtin_amdgcn_permlane32_swap(__float_as_uint(l_reg),__float_as_uint(l_reg),false,false);l_reg=__uint_as_float(rr[0])+__uint_as_float(rr[1]);}
  if(hi==0)wsf[32+r32]=l_reg;asm volatile("s_waitcnt lgkmcnt(0)":::"memory");
  float rli[16];
  #pragma unroll
  for(int r=0;r<16;++r)rli[r]=__builtin_amdgcn_rcpf(wsf[32+crow(r,hi)]);
  bf16*Ow=O+(long)(q0+wid*QBLK)*PO;
  { bf16*stg=(bf16*)(shm+LDS_OST)+wid*2048;
    #pragma unroll
    for(int r=0;r<16;++r){const int orow=crow(r,hi);
      #pragma unroll
      for(int d0=0;d0<2;++d0)stg[orow*64+d0*32+r32]=__float2bfloat16(o[d0][r]*rli[r]);}
    asm volatile("s_waitcnt lgkmcnt(0)":::"memory");
    #pragma unroll
    for(int i=0;i<4;++i){const int row=i*8+(lane>>3),ch=lane&7; const u32x4 v=*(const u32x4*)(stg+row*64+ch*8); ATTN_STORE16(Ow+(long)row*PO+ch*8,v);} }
  asm volatile("s_waitcnt lgkmcnt(0)\n\ts_barrier":::"memory");
  #undef DMA_K
  #undef DMA_V
  #undef CMASK
  #undef START
  #undef RESC
  #undef ROT
}
constexpr int ATTN_LDS_BYTES=LDS_BYTES;
template<int THRL=8> __device__ __forceinline__ void attn_phase(char*lds,const bf16*PD,bf16*O,int vcu){
  const int pr=vcu>>3,s=vcu&7,h=pr>>2,m=(pr>>1)&1,vh=pr&1;
  const bf16*Q=PD+h*128+m*64,*K=PD+1024+h*128+m*64,*V=PD+2048+h*128+vh*64; bf16*Op=O+m*1024+h*128+vh*64;
  _Pragma("unroll 1") for(int i=0;i<8;++i){ const int qb=(i>>1)*16+((i&1)?15-s:s); attn_unit<THRL>(qb,Q,K,V,Op,lds); }
}
#undef SBAR
#undef WAIT_BAR
}
#define GAS __attribute__((address_space(1)))
#define LAS __attribute__((address_space(3)))
typedef unsigned short bf16;
typedef unsigned v4u __attribute__((ext_vector_type(4)));
typedef float f32x4 __attribute__((ext_vector_type(4)));
typedef short bf16x8 __attribute__((ext_vector_type(8)));
typedef GAS unsigned gu32;
typedef GAS unsigned long long gu64;
#define RLX_AGENT __ATOMIC_RELAXED, __HIP_MEMORY_SCOPE_AGENT
#define LDS_WAIT() asm volatile("s_waitcnt lgkmcnt(0)" ::: "memory")
#define VM_WAIT() asm volatile("s_waitcnt vmcnt(0)" ::: "memory")
__device__ __forceinline__ unsigned long long rt() { return __builtin_amdgcn_s_memrealtime(); }
__device__ __forceinline__ unsigned f2bf(float f) { unsigned u = __builtin_bit_cast(unsigned, f); return (u + 0x7fffu + ((u >> 16) & 1u)) >> 16; }
__device__ __forceinline__ unsigned pk2(float lo, float hi) { return f2bf(lo) | (f2bf(hi) << 16); }

#define XB_TMO      128
#define XB_XCNT(j)  (256  + 64 * (j))
#define XB_XSUB(j)  (1280 + 64 * (j))
#define XB_XGEN(j)  (2304 + 64 * (j))
#define XB_TOP      3328
#define XB_TOPGEN   3392
#define XCD_BAR_WORDS 3456
#define XB_SPIN_CAP (1u << 18)

__device__ __forceinline__ unsigned xb_ld(unsigned* p)              { return __hip_atomic_load(p, __ATOMIC_RELAXED, __HIP_MEMORY_SCOPE_AGENT); }
__device__ __forceinline__ unsigned xb_add(unsigned* p, unsigned v) { return __hip_atomic_fetch_add(p, v, __ATOMIC_RELAXED, __HIP_MEMORY_SCOPE_AGENT); }
__device__ __forceinline__ unsigned xb_xcc_id() { return (unsigned)__builtin_amdgcn_s_getreg((3 << 11) | 20) & 0xFu; }
#define XB_SPIN(cond, bar) do { unsigned _sp = 0; while (cond) { __builtin_amdgcn_s_sleep(1); \
    if ((++_sp & 255u) == 0u) { if (xb_ld(&(bar)[XB_TMO])) break; if (_sp > XB_SPIN_CAP) { atomicAdd(&(bar)[XB_TMO], 1u); break; } } } } while (0)

struct XcdBarrier {
    unsigned* bar; unsigned x;
    volatile LAS unsigned* st;
};

__device__ __forceinline__ XcdBarrier xcd_barrier_post(unsigned* bar, volatile LAS unsigned* st) {
    XcdBarrier b; b.bar = bar; b.x = xb_xcc_id(); b.st = st;
    if (threadIdx.x == 0) (void)xb_add(&bar[XB_XCNT(b.x)], 1u);
    return b;
}
__device__ __forceinline__ void xcd_barrier_complete(unsigned* bar, unsigned x, unsigned& nloc, unsigned& nx) {
    const unsigned G = gridDim.x * gridDim.y * gridDim.z;
    unsigned sum, cnt, mine, sp = 0u;
    for (;;) {
        sum = 0u; cnt = 0u; mine = 0u;
#pragma unroll
        for (unsigned j = 0; j < 16; ++j) { const unsigned c = xb_ld(&bar[XB_XCNT(j)]); sum += c; cnt += (c > 0u) ? 1u : 0u; mine = (j == x) ? c : mine; }
        if (sum == G) break;
        __builtin_amdgcn_s_sleep(1);
        if ((++sp & 255u) == 0u) { if (xb_ld(&bar[XB_TMO])) break; if (sp > XB_SPIN_CAP) { atomicAdd(&bar[XB_TMO], 1u); break; } }
    }
    nloc = mine > 0u ? mine : 1u; nx = cnt > 0u ? cnt : 1u;
}

__device__ __forceinline__ void xcd_barrier(const XcdBarrier& b) {
    asm volatile("s_waitcnt vmcnt(0)" ::: "memory");
    __syncthreads();
    if (threadIdx.x == 0) {
        unsigned* bar = b.bar;
        __builtin_amdgcn_s_waitcnt(0);
        unsigned nloc = b.st[0], nx = b.st[1];
        if (nloc == 0u) { xcd_barrier_complete(bar, b.x, nloc, nx); b.st[0] = nloc; b.st[1] = nx; }
        const unsigned old = xb_add(&bar[XB_XSUB(b.x)], 1u);
        const unsigned gen = old / nloc;
        if (old + 1u == (gen + 1u) * nloc) {
            __builtin_amdgcn_fence(__ATOMIC_RELEASE, "agent");
            asm volatile("s_waitcnt vmcnt(0)" ::: "memory");
            const unsigned og = xb_add(&bar[XB_TOP], 1u);
            const unsigned tg = og / nx;
            if (og + 1u == (tg + 1u) * nx) xb_add(&bar[XB_TOPGEN], 1u);
            else XB_SPIN(xb_ld(&bar[XB_TOPGEN]) == tg, bar);
            __builtin_amdgcn_fence(__ATOMIC_ACQUIRE, "agent");
            xb_add(&bar[XB_XGEN(b.x)], 1u);
            asm volatile("s_waitcnt vmcnt(0)" ::: "memory");
        } else {
            XB_SPIN(xb_ld(&bar[XB_XGEN(b.x)]) == gen, bar);
            __builtin_amdgcn_fence(__ATOMIC_ACQUIRE, "agent");
            asm volatile("s_waitcnt vmcnt(0)" ::: "memory");
        }
    }
    __syncthreads();
}
constexpr int NWAVES = 8;
constexpr int S_ = 16384, DM = 2048;
constexpr int NPH = 16;
#ifndef MK_PER_PHASE
#define MK_PER_PHASE 0
#endif
constexpr size_t MiB = 1u << 20;
constexpr size_t WS_CTL = 0, CTL_ZERO_BYTES = 1 * MiB;
constexpr size_t WS_WA = 1 * MiB, WS_WB = 5 * MiB, WS_WOUT = 9 * MiB, WS_WS = 17 * MiB, WS_LORA = 25 * MiB;
constexpr size_t WS_WIN = 27 * MiB, WS_PR = 69 * MiB, WS_PD = 181 * MiB, WS_PG = 277 * MiB;
constexpr size_t WS_A = 405 * MiB, WS_E = 437 * MiB, WS_G = 469 * MiB, WS_END = 507 * MiB;
constexpr size_t WS_SCN = 27 * MiB, WS_SCAL = 123 * MiB, WS_SLOC = 127 * MiB, WS_ASEG = 143 * MiB, WS_SIN = 159 * MiB;
constexpr size_t WS_YA = 405 * MiB, WS_OATT = 27 * MiB, WS_YB = 91 * MiB, WS_T1 = 123 * MiB, WS_MERGED = 27 * MiB;
constexpr size_t WS_H2 = 123 * MiB, WS_XN2 = 27 * MiB, WS_UTAB = 251 * MiB, WS_VTAB = 315 * MiB, WS_SCORES = 379 * MiB;
constexpr size_t WS_USCL = WS_UTAB + 16 * MiB, WS_VSCL = WS_VTAB + 16 * MiB;
constexpr size_t OUT_XN = 0, OUT_RKV = 0, OUT_LIN = 96 * MiB;
constexpr int CW_BAR = 4096;
constexpr int RING_OFF = 0, RING_BYTES = 131072;
constexpr int LDSCTL_OFF = RING_BYTES, MISC_OFF = LDSCTL_OFF + 320;
constexpr int LDS_BYTES = 147456;
constexpr int NSEG = 64, SEGLEN = S_ / NSEG;

struct Args { const float* in[28]; float* out; unsigned char* ws; int ph_lo, ph_hi; };

struct Frame {
    LAS unsigned char* lds; volatile LAS unsigned* MISC; gu32* ctl;
    int tid, lane, wave, vcu, G;
};

__device__ __forceinline__ float bf2f(unsigned short b) { return __uint_as_float((unsigned)b << 16); }
__device__ __forceinline__ float wave_sum(float v) {
#pragma unroll
    for (int o = 1; o < 64; o <<= 1) v += __shfl_xor(v, o);
    return v;
}
__device__ __forceinline__ float wave_max(float v) {
#pragma unroll
    for (int o = 1; o < 64; o <<= 1) v = fmaxf(v, __shfl_xor(v, o));
    return v;
}
template <int CTRL, int RM> __device__ __forceinline__ float dppf(float oldv, float x) { return __builtin_bit_cast(float, __builtin_amdgcn_update_dpp(__builtin_bit_cast(int, oldv), __builtin_bit_cast(int, x), CTRL, RM, 0xf, false)); }
__device__ __forceinline__ float wsum(float v) {
    v += dppf<0xB1, 0xf>(v, v); v += dppf<0x4E, 0xf>(v, v); v += dppf<0x141, 0xf>(v, v); v += dppf<0x140, 0xf>(v, v);
    v += dppf<0x142, 0xa>(0.f, v); v += dppf<0x143, 0xc>(0.f, v);
    return __builtin_bit_cast(float, __builtin_amdgcn_readlane(__builtin_bit_cast(int, v), 63));
}
__device__ __forceinline__ float wmax(float v) {
    v = fmaxf(v, dppf<0xB1, 0xf>(v, v)); v = fmaxf(v, dppf<0x4E, 0xf>(v, v)); v = fmaxf(v, dppf<0x141, 0xf>(v, v)); v = fmaxf(v, dppf<0x140, 0xf>(v, v));
    v = fmaxf(v, dppf<0x142, 0xa>(0.f, v)); v = fmaxf(v, dppf<0x143, 0xc>(0.f, v));
    return __builtin_bit_cast(float, __builtin_amdgcn_readlane(__builtin_bit_cast(int, v), 63));
}
__device__ __forceinline__ float sigmf(float x) { return __builtin_amdgcn_rcpf(1.0f + __expf(-x)); }

__device__ __forceinline__ void transpose_block(const float* W, int ldw, int k0, int n0, int kvalid, bf16* WT, int ldt, int drow0, LAS float* scr, int lane) {
#pragma unroll 8
    for (int i = 0; i < 32; ++i) { const int kk = 2 * i + (lane >> 5); const int k = k0 + kk; scr[kk * 33 + (lane & 31)] = (k < kvalid) ? W[(size_t)k * ldw + n0 + (lane & 31)] : 0.f; }
    LDS_WAIT(); asm volatile("" ::: "memory");
    const int c = lane & 7;
#pragma unroll
    for (int j = 0; j < 4; ++j) { const int n = (lane >> 3) + 8 * j; const LAS float* s = scr + (8 * c) * 33 + n;
        v4u o; o.x = pk2(s[0 * 33], s[1 * 33]); o.y = pk2(s[2 * 33], s[3 * 33]); o.z = pk2(s[4 * 33], s[5 * 33]); o.w = pk2(s[6 * 33], s[7 * 33]);
        *(GAS v4u*)(WT + (size_t)(drow0 + n) * ldt + k0 + 8 * c) = o; }
    LDS_WAIT(); asm volatile("" ::: "memory");
}
__device__ __forceinline__ void rms_row_to_bf16(const float* xrow, const float* g, bf16* orow, int lane) {
    const GAS f32x4* xr = (const GAS f32x4*)xrow + lane; const f32x4* gr = (const f32x4*)g + lane;
    f32x4 v[8]; float s = 0.f;
#pragma unroll
    for (int j = 0; j < 8; ++j) { v[j] = xr[64 * j]; s += (v[j].x * v[j].x + v[j].y * v[j].y) + (v[j].z * v[j].z + v[j].w * v[j].w); }
    const float rstd = rsqrtf(wave_sum(s) * (1.f / 2048.f) + 1e-6f);
    GAS unsigned long long* o8 = (GAS unsigned long long*)orow + lane;
#pragma unroll
    for (int j = 0; j < 8; ++j) { const f32x4 gg = gr[64 * j];
        o8[64 * j] = (unsigned long long)pk2(v[j].x * rstd * gg.x, v[j].y * rstd * gg.y) | ((unsigned long long)pk2(v[j].z * rstd * gg.z, v[j].w * rstd * gg.w) << 32); }
}

template <int K, int VAR = 0> __device__ __forceinline__ void fmac_dpp(float& acc, float op, float s) {
    if (VAR == 0) asm("v_fmac_f32_dpp %0, %1, %2 quad_perm:[%c3,%c3,%c3,%c3] row_mask:0xf bank_mask:0xf" : "+v"(acc) : "v"(op), "v"(s), "i"(K));
    else asm("v_fmac_f32_e32 %0, %1, %2" : "+v"(acc) : "v"(op), "v"(s)); }
template <int K, int VAR = 0> __device__ __forceinline__ void mulip_dpp(float& s, float op) {
    if (VAR == 0) asm("v_mul_f32_dpp %0, %1, %0 quad_perm:[%c2,%c2,%c2,%c2] row_mask:0xf bank_mask:0xf" : "+v"(s) : "v"(op), "i"(K));
    else asm("v_mul_f32_e32 %0, %1, %0" : "+v"(s) : "v"(op)); }
#define SCAN_FOR_C(...) _Pragma("unroll") for (int j = 0; j < 4; ++j) { \
    { constexpr int k = 0; _Pragma("unroll") for (int i = 0; i < 4; ++i) { const int c = 16 * j + 4 * k + i; __VA_ARGS__ } } \
    { constexpr int k = 1; _Pragma("unroll") for (int i = 0; i < 4; ++i) { const int c = 16 * j + 4 * k + i; __VA_ARGS__ } } \
    { constexpr int k = 2; _Pragma("unroll") for (int i = 0; i < 4; ++i) { const int c = 16 * j + 4 * k + i; __VA_ARGS__ } } \
    { constexpr int k = 3; _Pragma("unroll") for (int i = 0; i < 4; ++i) { const int c = 16 * j + 4 * k + i; __VA_ARGS__ } } }

constexpr int SCAN_CH = 4;
constexpr int SC_RING = 0, SC_VG = 2 * SCAN_CH * 320, SC_SC = SC_VG + 2 * SCAN_CH * 128, SC_Y = SC_SC + 2 * SCAN_CH * 4, SC_SLOT_F = SC_Y + 2 * SCAN_CH * 64;
template <int KIND, int NOLOAD = 0> __device__ __forceinline__ void scan3_phase(bf16* yabase, const int lane, const int wave, const int vcu, const int G, unsigned char* ws, const float* const* in, const bf16* RKV, LAS float* ldsf) {
    constexpr int CH = SCAN_CH, NCHUNK = SEGLEN / CH;
#define SCAN_BAR() do { asm volatile("s_waitcnt lgkmcnt(0)" ::: "memory"); __builtin_amdgcn_s_barrier(); asm volatile("" ::: "memory"); } while (0)
    const int slot = wave & 3; LAS float* sl = ldsf + slot * SC_SLOT_F;
    for (int round = 0; round * G * 4 < 16 * NSEG; ++round) {
        const int task = round * G * 4 + vcu * 4 + slot; const bool valid = task < 16 * NSEG; const int h = valid ? task / NSEG : 0, seg = valid ? task % NSEG : 0; const int t0 = seg * SEGLEN;
        if (wave >= 4) {
            const bf16* SCN = (const bf16*)(ws + WS_SCN) + ((size_t)h * S_) * 192; const float* SCAL = (const float*)(ws + WS_SCAL) + ((size_t)h * S_) * 4;
            const bf16* Eb = (const bf16*)(ws + WS_E); const bf16* Gb = (const bf16*)(ws + WS_G); bf16* YA = yabase + h * 64 + lane;
            unsigned short pk[CH], pb[CH], pt[CH], pr[CH], pe[CH], pv[CH], pg[CH]; f32x4 psc = (f32x4){0.f, 0.f, 0.f, 0.f};
#define SCAN_ISSUE(n) do { const int tc_ = NOLOAD ? t0 : t0 + (n) * CH; if (NOLOAD && (n) > 1) break; \
            _Pragma("unroll") for (int s = 0; s < CH; ++s) { const size_t t = (size_t)(tc_ + s); \
                pk[s] = SCN[t * 192 + lane]; pb[s] = SCN[t * 192 + 64 + lane]; pt[s] = SCN[t * 192 + 128 + lane]; \
                pr[s] = RKV[t * 3072 + h * 64 + lane]; pe[s] = Eb[t * 1024 + h * 64 + lane]; pv[s] = RKV[t * 3072 + 2048 + h * 64 + lane]; \
                if (KIND == 2) pg[s] = Gb[t * 1024 + h * 64 + lane]; } \
            if (KIND == 2) { if (lane < CH) psc = *(const f32x4*)(SCAL + (size_t)(tc_ + lane) * 4); } } while (0)
#define SCAN_WRITE(n) do { const int b_ = (n) & 1; \
            _Pragma("unroll") for (int s = 0; s < CH; ++s) { const float w = __expf(-bf2f(pe[s])); LAS float* q = sl + SC_RING + (b_ * CH + s) * 320; \
                q[lane] = bf2f(pk[s]); q[64 + lane] = w * bf2f(pr[s]); q[128 + lane] = w; q[192 + lane] = bf2f(pb[s]); q[256 + lane] = bf2f(pt[s]); \
                LAS float* q2 = sl + SC_VG + (b_ * CH + s) * 128; q2[lane] = bf2f(pv[s]); if (KIND == 2) q2[64 + lane] = bf2f(pg[s]); } \
            if (KIND == 2) { if (lane < CH) *(LAS f32x4*)(sl + SC_SC + (b_ * CH + lane) * 4) = psc; } } while (0)
#define SCAN_YSTORE(n) do { if (KIND == 2) { const int tc_ = t0 + (n) * CH; const int b_ = (n) & 1; \
            _Pragma("unroll") for (int s = 0; s < CH; ++s) YA[(size_t)(tc_ + s) * 1024] = (unsigned short)f2bf(sl[SC_Y + (b_ * CH + s) * 64 + lane]); } } while (0)
            if (valid) { SCAN_ISSUE(0); SCAN_WRITE(0); SCAN_ISSUE(1); }
            SCAN_BAR();
#pragma unroll 1
            for (int n = 0; n < NCHUNK; ++n) {
                if (valid) { if (n + 1 < NCHUNK) SCAN_WRITE(n + 1); if (n >= 1) SCAN_YSTORE(n - 1); if (n + 2 < NCHUNK) SCAN_ISSUE(n + 2); }
                SCAN_BAR();
            }
            if (valid) SCAN_YSTORE(NCHUNK - 1);
#undef SCAN_ISSUE
#undef SCAN_WRITE
#undef SCAN_YSTORE
        } else {
            float S[64], M[64]; int ln_ = lane; asm volatile("" : "+v"(ln_));
            if (KIND == 3) {
#pragma unroll
                for (int c = 0; c < 64; ++c) { S[c] = 0.f; M[c] = (c == ln_) ? 1.f : 0.f; }
            } else {
                const f32x4* sp = (const f32x4*)((const float*)(ws + WS_SIN) + (((size_t)h * NSEG + seg) * 64 + lane) * 64);
#pragma unroll
                for (int q = 0; q < 16; ++q) { const f32x4 x = sp[q]; S[4 * q] = x.x; S[4 * q + 1] = x.y; S[4 * q + 2] = x.z; S[4 * q + 3] = x.w; }
            }
            float lg = 0.f, lb = 0.f;
            if (KIND == 2) { lg = in[12][h * 64 + lane]; lb = in[13][h * 64 + lane]; }
            SCAN_BAR();
#pragma unroll 1
            for (int n = 0; n < NCHUNK; ++n) {
                const int b = n & 1;
                if (valid) {
                f32x4 KK[4], WR[4];
                { const LAS f32x4* q4 = (const LAS f32x4*)(sl + SC_RING + (b * CH) * 320) + (lane & 3);
#pragma unroll
                  for (int j = 0; j < 4; ++j) { KK[j] = q4[j * 4]; if (KIND == 2) WR[j] = q4[16 + j * 4]; } }
#pragma unroll 1
                for (int s = 0; s < CH; ++s) {
                    const LAS f32x4* q4 = (const LAS f32x4*)(sl + SC_RING + (b * CH + s) * 320) + (lane & 3);
                    f32x4 WW[4], BB[4], KT[4];
#pragma unroll
                    for (int j = 0; j < 4; ++j) { WW[j] = q4[32 + j * 4]; BB[j] = q4[48 + j * 4]; KT[j] = q4[64 + j * 4]; }
                    const float vt = sl[SC_VG + (b * CH + s) * 128 + lane];
                    float saq[8], ypq[8], sbq[8];
#pragma unroll
                    for (int q = 0; q < 8; ++q) { saq[q] = 0.f; ypq[q] = 0.f; sbq[q] = 0.f; }
                    SCAN_FOR_C( if (NOLOAD != 2) fmac_dpp<k>(saq[(k & 1) * 4 + i], KK[j][i], S[c]); if (KIND == 2) if (NOLOAD != 2) fmac_dpp<k>(ypq[(k & 1) * 4 + i], WR[j][i], S[c]); if (KIND == 3) if (NOLOAD != 2) fmac_dpp<k>(sbq[(k & 1) * 4 + i], KK[j][i], M[c]); )
                    const float sa = ((saq[0] + saq[1]) + (saq[2] + saq[3])) + ((saq[4] + saq[5]) + (saq[6] + saq[7]));
                    const float sb = ((sbq[0] + sbq[1]) + (sbq[2] + sbq[3])) + ((sbq[4] + sbq[5]) + (sbq[6] + sbq[7]));
                    const float yp0 = ((ypq[0] + ypq[1]) + (ypq[2] + ypq[3])), yp1 = ((ypq[4] + ypq[5]) + (ypq[6] + ypq[7]));
                    if (KIND == 2) { const LAS f32x4* qn = (const LAS f32x4*)(sl + SC_RING + (b * CH + ((s + 1) & (CH - 1))) * 320) + (lane & 3);
#pragma unroll
                      for (int j = 0; j < 4; ++j) { KK[j] = qn[j * 4]; WR[j] = qn[16 + j * 4]; } }
                    SCAN_FOR_C( if (NOLOAD != 2) mulip_dpp<k>(S[c], WW[j][i]); )
                    SCAN_FOR_C( if (NOLOAD != 2) fmac_dpp<k>(S[c], BB[j][i], sa); )
                    SCAN_FOR_C( if (NOLOAD != 2) fmac_dpp<k>(S[c], KT[j][i], vt); )
                    if (KIND == 3) { asm volatile("" ::: "memory");
                      { const LAS f32x4* qn = (const LAS f32x4*)(sl + SC_RING + (b * CH + ((s + 1) & (CH - 1))) * 320) + (lane & 3);
#pragma unroll
                        for (int j = 0; j < 4; ++j) KK[j] = qn[j * 4]; }
                      SCAN_FOR_C( if (NOLOAD != 2) mulip_dpp<k>(M[c], WW[j][i]); )
                      SCAN_FOR_C( if (NOLOAD != 2) fmac_dpp<k>(M[c], BB[j][i], sb); ) }
                    if (KIND == 2) {
                        const f32x4 sc = *(const LAS f32x4*)(sl + SC_SC + (b * CH + s) * 4); const float gt_ = sl[SC_VG + (b * CH + s) * 128 + 64 + lane];
                        const float y = (yp0 + yp1) + sa * sc.x + vt * sc.y;
                        const float mean = wsum(y) * (1.f / 64.f); const float d = y - mean;
                        const float var = wsum(d * d) * (1.f / 64.f);
                        sl[SC_Y + (b * CH + s) * 64 + lane] = (d * rsqrtf(var + 64e-5f) * lg + lb + sc.z * vt) * gt_;
                    }
                }
                }
                SCAN_BAR();
            }
            if (KIND == 3 && valid) {
                f32x4* op = (f32x4*)((float*)(ws + WS_SLOC) + (((size_t)h * NSEG + seg) * 64 + lane) * 64);
                f32x4* oq = (f32x4*)((float*)(ws + WS_ASEG) + (((size_t)h * NSEG + seg) * 64 + lane) * 64);
#pragma unroll
                for (int q = 0; q < 16; ++q) { op[q] = (f32x4){S[4 * q], S[4 * q + 1], S[4 * q + 2], S[4 * q + 3]}; oq[q] = (f32x4){M[4 * q], M[4 * q + 1], M[4 * q + 2], M[4 * q + 3]}; }
            }
        }
        SCAN_BAR();
    }
}

__global__ void __launch_bounds__(NWAVES * 64, 2) mk_fwd(Args args) {
    extern __shared__ __attribute__((aligned(16))) unsigned char lds[];
    Frame F;
    F.lds = (LAS unsigned char*)lds; F.MISC = (volatile LAS unsigned*)(F.lds + MISC_OFF);
    F.tid = threadIdx.x; F.wave = __builtin_amdgcn_readfirstlane(F.tid >> 6);
    F.G = gridDim.x; { const int bx = blockIdx.x; F.vcu = (F.G % 8 == 0) ? (bx % 8) * (F.G / 8) + bx / 8 : bx; }
    unsigned char* ws = args.ws; F.ctl = (gu32*)(ws + WS_CTL);
    const float* const* in = args.in;
    unsigned char* ob = (unsigned char*)args.out;
    for (int u = threadIdx.x; u < (LDS_BYTES - LDSCTL_OFF) / 4; u += NWAVES * 64) ((LAS unsigned*)(F.lds + LDSCTL_OFF))[u] = 0u;
    __syncthreads();
    XcdBarrier bar; bar.bar = (unsigned*)(F.ctl + CW_BAR); bar.x = 0; bar.st = nullptr;
    if (!MK_PER_PHASE) bar = xcd_barrier_post((unsigned*)(F.ctl + CW_BAR), F.MISC + 8);
    const int lo = args.ph_lo, hi = args.ph_hi;
#ifndef PH_MASK
#define PH_MASK 0xFFFF
#endif
#define IN(k) ((((PH_MASK) >> (k)) & 1) && lo <= (k) && (k) < hi)
#ifndef PROBE_MASK
#define PROBE_MASK 0
#endif
#ifndef PROBE_VARIANT
#define PROBE_VARIANT 0
#endif
#ifndef PROBE_N
#define PROBE_N 1
#endif
#define PHASE_BEGIN(k) if (IN(k)) { for (int rep_ = 0; rep_ < 1 + ((((PROBE_MASK) >> (k)) & 1) ? (PROBE_N) : 0); ++rep_) { if (rep_) xcd_barrier(bar); PHASE_IDS
#define PHASE_END } }
#define SEAM(k) do { if (IN(k) && IN((k) + 1)) xcd_barrier(bar); } while (0)
    const int gw = F.vcu * NWAVES + F.wave, NGW = F.G * NWAVES; const int NGT = F.G * NWAVES * 64;
#define PHASE_IDS int tid__ = threadIdx.x; asm volatile("" : "+v"(tid__)); const int tid = tid__, lane = tid & 63, gt = F.vcu * (NWAVES * 64) + tid; (void)gt; (void)lane;

    bf16* WIN_T = (bf16*)(ws + WS_WIN); bf16* WA_T = (bf16*)(ws + WS_WA); bf16* WB_T = (bf16*)(ws + WS_WB); bf16* WOUT_T = (bf16*)(ws + WS_WOUT);
    bf16* WS_T = (bf16*)(ws + WS_WS); bf16* LORA_T = (bf16*)(ws + WS_LORA);
    bf16* XN = (bf16*)(ob + OUT_XN); bf16* RKV = (bf16*)(ob + OUT_RKV); bf16* LIN = (bf16*)(ob + OUT_LIN);
    bf16* PR = (bf16*)(ws + WS_PR); bf16* PD = (bf16*)(ws + WS_PD); bf16* PG = (bf16*)(ws + WS_PG);

    PHASE_BEGIN(0)
        LAS float* scr = (LAS float*)(F.lds + RING_OFF + F.wave * 16384);
        constexpr int I_IN = 32 * 334, I_A = 16 * 64, I_B = 16 * 64, I_O = 32 * 64, I_L = 4 * 32;
        constexpr int NIT = I_IN + I_A + I_B + I_O + 3 * I_L;
        for (int it = gw; it < NIT; it += NGW) {
            int r = it;
            if (r < I_IN) { const int kb = r / 334, nb = r % 334, n0 = nb * 32; transpose_block(in[2], 10688, kb * 64, n0, 2048, WIN_T, 2048, n0 + (n0 >= 3520 ? 64 : 0), scr, lane); continue; } r -= I_IN;
            if (r < I_A) { const int kb = r / 64, nb = r % 64; transpose_block(in[19], 2048, kb * 64, nb * 32, 1024, WA_T, 1024, nb * 32, scr, lane); continue; } r -= I_A;
            if (r < I_B) { const int kb = r / 64, nb = r % 64; transpose_block(in[20], 2048, kb * 64, nb * 32, 1024, WB_T, 1024, nb * 32, scr, lane); continue; } r -= I_B;
            if (r < I_O) { const int kb = r / 64, nb = r % 64; transpose_block(in[21], 2048, kb * 64, nb * 32, 2048, WOUT_T, 2048, nb * 32, scr, lane); continue; } r -= I_O;
            { const int which = r / I_L, rr = r % I_L, kb = rr / 32, nb = rr % 32; const float* W = which == 0 ? in[5] : (which == 1 ? in[7] : in[8]);
              transpose_block(W, 1024, kb * 64, nb * 32, which == 2 ? 256 : 96, LORA_T + (size_t)which * 1024 * 256, 256, nb * 32, scr, lane); }
        }
        for (int i = gt; i < 16384; i += NGT) *(GAS v4u*)(WIN_T + (size_t)3520 * 2048 + (size_t)i * 8) = (v4u){0u, 0u, 0u, 0u};
        for (int task = gw; task < 16 * 32 * 4; task += NGW) {
            const int hp = task >> 7, kb = (task >> 2) & 31, ng = task & 3; const int k = kb * 64 + lane;
            const f32x4* wq = (const f32x4*)(in[23] + (size_t)k * 2048 + hp * 128);
            f32x4 q[32];
#pragma unroll
            for (int d = 0; d < 32; ++d) q[d] = wq[d];
            const float* sk = in[24] + ((size_t)hp * 128 + ng * 32) * 128;
            for (int n = 0; n < 32; ++n) { const f32x4* s4 = (const f32x4*)(sk + (size_t)n * 128); float a0 = 0.f, a1 = 0.f;
#pragma unroll
                for (int d = 0; d < 32; ++d) { const f32x4 s = s4[d]; a0 = fmaf(q[d].x, s.x, a0); a1 = fmaf(q[d].y, s.y, a1); a0 = fmaf(q[d].z, s.z, a0); a1 = fmaf(q[d].w, s.w, a1); }
                WS_T[(size_t)(hp * 128 + ng * 32 + n) * 2048 + k] = (bf16)f2bf(a0 + a1); }
        }
        for (int m = gw; m < S_; m += NGW) rms_row_to_bf16(in[0] + (size_t)m * DM, in[1], XN + (size_t)m * DM, lane);
    PHASE_END
    SEAM(0);
    PHASE_BEGIN(1)
        pg8::Gemm g{XN, WIN_T, S_, 10752, 2048, 2048, 2048}; pg8::StaticOrder S; S.init(S_, 10752, F.G, (int)blockIdx.x);
        pg8::Epi<pg8::EM_G1> E{PR, PD, PG, nullptr, nullptr, nullptr, attn_body::C2};
        pg8::gemm_phase<pg8::Epi<pg8::EM_G1>, pg8::StaticOrder, true, true>(F.lds + RING_OFF, g, S, E);
    PHASE_END
    SEAM(1);
    PHASE_BEGIN(2)
        const float* mu = in[3];
        for (int t = gw; t < S_; t += NGW) {
            const bf16* cur = PR + (size_t)t * 3584; const bf16* prv = cur - 3584;
#pragma unroll 1
            for (int j = 0; j < 7; ++j) { const int ch = lane + 64 * j; if (ch >= 440) break;
                const v4u c4 = *(const GAS v4u*)(cur + ch * 8); v4u p4 = (v4u){0u, 0u, 0u, 0u}; if (t > 0) p4 = *(const GAS v4u*)(prv + ch * 8);
                const f32x4 m0 = *(const f32x4*)(mu + ch * 8), m1 = *(const f32x4*)(mu + ch * 8 + 4);
                float c[8] = {pg8::bflo(c4.x), pg8::bfhi(c4.x), pg8::bflo(c4.y), pg8::bfhi(c4.y), pg8::bflo(c4.z), pg8::bfhi(c4.z), pg8::bflo(c4.w), pg8::bfhi(c4.w)};
                const float p[8] = {pg8::bflo(p4.x), pg8::bfhi(p4.x), pg8::bflo(p4.y), pg8::bfhi(p4.y), pg8::bflo(p4.z), pg8::bfhi(p4.z), pg8::bflo(p4.w), pg8::bfhi(p4.w)};
                const float mm[8] = {m0.x, m0.y, m0.z, m0.w, m1.x, m1.y, m1.z, m1.w};
#pragma unroll
                for (int e = 0; e < 8; ++e) c[e] = c[e] + (p[e] - c[e]) * mm[e];
                bf16* dst;
                if (ch < 384) dst = RKV + (size_t)t * 3072 + ch * 8;
                else { const int col = ch * 8 - 3072;
                    if (col < 96) { dst = LIN + (size_t)t * 768 + col;
#pragma unroll
                        for (int e = 0; e < 8; ++e) c[e] = tanhf(c[e]); }
                    else if (col < 192) dst = LIN + (size_t)t * 768 + 256 + (col - 96);
                    else { dst = LIN + (size_t)t * 768 + 512 + (col - 192);
#pragma unroll
                        for (int e = 0; e < 8; ++e) c[e] = sigmf(c[e]); } }
                *(GAS v4u*)dst = (v4u){pk2(c[0], c[1]), pk2(c[2], c[3]), pk2(c[4], c[5]), pk2(c[6], c[7])};
            }
            if (lane < 40) { const int z = lane < 20 ? 96 + lane * 8 : 352 + (lane - 20) * 8; *(GAS v4u*)(LIN + (size_t)t * 768 + z) = (v4u){0u, 0u, 0u, 0u}; }
        }
    PHASE_END
    SEAM(2);
    PHASE_BEGIN(3)
#pragma unroll 1
        for (int which = 0; which < 3; ++which) {
            int kd = 256; asm volatile("" : "+s"(kd));
            pg8::Gemm g{LIN + which * 256, LORA_T + (size_t)which * 1024 * 256, S_, 1024, kd, 768, 256}; pg8::StaticOrder S; S.init(S_, 1024, F.G, (int)blockIdx.x);
            pg8::Epi<pg8::EM_LORA_W> E{ws + (which == 0 ? WS_E : (which == 1 ? WS_A : WS_G)), nullptr, nullptr, nullptr, nullptr, which == 0 ? in[4] : (which == 1 ? in[6] : nullptr), which == 0 ? 0.60653065971f : 1.f};
            pg8::gemm_phase<pg8::Epi<pg8::EM_LORA_W>, pg8::StaticOrder, true, true>(F.lds + RING_OFF, g, S, E); }
    PHASE_END
    SEAM(3);
    PHASE_BEGIN(4)
        bf16* SCN = (bf16*)(ws + WS_SCN); float* SCAL = (float*)(ws + WS_SCAL); const bf16* Ab = (const bf16*)(ws + WS_A);
        for (int t = gw; t < S_; t += NGW) {
#pragma unroll 2
            for (int h = 0; h < 16; ++h) { const int cc = h * 64 + lane;
                const float r = bf2f(RKV[(size_t)t * 3072 + cc]), k = bf2f(RKV[(size_t)t * 3072 + 1024 + cc]), a = bf2f(Ab[(size_t)t * 1024 + cc]);
                float kk = k * in[9][cc]; const float nrm = sqrtf(wsum(kk * kk)); kk = kk / fmaxf(nrm, 1e-12f);
                const float kt = k * (1.f + (a - 1.f) * in[10][cc]); const float b = kk * a;
                const unsigned short kkb = (unsigned short)f2bf(-kk), bb = (unsigned short)f2bf(b), ktb = (unsigned short)f2bf(kt);
                bf16* q = SCN + ((size_t)h * S_ + t) * 192; q[lane] = kkb; q[64 + lane] = bb; q[128 + lane] = ktb;
                const float br = wsum(bf2f(bb) * r), kr = wsum(bf2f(ktb) * r), bon = wsum(r * kt * in[11][cc]);
                if (lane == 0) *(f32x4*)(SCAL + ((size_t)h * S_ + t) * 4) = (f32x4){br, kr, bon, 0.f}; }
        }
    PHASE_END
    SEAM(4);
    PHASE_BEGIN(5)
        scan3_phase<3>(nullptr, lane, F.wave, F.vcu, F.G, ws, in, RKV, (LAS float*)(F.lds + RING_OFF));
    PHASE_END
    SEAM(5);
    PHASE_BEGIN(6)
        if (F.vcu < 16) { const int h = F.vcu; const int v = tid >> 3, cg = tid & 7;
            LAS float* Sb = (LAS float*)(F.lds + RING_OFF); LAS float* Ab = Sb + 2 * 64 * 65;
            const float* SL = (const float*)(ws + WS_SLOC) + (size_t)h * NSEG * 4096; const float* AS = (const float*)(ws + WS_ASEG) + (size_t)h * NSEG * 4096; float* SI = (float*)(ws + WS_SIN) + (size_t)h * NSEG * 4096;
            f32x4 s0 = (f32x4){0.f, 0.f, 0.f, 0.f}, s1 = s0; int cur = 0;
            f32x4 na0 = *(const f32x4*)(AS + (size_t)v * 64 + cg * 8), na1 = *(const f32x4*)(AS + (size_t)v * 64 + cg * 8 + 4);
            f32x4 nl0 = *(const f32x4*)(SL + (size_t)v * 64 + cg * 8), nl1 = *(const f32x4*)(SL + (size_t)v * 64 + cg * 8 + 4);
            for (int p = 0; p < NSEG; ++p) {
                *(f32x4*)(SI + (size_t)p * 4096 + v * 64 + cg * 8) = s0; *(f32x4*)(SI + (size_t)p * 4096 + v * 64 + cg * 8 + 4) = s1;
                if (p == NSEG - 1) break;
                LAS float* sw = Sb + cur * 64 * 65 + v * 65 + cg * 8; sw[0] = s0.x; sw[1] = s0.y; sw[2] = s0.z; sw[3] = s0.w; sw[4] = s1.x; sw[5] = s1.y; sw[6] = s1.z; sw[7] = s1.w;
                *(LAS f32x4*)(Ab + v * 64 + cg * 8) = na0; *(LAS f32x4*)(Ab + v * 64 + cg * 8 + 4) = na1;
                f32x4 a0 = nl0, a1 = nl1;
                if (p + 1 < NSEG - 1) { const size_t o = (size_t)(p + 1) * 4096 + v * 64 + cg * 8; na0 = *(const f32x4*)(AS + o); na1 = *(const f32x4*)(AS + o + 4); nl0 = *(const f32x4*)(SL + o); nl1 = *(const f32x4*)(SL + o + 4); }
                __syncthreads();
                const LAS float* sr = Sb + cur * 64 * 65 + v * 65;
#pragma unroll 8
                for (int c = 0; c < 64; ++c) { const float s = sr[c]; const f32x4 x0 = *(const LAS f32x4*)(Ab + c * 64 + cg * 8), x1 = *(const LAS f32x4*)(Ab + c * 64 + cg * 8 + 4); a0 = a0 + x0 * s; a1 = a1 + x1 * s; }
                s0 = a0; s1 = a1; cur ^= 1;
                __syncthreads();
            }
        }
    PHASE_END
    SEAM(6);
    PHASE_BEGIN(7)
#if PROBE_VARIANT
        if (rep_) scan3_phase<2, PROBE_VARIANT>((bf16*)(ob + OUT_LIN), lane, F.wave, F.vcu, F.G, ws, in, RKV, (LAS float*)(F.lds + RING_OFF)); else
#endif
        scan3_phase<2>((bf16*)(ws + WS_YA), lane, F.wave, F.vcu, F.G, ws, in, RKV, (LAS float*)(F.lds + RING_OFF));
    PHASE_END
    SEAM(7);
    PHASE_BEGIN(8)
        __syncthreads();
        attn_body::attn_phase<8>((char*)lds + RING_OFF, (const attn_body::bf16*)PD, (attn_body::bf16*)(ws + WS_OATT), F.vcu);
    PHASE_END
    SEAM(8);
    PHASE_BEGIN(9)
        float d1 = 0.f, d2 = 0.f; d1 = in[14][lane] * in[15][lane]; d2 = in[16][lane] * in[17][lane];
        const float lam = __expf(wave_sum(d1)) - __expf(wave_sum(d2)) + 0.2f;
        const bf16* OA = (const bf16*)(ws + WS_OATT); bf16* YB = (bf16*)(ws + WS_YB);
        f32x4 sg[4];
#pragma unroll
        for (int q = 0; q < 4; ++q) sg[q] = *(const f32x4*)(in[18] + (lane & 7) * 16 + q * 4);
        for (int t = gw; t < S_; t += NGW) {
            const v4u a0 = *(const GAS v4u*)(OA + (size_t)t * 2048 + lane * 16), a1 = *(const GAS v4u*)(OA + (size_t)t * 2048 + lane * 16 + 8);
            const v4u b0 = *(const GAS v4u*)(OA + (size_t)t * 2048 + 1024 + lane * 16), b1 = *(const GAS v4u*)(OA + (size_t)t * 2048 + 1024 + lane * 16 + 8);
            const unsigned aw[8] = {a0.x, a0.y, a0.z, a0.w, a1.x, a1.y, a1.z, a1.w}, bw[8] = {b0.x, b0.y, b0.z, b0.w, b1.x, b1.y, b1.z, b1.w};
            float o[16]; float ss = 0.f;
#pragma unroll
            for (int e = 0; e < 8; ++e) { o[2 * e] = pg8::bflo(aw[e]) - lam * pg8::bflo(bw[e]); o[2 * e + 1] = pg8::bfhi(aw[e]) - lam * pg8::bfhi(bw[e]); ss += o[2 * e] * o[2 * e] + o[2 * e + 1] * o[2 * e + 1]; }
            ss += __shfl_xor(ss, 1); ss += __shfl_xor(ss, 2); ss += __shfl_xor(ss, 4);
            const float rs = rsqrtf(ss * (1.f / 128.f) + 1e-5f) * 0.8f;
            const float gg[16] = {sg[0].x, sg[0].y, sg[0].z, sg[0].w, sg[1].x, sg[1].y, sg[1].z, sg[1].w, sg[2].x, sg[2].y, sg[2].z, sg[2].w, sg[3].x, sg[3].y, sg[3].z, sg[3].w};
#pragma unroll
            for (int e = 0; e < 16; ++e) o[e] = o[e] * rs * gg[e];
            *(GAS v4u*)(YB + (size_t)t * 1024 + lane * 16) = (v4u){pk2(o[0], o[1]), pk2(o[2], o[3]), pk2(o[4], o[5]), pk2(o[6], o[7])};
            *(GAS v4u*)(YB + (size_t)t * 1024 + lane * 16 + 8) = (v4u){pk2(o[8], o[9]), pk2(o[10], o[11]), pk2(o[12], o[13]), pk2(o[14], o[15])};
        }
    PHASE_END
    SEAM(9);
    PHASE_BEGIN(10)
        pg8::Gemm g{(const bf16*)(ws + WS_YA), WA_T, S_, 2048, 1024, 1024, 1024}; pg8::StaticOrder S; S.init(S_, 2048, F.G, (int)blockIdx.x);
        pg8::Epi<pg8::EM_PROJA> E{ws + WS_T1, nullptr, nullptr, PG, nullptr, nullptr, 1.f};
        pg8::gemm_phase<pg8::Epi<pg8::EM_PROJA>, pg8::StaticOrder, true, true>(F.lds + RING_OFF, g, S, E);
    PHASE_END
    SEAM(10);
    PHASE_BEGIN(11)
        pg8::Gemm g{(const bf16*)(ws + WS_YB), WB_T, S_, 2048, 1024, 1024, 1024}; pg8::StaticOrder S; S.init(S_, 2048, F.G, (int)blockIdx.x);
        pg8::Epi<pg8::EM_PROJB> E{ws + WS_MERGED, nullptr, nullptr, PG, ws + WS_T1, nullptr, 1.f};
        pg8::gemm_phase<pg8::Epi<pg8::EM_PROJB>, pg8::StaticOrder, true, true>(F.lds + RING_OFF, g, S, E);
    PHASE_END
    SEAM(11);
    PHASE_BEGIN(12)
        pg8::Gemm g{(const bf16*)(ws + WS_MERGED), WOUT_T, S_, 2048, 2048, 2048, 2048}; pg8::StaticOrder S; S.init(S_, 2048, F.G, (int)blockIdx.x);
        pg8::Epi<pg8::EM_WOUT> E{ws + WS_H2, nullptr, nullptr, nullptr, in[0], nullptr, 1.f};
        pg8::gemm_phase<pg8::Epi<pg8::EM_WOUT>, pg8::StaticOrder, true, true>(F.lds + RING_OFF, g, S, E);
    PHASE_END
    SEAM(12);
    PHASE_BEGIN(13)
        for (int m = gw; m < S_; m += NGW) rms_row_to_bf16((const float*)(ws + WS_H2) + (size_t)m * DM, in[22], (bf16*)(ws + WS_XN2) + (size_t)m * DM, lane);
        for (int row = gw; row < 32768; row += NGW) { const int which = row >> 14, r = row & 16383;
            const f32x4* src = (const f32x4*)(in[25 + which] + (size_t)r * 2048) + lane; f32x4 v[8]; float am = 0.f;
#pragma unroll
            for (int j = 0; j < 8; ++j) { v[j] = __builtin_nontemporal_load(src + 64 * j); am = fmaxf(am, fmaxf(fmaxf(fabsf(v[j].x), fabsf(v[j].y)), fmaxf(fabsf(v[j].z), fabsf(v[j].w)))); }
            const unsigned tb = __float_as_uint(am * (1.f / 6.f)); unsigned eb = (tb >> 23) + ((tb & 0x7fffffu) ? 1u : 0u); eb = eb < 1u ? 1u : (eb > 254u ? 254u : eb);
            const float sc = __uint_as_float(eb << 23);
            unsigned wd[4];
#pragma unroll
            for (int w = 0; w < 4; ++w) { unsigned q = 0u;
                q = __builtin_amdgcn_cvt_scalef32_pk_fp4_f32(q, v[2 * w].x, v[2 * w].y, sc, 0); q = __builtin_amdgcn_cvt_scalef32_pk_fp4_f32(q, v[2 * w].z, v[2 * w].w, sc, 1);
                q = __builtin_amdgcn_cvt_scalef32_pk_fp4_f32(q, v[2 * w + 1].x, v[2 * w + 1].y, sc, 2); q = __builtin_amdgcn_cvt_scalef32_pk_fp4_f32(q, v[2 * w + 1].z, v[2 * w + 1].w, sc, 3); wd[w] = q; }
            *(GAS v4u*)(ws + (which ? WS_VTAB : WS_UTAB) + (size_t)r * 1024 + lane * 16) = (v4u){wd[0], wd[1], wd[2], wd[3]};
            ((unsigned char*)(ws + (which ? WS_VSCL : WS_USCL)))[(size_t)r * 64 + lane] = (unsigned char)eb; }
    PHASE_END
    SEAM(13);
    PHASE_BEGIN(14)
        pg8::Gemm g{(const bf16*)(ws + WS_XN2), WS_T, S_, 2048, 2048, 2048, 2048}; pg8::StaticOrder S; S.init(S_, 2048, F.G, (int)blockIdx.x);
        pg8::Epi<pg8::EM_SCORES> E{ws + WS_SCORES, nullptr, nullptr, nullptr, nullptr, nullptr, 1.f};
        pg8::gemm_phase<pg8::Epi<pg8::EM_SCORES>, pg8::StaticOrder, true, true>(F.lds + RING_OFF, g, S, E);
    PHASE_END
    SEAM(14);
    PHASE_BEGIN(15)
        const float* SC = (const float*)(ws + WS_SCORES); const bf16* XN2 = (const bf16*)(ws + WS_XN2);
        const unsigned char* UT = (const unsigned char*)(ws + WS_UTAB); const unsigned char* VT = (const unsigned char*)(ws + WS_VTAB);
        const unsigned char* USB = (const unsigned char*)(ws + WS_USCL); const unsigned char* VSB = (const unsigned char*)(ws + WS_VSCL);
        LAS unsigned* lst = (LAS unsigned*)(F.lds + RING_OFF + F.wave * 10240);
        for (int tb = gw; tb < S_ / 8; tb += NGW) {
            { const int tl = lane >> 3, h = lane & 7; const float* srow = SC + (size_t)(tb * 8 + tl) * 2048 + h * 256;
              float A[16], B[16];
#pragma unroll
              for (int p = 0; p < 2; ++p) { float top[16];
#pragma unroll
                  for (int k = 0; k < 16; ++k) top[k] = -INFINITY;
#pragma unroll 2
                  for (int i4 = 0; i4 < 32; ++i4) { const f32x4 v = *(const f32x4*)(srow + p * 128 + i4 * 4); const float ve[4] = {v.x, v.y, v.z, v.w};
#pragma unroll
                      for (int e = 0; e < 4; ++e) { float x = __uint_as_float((__float_as_uint(ve[e]) & 0xffffff80u) | (unsigned)(i4 * 4 + e));
#pragma unroll
                          for (int k = 0; k < 16; ++k) { const float hi = fmaxf(top[k], x); x = fminf(top[k], x); top[k] = hi; } } }
#pragma unroll
                  for (int k = 0; k < 16; ++k) { if (p == 0) A[k] = top[k]; else B[k] = top[k]; } }
              LAS unsigned* ixl = (LAS unsigned*)(F.lds + RING_OFF + F.wave * 10240 + 8192) + lane * 8;
              { unsigned wa[4], wb[4];
#pragma unroll
                for (int q = 0; q < 4; ++q) { wa[q] = 0u; wb[q] = 0u;
#pragma unroll
                    for (int e = 0; e < 4; ++e) { wa[q] |= (__float_as_uint(A[q * 4 + e]) & 127u) << (8 * e); wb[q] |= (__float_as_uint(B[q * 4 + e]) & 127u) << (8 * e); } }
                *(LAS v4u*)ixl = (v4u){wa[0], wa[1], wa[2], wa[3]}; *(LAS v4u*)(ixl + 4) = (v4u){wb[0], wb[1], wb[2], wb[3]}; }
              float cs[16];
#pragma unroll
              for (int k = 0; k < 16; ++k) cs[k] = -INFINITY;
#pragma unroll
              for (int i = 0; i < 16; ++i)
#pragma unroll
                  for (int j = 0; j < 16; ++j) if ((i + 1) * (j + 1) <= 16) {
                      float x = __uint_as_float((__float_as_uint(A[i] + B[j]) & 0xffffff00u) | (unsigned)(i * 16 + j));
#pragma unroll
                      for (int k = 0; k < 16; ++k) { const float hi = fmaxf(cs[k], x); x = fminf(cs[k], x); cs[k] = hi; } }
              LDS_WAIT(); asm volatile("" ::: "memory");
              const LAS unsigned char* ixb = (const LAS unsigned char*)ixl;
              unsigned cx[16]; float gsum = 0.f; const float cmax = cs[0];
#pragma unroll
              for (int k = 0; k < 16; ++k) { const unsigned ij = __float_as_uint(cs[k]) & 255u; cx[k] = ((unsigned)ixb[ij >> 4] << 7) | (unsigned)ixb[16 + (ij & 15u)]; cs[k] = __expf(cs[k] - cmax); gsum += cs[k]; }
              const float ginv = 1.f / gsum; LAS unsigned* lp = lst + (tl * 128 + h * 16) * 2;
#pragma unroll
              for (int k = 0; k < 16; k += 2) *(LAS v4u*)(lp + k * 2) = (v4u){cx[k], __float_as_uint(cs[k] * ginv), cx[k + 1], __float_as_uint(cs[k + 1] * ginv)}; }
            LDS_WAIT(); asm volatile("" ::: "memory");
#pragma unroll 1
            for (int tl = 0; tl < 8; ++tl) { const int t = tb * 8 + tl;
                float xf[32];
#pragma unroll
                for (int j = 0; j < 8; ++j) { const unsigned long long w = *(const GAS unsigned long long*)(XN2 + (size_t)t * 2048 + 256 * j + 4 * lane);
                    xf[4 * j] = pg8::bflo((unsigned)w); xf[4 * j + 1] = pg8::bfhi((unsigned)w); xf[4 * j + 2] = pg8::bflo((unsigned)(w >> 32)); xf[4 * j + 3] = pg8::bfhi((unsigned)(w >> 32)); }
                float acc[32];
#pragma unroll
                for (int e = 0; e < 32; ++e) acc[e] = 0.f;
                constexpr int EG = 8;
#pragma unroll 1
                for (int e0 = 0; e0 < 128; e0 += EG) {
                    v4u ur[EG], vr[EG]; float gate[EG]; unsigned char sub[EG], svb[EG];
#pragma unroll
                    for (int q = 0; q < EG; ++q) { const unsigned idx = __builtin_amdgcn_readfirstlane(lst[(tl * 128 + e0 + q) * 2]); gate[q] = __uint_as_float(__builtin_amdgcn_readfirstlane(lst[(tl * 128 + e0 + q) * 2 + 1]));
                        ur[q] = *(const GAS v4u*)(UT + (size_t)idx * 1024 + lane * 16); vr[q] = *(const GAS v4u*)(VT + (size_t)idx * 1024 + lane * 16);
                        sub[q] = USB[(size_t)idx * 64 + lane]; svb[q] = VSB[(size_t)idx * 64 + lane]; }
#pragma unroll
                    for (int q = 0; q < EG; ++q) { float d0 = 0.f, d1 = 0.f; const float su = __uint_as_float((unsigned)sub[q] << 23), sv = __uint_as_float((unsigned)svb[q] << 23);
                        const unsigned uw[4] = {ur[q].x, ur[q].y, ur[q].z, ur[q].w};
#pragma unroll
                        for (int w = 0; w < 4; ++w) {
                            const auto p0 = __builtin_amdgcn_cvt_scalef32_pk_f32_fp4(uw[w], su, 0), p1 = __builtin_amdgcn_cvt_scalef32_pk_f32_fp4(uw[w], su, 1), p2 = __builtin_amdgcn_cvt_scalef32_pk_f32_fp4(uw[w], su, 2), p3 = __builtin_amdgcn_cvt_scalef32_pk_f32_fp4(uw[w], su, 3);
                            d0 = fmaf(xf[8 * w], p0[0], d0); d1 = fmaf(xf[8 * w + 1], p0[1], d1); d0 = fmaf(xf[8 * w + 2], p1[0], d0); d1 = fmaf(xf[8 * w + 3], p1[1], d1);
                            d0 = fmaf(xf[8 * w + 4], p2[0], d0); d1 = fmaf(xf[8 * w + 5], p2[1], d1); d0 = fmaf(xf[8 * w + 6], p3[0], d0); d1 = fmaf(xf[8 * w + 7], p3[1], d1); }
                        const float d = wsum(d0 + d1);
                        const float act = 0.5f * d * (1.f + erff(d * 0.70710678118f)); const float cf = gate[q] * act; const float cs = cf * sv;
                        const unsigned vw[4] = {vr[q].x, vr[q].y, vr[q].z, vr[q].w};
#pragma unroll
                        for (int w = 0; w < 4; ++w) {
                            const auto p0 = __builtin_amdgcn_cvt_scalef32_pk_f32_fp4(vw[w], 1.0f, 0), p1 = __builtin_amdgcn_cvt_scalef32_pk_f32_fp4(vw[w], 1.0f, 1), p2 = __builtin_amdgcn_cvt_scalef32_pk_f32_fp4(vw[w], 1.0f, 2), p3 = __builtin_amdgcn_cvt_scalef32_pk_f32_fp4(vw[w], 1.0f, 3);
                            acc[8 * w] = fmaf(cs, p0[0], acc[8 * w]); acc[8 * w + 1] = fmaf(cs, p0[1], acc[8 * w + 1]); acc[8 * w + 2] = fmaf(cs, p1[0], acc[8 * w + 2]); acc[8 * w + 3] = fmaf(cs, p1[1], acc[8 * w + 3]);
                            acc[8 * w + 4] = fmaf(cs, p2[0], acc[8 * w + 4]); acc[8 * w + 5] = fmaf(cs, p2[1], acc[8 * w + 5]); acc[8 * w + 6] = fmaf(cs, p3[0], acc[8 * w + 6]); acc[8 * w + 7] = fmaf(cs, p3[1], acc[8 * w + 7]); }
                    }
                }
                float* orow = args.out + (size_t)t * 2048; const float* hrow = (const float*)(ws + WS_H2) + (size_t)t * 2048; float ss = 0.f;
#pragma unroll
                for (int j = 0; j < 8; ++j) { const f32x4 a = *(const f32x4*)(hrow + 256 * j + 4 * lane);
                    acc[4 * j] += a.x; acc[4 * j + 1] += a.y; acc[4 * j + 2] += a.z; acc[4 * j + 3] += a.w; }
#pragma unroll
                for (int e = 0; e < 32; ++e) ss += acc[e] * acc[e];
                const float rstd = rsqrtf(wsum(ss) * (1.f / 2048.f) + 1e-6f);
#pragma unroll
                for (int j = 0; j < 8; ++j) { const f32x4 g0 = *(const f32x4*)(in[27] + 256 * j + 4 * lane);
                    *(f32x4*)(orow + 256 * j + 4 * lane) = (f32x4){acc[4 * j] * rstd * g0.x, acc[4 * j + 1] * rstd * g0.y, acc[4 * j + 2] * rstd * g0.z, acc[4 * j + 3] * rstd * g0.w}; }
            }
            LDS_WAIT(); asm volatile("" ::: "memory");
        }
    PHASE_END
#undef IN
#undef SEAM
}

extern "C" void kernel_launch(void* const* d_in, const int* in_sizes, int n_in, void* d_out, int out_size, void* d_ws, size_t ws_size, hipStream_t stream) {
    static int grid = 0;
    if (grid == 0) {
        if (n_in != 28 || in_sizes[0] != S_ * DM || out_size != S_ * DM || ws_size < WS_END) { fprintf(stderr, "kernel_launch: unexpected shapes: n_in %d in0 %d out %d ws %zu (need >= %zu)\n", n_in, n_in > 0 ? in_sizes[0] : -1, out_size, ws_size, (size_t)WS_END); grid = -1; return; }
        if (hipFuncSetAttribute((const void*)mk_fwd, hipFuncAttributeMaxDynamicSharedMemorySize, LDS_BYTES) != hipSuccess) { fprintf(stderr, "kernel_launch: hipFuncSetAttribute failed\n"); grid = -1; return; }
        int per_cu = 0;
        if (hipOccupancyMaxActiveBlocksPerMultiprocessor(&per_cu, (const void*)mk_fwd, NWAVES * 64, LDS_BYTES) != hipSuccess || per_cu < 1) fprintf(stderr, "kernel_launch: note: occupancy query reports %d\n", per_cu);
        (void)hipGetLastError();
        grid = 256;
    }
    if (grid < 0) return;
    (void)hipMemsetAsync((char*)d_ws + WS_CTL, 0, CTL_ZERO_BYTES, stream);
    Args a{};
    for (int i = 0; i < 28; ++i) a.in[i] = (const float*)d_in[i];
    a.out = (float*)d_out; a.ws = (unsigned char*)d_ws;
#if MK_PER_PHASE
    for (int p = 0; p < NPH; ++p) { a.ph_lo = p; a.ph_hi = p + 1; hipLaunchKernelGGL(mk_fwd, dim3(grid), dim3(NWAVES * 64), LDS_BYTES, stream, a); }
#else
    a.ph_lo = 0; a.ph_hi = NPH; hipLaunchKernelGGL(mk_fwd, dim3(grid), dim3(NWAVES * 64), LDS_BYTES, stream, a);
#endif
    const hipError_t le = hipPeekAtLastError();
    if (le != hipSuccess) fprintf(stderr, "kernel_launch: launch failed: %s\n", hipGetErrorName(le));
}
```

```cpp
#include <hip/hip_runtime.h>
#include <cstdio>
#include <cstdint>
__device__ __forceinline__ int mk_lane_id() { int l; asm volatile("v_mbcnt_lo_u32_b32 %0, -1, 0\n\tv_mbcnt_hi_u32_b32 %0, -1, %0" : "=v"(l)); return l; }
namespace pg8 {
#define PG8_LAS __attribute__((address_space(3)))
typedef unsigned short bf16_t;
typedef short bf16x8 __attribute__((ext_vector_type(8)));
typedef float f32x4 __attribute__((ext_vector_type(4)));
typedef unsigned u32x4 __attribute__((ext_vector_type(4)));
constexpr int BM = 256, BK = 64, HALF = 128, HTB = HALF * BK * 2  , STAGE_BYTES = 8 * HTB, NXCD = 8, WGM = 8;

__host__ __device__ __forceinline__ int lds_byte(int r, int c) { const int st = (r >> 4) * 2 + (c >> 5), rr = r & 15, cc = c & 31, ob = rr * 64 + cc * 2; return st * 1024 + (ob ^ (((ob >> 9) & 1) << 5)); }
__host__ __device__ __forceinline__ void stage_rc(int b, int& R, int& C) { const int st = b / 1024, sb = b % 1024, swz = sb ^ (((sb >> 9) & 1) << 5); R = (st >> 1) * 16 + swz / 64; C = (st & 1) * 32 + (swz % 64) / 2; }
__host__ __device__ __forceinline__ int perm32(int rho) { const int n = rho >> 4, i = rho & 15; return 8 * (i >> 2) + 4 * n + (i & 3); }

struct Unit { int pm, pn; };
struct Gemm { const bf16_t* A; const bf16_t* Bt; int M, N, K, lda, ldb; };

struct StaticOrder {
    int nM, nN, nwg, G, c;
    __host__ __device__ void init(int M, int N, int G_, int c_) { nM = M / BM; nN = N / BM; nwg = nM * nN; G = G_; c = c_; }
    __host__ __device__ bool next(int i, Unit& u) const {
        const long L = (long)i * G + c; if (L >= nwg) return false;
        int wgid = (int)L; { const int q = nwg / NXCD, r = nwg % NXCD, xcd = wgid % NXCD, off = wgid / NXCD; wgid = (xcd < r ? xcd * (q + 1) : r * (q + 1) + (xcd - r) * q) + off; }
        const int nig = WGM * nN, gid = wgid / nig, fm = gid * WGM, gsz = (nM - fm) < WGM ? (nM - fm) : WGM;
        u.pm = fm + ((wgid % nig) % gsz); u.pn = (wgid % nig) / gsz; return true;
    }
    __device__ __forceinline__ void a_ready(const Unit&) const {}
    __device__ __forceinline__ void done(const Unit&) const {}
};

__device__ __forceinline__ unsigned cvt_pk_bf16(float lo, float hi) { unsigned r; asm volatile("v_cvt_pk_bf16_f32 %0, %1, %2" : "=v"(r) : "v"(lo), "v"(hi)); return r; }
__device__ __forceinline__ float sigm(float x) { return __builtin_amdgcn_rcpf(1.0f + __expf(-x)); }
__device__ __forceinline__ float bflo(unsigned w) { return __uint_as_float(w << 16); }
__device__ __forceinline__ float bfhi(unsigned w) { return __uint_as_float(w & 0xffff0000u); }
enum { EM_G1 = 0, EM_LORA_W = 1, EM_LORA_A = 2, EM_LORA_G = 3, EM_PROJA = 4, EM_PROJB = 5, EM_WOUT = 6, EM_SCORES = 7 };
template <int MODE> struct Epi {
    static constexpr bool PERM = true, AFTER_DRAIN = false;
    void* o0; void* o1; void* o2; const void* i0; const void* i1; const float* vec; float sc;
    __device__ __forceinline__ void operator()(const f32x4 (&acc)[2][2][4][2], const Unit& u, int wr, int wc, int fr, int fq) const {
        asm volatile("" ::: "memory");
        const int row0 = u.pm * BM + wr * 64 + fr;
        int colt = u.pn * BM; int ldc = 2048; int sub = 0;
        bf16_t* ob = (bf16_t*)o0; float scl = 1.f;
        if (MODE == EM_G1) {
            if (u.pn < 14) { ldc = 3584; }
            else if (u.pn < 26) { ob = (bf16_t*)o1; ldc = 3072; colt -= 14 * BM; if (u.pn < 18) scl = sc; }
            else { ob = (bf16_t*)o2; ldc = 4096; colt -= 26 * BM; sub = 1; }
        }
        if (MODE == EM_LORA_W || MODE == EM_LORA_A || MODE == EM_LORA_G) ldc = 1024;
        const int col0 = colt + wc * 32 + 8 * fq;
#pragma unroll
        for (int ai = 0; ai < 2; ++ai)
#pragma unroll
            for (int m = 0; m < 4; ++m) { const size_t row = (size_t)(row0 + ai * HALF + m * 16);
#pragma unroll
                for (int bj = 0; bj < 2; ++bj) { f32x4 v0 = acc[ai][bj][m][0], v1 = acc[ai][bj][m][1]; const int col = col0 + bj * HALF;
                    if (MODE == EM_G1) {
                        if (sub) { v0 = (f32x4){sigm(v0[0]), sigm(v0[1]), sigm(v0[2]), sigm(v0[3])}; v1 = (f32x4){sigm(v1[0]), sigm(v1[1]), sigm(v1[2]), sigm(v1[3])}; }
                        else { v0 = v0 * scl; v1 = v1 * scl; }
                        u32x4 w; w.x = cvt_pk_bf16(v0[0], v0[1]); w.y = cvt_pk_bf16(v0[2], v0[3]); w.z = cvt_pk_bf16(v1[0], v1[1]); w.w = cvt_pk_bf16(v1[2], v1[3]);
                        *(u32x4*)(ob + row * ldc + col) = w;
                    } else if (MODE == EM_LORA_W) {
                        if (vec) { const f32x4 b0 = *(const f32x4*)(vec + col), b1 = *(const f32x4*)(vec + col + 4);
                            v0 = v0 + b0; v1 = v1 + b1;
                            v0 = (f32x4){sigm(v0[0]), sigm(v0[1]), sigm(v0[2]), sigm(v0[3])}; v1 = (f32x4){sigm(v1[0]), sigm(v1[1]), sigm(v1[2]), sigm(v1[3])};
                            v0 = v0 * sc; v1 = v1 * sc; }
                        u32x4 w; w.x = cvt_pk_bf16(v0[0], v0[1]); w.y = cvt_pk_bf16(v0[2], v0[3]); w.z = cvt_pk_bf16(v1[0], v1[1]); w.w = cvt_pk_bf16(v1[2], v1[3]);
                        *(u32x4*)(ob + row * ldc + col) = w;
                    } else if (MODE == EM_PROJA) {
                        const u32x4 g = *(const u32x4*)((const bf16_t*)i0 + row * 4096 + col);
                        float* op = (float*)o0 + row * 2048 + col;
                        *(f32x4*)op = (f32x4){v0[0] * bflo(g.x), v0[1] * bfhi(g.x), v0[2] * bflo(g.y), v0[3] * bfhi(g.y)};
                        *(f32x4*)(op + 4) = (f32x4){v1[0] * bflo(g.z), v1[1] * bfhi(g.z), v1[2] * bflo(g.w), v1[3] * bfhi(g.w)};
                    } else if (MODE == EM_PROJB) {
                        const u32x4 g = *(const u32x4*)((const bf16_t*)i0 + row * 4096 + 2048 + col);
                        const float* tp = (const float*)i1 + row * 2048 + col; const f32x4 t0 = *(const f32x4*)tp, t1 = *(const f32x4*)(tp + 4);
                        v0 = (f32x4){t0[0] + v0[0] * bflo(g.x), t0[1] + v0[1] * bfhi(g.x), t0[2] + v0[2] * bflo(g.y), t0[3] + v0[3] * bfhi(g.y)};
                        v1 = (f32x4){t1[0] + v1[0] * bflo(g.z), t1[1] + v1[1] * bfhi(g.z), t1[2] + v1[2] * bflo(g.w), t1[3] + v1[3] * bfhi(g.w)};
                        u32x4 w; w.x = cvt_pk_bf16(v0[0], v0[1]); w.y = cvt_pk_bf16(v0[2], v0[3]); w.z = cvt_pk_bf16(v1[0], v1[1]); w.w = cvt_pk_bf16(v1[2], v1[3]);
                        *(u32x4*)(ob + row * 2048 + col) = w;
                    } else if (MODE == EM_WOUT) {
                        const float* xp = (const float*)i1 + row * 2048 + col; const f32x4 t0 = *(const f32x4*)xp, t1 = *(const f32x4*)(xp + 4);
                        float* op = (float*)o0 + row * 2048 + col; *(f32x4*)op = t0 + v0; *(f32x4*)(op + 4) = t1 + v1;
                    } else {
                        float* op = (float*)o0 + row * 2048 + col; *(f32x4*)op = v0; *(f32x4*)(op + 4) = v1;
                    }
                } }
    }
};

template <class Epi, class Sched, bool ALIGN_EPI = false, bool SP2 = false>
__device__ __forceinline__ void gemm_phase(PG8_LAS unsigned char* lds, const Gemm g, const Sched& S, const Epi& E, const int wid_in) {
    int tid_ = wid_in * 64 + mk_lane_id(); asm volatile("" : "+v"(tid_)); const int tid = tid_, wid = __builtin_amdgcn_readfirstlane(tid >> 6), lane = tid & 63, wr = wid >> 2, wc = wid & 3, fr = lane & 15, fq = lane >> 4;
    const int K = g.K, nt = K / BK;
    unsigned voffA[2], voffB[2];
#pragma unroll
    for (int i = 0; i < 2; ++i) { int R, C; stage_rc(tid * 16 + i * 8192, R, C); const int Rb = Epi::PERM ? ((R & ~31) + perm32(R & 31)) : R;
        voffA[i] = (unsigned)(R * g.lda + C) * 2u; voffB[i] = (unsigned)(Rb * g.ldb + C) * 2u; }
    const size_t kstep = (size_t)(BK * 2);
    const size_t hstepA = (size_t)HALF * g.lda * 2, hstepB = (size_t)HALF * g.ldb * 2;
    const size_t tstepA = 2 * hstepA, tstepB = 2 * hstepB;
    const unsigned ldsw = (unsigned)wid * 1024u;
    const int aoff = lds_byte(wr * 64 + fr, fq * 8), boff = lds_byte(wc * 32 + fr, fq * 8);
#define PG8_SA(b, h) (((b) * 2 + (h)) * HTB)
#define PG8_SB(b, h) ((4 + (b) * 2 + (h)) * HTB)
#define PG8_STAGE(bufoff, gbase, voff) do { _Pragma("unroll") for (int _i = 0; _i < 2; ++_i) \
        __builtin_amdgcn_global_load_lds((const unsigned*)((const char*)(gbase) + (voff)[_i]), (PG8_LAS unsigned*)(lds + (bufoff) + ldsw + _i * 8192), 16, 0, 0); } while (0)
#define PG8_LDA(dst, b, h) do { _Pragma("unroll") for (int m = 0; m < 4; ++m) _Pragma("unroll") for (int k = 0; k < 2; ++k) dst[m][k] = *(const PG8_LAS bf16x8*)(lds + PG8_SA(b, h) + aoff + m * 2048 + k * 1024); } while (0)
#define PG8_LDB(dst, b, h) do { _Pragma("unroll") for (int n = 0; n < 2; ++n) _Pragma("unroll") for (int k = 0; k < 2; ++k) dst[n][k] = *(const PG8_LAS bf16x8*)(lds + PG8_SB(b, h) + boff + n * 2048 + k * 1024); } while (0)
#define PG8_MMA(ai, bj, At, Bt) do { __builtin_amdgcn_s_setprio(1); _Pragma("unroll") for (int m = 0; m < 4; ++m) _Pragma("unroll") for (int n = 0; n < 2; ++n) _Pragma("unroll") for (int k = 0; k < 2; ++k) \
        acc[ai][bj][m][n] = __builtin_amdgcn_mfma_f32_16x16x32_bf16(Bt[n][k], At[m][k], acc[ai][bj][m][n], 0, 0, 0); __builtin_amdgcn_s_setprio(0); } while (0)
#define PG8_WAIT_V(n) asm volatile("s_waitcnt vmcnt(" #n ")" ::: "memory")
#define PG8_WAIT_L(n) asm volatile("s_waitcnt lgkmcnt(" #n ")" ::: "memory")
#define PG8_BAR __builtin_amdgcn_s_barrier()
#define PG8_SCHED __builtin_amdgcn_sched_barrier(0)
    Unit cur, nxt; int ui = 0;
    if (!S.next(0, cur)) return;
    f32x4 acc[2][2][4][2];
#pragma unroll
    for (int a = 0; a < 2; ++a)
#pragma unroll
        for (int b = 0; b < 2; ++b)
#pragma unroll
            for (int m = 0; m < 4; ++m)
#pragma unroll
                for (int n = 0; n < 2; ++n) acc[a][b][m][n] = (f32x4){0.f, 0.f, 0.f, 0.f};
    bf16x8 At[4][2], B0[2][2], B1[2][2];
    const char* cA = (const char*)g.A + (size_t)cur.pm * tstepA; const char* cB = (const char*)g.Bt + (size_t)cur.pn * tstepB;
    S.a_ready(cur);
    if constexpr (SP2) {
        PG8_STAGE(PG8_SB(0, 0), cB, voffB); PG8_STAGE(PG8_SB(0, 1), cB + hstepB, voffB); PG8_STAGE(PG8_SA(0, 0), cA, voffA); PG8_STAGE(PG8_SA(0, 1), cA + hstepA, voffA);
        if (wr == 1) PG8_BAR;
        PG8_WAIT_V(2); PG8_BAR;
        PG8_STAGE(PG8_SB(1, 0), cB + kstep, voffB); PG8_STAGE(PG8_SA(1, 0), cA + kstep, voffA); PG8_STAGE(PG8_SB(1, 1), cB + hstepB + kstep, voffB);
        PG8_WAIT_V(6); PG8_BAR;
    } else {
        PG8_STAGE(PG8_SB(0, 0), cB, voffB); PG8_STAGE(PG8_SA(0, 0), cA, voffA); PG8_STAGE(PG8_SB(0, 1), cB + hstepB, voffB); PG8_STAGE(PG8_SA(0, 1), cA + hstepA, voffA);
        if (wr == 1) PG8_BAR;
        PG8_WAIT_V(4); PG8_BAR;
        PG8_STAGE(PG8_SB(1, 0), cB + kstep, voffB); PG8_STAGE(PG8_SA(1, 0), cA + kstep, voffA); PG8_STAGE(PG8_SB(1, 1), cB + hstepB + kstep, voffB);
        PG8_WAIT_V(6); PG8_BAR;
    }
    for (;;) {
        const bool has_next = S.next(ui + 1, nxt);
        const char* nA = has_next ? (const char*)g.A + (size_t)nxt.pm * tstepA : cA; const char* nB = has_next ? (const char*)g.Bt + (size_t)nxt.pn * tstepB : cB;
        for (int t = 0; t < nt; t += 2) {
            const bool last = (t == nt - 2);
            const char* a1 = cA + (size_t)(t + 1) * kstep;
            const char* a2 = last ? nA : cA + (size_t)(t + 2) * kstep; const char* b2 = last ? nB : cB + (size_t)(t + 2) * kstep;
            const char* a3 = a2 + kstep; const char* b3 = b2 + kstep;
            if (last && has_next) S.a_ready(nxt);
            if constexpr (SP2) {
            PG8_LDB(B0, 0, 0); PG8_LDB(B1, 0, 1); PG8_SCHED; PG8_LDA(At, 0, 0); PG8_STAGE(PG8_SA(1, 1), a1 + hstepA, voffA);
            PG8_WAIT_V(8); PG8_WAIT_L(0); PG8_BAR; PG8_MMA(0, 0, At, B0); PG8_MMA(0, 1, At, B1); PG8_BAR; PG8_SCHED;
            PG8_LDA(At, 0, 1); PG8_STAGE(PG8_SB(0, 0), b2, voffB); PG8_STAGE(PG8_SB(0, 1), b2 + hstepB, voffB); PG8_STAGE(PG8_SA(0, 0), a2, voffA);
            PG8_WAIT_V(8); PG8_WAIT_L(0); PG8_BAR; PG8_MMA(1, 0, At, B0); PG8_MMA(1, 1, At, B1); PG8_BAR; PG8_SCHED;
            PG8_LDB(B0, 1, 0); PG8_LDB(B1, 1, 1); PG8_SCHED; PG8_LDA(At, 1, 0); PG8_STAGE(PG8_SA(0, 1), a2 + hstepA, voffA);
            PG8_WAIT_V(8); PG8_WAIT_L(0); PG8_BAR; PG8_MMA(0, 0, At, B0); PG8_MMA(0, 1, At, B1); PG8_BAR; PG8_SCHED;
            PG8_LDA(At, 1, 1); PG8_STAGE(PG8_SB(1, 0), b3, voffB); PG8_STAGE(PG8_SB(1, 1), b3 + hstepB, voffB); PG8_STAGE(PG8_SA(1, 0), a3, voffA);
            PG8_WAIT_V(8); PG8_WAIT_L(0); PG8_BAR; PG8_MMA(1, 0, At, B0); PG8_MMA(1, 1, At, B1); PG8_BAR; PG8_SCHED;
            } else {
            PG8_LDB(B0, 0, 0); PG8_SCHED; PG8_LDA(At, 0, 0); PG8_STAGE(PG8_SA(1, 1), a1 + hstepA, voffA);
            PG8_WAIT_L(8); PG8_BAR; PG8_WAIT_L(0); PG8_MMA(0, 0, At, B0); PG8_BAR; PG8_SCHED;
            PG8_LDB(B1, 0, 1); PG8_STAGE(PG8_SB(0, 0), b2, voffB);
            PG8_BAR; PG8_WAIT_L(0); PG8_MMA(0, 1, At, B1); PG8_BAR;
            PG8_LDA(At, 0, 1); PG8_STAGE(PG8_SA(0, 0), a2, voffA);
            PG8_BAR; PG8_WAIT_L(0); PG8_MMA(1, 0, At, B0); PG8_BAR; PG8_SCHED;
            PG8_STAGE(PG8_SB(0, 1), b2 + hstepB, voffB);
            PG8_WAIT_V(6); PG8_BAR; PG8_MMA(1, 1, At, B1); PG8_BAR;
            PG8_LDB(B0, 1, 0); PG8_SCHED; PG8_LDA(At, 1, 0); PG8_STAGE(PG8_SA(0, 1), a2 + hstepA, voffA);
            PG8_WAIT_L(8); PG8_BAR; PG8_WAIT_L(0); PG8_MMA(0, 0, At, B0); PG8_BAR; PG8_SCHED;
            PG8_LDB(B1, 1, 1); PG8_STAGE(PG8_SB(1, 0), b3, voffB);
            PG8_BAR; PG8_WAIT_L(0); PG8_MMA(0, 1, At, B1); PG8_BAR;
            PG8_LDA(At, 1, 1); PG8_STAGE(PG8_SA(1, 0), a3, voffA);
            PG8_BAR; PG8_WAIT_L(0); PG8_MMA(1, 0, At, B0); PG8_BAR; PG8_SCHED;
            PG8_STAGE(PG8_SB(1, 1), b3 + hstepB, voffB);
            PG8_WAIT_V(6); PG8_BAR; PG8_MMA(1, 1, At, B1); PG8_BAR;
            }
        }
        if constexpr (ALIGN_EPI) { if (wr == 0) PG8_BAR; }
        if constexpr (!Epi::AFTER_DRAIN) { E(acc, cur, wr, wc, fr, fq); S.done(cur); }
        if (!has_next) break;
#pragma unroll
        for (int a = 0; a < 2; ++a)
#pragma unroll
            for (int b = 0; b < 2; ++b)
#pragma unroll
                for (int m = 0; m < 4; ++m)
#pragma unroll
                    for (int n = 0; n < 2; ++n) acc[a][b][m][n] = (f32x4){0.f, 0.f, 0.f, 0.f};
        cur = nxt; cA = nA; cB = nB; ++ui;
        if constexpr (ALIGN_EPI) { if (wr == 1) PG8_BAR; }
    }
    PG8_WAIT_V(0);
    if constexpr (!ALIGN_EPI) { if (wr == 0) PG8_BAR; }
    PG8_BAR;
    if constexpr (Epi::AFTER_DRAIN) { E.fused(acc, cur, wr, wc, fr, fq, lds, wid, lane); S.done(cur); }
#undef PG8_SA
#undef PG8_SB
#undef PG8_STAGE
#undef PG8_LDA
#undef PG8_LDB
#undef PG8_MMA
#undef PG8_WAIT_V
#undef PG8_WAIT_L
#undef PG8_BAR
#undef PG8_SCHED
}
}
#include <hip/hip_bf16.h>
#include <cmath>
namespace attn_body {
using bf16=__hip_bfloat16;
using bf16x8=__attribute__((ext_vector_type(8)))short;
using s16x4=__attribute__((ext_vector_type(4)))short;
using f32x16=__attribute__((ext_vector_type(16)))float;
using u32x4=__attribute__((ext_vector_type(4)))unsigned;
constexpr int SEQ=16384,D=64,PQ=3072,PO=2048;
constexpr int NW=8,QBLK=32,QB=QBLK*NW,KVBLK=64,NQB=SEQ/QB;
constexpr int ATTN_UNIT_ROWS=QB;
__device__ __forceinline__ int crow(int r,int hi){return (r&3)+8*(r>>2)+4*hi;}
#define SBAR() __builtin_amdgcn_sched_barrier(0)
__device__ __forceinline__ void cmask(f32x16&p0,f32x16&p1,int jb,int qrel,int hi){
  const float NEG=-INFINITY; int kb=64*jb+4*hi;
  #pragma unroll
  for(int r=0;r<16;++r){int kv=kb+(r&3)+8*(r>>2); if(kv>qrel)p0[r]=NEG; if(kv+32>qrel)p1[r]=NEG;}
}

constexpr int NSLOT=3, SLOTB=8192, VSLOTB=16384;
constexpr int LDS_K=0, LDS_V=NSLOT*SLOTB, LDS_WS=LDS_V+NSLOT*VSLOTB, LDS_OST=0  , LDS_BYTES=LDS_WS+NW*64*4;
constexpr float C2=0.125f*1.4426950408889634f;
__device__ __forceinline__ void glds16(const void*gsrc,unsigned lds_dst){unsigned keep;
  asm volatile("s_mov_b32 %0, m0\n\ts_mov_b32 m0, %2\n\ts_nop 0\n\tglobal_load_lds_dwordx4 %1, off\n\ts_mov_b32 m0, %0":"=&s"(keep):"v"(gsrc),"s"(lds_dst):"memory");}
__device__ __forceinline__ float max3f(float a,float b,float c){float r;asm("v_max3_f32 %0, %1, %2, %3":"=v"(r):"v"(a),"v"(b),"v"(c));return r;}
__device__ __forceinline__ float max2f(float a,float b){float r;asm("v_max_f32_e32 %0, %1, %2":"=v"(r):"v"(a),"v"(b));return r;}
__device__ __forceinline__ float fadd_s(float a,float b){float r;asm("v_add_f32_e32 %0, %1, %2":"=v"(r):"v"(a),"v"(b));return r;}
__device__ __forceinline__ float fsub_s(float a,float b){float r;asm("v_sub_f32_e32 %0, %1, %2":"=v"(r):"v"(a),"v"(b));return r;}
typedef float f32x2_t __attribute__((ext_vector_type(2))); typedef __bf16 bf16x2_t __attribute__((ext_vector_type(2)));
__device__ __forceinline__ unsigned cvtpk_s(float lo,float hi){f32x2_t v={lo,hi};bf16x2_t b=__builtin_convertvector(v,bf16x2_t);return __builtin_bit_cast(unsigned,b);}
#define WAIT_BAR(N) asm volatile("s_waitcnt vmcnt(" #N ") lgkmcnt(0)\n\ts_barrier":::"memory")

__device__ __forceinline__ void qkt(f32x16&p0,f32x16&p1,const char*Kslot,const bf16x8*qr,const f32x16&negm,int r32,int hi){
  const char*kb=Kslot+hi*1024+r32*16;
  #pragma unroll
  for(int d0=0;d0<4;++d0){
    const bf16x8 b0=*reinterpret_cast<const bf16x8*>(kb+d0*2048);
    const bf16x8 b1=*reinterpret_cast<const bf16x8*>(kb+d0*2048+512);
    if(d0==0){p0=__builtin_amdgcn_mfma_f32_32x32x16_bf16(b0,qr[0],f32x16{},0,0,0);p1=__builtin_amdgcn_mfma_f32_32x32x16_bf16(b1,qr[0],f32x16{},0,0,0);}
    else{p0=__builtin_amdgcn_mfma_f32_32x32x16_bf16(b0,qr[d0],p0,0,0,0);p1=__builtin_amdgcn_mfma_f32_32x32x16_bf16(b1,qr[d0],p1,0,0,0);}}
}
typedef __attribute__((address_space(3))) const char* lds_cptr;
typedef short v4i16_t __attribute__((ext_vector_type(4)));
__device__ __forceinline__ void kload8(bf16x8*kf,lds_cptr kp){
  kf[0]=*(const __attribute__((address_space(3))) bf16x8*)(kp);      kf[1]=*(const __attribute__((address_space(3))) bf16x8*)(kp+512);
  kf[2]=*(const __attribute__((address_space(3))) bf16x8*)(kp+2048); kf[3]=*(const __attribute__((address_space(3))) bf16x8*)(kp+2560);
  kf[4]=*(const __attribute__((address_space(3))) bf16x8*)(kp+4096); kf[5]=*(const __attribute__((address_space(3))) bf16x8*)(kp+4608);
  kf[6]=*(const __attribute__((address_space(3))) bf16x8*)(kp+6144); kf[7]=*(const __attribute__((address_space(3))) bf16x8*)(kp+6656);
}
__device__ __forceinline__ void kload2(bf16x8*kf,lds_cptr kp,int j){ kf[2*j]=*(const __attribute__((address_space(3))) bf16x8*)(kp+j*2048); kf[2*j+1]=*(const __attribute__((address_space(3))) bf16x8*)(kp+j*2048+512); }
__device__ __forceinline__ s16x4 vtr(lds_cptr p){ return __builtin_bit_cast(s16x4,__builtin_amdgcn_ds_read_tr16_b64_v4i16((__attribute__((address_space(3))) v4i16_t*)p)); }
__device__ __forceinline__ float rowmax(const f32x16&p0,const f32x16&p1){
  float a=max3f(p0[0],p0[1],p1[0]),b=max3f(p0[2],p0[3],p1[1]);a=max3f(a,p1[2],p1[3]);
  #pragma unroll
  for(int r=4;r<16;r+=4){a=max3f(a,p0[r],p0[r+1]);b=max3f(b,p0[r+2],p0[r+3]);a=max3f(a,p1[r],p1[r+1]);b=max3f(b,p1[r+2],p1[r+3]);}
  const float m=max2f(a,b);
  auto rr=__builtin_amdgcn_permlane32_swap(__float_as_uint(m),__float_as_uint(m),false,false);
  return max2f(__uint_as_float(rr[0]),__uint_as_float(rr[1]));
}
__device__ __forceinline__ void pv(f32x16*o,int vb,bf16x8 pa0,bf16x8 pa1,bf16x8 pa2,bf16x8 pa3){
  #pragma unroll
  for(int d0=0;d0<4;++d0){s16x4 lo[4],hi[4];
    #pragma unroll
    for(int ks=0;ks<4;++ks){
      asm volatile("ds_read_b64_tr_b16 %0,%1 offset:%c2":"=&v"(lo[ks]):"v"(vb),"i"(d0*4096+ks*1024):"memory");
      asm volatile("ds_read_b64_tr_b16 %0,%1 offset:%c2":"=&v"(hi[ks]):"v"(vb),"i"(d0*4096+ks*1024+512):"memory");}
    asm volatile("s_waitcnt lgkmcnt(0)":::"memory");SBAR();
    #define PK(k) (bf16x8){lo[k][0],lo[k][1],lo[k][2],lo[k][3],hi[k][0],hi[k][1],hi[k][2],hi[k][3]}
    o[d0]=__builtin_amdgcn_mfma_f32_32x32x16_bf16(pa0,PK(0),o[d0],0,0,0);
    o[d0]=__builtin_amdgcn_mfma_f32_32x32x16_bf16(pa1,PK(1),o[d0],0,0,0);
    o[d0]=__builtin_amdgcn_mfma_f32_32x32x16_bf16(pa2,PK(2),o[d0],0,0,0);
    o[d0]=__builtin_amdgcn_mfma_f32_32x32x16_bf16(pa3,PK(3),o[d0],0,0,0);
    #undef PK
  }
}

#ifndef ATTN_STORE16
#define ATTN_STORE16(p,v) (*(u32x4*)(p)=(v))
#endif
template<int THRL> __device__ __forceinline__ void attn_unit(const int wid_in,int qb,const bf16*Q,const bf16*__restrict__ K,const bf16*__restrict__ V,bf16*O,char*shm){
  int tid_=wid_in*64+mk_lane_id(); asm volatile("":"+v"(tid_)); const int tid=tid_,lane=tid&63,r32=lane&31,hi=lane>>5; const int wid=__builtin_amdgcn_readfirstlane(tid>>6);
  const int q0=qb*QB;
  const bf16*Qw=Q+(long)(q0+wid*QBLK)*PQ;
  const bf16*Kh=K,*Vh=V;
  const unsigned lds0=(unsigned)(uintptr_t)shm;
  float*wsf=(float*)(shm+LDS_WS)+wid*64;
  const bf16*ksrc=Kh+(long)lane*PQ+wid*8;
  const bf16*vsrc=Vh+(long)(16*(wid&3)+(lane>>2))*PQ+(wid>>2)*32+(lane&3)*8;
  const unsigned kdst=lds0+LDS_K+wid*1024, vdst=lds0+LDS_V+wid*1024;
  #define DMA_K(t,slot) glds16(ksrc+(long)(t)*KVBLK*PQ,(unsigned)__builtin_amdgcn_readfirstlane(kdst+(slot)))
  #define DMA_V(t,slot) do{ glds16(vsrc+(long)(t)*KVBLK*PQ,(unsigned)__builtin_amdgcn_readfirstlane(vdst+2*(slot))); glds16(vsrc+64+(long)(t)*KVBLK*PQ,(unsigned)__builtin_amdgcn_readfirstlane(vdst+8192+2*(slot))); }while(0)
  const int vb0=(int)(lds0+LDS_V)+((lane>>4)&1)*32+(lane&3)*8+(4*hi+((lane&15)>>2))*64;
  const char*Kbase=shm+LDS_K; bf16x8 kf[8];
  const lds_cptr shm3=(lds_cptr)shm; const lds_cptr kp0=shm3+LDS_K+hi*1024+r32*16; const lds_cptr vp0=shm3+LDS_V+((lane>>4)&1)*32+(lane&3)*8+(4*hi+((lane&15)>>2))*64;
  const int NT=(q0+QB)/KVBLK;
  DMA_K(0,0);DMA_V(0,0);DMA_K(1,SLOTB);
  bf16x8 qr[4];
  #pragma unroll
  for(int d0=0;d0<4;++d0)qr[d0]=*reinterpret_cast<const bf16x8*>(&Qw[(long)r32*PQ+d0*16+hi*8]);
  float mhat=0.f,l_reg=0.f;f32x16 o[4];o[0]=f32x16{};o[1]=f32x16{};o[2]=f32x16{};o[3]=f32x16{};asm volatile("":"+v"(o[0]));asm volatile("":"+v"(o[1]));asm volatile("":"+v"(o[2]));asm volatile("":"+v"(o[3]));
  const int qrel=wid*QBLK+r32;
  #define CMASK(P0,P1,t) do{int jb_=(t)-(NT-4); if(jb_>=0)cmask(P0,P1,jb_,qrel,hi);}while(0)
  bool resc=false;
  #define START(P0,P1) do{ const float rm=rowmax(P0,P1); resc=false; mhat=rm; \
    _Pragma("unroll") for(int r=0;r<16;++r){P0[r]=__builtin_amdgcn_exp2f(fsub_s(P0[r],mhat));} }while(0)
  #define RESC() do{ if(resc){ asm volatile("s_waitcnt lgkmcnt(0)":::"memory"); \
      _Pragma("unroll") for(int d_=0;d_<4;++d_) _Pragma("unroll") for(int r=0;r<16;++r)o[d_][r]*=wsf[crow(r,hi)]; } }while(0)
  f32x16 pA0,pA1,pB0,pB1;
  int sl_prev=0,sl_cur=0,sl_next=SLOTB;
  #define ROT() do{sl_prev=sl_cur;sl_cur=sl_next;sl_next=(sl_next==(NSLOT-1)*SLOTB)?0:sl_next+SLOTB;}while(0)
  DMA_K(2,2*SLOTB);
  WAIT_BAR(4);
  qkt(pA0,pA1,Kbase,qr,f32x16{},r32,hi);asm volatile("s_nop 15\n\ts_nop 7":"+v"(pA0),"+v"(pA1));CMASK(pA0,pA1,0);
  START(pA0,pA1);
  _Pragma("unroll") for(int r=0;r<16;++r)pA1[r]=__builtin_amdgcn_exp2f(fsub_s(pA1[r],mhat));
  WAIT_BAR(0);
  DMA_K(3,0);DMA_V(1,SLOTB);
  ROT();
  kload8(kf,kp0+sl_cur);
  WAIT_BAR(3);
  s16x4 vlo[16],vhi[16]; u32x4 pw0,pw1,pw2,pw3;
  #define PKW(P,B) cvtpk_s(P[B],P[B+1])
  #define PAF(k) __builtin_bit_cast(bf16x8,pw##k)
  #define VFR(i) (bf16x8){vlo[i][0],vlo[i][1],vlo[i][2],vlo[i][3],vhi[i][0],vhi[i][1],vhi[i][2],vhi[i][3]}
  #define PIN(x) asm volatile("":"+v"(x))
  #define MX3(a,b,c) __builtin_fmaxf(__builtin_fmaxf((a),(b)),(c))
  #define GAPA(MF,A0,A1,A2,A3,W0,W1,PW) do{ MF; sacc+=A0; sacc+=A1; sacc+=A2; sacc+=A3; PIN(sacc); W0; W1; PIN(PW); SBAR(); }while(0)
  #define EX(v) __builtin_amdgcn_exp2f(v)
  #define GAPB(MF,X,B) do{ MF; X[B]=EX(X[B]-mhat); X[B+1]=EX(X[B+1]-mhat); PIN(X); SBAR(); }while(0)
  #define VRD(i) do{ vlo[i]=vtr(vp_+(((i)>>2)*4096+((i)&3)*1024)); vhi[i]=vtr(vp_+(((i)>>2)*4096+((i)&3)*1024+512)); }while(0)
  #define KRD(G,j) do{ if(G){ kload2(kf,kp0+sl_next,j); SBAR(); } }while(0)
  #define STEP(C0,C1,P0,P1,t,GK,GV,GL) do{ SBAR(); \
    const lds_cptr vp_=vp0+2*sl_prev; \
    float sacc=(P0[0]+P0[1]); \
    GAPA(C0=__builtin_amdgcn_mfma_f32_32x32x16_bf16(kf[0],qr[0],f32x16{},0,0,0), P0[2],P0[3],P0[4],P0[5],     pw0[0]=PKW(P0,0), pw0[1]=PKW(P0,2), pw0); \
    GAPA(C1=__builtin_amdgcn_mfma_f32_32x32x16_bf16(kf[1],qr[0],f32x16{},0,0,0), P0[6],P0[7],P0[8],P0[9],     pw0[2]=PKW(P0,4), pw0[3]=PKW(P0,6), pw0); \
    GAPA(C0=__builtin_amdgcn_mfma_f32_32x32x16_bf16(kf[2],qr[1],C0,0,0,0),   P0[10],P0[11],P0[12],P0[13], pw1[0]=PKW(P0,8), pw1[1]=PKW(P0,10), pw1); \
    GAPA(C1=__builtin_amdgcn_mfma_f32_32x32x16_bf16(kf[3],qr[1],C1,0,0,0),   P0[14],P0[15],P1[0],P1[1],   pw1[2]=PKW(P0,12),pw1[3]=PKW(P0,14), pw1); \
    VRD(0); SBAR(); GAPA(C0=__builtin_amdgcn_mfma_f32_32x32x16_bf16(kf[4],qr[2],C0,0,0,0),   P1[2],P1[3],P1[4],P1[5],     pw2[0]=PKW(P1,0), pw2[1]=PKW(P1,2), pw2); \
    VRD(4); SBAR(); GAPA(C1=__builtin_amdgcn_mfma_f32_32x32x16_bf16(kf[5],qr[2],C1,0,0,0),   P1[6],P1[7],P1[8],P1[9],     pw2[2]=PKW(P1,4), pw2[3]=PKW(P1,6), pw2); \
    VRD(8); SBAR(); GAPA(C0=__builtin_amdgcn_mfma_f32_32x32x16_bf16(kf[6],qr[3],C0,0,0,0),   P1[10],P1[11],P1[12],P1[13], pw3[0]=PKW(P1,8), pw3[1]=PKW(P1,10), pw3); \
    VRD(12); SBAR(); GAPA(C1=__builtin_amdgcn_mfma_f32_32x32x16_bf16(kf[7],qr[3],C1,0,0,0),   P1[14],P1[15],0.f,0.f,       pw3[2]=PKW(P1,12),pw3[3]=PKW(P1,14), pw3); \
    l_reg+=sacc; \
    if(GK){DMA_K((t)+3,sl_cur);} if(GV){DMA_V((t)+1,sl_next);} \
    CMASK(C0,C1,t); \
    { float a=MX3(C0[0],C0[1],C1[0]),b=MX3(C0[2],C0[3],C1[1]); a=MX3(a,C1[2],C1[3]); \
      _Pragma("unroll") for(int r=4;r<16;r+=4){a=MX3(a,C0[r],C0[r+1]);b=MX3(b,C0[r+2],C0[r+3]);a=MX3(a,C1[r],C1[r+1]);b=MX3(b,C1[r+2],C1[r+3]);} \
      float rm=__builtin_fmaxf(a,b); { auto rr=__builtin_amdgcn_permlane32_swap(__float_as_uint(rm),__float_as_uint(rm),false,false); rm=__builtin_fmaxf(__uint_as_float(rr[0]),__uint_as_float(rr[1])); } \
      rm-=mhat; resc=false; \
      if(__builtin_expect(__any(rm>(float)THRL),0)){ const float dl=__builtin_fmaxf(rm,0.f); mhat+=dl; \
        const float f=__builtin_amdgcn_exp2f(-dl); l_reg*=f; if(hi==0)wsf[r32]=f; resc=true; } } \
    SBAR(); \
    GAPB(o[0]=__builtin_amdgcn_mfma_f32_32x32x16_bf16(PAF(0),VFR(0),o[0],0,0,0), C0,0); VRD(1); SBAR(); \
    GAPB(o[1]=__builtin_amdgcn_mfma_f32_32x32x16_bf16(PAF(0),VFR(4),o[1],0,0,0), C0,2); VRD(5); SBAR(); \
    KRD(GL,0); GAPB(o[2]=__builtin_amdgcn_mfma_f32_32x32x16_bf16(PAF(0),VFR(8),o[2],0,0,0), C0,4); VRD(9); SBAR(); \
    KRD(GL,1); GAPB(o[3]=__builtin_amdgcn_mfma_f32_32x32x16_bf16(PAF(0),VFR(12),o[3],0,0,0), C0,6); VRD(13); SBAR(); \
    KRD(GL,2); GAPB(o[0]=__builtin_amdgcn_mfma_f32_32x32x16_bf16(PAF(1),VFR(1),o[0],0,0,0), C0,8); VRD(2); SBAR(); \
    KRD(GL,3); GAPB(o[1]=__builtin_amdgcn_mfma_f32_32x32x16_bf16(PAF(1),VFR(5),o[1],0,0,0), C0,10); VRD(6); SBAR(); \
    GAPB(o[2]=__builtin_amdgcn_mfma_f32_32x32x16_bf16(PAF(1),VFR(9),o[2],0,0,0), C0,12); VRD(10); SBAR(); \
    GAPB(o[3]=__builtin_amdgcn_mfma_f32_32x32x16_bf16(PAF(1),VFR(13),o[3],0,0,0), C0,14); VRD(14); SBAR(); \
    GAPB(o[0]=__builtin_amdgcn_mfma_f32_32x32x16_bf16(PAF(2),VFR(2),o[0],0,0,0), C1,0); VRD(3); SBAR(); \
    GAPB(o[1]=__builtin_amdgcn_mfma_f32_32x32x16_bf16(PAF(2),VFR(6),o[1],0,0,0), C1,2); VRD(7); SBAR(); \
    GAPB(o[2]=__builtin_amdgcn_mfma_f32_32x32x16_bf16(PAF(2),VFR(10),o[2],0,0,0), C1,4); VRD(11); SBAR(); \
    GAPB(o[3]=__builtin_amdgcn_mfma_f32_32x32x16_bf16(PAF(2),VFR(14),o[3],0,0,0), C1,6); VRD(15); SBAR(); \
    GAPB(o[0]=__builtin_amdgcn_mfma_f32_32x32x16_bf16(PAF(3),VFR(3),o[0],0,0,0), C1,8); \
    GAPB(o[1]=__builtin_amdgcn_mfma_f32_32x32x16_bf16(PAF(3),VFR(7),o[1],0,0,0), C1,10); \
    GAPB(o[2]=__builtin_amdgcn_mfma_f32_32x32x16_bf16(PAF(3),VFR(11),o[2],0,0,0), C1,12); \
    GAPB(o[3]=__builtin_amdgcn_mfma_f32_32x32x16_bf16(PAF(3),VFR(15),o[3],0,0,0), C1,14); \
    }while(0)
  int t=1;
  #undef CMASK
  #define CMASK(P0,P1,t) do{}while(0)
  for(;t+5<NT;t+=2){
    STEP(pB0,pB1,pA0,pA1,t,true,true,true);     WAIT_BAR(3); RESC(); ROT();
    STEP(pA0,pA1,pB0,pB1,t+1,true,true,true);   WAIT_BAR(3); RESC(); ROT();
  }
  #undef CMASK
  #define CMASK(P0,P1,t) do{int jb_=(t)-(NT-4); if(jb_>=0)cmask(P0,P1,jb_,qrel,hi);}while(0)
  #define ENDW(tt) do{ if((tt)+3<NT){WAIT_BAR(3);} else if((tt)+2<NT){WAIT_BAR(2);} else {WAIT_BAR(0);} }while(0)
  for(;t+1<NT;t+=2){
    STEP(pB0,pB1,pA0,pA1,t,(t+3<NT),(t+1<NT),(t+1<NT));       ENDW(t);   RESC(); ROT();
    STEP(pA0,pA1,pB0,pB1,t+1,(t+4<NT),(t+2<NT),(t+2<NT));     ENDW(t+1); RESC(); ROT();
  }
  STEP(pB0,pB1,pA0,pA1,NT-1,false,false,false); RESC();
  { float sacc=pB0[0]+pB0[1]; _Pragma("unroll") for(int r=2;r<16;++r)sacc+=pB0[r]; _Pragma("unroll") for(int r=0;r<16;++r)sacc+=pB1[r]; l_reg+=sacc;
    pw0=(u32x4){PKW(pB0,0),PKW(pB0,2),PKW(pB0,4),PKW(pB0,6)};pw1=(u32x4){PKW(pB0,8),PKW(pB0,10),PKW(pB0,12),PKW(pB0,14)};pw2=(u32x4){PKW(pB1,0),PKW(pB1,2),PKW(pB1,4),PKW(pB1,6)};pw3=(u32x4){PKW(pB1,8),PKW(pB1,10),PKW(pB1,12),PKW(pB1,14)};
    SBAR(); pv(o,vb0+2*sl_cur,PAF(0),PAF(1),PAF(2),PAF(3)); }
  asm volatile("s_waitcnt lgkmcnt(0)\n\ts_barrier":::"memory");
  #undef PKW
  #undef PAF
  #undef VFR
  #undef PIN
  #undef MX3
  #undef GAPA
  #undef GAPB
  #undef EX
  #undef VRD
  #undef KRD
  #undef STEP
  #undef ENDW
  {auto rr=__builtin_amdgcn_permlane32_swap(__float_as_uint(l_reg),__float_as_uint(l_reg),false,false);l_reg=__uint_as_float(rr[0])+__uint_as_float(rr[1]);}
  if(hi==0)wsf[32+r32]=l_reg;asm volatile("s_waitcnt lgkmcnt(0)":::"memory");
  float rli[16];
  #pragma unroll
  for(int r=0;r<16;++r)rli[r]=__builtin_amdgcn_rcpf(wsf[32+crow(r,hi)]);
  bf16*Ow=O+(long)(q0+wid*QBLK)*PO;
  { bf16*stg=(bf16*)(shm+LDS_OST)+wid*4096;
    #pragma unroll
    for(int r=0;r<16;++r){const int orow=crow(r,hi);
      #pragma unroll
      for(int d0=0;d0<4;++d0)stg[orow*128+d0*32+r32]=__float2bfloat16(o[d0][r]*rli[r]);}
    asm volatile("s_waitcnt lgkmcnt(0)":::"memory");
    #pragma unroll
    for(int i=0;i<8;++i){const int row=i*4+(lane>>4),ch=lane&15; const u32x4 v=*(const u32x4*)(stg+row*128+ch*8); ATTN_STORE16(Ow+(long)row*PO+ch*8,v);} }
  asm volatile("s_waitcnt lgkmcnt(0)\n\ts_barrier":::"memory");
  #undef DMA_K
  #undef DMA_V
  #undef CMASK
  #undef START
  #undef RESC
  #undef ROT
}
constexpr int ATTN_LDS_BYTES=LDS_BYTES;
template<int THRL=8> __device__ __forceinline__ void attn_phase(char*lds,const bf16*PD,bf16*O,int vcu,const int wid){
  const int pr=vcu>>4,s=vcu&15,h=pr>>1,m=pr&1;
  const bf16*Q=PD+h*128+m*64,*K=PD+1024+h*128+m*64,*V=PD+2048+h*128; bf16*Op=O+m*1024+h*128;
  _Pragma("unroll 1") for(int i=0;i<4;++i){ const int qb=(i>>1)*32+((i&1)?31-s:s); attn_unit<THRL>(wid,qb,Q,K,V,Op,lds); }
}
#undef SBAR
#undef WAIT_BAR
}
#define GAS __attribute__((address_space(1)))
#define LAS __attribute__((address_space(3)))
typedef unsigned short bf16;
typedef unsigned v4u __attribute__((ext_vector_type(4)));
typedef float f32x4 __attribute__((ext_vector_type(4)));
typedef short bf16x8 __attribute__((ext_vector_type(8)));
typedef GAS unsigned gu32;
typedef GAS unsigned long long gu64;
#define RLX_AGENT __ATOMIC_RELAXED, __HIP_MEMORY_SCOPE_AGENT
#define LDS_WAIT() asm volatile("s_waitcnt lgkmcnt(0)" ::: "memory")
#define VM_WAIT() asm volatile("s_waitcnt vmcnt(0)" ::: "memory")
__device__ __forceinline__ unsigned long long rt() { return __builtin_amdgcn_s_memrealtime(); }
__device__ __forceinline__ unsigned f2bf(float f) { unsigned u = __builtin_bit_cast(unsigned, f); return (u + 0x7fffu + ((u >> 16) & 1u)) >> 16; }
__device__ __forceinline__ unsigned pk2(float lo, float hi) { return f2bf(lo) | (f2bf(hi) << 16); }

#define XB_TMO      128
#define XB_XCNT(j)  (256  + 64 * (j))
#define XB_XSUB(j)  (1280 + 64 * (j))
#define XB_XGEN(j)  (2304 + 64 * (j))
#define XB_TOP      3328
#define XB_TOPGEN   3392
#define XCD_BAR_WORDS 3456
#define XB_SPIN_CAP (1u << 18)

__device__ __forceinline__ unsigned xb_ld(unsigned* p)              { return __hip_atomic_load(p, __ATOMIC_RELAXED, __HIP_MEMORY_SCOPE_AGENT); }
__device__ __forceinline__ unsigned xb_add(unsigned* p, unsigned v) { return __hip_atomic_fetch_add(p, v, __ATOMIC_RELAXED, __HIP_MEMORY_SCOPE_AGENT); }
__device__ __forceinline__ unsigned xb_xcc_id() { return (unsigned)__builtin_amdgcn_s_getreg((3 << 11) | 20) & 0xFu; }
#define XB_SPIN(cond, bar) do { unsigned _sp = 0; while (cond) { __builtin_amdgcn_s_sleep(1); \
    if ((++_sp & 255u) == 0u) { if (xb_ld(&(bar)[XB_TMO])) break; if (_sp > XB_SPIN_CAP) { atomicAdd(&(bar)[XB_TMO], 1u); break; } } } } while (0)

struct XcdBarrier {
    unsigned* bar; unsigned x;
    volatile LAS unsigned* st;
};

__device__ __forceinline__ XcdBarrier xcd_barrier_post(unsigned* bar, volatile LAS unsigned* st) {
    XcdBarrier b; b.bar = bar; b.x = xb_xcc_id(); b.st = st;
    if (threadIdx.x == 0) (void)xb_add(&bar[XB_XCNT(b.x)], 1u);
    return b;
}
__device__ __forceinline__ void xcd_barrier_complete(unsigned* bar, unsigned x, unsigned& nloc, unsigned& nx) {
    const unsigned G = gridDim.x * gridDim.y * gridDim.z;
    unsigned sum, cnt, mine, sp = 0u;
    for (;;) {
        sum = 0u; cnt = 0u; mine = 0u;
#pragma unroll
        for (unsigned j = 0; j < 16; ++j) { const unsigned c = xb_ld(&bar[XB_XCNT(j)]); sum += c; cnt += (c > 0u) ? 1u : 0u; mine = (j == x) ? c : mine; }
        if (sum == G) break;
        __builtin_amdgcn_s_sleep(1);
        if ((++sp & 255u) == 0u) { if (xb_ld(&bar[XB_TMO])) break; if (sp > XB_SPIN_CAP) { atomicAdd(&bar[XB_TMO], 1u); break; } }
    }
    nloc = mine > 0u ? mine : 1u; nx = cnt > 0u ? cnt : 1u;
}

__device__ __forceinline__ void xcd_barrier(const XcdBarrier& b) {
    asm volatile("s_waitcnt vmcnt(0)" ::: "memory");
    __syncthreads();
    if (threadIdx.x == 0) {
        unsigned* bar = b.bar;
        __builtin_amdgcn_s_waitcnt(0);
        unsigned nloc = b.st[0], nx = b.st[1];
        if (nloc == 0u) { xcd_barrier_complete(bar, b.x, nloc, nx); b.st[0] = nloc; b.st[1] = nx; }
        const unsigned old = xb_add(&bar[XB_XSUB(b.x)], 1u);
        const unsigned gen = old / nloc;
        if (old + 1u == (gen + 1u) * nloc) {
            __builtin_amdgcn_fence(__ATOMIC_RELEASE, "agent");
            asm volatile("s_waitcnt vmcnt(0)" ::: "memory");
            const unsigned og = xb_add(&bar[XB_TOP], 1u);
            const unsigned tg = og / nx;
            if (og + 1u == (tg + 1u) * nx) xb_add(&bar[XB_TOPGEN], 1u);
            else XB_SPIN(xb_ld(&bar[XB_TOPGEN]) == tg, bar);
            __builtin_amdgcn_fence(__ATOMIC_ACQUIRE, "agent");
            xb_add(&bar[XB_XGEN(b.x)], 1u);
            asm volatile("s_waitcnt vmcnt(0)" ::: "memory");
        } else {
            XB_SPIN(xb_ld(&bar[XB_XGEN(b.x)]) == gen, bar);
            __builtin_amdgcn_fence(__ATOMIC_ACQUIRE, "agent");
            asm volatile("s_waitcnt vmcnt(0)" ::: "memory");
        }
    }
    __syncthreads();
}
constexpr int NWAVES = 8;
constexpr int S_ = 16384, DM = 2048;
constexpr int NPH = 16;
#ifndef MK_PER_PHASE
#define MK_PER_PHASE 0
#endif
constexpr size_t MiB = 1u << 20;
constexpr size_t WS_CTL = 0, CTL_ZERO_BYTES = 1 * MiB;
constexpr size_t WS_WA = 1 * MiB, WS_WB = 5 * MiB, WS_WOUT = 9 * MiB, WS_WS = 17 * MiB, WS_LORA = 25 * MiB;
constexpr size_t WS_WIN = 27 * MiB, WS_PR = 69 * MiB, WS_PD = 181 * MiB, WS_PG = 277 * MiB;
constexpr size_t WS_A = 405 * MiB, WS_E = 437 * MiB, WS_G = 469 * MiB, WS_END = 507 * MiB;
constexpr size_t WS_SCN = 27 * MiB, WS_SCAL = 123 * MiB, WS_SLOC = 127 * MiB, WS_ASEG = 143 * MiB, WS_SIN = 159 * MiB;
constexpr size_t WS_YA = 405 * MiB, WS_OATT = 27 * MiB, WS_YB = 91 * MiB, WS_T1 = 123 * MiB, WS_MERGED = 27 * MiB;
constexpr size_t WS_H2 = 123 * MiB, WS_XN2 = 27 * MiB, WS_UTAB = 251 * MiB, WS_VTAB = 315 * MiB, WS_SCORES = 379 * MiB;
constexpr size_t WS_USCL = WS_UTAB + 16 * MiB, WS_VSCL = WS_VTAB + 16 * MiB;
constexpr size_t OUT_XN = 0, OUT_RKV = 0, OUT_LIN = 96 * MiB;
constexpr int CW_BAR = 4096;
constexpr int RING_OFF = 0, RING_BYTES = 131072;
constexpr int LDSCTL_OFF = RING_BYTES, MISC_OFF = LDSCTL_OFF + 320;
constexpr int LDS_BYTES = 147456;
constexpr int NSEG = 64, SEGLEN = S_ / NSEG;

struct Args { const float* in[28]; float* out; unsigned char* ws; int ph_lo, ph_hi; };

struct Frame {
    LAS unsigned char* lds; volatile LAS unsigned* MISC; gu32* ctl;
    int tid, lane, wave, vcu, G;
};

__device__ __forceinline__ float bf2f(unsigned short b) { return __uint_as_float((unsigned)b << 16); }
__device__ __forceinline__ float wave_sum(float v) {
#pragma unroll
    for (int o = 1; o < 64; o <<= 1) v += __shfl_xor(v, o);
    return v;
}
__device__ __forceinline__ float wave_max(float v) {
#pragma unroll
    for (int o = 1; o < 64; o <<= 1) v = fmaxf(v, __shfl_xor(v, o));
    return v;
}
template <int CTRL, int RM> __device__ __forceinline__ float dppf(float oldv, float x) { return __builtin_bit_cast(float, __builtin_amdgcn_update_dpp(__builtin_bit_cast(int, oldv), __builtin_bit_cast(int, x), CTRL, RM, 0xf, false)); }
__device__ __forceinline__ float wsum(float v) {
    v += dppf<0xB1, 0xf>(v, v); v += dppf<0x4E, 0xf>(v, v); v += dppf<0x141, 0xf>(v, v); v += dppf<0x140, 0xf>(v, v);
    v += dppf<0x142, 0xa>(0.f, v); v += dppf<0x143, 0xc>(0.f, v);
    return __builtin_bit_cast(float, __builtin_amdgcn_readlane(__builtin_bit_cast(int, v), 63));
}
__device__ __forceinline__ float wmax(float v) {
    v = fmaxf(v, dppf<0xB1, 0xf>(v, v)); v = fmaxf(v, dppf<0x4E, 0xf>(v, v)); v = fmaxf(v, dppf<0x141, 0xf>(v, v)); v = fmaxf(v, dppf<0x140, 0xf>(v, v));
    v = fmaxf(v, dppf<0x142, 0xa>(0.f, v)); v = fmaxf(v, dppf<0x143, 0xc>(0.f, v));
    return __builtin_bit_cast(float, __builtin_amdgcn_readlane(__builtin_bit_cast(int, v), 63));
}
__device__ __forceinline__ float sigmf(float x) { return __builtin_amdgcn_rcpf(1.0f + __expf(-x)); }

__device__ __forceinline__ void transpose_block(const float* W, int ldw, int k0, int n0, int kvalid, bf16* WT, int ldt, int drow0, LAS float* scr, int lane) {
    float tv[32];
#pragma unroll
    for (int i = 0; i < 32; ++i) { const int k = k0 + 2 * i + (lane >> 5); tv[i] = (k < kvalid) ? W[(size_t)k * ldw + n0 + (lane & 31)] : 0.f; }
#pragma unroll
    for (int i = 0; i < 32; ++i) scr[(2 * i + (lane >> 5)) * 33 + (lane & 31)] = tv[i];
    LDS_WAIT(); asm volatile("" ::: "memory");
    const int c = lane & 7;
#pragma unroll
    for (int j = 0; j < 4; ++j) { const int n = (lane >> 3) + 8 * j; const LAS float* s = scr + (8 * c) * 33 + n;
        v4u o; o.x = pk2(s[0 * 33], s[1 * 33]); o.y = pk2(s[2 * 33], s[3 * 33]); o.z = pk2(s[4 * 33], s[5 * 33]); o.w = pk2(s[6 * 33], s[7 * 33]);
        *(GAS v4u*)(WT + (size_t)(drow0 + n) * ldt + k0 + 8 * c) = o; }
    LDS_WAIT(); asm volatile("" ::: "memory");
}
__device__ __forceinline__ void rms_row_to_bf16(const float* xrow, const float* g, bf16* orow, int lane) {
    const GAS f32x4* xr = (const GAS f32x4*)xrow + lane; const f32x4* gr = (const f32x4*)g + lane;
    f32x4 v[8]; float s = 0.f;
#pragma unroll
    for (int j = 0; j < 8; ++j) { v[j] = xr[64 * j]; s += (v[j].x * v[j].x + v[j].y * v[j].y) + (v[j].z * v[j].z + v[j].w * v[j].w); }
    const float rstd = rsqrtf(wave_sum(s) * (1.f / 2048.f) + 1e-6f);
    GAS unsigned long long* o8 = (GAS unsigned long long*)orow + lane;
#pragma unroll
    for (int j = 0; j < 8; ++j) { const f32x4 gg = gr[64 * j];
        o8[64 * j] = (unsigned long long)pk2(v[j].x * rstd * gg.x, v[j].y * rstd * gg.y) | ((unsigned long long)pk2(v[j].z * rstd * gg.z, v[j].w * rstd * gg.w) << 32); }
}

__device__ __forceinline__ void rms_row2_to_bf16(const float* xa, const float* xb, const float* g, bf16* oa, bf16* ob_, int lane) {
    const GAS f32x4* xr = (const GAS f32x4*)xa + lane; const GAS f32x4* yr = (const GAS f32x4*)xb + lane; const f32x4* gr = (const f32x4*)g + lane;
    f32x4 v[8], w[8]; float s = 0.f, t = 0.f;
#pragma unroll
    for (int j = 0; j < 8; ++j) { v[j] = __builtin_nontemporal_load(xr + 64 * j); w[j] = __builtin_nontemporal_load(yr + 64 * j); }
#pragma unroll
    for (int j = 0; j < 8; ++j) { s += (v[j].x * v[j].x + v[j].y * v[j].y) + (v[j].z * v[j].z + v[j].w * v[j].w); t += (w[j].x * w[j].x + w[j].y * w[j].y) + (w[j].z * w[j].z + w[j].w * w[j].w); }
    const float rs = rsqrtf(wsum(s) * (1.f / 2048.f) + 1e-6f), rt = rsqrtf(wsum(t) * (1.f / 2048.f) + 1e-6f);
    GAS unsigned long long* o8 = (GAS unsigned long long*)oa + lane; GAS unsigned long long* p8 = (GAS unsigned long long*)ob_ + lane;
#pragma unroll
    for (int j = 0; j < 8; ++j) { const f32x4 gg = gr[64 * j];
        o8[64 * j] = (unsigned long long)pk2(v[j].x * rs * gg.x, v[j].y * rs * gg.y) | ((unsigned long long)pk2(v[j].z * rs * gg.z, v[j].w * rs * gg.w) << 32);
        p8[64 * j] = (unsigned long long)pk2(w[j].x * rt * gg.x, w[j].y * rt * gg.y) | ((unsigned long long)pk2(w[j].z * rt * gg.z, w[j].w * rt * gg.w) << 32); }
}

template <int K, int VAR = 0> __device__ __forceinline__ void fmac_dpp(float& acc, float op, float s) {
    if (VAR == 0) asm("v_fmac_f32_dpp %0, %1, %2 quad_perm:[%c3,%c3,%c3,%c3] row_mask:0xf bank_mask:0xf" : "+v"(acc) : "v"(op), "v"(s), "i"(K));
    else asm("v_fmac_f32_e32 %0, %1, %2" : "+v"(acc) : "v"(op), "v"(s)); }
template <int K, int VAR = 0> __device__ __forceinline__ void mulip_dpp(float& s, float op) {
    if (VAR == 0) asm("v_mul_f32_dpp %0, %1, %0 quad_perm:[%c2,%c2,%c2,%c2] row_mask:0xf bank_mask:0xf" : "+v"(s) : "v"(op), "i"(K));
    else asm("v_mul_f32_e32 %0, %1, %0" : "+v"(s) : "v"(op)); }
#define SCAN_FOR_C(...) _Pragma("unroll") for (int j = 0; j < 4; ++j) { \
    { constexpr int k = 0; _Pragma("unroll") for (int i = 0; i < 4; ++i) { const int c = 16 * j + 4 * k + i; __VA_ARGS__ } } \
    { constexpr int k = 1; _Pragma("unroll") for (int i = 0; i < 4; ++i) { const int c = 16 * j + 4 * k + i; __VA_ARGS__ } } \
    { constexpr int k = 2; _Pragma("unroll") for (int i = 0; i < 4; ++i) { const int c = 16 * j + 4 * k + i; __VA_ARGS__ } } \
    { constexpr int k = 3; _Pragma("unroll") for (int i = 0; i < 4; ++i) { const int c = 16 * j + 4 * k + i; __VA_ARGS__ } } }

constexpr int SCAN_CH = 4;
constexpr int SC_RING = 0, SC_VG = 2 * SCAN_CH * 320, SC_SC = SC_VG + 2 * SCAN_CH * 128, SC_Y = SC_SC + 2 * SCAN_CH * 4, SC_SLOT_F = SC_Y + 2 * SCAN_CH * 64;
template <int KIND, int NOLOAD = 0> __device__ __forceinline__ void scan3_phase(bf16* yabase, const int lane, const int wave, const int vcu, const int G, unsigned char* ws, const float* const* in, const bf16* RKV, LAS float* ldsf) {
    constexpr int CH = SCAN_CH, NCHUNK = SEGLEN / CH;
#define SCAN_BAR() do { asm volatile("s_waitcnt lgkmcnt(0)" ::: "memory"); __builtin_amdgcn_s_barrier(); asm volatile("" ::: "memory"); } while (0)
    const int slot = wave & 3; LAS float* sl = ldsf + slot * SC_SLOT_F;
    for (int round = 0; round * G * 4 < 16 * NSEG; ++round) {
        const int task = round * G * 4 + vcu * 4 + slot; const bool valid = task < 16 * NSEG; const int h = valid ? task / NSEG : 0, seg = valid ? task % NSEG : 0; const int t0 = seg * SEGLEN;
        if (wave >= 4) {
            const bf16* SCN = (const bf16*)(ws + WS_SCN) + ((size_t)h * S_) * 192; const float* SCAL = (const float*)(ws + WS_SCAL) + ((size_t)h * S_) * 4;
            const bf16* Eb = (const bf16*)(ws + WS_E); const bf16* Gb = (const bf16*)(ws + WS_G); bf16* YA = yabase + h * 64 + lane;
            unsigned short pk[CH], pb[CH], pt[CH], pr[CH], pe[CH], pv[CH], pg[CH]; f32x4 psc = (f32x4){0.f, 0.f, 0.f, 0.f};
#define SCAN_ISSUE(n) do { const int tc_ = NOLOAD ? t0 : t0 + (n) * CH; if (NOLOAD && (n) > 1) break; \
            _Pragma("unroll") for (int s = 0; s < CH; ++s) { const size_t t = (size_t)(tc_ + s); \
                pk[s] = SCN[t * 192 + lane]; pb[s] = SCN[t * 192 + 64 + lane]; pt[s] = SCN[t * 192 + 128 + lane]; \
                pr[s] = RKV[t * 3072 + h * 64 + lane]; pe[s] = Eb[t * 1024 + h * 64 + lane]; pv[s] = RKV[t * 3072 + 2048 + h * 64 + lane]; \
                if (KIND == 2) pg[s] = Gb[t * 1024 + h * 64 + lane]; } \
            if (KIND == 2) { if (lane < CH) psc = *(const f32x4*)(SCAL + (size_t)(tc_ + lane) * 4); } } while (0)
#define SCAN_WRITE(n) do { const int b_ = (n) & 1; \
            _Pragma("unroll") for (int s = 0; s < CH; ++s) { const float w = __expf(-bf2f(pe[s])); LAS float* q = sl + SC_RING + (b_ * CH + s) * 320; \
                q[lane] = bf2f(pk[s]); q[64 + lane] = w * bf2f(pr[s]); q[128 + lane] = w; q[192 + lane] = bf2f(pb[s]); q[256 + lane] = bf2f(pt[s]); \
                LAS float* q2 = sl + SC_VG + (b_ * CH + s) * 128; q2[lane] = bf2f(pv[s]); if (KIND == 2) q2[64 + lane] = bf2f(pg[s]); } \
            if (KIND == 2) { if (lane < CH) *(LAS f32x4*)(sl + SC_SC + (b_ * CH + lane) * 4) = psc; } } while (0)
#define SCAN_YSTORE(n) do { if (KIND == 2) { const int tc_ = t0 + (n) * CH; const int b_ = (n) & 1; \
            _Pragma("unroll") for (int s = 0; s < CH; ++s) YA[(size_t)(tc_ + s) * 1024] = (unsigned short)f2bf(sl[SC_Y + (b_ * CH + s) * 64 + lane]); } } while (0)
            if (valid) { SCAN_ISSUE(0); SCAN_WRITE(0); SCAN_ISSUE(1); }
            SCAN_BAR();
#pragma unroll 1
            for (int n = 0; n < NCHUNK; ++n) {
                if (valid) { if (n + 1 < NCHUNK) SCAN_WRITE(n + 1); if (n >= 1) SCAN_YSTORE(n - 1); if (n + 2 < NCHUNK) SCAN_ISSUE(n + 2); }
                SCAN_BAR();
            }
            if (valid) SCAN_YSTORE(NCHUNK - 1);
#undef SCAN_ISSUE
#undef SCAN_WRITE
#undef SCAN_YSTORE
        } else {
            float S[64], M[64]; int ln_ = lane; asm volatile("" : "+v"(ln_));
            if (KIND == 3) {
#pragma unroll
                for (int c = 0; c < 64; ++c) { S[c] = 0.f; M[c] = (c == ln_) ? 1.f : 0.f; }
            } else {
                const f32x4* sp = (const f32x4*)((const float*)(ws + WS_SIN) + (((size_t)h * NSEG + seg) * 64 + lane) * 64);
#pragma unroll
                for (int q = 0; q < 16; ++q) { const f32x4 x = sp[q]; S[4 * q] = x.x; S[4 * q + 1] = x.y; S[4 * q + 2] = x.z; S[4 * q + 3] = x.w; }
            }
            float lg = 0.f, lb = 0.f;
            if (KIND == 2) { lg = in[12][h * 64 + lane]; lb = in[13][h * 64 + lane]; }
            SCAN_BAR();
#pragma unroll 1
            for (int n = 0; n < NCHUNK; ++n) {
                const int b = n & 1;
                if (valid) {
                f32x4 KK[4], WR[4];
                { const LAS f32x4* q4 = (const LAS f32x4*)(sl + SC_RING + (b * CH) * 320) + (lane & 3);
#pragma unroll
                  for (int j = 0; j < 4; ++j) { KK[j] = q4[j * 4]; if (KIND == 2) WR[j] = q4[16 + j * 4]; } }
#pragma unroll 1
                for (int s = 0; s < CH; ++s) {
                    const LAS f32x4* q4 = (const LAS f32x4*)(sl + SC_RING + (b * CH + s) * 320) + (lane & 3);
                    f32x4 WW[4], BB[4], KT[4];
#pragma unroll
                    for (int j = 0; j < 4; ++j) { WW[j] = q4[32 + j * 4]; BB[j] = q4[48 + j * 4]; KT[j] = q4[64 + j * 4]; }
                    const float vt = sl[SC_VG + (b * CH + s) * 128 + lane];
                    float saq[8], ypq[8], sbq[8];
#pragma unroll
                    for (int q = 0; q < 8; ++q) { saq[q] = 0.f; ypq[q] = 0.f; sbq[q] = 0.f; }
                    SCAN_FOR_C( if (NOLOAD != 2) fmac_dpp<k>(saq[(k & 1) * 4 + i], KK[j][i], S[c]); if (KIND == 2) if (NOLOAD != 2) fmac_dpp<k>(ypq[(k & 1) * 4 + i], WR[j][i], S[c]); if (KIND == 3) if (NOLOAD != 2) fmac_dpp<k>(sbq[(k & 1) * 4 + i], KK[j][i], M[c]); )
                    const float sa = ((saq[0] + saq[1]) + (saq[2] + saq[3])) + ((saq[4] + saq[5]) + (saq[6] + saq[7]));
                    const float sb = ((sbq[0] + sbq[1]) + (sbq[2] + sbq[3])) + ((sbq[4] + sbq[5]) + (sbq[6] + sbq[7]));
                    const float yp0 = ((ypq[0] + ypq[1]) + (ypq[2] + ypq[3])), yp1 = ((ypq[4] + ypq[5]) + (ypq[6] + ypq[7]));
                    if (KIND == 2) { const LAS f32x4* qn = (const LAS f32x4*)(sl + SC_RING + (b * CH + ((s + 1) & (CH - 1))) * 320) + (lane & 3);
#pragma unroll
                      for (int j = 0; j < 4; ++j) { KK[j] = qn[j * 4]; WR[j] = qn[16 + j * 4]; } }
                    SCAN_FOR_C( if (NOLOAD != 2) mulip_dpp<k>(S[c], WW[j][i]); )
                    SCAN_FOR_C( if (NOLOAD != 2) fmac_dpp<k>(S[c], BB[j][i], sa); )
                    SCAN_FOR_C( if (NOLOAD != 2) fmac_dpp<k>(S[c], KT[j][i], vt); )
                    if (KIND == 3) { asm volatile("" ::: "memory");
                      { const LAS f32x4* qn = (const LAS f32x4*)(sl + SC_RING + (b * CH + ((s + 1) & (CH - 1))) * 320) + (lane & 3);
#pragma unroll
                        for (int j = 0; j < 4; ++j) KK[j] = qn[j * 4]; }
                      SCAN_FOR_C( if (NOLOAD != 2) mulip_dpp<k>(M[c], WW[j][i]); )
                      SCAN_FOR_C( if (NOLOAD != 2) fmac_dpp<k>(M[c], BB[j][i], sb); ) }
                    if (KIND == 2) {
                        const f32x4 sc = *(const LAS f32x4*)(sl + SC_SC + (b * CH + s) * 4); const float gt_ = sl[SC_VG + (b * CH + s) * 128 + 64 + lane];
                        const float y = (yp0 + yp1) + sa * sc.x + vt * sc.y;
                        const float mean = wsum(y) * (1.f / 64.f); const float d = y - mean;
                        const float var = wsum(d * d) * (1.f / 64.f);
                        sl[SC_Y + (b * CH + s) * 64 + lane] = (d * rsqrtf(var + 64e-5f) * lg + lb + sc.z * vt) * gt_;
                    }
                }
                }
                SCAN_BAR();
            }
            if (KIND == 3 && valid) {
                f32x4* op = (f32x4*)((float*)(ws + WS_SLOC) + (((size_t)h * NSEG + seg) * 64 + lane) * 64);
                bf16* oq = (bf16*)(ws + WS_ASEG) + ((size_t)h * NSEG + seg) * 4096 + lane;
#pragma unroll
                for (int q = 0; q < 16; ++q) op[q] = (f32x4){S[4 * q], S[4 * q + 1], S[4 * q + 2], S[4 * q + 3]};
#pragma unroll
                for (int c2 = 0; c2 < 64; ++c2) oq[c2 * 64] = (unsigned short)f2bf(M[c2]);
            }
        }
        SCAN_BAR();
    }
}

__global__ void __launch_bounds__(NWAVES * 64, 2) mk_fwd(Args args) {
    extern __shared__ __attribute__((aligned(16))) unsigned char lds[];
    Frame F;
    F.lds = (LAS unsigned char*)lds; F.MISC = (volatile LAS unsigned*)(F.lds + MISC_OFF);
    F.tid = threadIdx.x; F.wave = __builtin_amdgcn_readfirstlane(F.tid >> 6);
    F.G = gridDim.x; { const int bx = blockIdx.x; F.vcu = (F.G % 8 == 0) ? (bx % 8) * (F.G / 8) + bx / 8 : bx; }
    unsigned char* ws = args.ws; F.ctl = (gu32*)(ws + WS_CTL);
    const float* const* in = args.in;
    unsigned char* ob = (unsigned char*)args.out;
    for (int u = threadIdx.x; u < (LDS_BYTES - LDSCTL_OFF) / 4; u += NWAVES * 64) ((LAS unsigned*)(F.lds + LDSCTL_OFF))[u] = 0u;
    __syncthreads();
    XcdBarrier bar; bar.bar = (unsigned*)(F.ctl + CW_BAR); bar.x = 0; bar.st = nullptr;
    if (!MK_PER_PHASE) bar = xcd_barrier_post((unsigned*)(F.ctl + CW_BAR), F.MISC + 8);
    const int lo = args.ph_lo, hi = args.ph_hi;
#ifndef PH_MASK
#define PH_MASK 0xFFFF
#endif
#define IN(k) ((((PH_MASK) >> (k)) & 1) && lo <= (k) && (k) < hi)
#ifndef PROBE_MASK
#define PROBE_MASK 0
#endif
#ifndef PROBE_VARIANT
#define PROBE_VARIANT 0
#endif
#ifndef PROBE_N
#define PROBE_N 1
#endif
#define PHASE_BEGIN(k) if (IN(k)) { for (int rep_ = 0; rep_ < 1 + ((((PROBE_MASK) >> (k)) & 1) ? (PROBE_N) : 0); ++rep_) { if (rep_) xcd_barrier(bar); PHASE_IDS
#define PHASE_END } }
#define SEAM(k) do { if (IN(k) && IN((k) + 1)) xcd_barrier(bar); } while (0)
    const int gw = F.vcu * NWAVES + F.wave, NGW = F.G * NWAVES; const int NGT = F.G * NWAVES * 64;
#define PHASE_IDS const int lane = mk_lane_id(), tid = F.wave * 64 + lane, gt = F.vcu * (NWAVES * 64) + tid; (void)gt; (void)lane;

    bf16* WIN_T = (bf16*)(ws + WS_WIN); bf16* WA_T = (bf16*)(ws + WS_WA); bf16* WB_T = (bf16*)(ws + WS_WB); bf16* WOUT_T = (bf16*)(ws + WS_WOUT);
    bf16* WS_T = (bf16*)(ws + WS_WS); bf16* LORA_T = (bf16*)(ws + WS_LORA);
    bf16* XN = (bf16*)(ob + OUT_XN); bf16* RKV = (bf16*)(ob + OUT_RKV); bf16* LIN = (bf16*)(ob + OUT_LIN);
    bf16* PR = (bf16*)(ws + WS_PR); bf16* PD = (bf16*)(ws + WS_PD); bf16* PG = (bf16*)(ws + WS_PG);

    PHASE_BEGIN(0)
        LAS float* scr = (LAS float*)(F.lds + RING_OFF + F.wave * 16384);
        constexpr int I_IN = 32 * 334, I_A = 16 * 64, I_B = 16 * 64, I_O = 32 * 64, I_L = 4 * 32;
        constexpr int NIT = I_IN + I_A + I_B + I_O + 3 * I_L;
        for (int it = gw; it < NIT; it += NGW) {
            int r = it;
            if (r < I_IN) { const int kb = r / 334, nb = r % 334, n0 = nb * 32; transpose_block(in[2], 10688, kb * 64, n0, 2048, WIN_T, 2048, n0 + (n0 >= 3520 ? 64 : 0), scr, lane); continue; } r -= I_IN;
            if (r < I_A) { const int kb = r / 64, nb = r % 64; transpose_block(in[19], 2048, kb * 64, nb * 32, 1024, WA_T, 1024, nb * 32, scr, lane); continue; } r -= I_A;
            if (r < I_B) { const int kb = r / 64, nb = r % 64; transpose_block(in[20], 2048, kb * 64, nb * 32, 1024, WB_T, 1024, nb * 32, scr, lane); continue; } r -= I_B;
            if (r < I_O) { const int kb = r / 64, nb = r % 64; transpose_block(in[21], 2048, kb * 64, nb * 32, 2048, WOUT_T, 2048, nb * 32, scr, lane); continue; } r -= I_O;
            { const int which = r / I_L, rr = r % I_L, kb = rr / 32, nb = rr % 32; const float* W = which == 0 ? in[5] : (which == 1 ? in[7] : in[8]);
              transpose_block(W, 1024, kb * 64, nb * 32, which == 2 ? 256 : 96, LORA_T + (size_t)which * 1024 * 256, 256, nb * 32, scr, lane); }
        }
        for (int i = gt; i < 16384; i += NGT) *(GAS v4u*)(WIN_T + (size_t)3520 * 2048 + (size_t)i * 8) = (v4u){0u, 0u, 0u, 0u};
        for (int task = gw; task < 16 * 32 * 4; task += NGW) {
            const int hp = task >> 7, kb = (task >> 2) & 31, ng = task & 3; const int k = kb * 64 + lane;
            const f32x4* wq = (const f32x4*)(in[23] + (size_t)k * 2048 + hp * 128);
            f32x4 q[32];
#pragma unroll
            for (int d = 0; d < 32; ++d) q[d] = wq[d];
            const f32x4* sk4 = (const f32x4*)(in[24] + ((size_t)hp * 128 + ng * 32) * 128); LAS f32x4* sks = (LAS f32x4*)scr;
#pragma unroll
            for (int i = 0; i < 16; ++i) sks[i * 64 + lane] = sk4[i * 64 + lane];
            LDS_WAIT(); asm volatile("" ::: "memory");
#pragma unroll 2
            for (int n = 0; n < 32; ++n) { const LAS f32x4* s4 = sks + n * 32; float a0 = 0.f, a1 = 0.f;
#pragma unroll
                for (int d = 0; d < 32; ++d) { const f32x4 s = s4[d]; a0 = fmaf(q[d].x, s.x, a0); a1 = fmaf(q[d].y, s.y, a1); a0 = fmaf(q[d].z, s.z, a0); a1 = fmaf(q[d].w, s.w, a1); }
                WS_T[(size_t)(hp * 128 + ng * 32 + n) * 2048 + k] = (bf16)f2bf(a0 + a1); }
            LDS_WAIT(); asm volatile("" ::: "memory");
        }
        for (int m = gw; m < S_; m += 2 * NGW) rms_row2_to_bf16(in[0] + (size_t)m * DM, in[0] + (size_t)(m + NGW) * DM, in[1], XN + (size_t)m * DM, XN + (size_t)(m + NGW) * DM, lane);
    PHASE_END
    SEAM(0);
    PHASE_BEGIN(1)
        pg8::Gemm g{XN, WIN_T, S_, 10752, 2048, 2048, 2048}; pg8::StaticOrder S; S.init(S_, 10752, F.G, (int)blockIdx.x);
        pg8::Epi<pg8::EM_G1> E{PR, PD, PG, nullptr, nullptr, nullptr, attn_body::C2};
        pg8::gemm_phase<pg8::Epi<pg8::EM_G1>, pg8::StaticOrder, true, true>(F.lds + RING_OFF, g, S, E, F.wave);
    PHASE_END
    SEAM(1);
    PHASE_BEGIN(2)
        const float* mu = in[3];
        for (int t = gw; t < S_; t += NGW) {
            const bf16* cur = PR + (size_t)t * 3584; const bf16* prv = cur - 3584;
#pragma unroll 1
            for (int j = 0; j < 7; ++j) { const int ch = lane + 64 * j; if (ch >= 440) break;
                const v4u c4 = *(const GAS v4u*)(cur + ch * 8); v4u p4 = (v4u){0u, 0u, 0u, 0u}; if (t > 0) p4 = *(const GAS v4u*)(prv + ch * 8);
                const f32x4 m0 = *(const f32x4*)(mu + ch * 8), m1 = *(const f32x4*)(mu + ch * 8 + 4);
                float c[8] = {pg8::bflo(c4.x), pg8::bfhi(c4.x), pg8::bflo(c4.y), pg8::bfhi(c4.y), pg8::bflo(c4.z), pg8::bfhi(c4.z), pg8::bflo(c4.w), pg8::bfhi(c4.w)};
                const float p[8] = {pg8::bflo(p4.x), pg8::bfhi(p4.x), pg8::bflo(p4.y), pg8::bfhi(p4.y), pg8::bflo(p4.z), pg8::bfhi(p4.z), pg8::bflo(p4.w), pg8::bfhi(p4.w)};
                const float mm[8] = {m0.x, m0.y, m0.z, m0.w, m1.x, m1.y, m1.z, m1.w};
#pragma unroll
                for (int e = 0; e < 8; ++e) c[e] = c[e] + (p[e] - c[e]) * mm[e];
                bf16* dst;
                if (ch < 384) dst = RKV + (size_t)t * 3072 + ch * 8;
                else { const int col = ch * 8 - 3072;
                    if (col < 96) { dst = LIN + (size_t)t * 768 + col;
#pragma unroll
                        for (int e = 0; e < 8; ++e) c[e] = tanhf(c[e]); }
                    else if (col < 192) dst = LIN + (size_t)t * 768 + 256 + (col - 96);
                    else { dst = LIN + (size_t)t * 768 + 512 + (col - 192);
#pragma unroll
                        for (int e = 0; e < 8; ++e) c[e] = sigmf(c[e]); } }
                *(GAS v4u*)dst = (v4u){pk2(c[0], c[1]), pk2(c[2], c[3]), pk2(c[4], c[5]), pk2(c[6], c[7])};
            }
            if (lane < 40) { const int z = lane < 20 ? 96 + lane * 8 : 352 + (lane - 20) * 8; *(GAS v4u*)(LIN + (size_t)t * 768 + z) = (v4u){0u, 0u, 0u, 0u}; }
        }
    PHASE_END
    SEAM(2);
    PHASE_BEGIN(3)
#pragma unroll 1
        for (int which = 0; which < 3; ++which) {
            int kd = 256; asm volatile("" : "+s"(kd));
            pg8::Gemm g{LIN + which * 256, LORA_T + (size_t)which * 1024 * 256, S_, 1024, kd, 768, 256}; pg8::StaticOrder S; S.init(S_, 1024, F.G, (int)blockIdx.x);
            pg8::Epi<pg8::EM_LORA_W> E{ws + (which == 0 ? WS_E : (which == 1 ? WS_A : WS_G)), nullptr, nullptr, nullptr, nullptr, which == 0 ? in[4] : (which == 1 ? in[6] : nullptr), which == 0 ? 0.60653065971f : 1.f};
            pg8::gemm_phase<pg8::Epi<pg8::EM_LORA_W>, pg8::StaticOrder, true, true>(F.lds + RING_OFF, g, S, E, F.wave); }
    PHASE_END
    SEAM(3);
    PHASE_BEGIN(4)
        bf16* SCN = (bf16*)(ws + WS_SCN); float* SCAL = (float*)(ws + WS_SCAL); const bf16* Ab = (const bf16*)(ws + WS_A);
        for (int t = gw; t < S_; t += NGW) {
#pragma unroll 2
            for (int h = 0; h < 16; ++h) { const int cc = h * 64 + lane;
                const float r = bf2f(RKV[(size_t)t * 3072 + cc]), k = bf2f(RKV[(size_t)t * 3072 + 1024 + cc]), a = bf2f(Ab[(size_t)t * 1024 + cc]);
                float kk = k * in[9][cc]; const float nrm = sqrtf(wsum(kk * kk)); kk = kk / fmaxf(nrm, 1e-12f);
                const float kt = k * (1.f + (a - 1.f) * in[10][cc]); const float b = kk * a;
                const unsigned short kkb = (unsigned short)f2bf(-kk), bb = (unsigned short)f2bf(b), ktb = (unsigned short)f2bf(kt);
                bf16* q = SCN + ((size_t)h * S_ + t) * 192; q[lane] = kkb; q[64 + lane] = bb; q[128 + lane] = ktb;
                const float br = wsum(bf2f(bb) * r), kr = wsum(bf2f(ktb) * r), bon = wsum(r * kt * in[11][cc]);
                if (lane == 0) *(f32x4*)(SCAL + ((size_t)h * S_ + t) * 4) = (f32x4){br, kr, bon, 0.f}; }
        }
    PHASE_END
    SEAM(4);
    PHASE_BEGIN(5)
        scan3_phase<3>(nullptr, lane, F.wave, F.vcu, F.G, ws, in, RKV, (LAS float*)(F.lds + RING_OFF));
    PHASE_END
    SEAM(5);
    PHASE_BEGIN(6)
        if (F.vcu < 16) { const int h = F.vcu; const int wv = F.wave;
            constexpr int PIT = 72;
            LAS bf16* Sb = (LAS bf16*)(F.lds + RING_OFF);
            LAS bf16* Atb = Sb + 2 * 64 * PIT;
            const float* SL = (const float*)(ws + WS_SLOC) + (size_t)h * NSEG * 4096; const bf16* AT = (const bf16*)(ws + WS_ASEG) + (size_t)h * NSEG * 4096; float* SI = (float*)(ws + WS_SIN) + (size_t)h * NSEG * 4096;
            for (int i = tid; i < 2 * 64 * PIT / 2; i += 512) ((LAS unsigned*)Sb)[i] = 0u;
#define P6_BAR() do { asm volatile("s_waitcnt lgkmcnt(0)" ::: "memory"); __builtin_amdgcn_s_barrier(); asm volatile("" ::: "memory"); } while (0)
            if (wv >= 4) {
                const int li = tid - 256, row = li >> 2, ch = li & 3;
                v4u r0a, r0b, r1a, r1b;
#define P6_LD(p, ra, rb) do { const bf16* s_ = AT + (size_t)(p) * 4096 + row * 64 + ch * 16; ra = *(const GAS v4u*)s_; rb = *(const GAS v4u*)(s_ + 8); } while (0)
#define P6_ST(p, ra, rb) do { LAS bf16* d_ = Atb + ((p) % 3) * 64 * PIT + row * PIT + ch * 16; *(LAS v4u*)d_ = ra; *(LAS v4u*)(d_ + 8) = rb; } while (0)
                P6_LD(0, r0a, r0b); P6_ST(0, r0a, r0b); P6_LD(1, r0a, r0b); P6_LD(2, r1a, r1b);
                P6_BAR();
#pragma unroll 1
                for (int p = 0; p < NSEG - 1; p += 2) {
                    if (p + 1 < NSEG - 1) P6_ST(p + 1, r0a, r0b); if (p + 3 < NSEG - 1) P6_LD(p + 3, r0a, r0b);
                    P6_BAR();
                    if (p + 1 < NSEG - 1) { if (p + 2 < NSEG - 1) P6_ST(p + 2, r1a, r1b); if (p + 4 < NSEG - 1) P6_LD(p + 4, r1a, r1b); P6_BAR(); }
                }
#undef P6_LD
#undef P6_ST
            } else {
                const int vt = wv >> 1, ct = wv & 1, r = lane & 31, hb = lane >> 5;
                typedef float f32x16 __attribute__((ext_vector_type(16)));
                f32x16 nl;
#define P6_LDL(p) do { const float* s_ = SL + (size_t)(p) * 4096 + (32 * vt + 4 * hb) * 64 + 32 * ct + r; _Pragma("unroll") for (int q = 0; q < 16; ++q) nl[q] = s_[((q & 3) + 8 * (q >> 2)) * 64]; } while (0)
                P6_LDL(0);
                { float* o_ = SI + (32 * vt + 4 * hb) * 64 + 32 * ct + r;
#pragma unroll
                  for (int q = 0; q < 16; ++q) o_[((q & 3) + 8 * (q >> 2)) * 64] = 0.f; }
                P6_BAR();
#pragma unroll 1
                for (int p = 0; p < NSEG - 1; ++p) {
                    const LAS bf16* sa_ = Sb + (p & 1) * 64 * PIT + (32 * vt + r) * PIT + 8 * hb; const LAS bf16* at_ = Atb + (p % 3) * 64 * PIT + (32 * ct + r) * PIT + 8 * hb;
                    f32x16 acc = nl; if (p + 1 < NSEG - 1) P6_LDL(p + 1);
#pragma unroll
                    for (int ks = 0; ks < 4; ++ks) { const bf16x8 af = *(const LAS bf16x8*)(sa_ + 16 * ks), bfr = *(const LAS bf16x8*)(at_ + 16 * ks);
                        acc = __builtin_amdgcn_mfma_f32_32x32x16_bf16(af, bfr, acc, 0, 0, 0); }
                    float* o_ = SI + (size_t)(p + 1) * 4096 + (32 * vt + 4 * hb) * 64 + 32 * ct + r; LAS bf16* sn_ = Sb + ((p + 1) & 1) * 64 * PIT + (32 * vt + 4 * hb) * PIT + 32 * ct + r;
#pragma unroll
                    for (int q = 0; q < 16; ++q) { const int rr = (q & 3) + 8 * (q >> 2); o_[rr * 64] = acc[q]; sn_[rr * PIT] = (unsigned short)f2bf(acc[q]); }
                    P6_BAR();
                }
#undef P6_LDL
            }
#undef P6_BAR
        }
    PHASE_END
    SEAM(6);
    PHASE_BEGIN(7)
#if PROBE_VARIANT
        if (rep_) scan3_phase<2, PROBE_VARIANT>((bf16*)(ob + OUT_LIN), lane, F.wave, F.vcu, F.G, ws, in, RKV, (LAS float*)(F.lds + RING_OFF)); else
#endif
        scan3_phase<2>((bf16*)(ws + WS_YA), lane, F.wave, F.vcu, F.G, ws, in, RKV, (LAS float*)(F.lds + RING_OFF));
    PHASE_END
    SEAM(7);
    PHASE_BEGIN(8)
        __syncthreads();
        attn_body::attn_phase<8>((char*)lds + RING_OFF, (const attn_body::bf16*)PD, (attn_body::bf16*)(ws + WS_OATT), F.vcu, F.wave);
    PHASE_END
    SEAM(8);
    PHASE_BEGIN(9)
        float d1 = 0.f, d2 = 0.f; d1 = in[14][lane] * in[15][lane]; d2 = in[16][lane] * in[17][lane];
        const float lam = __expf(wave_sum(d1)) - __expf(wave_sum(d2)) + 0.2f;
        const bf16* OA = (const bf16*)(ws + WS_OATT); bf16* YB = (bf16*)(ws + WS_YB);
        f32x4 sg[4];
#pragma unroll
        for (int q = 0; q < 4; ++q) sg[q] = *(const f32x4*)(in[18] + (lane & 7) * 16 + q * 4);
        for (int t = gw; t < S_; t += NGW) {
            const v4u a0 = *(const GAS v4u*)(OA + (size_t)t * 2048 + lane * 16), a1 = *(const GAS v4u*)(OA + (size_t)t * 2048 + lane * 16 + 8);
            const v4u b0 = *(const GAS v4u*)(OA + (size_t)t * 2048 + 1024 + lane * 16), b1 = *(const GAS v4u*)(OA + (size_t)t * 2048 + 1024 + lane * 16 + 8);
            const unsigned aw[8] = {a0.x, a0.y, a0.z, a0.w, a1.x, a1.y, a1.z, a1.w}, bw[8] = {b0.x, b0.y, b0.z, b0.w, b1.x, b1.y, b1.z, b1.w};
            float o[16]; float ss = 0.f;
#pragma unroll
            for (int e = 0; e < 8; ++e) { o[2 * e] = pg8::bflo(aw[e]) - lam * pg8::bflo(bw[e]); o[2 * e + 1] = pg8::bfhi(aw[e]) - lam * pg8::bfhi(bw[e]); ss += o[2 * e] * o[2 * e] + o[2 * e + 1] * o[2 * e + 1]; }
            ss += __shfl_xor(ss, 1); ss += __shfl_xor(ss, 2); ss += __shfl_xor(ss, 4);
            const float rs = rsqrtf(ss * (1.f / 128.f) + 1e-5f) * 0.8f;
            const float gg[16] = {sg[0].x, sg[0].y, sg[0].z, sg[0].w, sg[1].x, sg[1].y, sg[1].z, sg[1].w, sg[2].x, sg[2].y, sg[2].z, sg[2].w, sg[3].x, sg[3].y, sg[3].z, sg[3].w};
#pragma unroll
            for (int e = 0; e < 16; ++e) o[e] = o[e] * rs * gg[e];
            *(GAS v4u*)(YB + (size_t)t * 1024 + lane * 16) = (v4u){pk2(o[0], o[1]), pk2(o[2], o[3]), pk2(o[4], o[5]), pk2(o[6], o[7])};
            *(GAS v4u*)(YB + (size_t)t * 1024 + lane * 16 + 8) = (v4u){pk2(o[8], o[9]), pk2(o[10], o[11]), pk2(o[12], o[13]), pk2(o[14], o[15])};
        }
    PHASE_END
    SEAM(9);
    PHASE_BEGIN(10)
        pg8::Gemm g{(const bf16*)(ws + WS_YA), WA_T, S_, 2048, 1024, 1024, 1024}; pg8::StaticOrder S; S.init(S_, 2048, F.G, (int)blockIdx.x);
        pg8::Epi<pg8::EM_PROJA> E{ws + WS_T1, nullptr, nullptr, PG, nullptr, nullptr, 1.f};
        pg8::gemm_phase<pg8::Epi<pg8::EM_PROJA>, pg8::StaticOrder, true, true>(F.lds + RING_OFF, g, S, E, F.wave);
    PHASE_END
    SEAM(10);
    PHASE_BEGIN(11)
        pg8::Gemm g{(const bf16*)(ws + WS_YB), WB_T, S_, 2048, 1024, 1024, 1024}; pg8::StaticOrder S; S.init(S_, 2048, F.G, (int)blockIdx.x);
        pg8::Epi<pg8::EM_PROJB> E{ws + WS_MERGED, nullptr, nullptr, PG, ws + WS_T1, nullptr, 1.f};
        pg8::gemm_phase<pg8::Epi<pg8::EM_PROJB>, pg8::StaticOrder, true, true>(F.lds + RING_OFF, g, S, E, F.wave);
    PHASE_END
    SEAM(11);
    PHASE_BEGIN(12)
        pg8::Gemm g{(const bf16*)(ws + WS_MERGED), WOUT_T, S_, 2048, 2048, 2048, 2048}; pg8::StaticOrder S; S.init(S_, 2048, F.G, (int)blockIdx.x);
        pg8::Epi<pg8::EM_WOUT> E{ws + WS_H2, nullptr, nullptr, nullptr, in[0], nullptr, 1.f};
        pg8::gemm_phase<pg8::Epi<pg8::EM_WOUT>, pg8::StaticOrder, true, true>(F.lds + RING_OFF, g, S, E, F.wave);
    PHASE_END
    SEAM(12);
    PHASE_BEGIN(13)
        for (int m = gw; m < S_; m += 2 * NGW) rms_row2_to_bf16((const float*)(ws + WS_H2) + (size_t)m * DM, (const float*)(ws + WS_H2) + (size_t)(m + NGW) * DM, in[22], (bf16*)(ws + WS_XN2) + (size_t)m * DM, (bf16*)(ws + WS_XN2) + (size_t)(m + NGW) * DM, lane);
        for (int row = gw; row < 32768; row += NGW) { const int which = row >> 14, r = row & 16383;
            const f32x4* src = (const f32x4*)(in[25 + which] + (size_t)r * 2048) + lane; f32x4 v[8]; float am = 0.f;
#pragma unroll
            for (int j = 0; j < 8; ++j) { v[j] = __builtin_nontemporal_load(src + 64 * j); am = fmaxf(am, fmaxf(fmaxf(fabsf(v[j].x), fabsf(v[j].y)), fmaxf(fabsf(v[j].z), fabsf(v[j].w)))); }
            const unsigned tb = __float_as_uint(am * (1.f / 6.f)); unsigned eb = (tb >> 23) + ((tb & 0x7fffffu) ? 1u : 0u); eb = eb < 1u ? 1u : (eb > 254u ? 254u : eb);
            const float sc = __uint_as_float(eb << 23);
            unsigned wd[4];
#pragma unroll
            for (int w = 0; w < 4; ++w) { unsigned q = 0u;
                q = __builtin_amdgcn_cvt_scalef32_pk_fp4_f32(q, v[2 * w].x, v[2 * w].y, sc, 0); q = __builtin_amdgcn_cvt_scalef32_pk_fp4_f32(q, v[2 * w].z, v[2 * w].w, sc, 1);
                q = __builtin_amdgcn_cvt_scalef32_pk_fp4_f32(q, v[2 * w + 1].x, v[2 * w + 1].y, sc, 2); q = __builtin_amdgcn_cvt_scalef32_pk_fp4_f32(q, v[2 * w + 1].z, v[2 * w + 1].w, sc, 3); wd[w] = q; }
            *(GAS v4u*)(ws + (which ? WS_VTAB : WS_UTAB) + (size_t)r * 1024 + lane * 16) = (v4u){wd[0], wd[1], wd[2], wd[3]};
            ((unsigned char*)(ws + (which ? WS_VSCL : WS_USCL)))[(size_t)r * 64 + lane] = (unsigned char)eb; }
    PHASE_END
    SEAM(13);
    PHASE_BEGIN(14)
        pg8::Gemm g{(const bf16*)(ws + WS_XN2), WS_T, S_, 2048, 2048, 2048, 2048}; pg8::StaticOrder S; S.init(S_, 2048, F.G, (int)blockIdx.x);
        pg8::Epi<pg8::EM_SCORES> E{ws + WS_SCORES, nullptr, nullptr, nullptr, nullptr, nullptr, 1.f};
        pg8::gemm_phase<pg8::Epi<pg8::EM_SCORES>, pg8::StaticOrder, true, true>(F.lds + RING_OFF, g, S, E, F.wave);
    PHASE_END
    SEAM(14);
    PHASE_BEGIN(15)
        const float* SC = (const float*)(ws + WS_SCORES); const bf16* XN2 = (const bf16*)(ws + WS_XN2);
        const unsigned char* UT = (const unsigned char*)(ws + WS_UTAB); const unsigned char* VT = (const unsigned char*)(ws + WS_VTAB);
        const unsigned char* USB = (const unsigned char*)(ws + WS_USCL); const unsigned char* VSB = (const unsigned char*)(ws + WS_VSCL);
        LAS unsigned* lst = (LAS unsigned*)(F.lds + RING_OFF + F.wave * 10240);
        for (int tb = gw; tb < S_ / 8; tb += NGW) {
            { const int tl = lane >> 3, h = lane & 7; const float* srow = SC + (size_t)(tb * 8 + tl) * 2048 + h * 256;
              float A[16], B[16];
#pragma unroll
              for (int p = 0; p < 2; ++p) { float top[16];
#pragma unroll
                  for (int k = 0; k < 16; ++k) top[k] = -INFINITY;
#pragma unroll 2
                  for (int i4 = 0; i4 < 32; ++i4) { const f32x4 v = *(const f32x4*)(srow + p * 128 + i4 * 4); const float ve[4] = {v.x, v.y, v.z, v.w};
#pragma unroll
                      for (int e = 0; e < 4; ++e) { float x = __uint_as_float((__float_as_uint(ve[e]) & 0xffffff80u) | (unsigned)(i4 * 4 + e));
#pragma unroll
                          for (int k = 0; k < 16; ++k) { const float hi = fmaxf(top[k], x); x = fminf(top[k], x); top[k] = hi; } } }
#pragma unroll
                  for (int k = 0; k < 16; ++k) { if (p == 0) A[k] = top[k]; else B[k] = top[k]; } }
              LAS unsigned* ixl = (LAS unsigned*)(F.lds + RING_OFF + F.wave * 10240 + 8192) + lane * 8;
              { unsigned wa[4], wb[4];
#pragma unroll
                for (int q = 0; q < 4; ++q) { wa[q] = 0u; wb[q] = 0u;
#pragma unroll
                    for (int e = 0; e < 4; ++e) { wa[q] |= (__float_as_uint(A[q * 4 + e]) & 127u) << (8 * e); wb[q] |= (__float_as_uint(B[q * 4 + e]) & 127u) << (8 * e); } }
                *(LAS v4u*)ixl = (v4u){wa[0], wa[1], wa[2], wa[3]}; *(LAS v4u*)(ixl + 4) = (v4u){wb[0], wb[1], wb[2], wb[3]}; }
              float cs[16];
#pragma unroll
              for (int k = 0; k < 16; ++k) cs[k] = -INFINITY;
#pragma unroll
              for (int i = 0; i < 16; ++i)
#pragma unroll
                  for (int j = 0; j < 16; ++j) if ((i + 1) * (j + 1) <= 16) {
                      float x = __uint_as_float((__float_as_uint(A[i] + B[j]) & 0xffffff00u) | (unsigned)(i * 16 + j));
#pragma unroll
                      for (int k = 0; k < 16; ++k) { const float hi = fmaxf(cs[k], x); x = fminf(cs[k], x); cs[k] = hi; } }
              LDS_WAIT(); asm volatile("" ::: "memory");
              const LAS unsigned char* ixb = (const LAS unsigned char*)ixl;
              unsigned cx[16]; float gsum = 0.f; const float cmax = cs[0];
#pragma unroll
              for (int k = 0; k < 16; ++k) { const unsigned ij = __float_as_uint(cs[k]) & 255u; cx[k] = ((unsigned)ixb[ij >> 4] << 7) | (unsigned)ixb[16 + (ij & 15u)]; cs[k] = __expf(cs[k] - cmax); gsum += cs[k]; }
              const float ginv = 1.f / gsum; LAS unsigned* lp = lst + (tl * 128 + h * 16) * 2;
#pragma unroll
              for (int k = 0; k < 16; k += 2) *(LAS v4u*)(lp + k * 2) = (v4u){cx[k], __float_as_uint(cs[k] * ginv), cx[k + 1], __float_as_uint(cs[k + 1] * ginv)}; }
            LDS_WAIT(); asm volatile("" ::: "memory");
#pragma unroll 1
            for (int tl = 0; tl < 8; ++tl) { const int t = tb * 8 + tl;
                float xf[32];
#pragma unroll
                for (int j = 0; j < 8; ++j) { const unsigned long long w = *(const GAS unsigned long long*)(XN2 + (size_t)t * 2048 + 256 * j + 4 * lane);
                    xf[4 * j] = pg8::bflo((unsigned)w); xf[4 * j + 1] = pg8::bfhi((unsigned)w); xf[4 * j + 2] = pg8::bflo((unsigned)(w >> 32)); xf[4 * j + 3] = pg8::bfhi((unsigned)(w >> 32)); }
                float acc[32];
#pragma unroll
                for (int e = 0; e < 32; ++e) acc[e] = 0.f;
                constexpr int EG = 8;
#pragma unroll 1
                for (int e0 = 0; e0 < 128; e0 += EG) {
                    v4u ur[EG], vr[EG]; float gate[EG]; unsigned char sub[EG], svb[EG];
#pragma unroll
                    for (int q = 0; q < EG; ++q) { const unsigned idx = __builtin_amdgcn_readfirstlane(lst[(tl * 128 + e0 + q) * 2]); gate[q] = __uint_as_float(__builtin_amdgcn_readfirstlane(lst[(tl * 128 + e0 + q) * 2 + 1]));
                        ur[q] = *(const GAS v4u*)(UT + (size_t)idx * 1024 + lane * 16); vr[q] = *(const GAS v4u*)(VT + (size_t)idx * 1024 + lane * 16);
                        sub[q] = USB[(size_t)idx * 64 + lane]; svb[q] = VSB[(size_t)idx * 64 + lane]; }
#pragma unroll
                    for (int q = 0; q < EG; ++q) { float d0 = 0.f, d1 = 0.f; const float su = __uint_as_float((unsigned)sub[q] << 23), sv = __uint_as_float((unsigned)svb[q] << 23);
                        const unsigned uw[4] = {ur[q].x, ur[q].y, ur[q].z, ur[q].w};
#pragma unroll
                        for (int w = 0; w < 4; ++w) {
                            const auto p0 = __builtin_amdgcn_cvt_scalef32_pk_f32_fp4(uw[w], su, 0), p1 = __builtin_amdgcn_cvt_scalef32_pk_f32_fp4(uw[w], su, 1), p2 = __builtin_amdgcn_cvt_scalef32_pk_f32_fp4(uw[w], su, 2), p3 = __builtin_amdgcn_cvt_scalef32_pk_f32_fp4(uw[w], su, 3);
                            d0 = fmaf(xf[8 * w], p0[0], d0); d1 = fmaf(xf[8 * w + 1], p0[1], d1); d0 = fmaf(xf[8 * w + 2], p1[0], d0); d1 = fmaf(xf[8 * w + 3], p1[1], d1);
                            d0 = fmaf(xf[8 * w + 4], p2[0], d0); d1 = fmaf(xf[8 * w + 5], p2[1], d1); d0 = fmaf(xf[8 * w + 6], p3[0], d0); d1 = fmaf(xf[8 * w + 7], p3[1], d1); }
                        const float d = wsum(d0 + d1);
                        const float act = 0.5f * d * (1.f + erff(d * 0.70710678118f)); const float cf = gate[q] * act; const float cs = cf * sv;
                        const unsigned vw[4] = {vr[q].x, vr[q].y, vr[q].z, vr[q].w};
#pragma unroll
                        for (int w = 0; w < 4; ++w) {
                            const auto p0 = __builtin_amdgcn_cvt_scalef32_pk_f32_fp4(vw[w], 1.0f, 0), p1 = __builtin_amdgcn_cvt_scalef32_pk_f32_fp4(vw[w], 1.0f, 1), p2 = __builtin_amdgcn_cvt_scalef32_pk_f32_fp4(vw[w], 1.0f, 2), p3 = __builtin_amdgcn_cvt_scalef32_pk_f32_fp4(vw[w], 1.0f, 3);
                            acc[8 * w] = fmaf(cs, p0[0], acc[8 * w]); acc[8 * w + 1] = fmaf(cs, p0[1], acc[8 * w + 1]); acc[8 * w + 2] = fmaf(cs, p1[0], acc[8 * w + 2]); acc[8 * w + 3] = fmaf(cs, p1[1], acc[8 * w + 3]);
                            acc[8 * w + 4] = fmaf(cs, p2[0], acc[8 * w + 4]); acc[8 * w + 5] = fmaf(cs, p2[1], acc[8 * w + 5]); acc[8 * w + 6] = fmaf(cs, p3[0], acc[8 * w + 6]); acc[8 * w + 7] = fmaf(cs, p3[1], acc[8 * w + 7]); }
                    }
                }
                float* orow = args.out + (size_t)t * 2048; const float* hrow = (const float*)(ws + WS_H2) + (size_t)t * 2048; float ss = 0.f;
#pragma unroll
                for (int j = 0; j < 8; ++j) { const f32x4 a = *(const f32x4*)(hrow + 256 * j + 4 * lane);
                    acc[4 * j] += a.x; acc[4 * j + 1] += a.y; acc[4 * j + 2] += a.z; acc[4 * j + 3] += a.w; }
#pragma unroll
                for (int e = 0; e < 32; ++e) ss += acc[e] * acc[e];
                const float rstd = rsqrtf(wsum(ss) * (1.f / 2048.f) + 1e-6f);
#pragma unroll
                for (int j = 0; j < 8; ++j) { const f32x4 g0 = *(const f32x4*)(in[27] + 256 * j + 4 * lane);
                    *(f32x4*)(orow + 256 * j + 4 * lane) = (f32x4){acc[4 * j] * rstd * g0.x, acc[4 * j + 1] * rstd * g0.y, acc[4 * j + 2] * rstd * g0.z, acc[4 * j + 3] * rstd * g0.w}; }
            }
            LDS_WAIT(); asm volatile("" ::: "memory");
        }
    PHASE_END
#undef IN
#undef SEAM
}

extern "C" void kernel_launch(void* const* d_in, const int* in_sizes, int n_in, void* d_out, int out_size, void* d_ws, size_t ws_size, hipStream_t stream) {
    static int grid = 0;
    if (grid == 0) {
        if (n_in != 28 || in_sizes[0] != S_ * DM || out_size != S_ * DM || ws_size < WS_END) { fprintf(stderr, "kernel_launch: unexpected shapes: n_in %d in0 %d out %d ws %zu (need >= %zu)\n", n_in, n_in > 0 ? in_sizes[0] : -1, out_size, ws_size, (size_t)WS_END); grid = -1; return; }
        if (hipFuncSetAttribute((const void*)mk_fwd, hipFuncAttributeMaxDynamicSharedMemorySize, LDS_BYTES) != hipSuccess) { fprintf(stderr, "kernel_launch: hipFuncSetAttribute failed\n"); grid = -1; return; }
        int per_cu = 0;
        if (hipOccupancyMaxActiveBlocksPerMultiprocessor(&per_cu, (const void*)mk_fwd, NWAVES * 64, LDS_BYTES) != hipSuccess || per_cu < 1) fprintf(stderr, "kernel_launch: note: occupancy query reports %d\n", per_cu);
        (void)hipGetLastError();
        grid = 256;
    }
    if (grid < 0) return;
    (void)hipMemsetAsync((char*)d_ws + WS_CTL, 0, CTL_ZERO_BYTES, stream);
    Args a{};
    for (int i = 0; i < 28; ++i) a.in[i] = (const float*)d_in[i];
    a.out = (float*)d_out; a.ws = (unsigned char*)d_ws;
#if MK_PER_PHASE
    for (int p = 0; p < NPH; ++p) { a.ph_lo = p; a.ph_hi = p + 1; hipLaunchKernelGGL(mk_fwd, dim3(grid), dim3(NWAVES * 64), LDS_BYTES, stream, a); }
#else
    a.ph_lo = 0; a.ph_hi = NPH; hipLaunchKernelGGL(mk_fwd, dim3(grid), dim3(NWAVES * 64), LDS_BYTES, stream, a);
#endif
    const hipError_t le = hipPeekAtLastError();
    if (le != hipSuccess) fprintf(stderr, "kernel_launch: launch failed: %s\n", hipGetErrorName(le));
}
```

```cpp
#include <hip/hip_runtime.h>
#include <cstdio>
#include <cstdint>
__device__ __forceinline__ int mk_lane_id() { int l; asm volatile("v_mbcnt_lo_u32_b32 %0, -1, 0\n\tv_mbcnt_hi_u32_b32 %0, -1, %0" : "=v"(l)); return l; }
namespace pg8 {
#define PG8_LAS __attribute__((address_space(3)))
typedef unsigned short bf16_t;
typedef short bf16x8 __attribute__((ext_vector_type(8)));
typedef float f32x4 __attribute__((ext_vector_type(4)));
typedef unsigned u32x4 __attribute__((ext_vector_type(4)));
constexpr int BM = 256, BK = 64, HALF = 128, HTB = HALF * BK * 2  , STAGE_BYTES = 8 * HTB, NXCD = 8, WGM = 8;

__host__ __device__ __forceinline__ int lds_byte(int r, int c) { const int st = (r >> 4) * 2 + (c >> 5), rr = r & 15, cc = c & 31, ob = rr * 64 + cc * 2; return st * 1024 + (ob ^ (((ob >> 9) & 1) << 5)); }
__host__ __device__ __forceinline__ void stage_rc(int b, int& R, int& C) { const int st = b / 1024, sb = b % 1024, swz = sb ^ (((sb >> 9) & 1) << 5); R = (st >> 1) * 16 + swz / 64; C = (st & 1) * 32 + (swz % 64) / 2; }
__host__ __device__ __forceinline__ int perm32(int rho) { const int n = rho >> 4, i = rho & 15; return 8 * (i >> 2) + 4 * n + (i & 3); }

struct Unit { int pm, pn; };
struct Gemm { const bf16_t* A; const bf16_t* Bt; int M, N, K, lda, ldb; };

struct StaticOrder {
    int nM, nN, nwg, G, c;
    __host__ __device__ void init(int M, int N, int G_, int c_) { nM = M / BM; nN = N / BM; nwg = nM * nN; G = G_; c = c_; }
    __host__ __device__ bool next(int i, Unit& u) const {
        const long L = (long)i * G + c; if (L >= nwg) return false;
        int wgid = (int)L; { const int q = nwg / NXCD, r = nwg % NXCD, xcd = wgid % NXCD, off = wgid / NXCD; wgid = (xcd < r ? xcd * (q + 1) : r * (q + 1) + (xcd - r) * q) + off; }
        const int nig = WGM * nN, gid = wgid / nig, fm = gid * WGM, gsz = (nM - fm) < WGM ? (nM - fm) : WGM;
        u.pm = fm + ((wgid % nig) % gsz); u.pn = (wgid % nig) / gsz; return true;
    }
    __device__ __forceinline__ void a_ready(const Unit&) const {}
    __device__ __forceinline__ void done(const Unit&) const {}
};

__device__ __forceinline__ unsigned cvt_pk_bf16(float lo, float hi) { unsigned r; asm volatile("v_cvt_pk_bf16_f32 %0, %1, %2" : "=v"(r) : "v"(lo), "v"(hi)); return r; }
__device__ __forceinline__ float sigm(float x) { return __builtin_amdgcn_rcpf(1.0f + __expf(-x)); }
__device__ __forceinline__ float bflo(unsigned w) { return __uint_as_float(w << 16); }
__device__ __forceinline__ float bfhi(unsigned w) { return __uint_as_float(w & 0xffff0000u); }
enum { EM_G1 = 0, EM_LORA_W = 1, EM_LORA_A = 2, EM_LORA_G = 3, EM_PROJA = 4, EM_PROJB = 5, EM_WOUT = 6, EM_SCORES = 7 };
template <int MODE> struct Epi {
    static constexpr bool PERM = true, AFTER_DRAIN = false;
    void* o0; void* o1; void* o2; const void* i0; const void* i1; const float* vec; float sc;
    __device__ __forceinline__ void operator()(const f32x4 (&acc)[2][2][4][2], const Unit& u, int wr, int wc, int fr, int fq) const {
        asm volatile("" ::: "memory");
        const int row0 = u.pm * BM + wr * 64 + fr;
        int colt = u.pn * BM; int ldc = 2048; int sub = 0;
        bf16_t* ob = (bf16_t*)o0; float scl = 1.f;
        if (MODE == EM_G1) {
            if (u.pn < 14) { ldc = 3584; }
            else if (u.pn < 26) { ob = (bf16_t*)o1; ldc = 3072; colt -= 14 * BM; if (u.pn < 18) scl = sc; }
            else { ob = (bf16_t*)o2; ldc = 4096; colt -= 26 * BM; sub = 1; }
        }
        if (MODE == EM_LORA_W || MODE == EM_LORA_A || MODE == EM_LORA_G) ldc = 1024;
        const int col0 = colt + wc * 32 + 8 * fq;
#pragma unroll
        for (int ai = 0; ai < 2; ++ai)
#pragma unroll
            for (int m = 0; m < 4; ++m) { const size_t row = (size_t)(row0 + ai * HALF + m * 16);
#pragma unroll
                for (int bj = 0; bj < 2; ++bj) { f32x4 v0 = acc[ai][bj][m][0], v1 = acc[ai][bj][m][1]; const int col = col0 + bj * HALF;
                    if (MODE == EM_G1) {
                        if (sub) { v0 = (f32x4){sigm(v0[0]), sigm(v0[1]), sigm(v0[2]), sigm(v0[3])}; v1 = (f32x4){sigm(v1[0]), sigm(v1[1]), sigm(v1[2]), sigm(v1[3])}; }
                        else { v0 = v0 * scl; v1 = v1 * scl; }
                        u32x4 w; w.x = cvt_pk_bf16(v0[0], v0[1]); w.y = cvt_pk_bf16(v0[2], v0[3]); w.z = cvt_pk_bf16(v1[0], v1[1]); w.w = cvt_pk_bf16(v1[2], v1[3]);
                        *(u32x4*)(ob + row * ldc + col) = w;
                    } else if (MODE == EM_LORA_W) {
                        if (vec) { const f32x4 b0 = *(const f32x4*)(vec + col), b1 = *(const f32x4*)(vec + col + 4);
                            v0 = v0 + b0; v1 = v1 + b1;
                            v0 = (f32x4){sigm(v0[0]), sigm(v0[1]), sigm(v0[2]), sigm(v0[3])}; v1 = (f32x4){sigm(v1[0]), sigm(v1[1]), sigm(v1[2]), sigm(v1[3])};
                            v0 = v0 * sc; v1 = v1 * sc; }
                        u32x4 w; w.x = cvt_pk_bf16(v0[0], v0[1]); w.y = cvt_pk_bf16(v0[2], v0[3]); w.z = cvt_pk_bf16(v1[0], v1[1]); w.w = cvt_pk_bf16(v1[2], v1[3]);
                        *(u32x4*)(ob + row * ldc + col) = w;
                    } else if (MODE == EM_PROJA) {
                        const u32x4 g = *(const u32x4*)((const bf16_t*)i0 + row * 4096 + col);
                        float* op = (float*)o0 + row * 2048 + col;
                        *(f32x4*)op = (f32x4){v0[0] * bflo(g.x), v0[1] * bfhi(g.x), v0[2] * bflo(g.y), v0[3] * bfhi(g.y)};
                        *(f32x4*)(op + 4) = (f32x4){v1[0] * bflo(g.z), v1[1] * bfhi(g.z), v1[2] * bflo(g.w), v1[3] * bfhi(g.w)};
                    } else if (MODE == EM_PROJB) {
                        const u32x4 g = *(const u32x4*)((const bf16_t*)i0 + row * 4096 + 2048 + col);
                        const float* tp = (const float*)i1 + row * 2048 + col; const f32x4 t0 = *(const f32x4*)tp, t1 = *(const f32x4*)(tp + 4);
                        v0 = (f32x4){t0[0] + v0[0] * bflo(g.x), t0[1] + v0[1] * bfhi(g.x), t0[2] + v0[2] * bflo(g.y), t0[3] + v0[3] * bfhi(g.y)};
                        v1 = (f32x4){t1[0] + v1[0] * bflo(g.z), t1[1] + v1[1] * bfhi(g.z), t1[2] + v1[2] * bflo(g.w), t1[3] + v1[3] * bfhi(g.w)};
                        u32x4 w; w.x = cvt_pk_bf16(v0[0], v0[1]); w.y = cvt_pk_bf16(v0[2], v0[3]); w.z = cvt_pk_bf16(v1[0], v1[1]); w.w = cvt_pk_bf16(v1[2], v1[3]);
                        *(u32x4*)(ob + row * 2048 + col) = w;
                    } else if (MODE == EM_WOUT) {
                        const float* xp = (const float*)i1 + row * 2048 + col; const f32x4 t0 = *(const f32x4*)xp, t1 = *(const f32x4*)(xp + 4);
                        float* op = (float*)o0 + row * 2048 + col; *(f32x4*)op = t0 + v0; *(f32x4*)(op + 4) = t1 + v1;
                    } else {
                        float* op = (float*)o0 + row * 2048 + col; *(f32x4*)op = v0; *(f32x4*)(op + 4) = v1;
                    }
                } }
    }
};

template <class Epi, class Sched, bool ALIGN_EPI = false, bool SP2 = false>
__device__ __forceinline__ void gemm_phase(PG8_LAS unsigned char* lds, const Gemm g, const Sched& S, const Epi& E, const int wid_in) {
    int tid_ = wid_in * 64 + mk_lane_id(); asm volatile("" : "+v"(tid_)); const int tid = tid_, wid = __builtin_amdgcn_readfirstlane(tid >> 6), lane = tid & 63, wr = wid >> 2, wc = wid & 3, fr = lane & 15, fq = lane >> 4;
    const int K = g.K, nt = K / BK;
    unsigned voffA[2], voffB[2];
#pragma unroll
    for (int i = 0; i < 2; ++i) { int R, C; stage_rc(tid * 16 + i * 8192, R, C); const int Rb = Epi::PERM ? ((R & ~31) + perm32(R & 31)) : R;
        voffA[i] = (unsigned)(R * g.lda + C) * 2u; voffB[i] = (unsigned)(Rb * g.ldb + C) * 2u; }
    const size_t kstep = (size_t)(BK * 2);
    const size_t hstepA = (size_t)HALF * g.lda * 2, hstepB = (size_t)HALF * g.ldb * 2;
    const size_t tstepA = 2 * hstepA, tstepB = 2 * hstepB;
    const unsigned ldsw = (unsigned)wid * 1024u;
    const int aoff = lds_byte(wr * 64 + fr, fq * 8), boff = lds_byte(wc * 32 + fr, fq * 8);
#define PG8_SA(b, h) (((b) * 2 + (h)) * HTB)
#define PG8_SB(b, h) ((4 + (b) * 2 + (h)) * HTB)
#define PG8_STAGE(bufoff, gbase, voff) do { _Pragma("unroll") for (int _i = 0; _i < 2; ++_i) \
        __builtin_amdgcn_global_load_lds((const unsigned*)((const char*)(gbase) + (voff)[_i]), (PG8_LAS unsigned*)(lds + (bufoff) + ldsw + _i * 8192), 16, 0, 0); } while (0)
#define PG8_LDA(dst, b, h) do { _Pragma("unroll") for (int m = 0; m < 4; ++m) _Pragma("unroll") for (int k = 0; k < 2; ++k) dst[m][k] = *(const PG8_LAS bf16x8*)(lds + PG8_SA(b, h) + aoff + m * 2048 + k * 1024); } while (0)
#define PG8_LDB(dst, b, h) do { _Pragma("unroll") for (int n = 0; n < 2; ++n) _Pragma("unroll") for (int k = 0; k < 2; ++k) dst[n][k] = *(const PG8_LAS bf16x8*)(lds + PG8_SB(b, h) + boff + n * 2048 + k * 1024); } while (0)
#define PG8_MMA(ai, bj, At, Bt) do { __builtin_amdgcn_s_setprio(1); _Pragma("unroll") for (int m = 0; m < 4; ++m) _Pragma("unroll") for (int n = 0; n < 2; ++n) _Pragma("unroll") for (int k = 0; k < 2; ++k) \
        acc[ai][bj][m][n] = __builtin_amdgcn_mfma_f32_16x16x32_bf16(Bt[n][k], At[m][k], acc[ai][bj][m][n], 0, 0, 0); __builtin_amdgcn_s_setprio(0); } while (0)
#define PG8_WAIT_V(n) asm volatile("s_waitcnt vmcnt(" #n ")" ::: "memory")
#define PG8_WAIT_L(n) asm volatile("s_waitcnt lgkmcnt(" #n ")" ::: "memory")
#define PG8_BAR __builtin_amdgcn_s_barrier()
#define PG8_SCHED __builtin_amdgcn_sched_barrier(0)
    Unit cur, nxt; int ui = 0;
    if (!S.next(0, cur)) return;
    f32x4 acc[2][2][4][2];
#pragma unroll
    for (int a = 0; a < 2; ++a)
#pragma unroll
        for (int b = 0; b < 2; ++b)
#pragma unroll
            for (int m = 0; m < 4; ++m)
#pragma unroll
                for (int n = 0; n < 2; ++n) acc[a][b][m][n] = (f32x4){0.f, 0.f, 0.f, 0.f};
    bf16x8 At[4][2], B0[2][2], B1[2][2];
    const char* cA = (const char*)g.A + (size_t)cur.pm * tstepA; const char* cB = (const char*)g.Bt + (size_t)cur.pn * tstepB;
    S.a_ready(cur);
    if constexpr (SP2) {
        PG8_STAGE(PG8_SB(0, 0), cB, voffB); PG8_STAGE(PG8_SB(0, 1), cB + hstepB, voffB); PG8_STAGE(PG8_SA(0, 0), cA, voffA); PG8_STAGE(PG8_SA(0, 1), cA + hstepA, voffA);
        if (wr == 1) PG8_BAR;
        PG8_WAIT_V(2); PG8_BAR;
        PG8_STAGE(PG8_SB(1, 0), cB + kstep, voffB); PG8_STAGE(PG8_SA(1, 0), cA + kstep, voffA); PG8_STAGE(PG8_SB(1, 1), cB + hstepB + kstep, voffB);
        PG8_WAIT_V(6); PG8_BAR;
    } else {
        PG8_STAGE(PG8_SB(0, 0), cB, voffB); PG8_STAGE(PG8_SA(0, 0), cA, voffA); PG8_STAGE(PG8_SB(0, 1), cB + hstepB, voffB); PG8_STAGE(PG8_SA(0, 1), cA + hstepA, voffA);
        if (wr == 1) PG8_BAR;
        PG8_WAIT_V(4); PG8_BAR;
        PG8_STAGE(PG8_SB(1, 0), cB + kstep, voffB); PG8_STAGE(PG8_SA(1, 0), cA + kstep, voffA); PG8_STAGE(PG8_SB(1, 1), cB + hstepB + kstep, voffB);
        PG8_WAIT_V(6); PG8_BAR;
    }
    for (;;) {
        const bool has_next = S.next(ui + 1, nxt);
        const char* nA = has_next ? (const char*)g.A + (size_t)nxt.pm * tstepA : cA; const char* nB = has_next ? (const char*)g.Bt + (size_t)nxt.pn * tstepB : cB;
        for (int t = 0; t < nt; t += 2) {
            const bool last = (t == nt - 2);
            const char* a1 = cA + (size_t)(t + 1) * kstep;
            const char* a2 = last ? nA : cA + (size_t)(t + 2) * kstep; const char* b2 = last ? nB : cB + (size_t)(t + 2) * kstep;
            const char* a3 = a2 + kstep; const char* b3 = b2 + kstep;
            if (last && has_next) S.a_ready(nxt);
            if constexpr (SP2) {
            PG8_LDB(B0, 0, 0); PG8_LDB(B1, 0, 1); PG8_SCHED; PG8_LDA(At, 0, 0); PG8_STAGE(PG8_SA(1, 1), a1 + hstepA, voffA);
            PG8_WAIT_V(8); PG8_WAIT_L(0); PG8_BAR; PG8_MMA(0, 0, At, B0); PG8_MMA(0, 1, At, B1); PG8_BAR; PG8_SCHED;
            PG8_LDA(At, 0, 1); PG8_STAGE(PG8_SB(0, 0), b2, voffB); PG8_STAGE(PG8_SB(0, 1), b2 + hstepB, voffB); PG8_STAGE(PG8_SA(0, 0), a2, voffA);
            PG8_WAIT_V(8); PG8_WAIT_L(0); PG8_BAR; PG8_MMA(1, 0, At, B0); PG8_MMA(1, 1, At, B1); PG8_BAR; PG8_SCHED;
            PG8_LDB(B0, 1, 0); PG8_LDB(B1, 1, 1); PG8_SCHED; PG8_LDA(At, 1, 0); PG8_STAGE(PG8_SA(0, 1), a2 + hstepA, voffA);
            PG8_WAIT_V(8); PG8_WAIT_L(0); PG8_BAR; PG8_MMA(0, 0, At, B0); PG8_MMA(0, 1, At, B1); PG8_BAR; PG8_SCHED;
            PG8_LDA(At, 1, 1); PG8_STAGE(PG8_SB(1, 0), b3, voffB); PG8_STAGE(PG8_SB(1, 1), b3 + hstepB, voffB); PG8_STAGE(PG8_SA(1, 0), a3, voffA);
            PG8_WAIT_V(8); PG8_WAIT_L(0); PG8_BAR; PG8_MMA(1, 0, At, B0); PG8_MMA(1, 1, At, B1); PG8_BAR; PG8_SCHED;
            } else {
            PG8_LDB(B0, 0, 0); PG8_SCHED; PG8_LDA(At, 0, 0); PG8_STAGE(PG8_SA(1, 1), a1 + hstepA, voffA);
            PG8_WAIT_L(8); PG8_BAR; PG8_WAIT_L(0); PG8_MMA(0, 0, At, B0); PG8_BAR; PG8_SCHED;
            PG8_LDB(B1, 0, 1); PG8_STAGE(PG8_SB(0, 0), b2, voffB);
            PG8_BAR; PG8_WAIT_L(0); PG8_MMA(0, 1, At, B1); PG8_BAR;
            PG8_LDA(At, 0, 1); PG8_STAGE(PG8_SA(0, 0), a2, voffA);
            PG8_BAR; PG8_WAIT_L(0); PG8_MMA(1, 0, At, B0); PG8_BAR; PG8_SCHED;
            PG8_STAGE(PG8_SB(0, 1), b2 + hstepB, voffB);
            PG8_WAIT_V(6); PG8_BAR; PG8_MMA(1, 1, At, B1); PG8_BAR;
            PG8_LDB(B0, 1, 0); PG8_SCHED; PG8_LDA(At, 1, 0); PG8_STAGE(PG8_SA(0, 1), a2 + hstepA, voffA);
            PG8_WAIT_L(8); PG8_BAR; PG8_WAIT_L(0); PG8_MMA(0, 0, At, B0); PG8_BAR; PG8_SCHED;
            PG8_LDB(B1, 1, 1); PG8_STAGE(PG8_SB(1, 0), b3, voffB);
            PG8_BAR; PG8_WAIT_L(0); PG8_MMA(0, 1, At, B1); PG8_BAR;
            PG8_LDA(At, 1, 1); PG8_STAGE(PG8_SA(1, 0), a3, voffA);
            PG8_BAR; PG8_WAIT_L(0); PG8_MMA(1, 0, At, B0); PG8_BAR; PG8_SCHED;
            PG8_STAGE(PG8_SB(1, 1), b3 + hstepB, voffB);
            PG8_WAIT_V(6); PG8_BAR; PG8_MMA(1, 1, At, B1); PG8_BAR;
            }
        }
        if constexpr (ALIGN_EPI) { if (wr == 0) PG8_BAR; }
        if constexpr (!Epi::AFTER_DRAIN) { E(acc, cur, wr, wc, fr, fq); S.done(cur); }
        if (!has_next) break;
#pragma unroll
        for (int a = 0; a < 2; ++a)
#pragma unroll
            for (int b = 0; b < 2; ++b)
#pragma unroll
                for (int m = 0; m < 4; ++m)
#pragma unroll
                    for (int n = 0; n < 2; ++n) acc[a][b][m][n] = (f32x4){0.f, 0.f, 0.f, 0.f};
        cur = nxt; cA = nA; cB = nB; ++ui;
        if constexpr (ALIGN_EPI) { if (wr == 1) PG8_BAR; }
    }
    PG8_WAIT_V(0);
    if constexpr (!ALIGN_EPI) { if (wr == 0) PG8_BAR; }
    PG8_BAR;
    if constexpr (Epi::AFTER_DRAIN) { E.fused(acc, cur, wr, wc, fr, fq, lds, wid, lane); S.done(cur); }
#undef PG8_SA
#undef PG8_SB
#undef PG8_STAGE
#undef PG8_LDA
#undef PG8_LDB
#undef PG8_MMA
#undef PG8_WAIT_V
#undef PG8_WAIT_L
#undef PG8_BAR
#undef PG8_SCHED
}
}
#include <hip/hip_bf16.h>
#include <cmath>
namespace attn_body {
using bf16=__hip_bfloat16;
using bf16x8=__attribute__((ext_vector_type(8)))short;
using s16x4=__attribute__((ext_vector_type(4)))short;
using f32x16=__attribute__((ext_vector_type(16)))float;
using u32x4=__attribute__((ext_vector_type(4)))unsigned;
constexpr int SEQ=16384,D=64,PQ=3072,PO=2048;
constexpr int NW=8,QBLK=32,QB=QBLK*NW,KVBLK=64,NQB=SEQ/QB;
constexpr int ATTN_UNIT_ROWS=QB;
__device__ __forceinline__ int crow(int r,int hi){return (r&3)+8*(r>>2)+4*hi;}
#define SBAR() __builtin_amdgcn_sched_barrier(0)
__device__ __forceinline__ void cmask(f32x16&p0,f32x16&p1,int jb,int qrel,int hi){
  const float NEG=-INFINITY; int kb=64*jb+4*hi;
  #pragma unroll
  for(int r=0;r<16;++r){int kv=kb+(r&3)+8*(r>>2); if(kv>qrel)p0[r]=NEG; if(kv+32>qrel)p1[r]=NEG;}
}

constexpr int NSLOT=3, SLOTB=8192, VSLOTB=16384;
constexpr int LDS_K=0, LDS_V=NSLOT*SLOTB, LDS_WS=LDS_V+NSLOT*VSLOTB, LDS_OST=0  , LDS_BYTES=LDS_WS+NW*64*4;
constexpr float C2=0.125f*1.4426950408889634f;
__device__ __forceinline__ void glds16(const void*gsrc,unsigned lds_dst){unsigned keep;
  asm volatile("s_mov_b32 %0, m0\n\ts_mov_b32 m0, %2\n\ts_nop 0\n\tglobal_load_lds_dwordx4 %1, off\n\ts_mov_b32 m0, %0":"=&s"(keep):"v"(gsrc),"s"(lds_dst):"memory");}
__device__ __forceinline__ float max3f(float a,float b,float c){float r;asm("v_max3_f32 %0, %1, %2, %3":"=v"(r):"v"(a),"v"(b),"v"(c));return r;}
__device__ __forceinline__ float max2f(float a,float b){float r;asm("v_max_f32_e32 %0, %1, %2":"=v"(r):"v"(a),"v"(b));return r;}
__device__ __forceinline__ float fadd_s(float a,float b){float r;asm("v_add_f32_e32 %0, %1, %2":"=v"(r):"v"(a),"v"(b));return r;}
__device__ __forceinline__ float fsub_s(float a,float b){float r;asm("v_sub_f32_e32 %0, %1, %2":"=v"(r):"v"(a),"v"(b));return r;}
typedef float f32x2_t __attribute__((ext_vector_type(2))); typedef __bf16 bf16x2_t __attribute__((ext_vector_type(2)));
__device__ __forceinline__ unsigned cvtpk_s(float lo,float hi){f32x2_t v={lo,hi};bf16x2_t b=__builtin_convertvector(v,bf16x2_t);return __builtin_bit_cast(unsigned,b);}
#define WAIT_BAR(N) asm volatile("s_waitcnt vmcnt(" #N ") lgkmcnt(0)\n\ts_barrier":::"memory")

__device__ __forceinline__ void qkt(f32x16&p0,f32x16&p1,const char*Kslot,const bf16x8*qr,const f32x16&negm,int r32,int hi){
  const char*kb=Kslot+hi*1024+r32*16;
  #pragma unroll
  for(int d0=0;d0<4;++d0){
    const bf16x8 b0=*reinterpret_cast<const bf16x8*>(kb+d0*2048);
    const bf16x8 b1=*reinterpret_cast<const bf16x8*>(kb+d0*2048+512);
    if(d0==0){p0=__builtin_amdgcn_mfma_f32_32x32x16_bf16(b0,qr[0],f32x16{},0,0,0);p1=__builtin_amdgcn_mfma_f32_32x32x16_bf16(b1,qr[0],f32x16{},0,0,0);}
    else{p0=__builtin_amdgcn_mfma_f32_32x32x16_bf16(b0,qr[d0],p0,0,0,0);p1=__builtin_amdgcn_mfma_f32_32x32x16_bf16(b1,qr[d0],p1,0,0,0);}}
}
typedef __attribute__((address_space(3))) const char* lds_cptr;
typedef short v4i16_t __attribute__((ext_vector_type(4)));
__device__ __forceinline__ void kload8(bf16x8*kf,lds_cptr kp){
  kf[0]=*(const __attribute__((address_space(3))) bf16x8*)(kp);      kf[1]=*(const __attribute__((address_space(3))) bf16x8*)(kp+512);
  kf[2]=*(const __attribute__((address_space(3))) bf16x8*)(kp+2048); kf[3]=*(const __attribute__((address_space(3))) bf16x8*)(kp+2560);
  kf[4]=*(const __attribute__((address_space(3))) bf16x8*)(kp+4096); kf[5]=*(const __attribute__((address_space(3))) bf16x8*)(kp+4608);
  kf[6]=*(const __attribute__((address_space(3))) bf16x8*)(kp+6144); kf[7]=*(const __attribute__((address_space(3))) bf16x8*)(kp+6656);
}
__device__ __forceinline__ void kload2(bf16x8*kf,lds_cptr kp,int j){ kf[2*j]=*(const __attribute__((address_space(3))) bf16x8*)(kp+j*2048); kf[2*j+1]=*(const __attribute__((address_space(3))) bf16x8*)(kp+j*2048+512); }
__device__ __forceinline__ s16x4 vtr(lds_cptr p){ return __builtin_bit_cast(s16x4,__builtin_amdgcn_ds_read_tr16_b64_v4i16((__attribute__((address_space(3))) v4i16_t*)p)); }
__device__ __forceinline__ float rowmax(const f32x16&p0,const f32x16&p1){
  float a=max3f(p0[0],p0[1],p1[0]),b=max3f(p0[2],p0[3],p1[1]);a=max3f(a,p1[2],p1[3]);
  #pragma unroll
  for(int r=4;r<16;r+=4){a=max3f(a,p0[r],p0[r+1]);b=max3f(b,p0[r+2],p0[r+3]);a=max3f(a,p1[r],p1[r+1]);b=max3f(b,p1[r+2],p1[r+3]);}
  const float m=max2f(a,b);
  auto rr=__builtin_amdgcn_permlane32_swap(__float_as_uint(m),__float_as_uint(m),false,false);
  return max2f(__uint_as_float(rr[0]),__uint_as_float(rr[1]));
}
__device__ __forceinline__ void pv(f32x16*o,int vb,bf16x8 pa0,bf16x8 pa1,bf16x8 pa2,bf16x8 pa3){
  #pragma unroll
  for(int d0=0;d0<4;++d0){s16x4 lo[4],hi[4];
    #pragma unroll
    for(int ks=0;ks<4;++ks){
      asm volatile("ds_read_b64_tr_b16 %0,%1 offset:%c2":"=&v"(lo[ks]):"v"(vb),"i"(d0*4096+ks*1024):"memory");
      asm volatile("ds_read_b64_tr_b16 %0,%1 offset:%c2":"=&v"(hi[ks]):"v"(vb),"i"(d0*4096+ks*1024+512):"memory");}
    asm volatile("s_waitcnt lgkmcnt(0)":::"memory");SBAR();
    #define PK(k) (bf16x8){lo[k][0],lo[k][1],lo[k][2],lo[k][3],hi[k][0],hi[k][1],hi[k][2],hi[k][3]}
    o[d0]=__builtin_amdgcn_mfma_f32_32x32x16_bf16(pa0,PK(0),o[d0],0,0,0);
    o[d0]=__builtin_amdgcn_mfma_f32_32x32x16_bf16(pa1,PK(1),o[d0],0,0,0);
    o[d0]=__builtin_amdgcn_mfma_f32_32x32x16_bf16(pa2,PK(2),o[d0],0,0,0);
    o[d0]=__builtin_amdgcn_mfma_f32_32x32x16_bf16(pa3,PK(3),o[d0],0,0,0);
    #undef PK
  }
}

#ifndef ATTN_STORE16
#define ATTN_STORE16(p,v) (*(u32x4*)(p)=(v))
#endif
template<int THRL> __device__ __forceinline__ void attn_unit(const int wid_in,int qb,const bf16*Q,const bf16*__restrict__ K,const bf16*__restrict__ V,bf16*O,char*shm){
  int tid_=wid_in*64+mk_lane_id(); asm volatile("":"+v"(tid_)); const int tid=tid_,lane=tid&63,r32=lane&31,hi=lane>>5; const int wid=__builtin_amdgcn_readfirstlane(tid>>6);
  const int q0=qb*QB;
  const bf16*Qw=Q+(long)(q0+wid*QBLK)*PQ;
  const bf16*Kh=K,*Vh=V;
  const unsigned lds0=(unsigned)(uintptr_t)shm;
  float*wsf=(float*)(shm+LDS_WS)+wid*64;
  const bf16*ksrc=Kh+(long)lane*PQ+wid*8;
  const bf16*vsrc=Vh+(long)(16*(wid&3)+(lane>>2))*PQ+(wid>>2)*32+(lane&3)*8;
  const unsigned kdst=lds0+LDS_K+wid*1024, vdst=lds0+LDS_V+wid*1024;
  #define DMA_K(t,slot) glds16(ksrc+(long)(t)*KVBLK*PQ,(unsigned)__builtin_amdgcn_readfirstlane(kdst+(slot)))
  #define DMA_V(t,slot) do{ glds16(vsrc+(long)(t)*KVBLK*PQ,(unsigned)__builtin_amdgcn_readfirstlane(vdst+2*(slot))); glds16(vsrc+64+(long)(t)*KVBLK*PQ,(unsigned)__builtin_amdgcn_readfirstlane(vdst+8192+2*(slot))); }while(0)
  const int vb0=(int)(lds0+LDS_V)+((lane>>4)&1)*32+(lane&3)*8+(4*hi+((lane&15)>>2))*64;
  const char*Kbase=shm+LDS_K; bf16x8 kf[8];
  const lds_cptr shm3=(lds_cptr)shm; const lds_cptr kp0=shm3+LDS_K+hi*1024+r32*16; const lds_cptr vp0=shm3+LDS_V+((lane>>4)&1)*32+(lane&3)*8+(4*hi+((lane&15)>>2))*64;
  const int NT=(q0+QB)/KVBLK;
  DMA_K(0,0);DMA_V(0,0);DMA_K(1,SLOTB);
  bf16x8 qr[4];
  #pragma unroll
  for(int d0=0;d0<4;++d0)qr[d0]=*reinterpret_cast<const bf16x8*>(&Qw[(long)r32*PQ+d0*16+hi*8]);
  float mhat=0.f,l_reg=0.f;f32x16 o[4];o[0]=f32x16{};o[1]=f32x16{};o[2]=f32x16{};o[3]=f32x16{};asm volatile("":"+v"(o[0]));asm volatile("":"+v"(o[1]));asm volatile("":"+v"(o[2]));asm volatile("":"+v"(o[3]));
  const int qrel=wid*QBLK+r32;
  #define CMASK(P0,P1,t) do{int jb_=(t)-(NT-4); if(jb_>=0)cmask(P0,P1,jb_,qrel,hi);}while(0)
  bool resc=false;
  #define START(P0,P1) do{ const float rm=rowmax(P0,P1); resc=false; mhat=rm; \
    _Pragma("unroll") for(int r=0;r<16;++r){P0[r]=__builtin_amdgcn_exp2f(fsub_s(P0[r],mhat));} }while(0)
  #define RESC() do{ if(resc){ asm volatile("s_waitcnt lgkmcnt(0)":::"memory"); \
      _Pragma("unroll") for(int d_=0;d_<4;++d_) _Pragma("unroll") for(int r=0;r<16;++r)o[d_][r]*=wsf[crow(r,hi)]; } }while(0)
  f32x16 pA0,pA1,pB0,pB1;
  int sl_prev=0,sl_cur=0,sl_next=SLOTB;
  #define ROT() do{sl_prev=sl_cur;sl_cur=sl_next;sl_next=(sl_next==(NSLOT-1)*SLOTB)?0:sl_next+SLOTB;}while(0)
  DMA_K(2,2*SLOTB);
  WAIT_BAR(4);
  qkt(pA0,pA1,Kbase,qr,f32x16{},r32,hi);asm volatile("s_nop 15\n\ts_nop 7":"+v"(pA0),"+v"(pA1));CMASK(pA0,pA1,0);
  START(pA0,pA1);
  _Pragma("unroll") for(int r=0;r<16;++r)pA1[r]=__builtin_amdgcn_exp2f(fsub_s(pA1[r],mhat));
  WAIT_BAR(0);
  DMA_K(3,0);DMA_V(1,SLOTB);
  ROT();
  kload8(kf,kp0+sl_cur);
  WAIT_BAR(3);
  s16x4 vlo[16],vhi[16]; u32x4 pw0,pw1,pw2,pw3;
  #define PKW(P,B) cvtpk_s(P[B],P[B+1])
  #define PAF(k) __builtin_bit_cast(bf16x8,pw##k)
  #define VFR(i) (bf16x8){vlo[i][0],vlo[i][1],vlo[i][2],vlo[i][3],vhi[i][0],vhi[i][1],vhi[i][2],vhi[i][3]}
  #define PIN(x) asm volatile("":"+v"(x))
  #define MX3(a,b,c) __builtin_fmaxf(__builtin_fmaxf((a),(b)),(c))
  #define GAPA(MF,A0,A1,A2,A3,W0,W1,PW) do{ MF; sacc+=A0; sacc+=A1; sacc+=A2; sacc+=A3; PIN(sacc); W0; W1; PIN(PW); SBAR(); }while(0)
  #define EX(v) __builtin_amdgcn_exp2f(v)
  #define GAPB(MF,X,B) do{ MF; X[B]=EX(X[B]-mhat); X[B+1]=EX(X[B+1]-mhat); PIN(X); SBAR(); }while(0)
  #define VRD(i) do{ vlo[i]=vtr(vp_+(((i)>>2)*4096+((i)&3)*1024)); vhi[i]=vtr(vp_+(((i)>>2)*4096+((i)&3)*1024+512)); }while(0)
  #define KRD(G,j) do{ if(G){ kload2(kf,kp0+sl_next,j); SBAR(); } }while(0)
  #define STEP(C0,C1,P0,P1,t,GK,GV,GL) do{ SBAR(); \
    const lds_cptr vp_=vp0+2*sl_prev; \
    float sacc=(P0[0]+P0[1]); \
    GAPA(C0=__builtin_amdgcn_mfma_f32_32x32x16_bf16(kf[0],qr[0],f32x16{},0,0,0), P0[2],P0[3],P0[4],P0[5],     pw0[0]=PKW(P0,0), pw0[1]=PKW(P0,2), pw0); \
    GAPA(C1=__builtin_amdgcn_mfma_f32_32x32x16_bf16(kf[1],qr[0],f32x16{},0,0,0), P0[6],P0[7],P0[8],P0[9],     pw0[2]=PKW(P0,4), pw0[3]=PKW(P0,6), pw0); \
    GAPA(C0=__builtin_amdgcn_mfma_f32_32x32x16_bf16(kf[2],qr[1],C0,0,0,0),   P0[10],P0[11],P0[12],P0[13], pw1[0]=PKW(P0,8), pw1[1]=PKW(P0,10), pw1); \
    GAPA(C1=__builtin_amdgcn_mfma_f32_32x32x16_bf16(kf[3],qr[1],C1,0,0,0),   P0[14],P0[15],P1[0],P1[1],   pw1[2]=PKW(P0,12),pw1[3]=PKW(P0,14), pw1); \
    VRD(0); SBAR(); GAPA(C0=__builtin_amdgcn_mfma_f32_32x32x16_bf16(kf[4],qr[2],C0,0,0,0),   P1[2],P1[3],P1[4],P1[5],     pw2[0]=PKW(P1,0), pw2[1]=PKW(P1,2), pw2); \
    VRD(4); SBAR(); GAPA(C1=__builtin_amdgcn_mfma_f32_32x32x16_bf16(kf[5],qr[2],C1,0,0,0),   P1[6],P1[7],P1[8],P1[9],     pw2[2]=PKW(P1,4), pw2[3]=PKW(P1,6), pw2); \
    VRD(8); SBAR(); GAPA(C0=__builtin_amdgcn_mfma_f32_32x32x16_bf16(kf[6],qr[3],C0,0,0,0),   P1[10],P1[11],P1[12],P1[13], pw3[0]=PKW(P1,8), pw3[1]=PKW(P1,10), pw3); \
    VRD(12); SBAR(); GAPA(C1=__builtin_amdgcn_mfma_f32_32x32x16_bf16(kf[7],qr[3],C1,0,0,0),   P1[14],P1[15],0.f,0.f,       pw3[2]=PKW(P1,12),pw3[3]=PKW(P1,14), pw3); \
    l_reg+=sacc; \
    if(GK){DMA_K((t)+3,sl_cur);} if(GV){DMA_V((t)+1,sl_next);} \
    CMASK(C0,C1,t); \
    { float a=MX3(C0[0],C0[1],C1[0]),b=MX3(C0[2],C0[3],C1[1]); a=MX3(a,C1[2],C1[3]); \
      _Pragma("unroll") for(int r=4;r<16;r+=4){a=MX3(a,C0[r],C0[r+1]);b=MX3(b,C0[r+2],C0[r+3]);a=MX3(a,C1[r],C1[r+1]);b=MX3(b,C1[r+2],C1[r+3]);} \
      float rm=__builtin_fmaxf(a,b); { auto rr=__builtin_amdgcn_permlane32_swap(__float_as_uint(rm),__float_as_uint(rm),false,false); rm=__builtin_fmaxf(__uint_as_float(rr[0]),__uint_as_float(rr[1])); } \
      rm-=mhat; resc=false; \
      if(__builtin_expect(__any(rm>(float)THRL),0)){ const float dl=__builtin_fmaxf(rm,0.f); mhat+=dl; \
        const float f=__builtin_amdgcn_exp2f(-dl); l_reg*=f; if(hi==0)wsf[r32]=f; resc=true; } } \
    SBAR(); \
    GAPB(o[0]=__builtin_amdgcn_mfma_f32_32x32x16_bf16(PAF(0),VFR(0),o[0],0,0,0), C0,0); VRD(1); SBAR(); \
    GAPB(o[1]=__builtin_amdgcn_mfma_f32_32x32x16_bf16(PAF(0),VFR(4),o[1],0,0,0), C0,2); VRD(5); SBAR(); \
    KRD(GL,0); GAPB(o[2]=__builtin_amdgcn_mfma_f32_32x32x16_bf16(PAF(0),VFR(8),o[2],0,0,0), C0,4); VRD(9); SBAR(); \
    KRD(GL,1); GAPB(o[3]=__builtin_amdgcn_mfma_f32_32x32x16_bf16(PAF(0),VFR(12),o[3],0,0,0), C0,6); VRD(13); SBAR(); \
    KRD(GL,2); GAPB(o[0]=__builtin_amdgcn_mfma_f32_32x32x16_bf16(PAF(1),VFR(1),o[0],0,0,0), C0,8); VRD(2); SBAR(); \
    KRD(GL,3); GAPB(o[1]=__builtin_amdgcn_mfma_f32_32x32x16_bf16(PAF(1),VFR(5),o[1],0,0,0), C0,10); VRD(6); SBAR(); \
    GAPB(o[2]=__builtin_amdgcn_mfma_f32_32x32x16_bf16(PAF(1),VFR(9),o[2],0,0,0), C0,12); VRD(10); SBAR(); \
    GAPB(o[3]=__builtin_amdgcn_mfma_f32_32x32x16_bf16(PAF(1),VFR(13),o[3],0,0,0), C0,14); VRD(14); SBAR(); \
    GAPB(o[0]=__builtin_amdgcn_mfma_f32_32x32x16_bf16(PAF(2),VFR(2),o[0],0,0,0), C1,0); VRD(3); SBAR(); \
    GAPB(o[1]=__builtin_amdgcn_mfma_f32_32x32x16_bf16(PAF(2),VFR(6),o[1],0,0,0), C1,2); VRD(7); SBAR(); \
    GAPB(o[2]=__builtin_amdgcn_mfma_f32_32x32x16_bf16(PAF(2),VFR(10),o[2],0,0,0), C1,4); VRD(11); SBAR(); \
    GAPB(o[3]=__builtin_amdgcn_mfma_f32_32x32x16_bf16(PAF(2),VFR(14),o[3],0,0,0), C1,6); VRD(15); SBAR(); \
    GAPB(o[0]=__builtin_amdgcn_mfma_f32_32x32x16_bf16(PAF(3),VFR(3),o[0],0,0,0), C1,8); \
    GAPB(o[1]=__builtin_amdgcn_mfma_f32_32x32x16_bf16(PAF(3),VFR(7),o[1],0,0,0), C1,10); \
    GAPB(o[2]=__builtin_amdgcn_mfma_f32_32x32x16_bf16(PAF(3),VFR(11),o[2],0,0,0), C1,12); \
    GAPB(o[3]=__builtin_amdgcn_mfma_f32_32x32x16_bf16(PAF(3),VFR(15),o[3],0,0,0), C1,14); \
    }while(0)
  int t=1;
  #undef CMASK
  #define CMASK(P0,P1,t) do{}while(0)
  for(;t+5<NT;t+=2){
    STEP(pB0,pB1,pA0,pA1,t,true,true,true);     WAIT_BAR(3); RESC(); ROT();
    STEP(pA0,pA1,pB0,pB1,t+1,true,true,true);   WAIT_BAR(3); RESC(); ROT();
  }
  #undef CMASK
  #define CMASK(P0,P1,t) do{int jb_=(t)-(NT-4); if(jb_>=0)cmask(P0,P1,jb_,qrel,hi);}while(0)
  #define ENDW(tt) do{ if((tt)+3<NT){WAIT_BAR(3);} else if((tt)+2<NT){WAIT_BAR(2);} else {WAIT_BAR(0);} }while(0)
  for(;t+1<NT;t+=2){
    STEP(pB0,pB1,pA0,pA1,t,(t+3<NT),(t+1<NT),(t+1<NT));       ENDW(t);   RESC(); ROT();
    STEP(pA0,pA1,pB0,pB1,t+1,(t+4<NT),(t+2<NT),(t+2<NT));     ENDW(t+1); RESC(); ROT();
  }
  STEP(pB0,pB1,pA0,pA1,NT-1,false,false,false); RESC();
  { float sacc=pB0[0]+pB0[1]; _Pragma("unroll") for(int r=2;r<16;++r)sacc+=pB0[r]; _Pragma("unroll") for(int r=0;r<16;++r)sacc+=pB1[r]; l_reg+=sacc;
    pw0=(u32x4){PKW(pB0,0),PKW(pB0,2),PKW(pB0,4),PKW(pB0,6)};pw1=(u32x4){PKW(pB0,8),PKW(pB0,10),PKW(pB0,12),PKW(pB0,14)};pw2=(u32x4){PKW(pB1,0),PKW(pB1,2),PKW(pB1,4),PKW(pB1,6)};pw3=(u32x4){PKW(pB1,8),PKW(pB1,10),PKW(pB1,12),PKW(pB1,14)};
    SBAR(); pv(o,vb0+2*sl_cur,PAF(0),PAF(1),PAF(2),PAF(3)); }
  asm volatile("s_waitcnt lgkmcnt(0)\n\ts_barrier":::"memory");
  #undef PKW
  #undef PAF
  #undef VFR
  #undef PIN
  #undef MX3
  #undef GAPA
  #undef GAPB
  #undef EX
  #undef VRD
  #undef KRD
  #undef STEP
  #undef ENDW
  {auto rr=__builtin_amdgcn_permlane32_swap(__float_as_uint(l_reg),__float_as_uint(l_reg),false,false);l_reg=__uint_as_float(rr[0])+__uint_as_float(rr[1]);}
  if(hi==0)wsf[32+r32]=l_reg;asm volatile("s_waitcnt lgkmcnt(0)":::"memory");
  float rli[16];
  #pragma unroll
  for(int r=0;r<16;++r)rli[r]=__builtin_amdgcn_rcpf(wsf[32+crow(r,hi)]);
  bf16*Ow=O+(long)(q0+wid*QBLK)*PO;
  { bf16*stg=(bf16*)(shm+LDS_OST)+wid*4096;
    #pragma unroll
    for(int r=0;r<16;++r){const int orow=crow(r,hi);
      #pragma unroll
      for(int d0=0;d0<4;++d0)stg[orow*128+d0*32+r32]=__float2bfloat16(o[d0][r]*rli[r]);}
    asm volatile("s_waitcnt lgkmcnt(0)":::"memory");
    #pragma unroll
    for(int i=0;i<8;++i){const int row=i*4+(lane>>4),ch=lane&15; const u32x4 v=*(const u32x4*)(stg+row*128+ch*8); ATTN_STORE16(Ow+(long)row*PO+ch*8,v);} }
  asm volatile("s_waitcnt lgkmcnt(0)\n\ts_barrier":::"memory");
  #undef DMA_K
  #undef DMA_V
  #undef CMASK
  #undef START
  #undef RESC
  #undef ROT
}
constexpr int ATTN_LDS_BYTES=LDS_BYTES;
template<int THRL=8> __device__ __forceinline__ void attn_phase(char*lds,const bf16*PD,bf16*O,int vcu,const int wid){
  const int pr=vcu>>4,s=vcu&15,h=pr>>1,m=pr&1;
  const bf16*Q=PD+h*128+m*64,*K=PD+1024+h*128+m*64,*V=PD+2048+h*128; bf16*Op=O+m*1024+h*128;
  _Pragma("unroll 1") for(int i=0;i<4;++i){ const int qb=(i>>1)*32+((i&1)?31-s:s); attn_unit<THRL>(wid,qb,Q,K,V,Op,lds); }
}
#undef SBAR
#undef WAIT_BAR
}
#define GAS __attribute__((address_space(1)))
#define LAS __attribute__((address_space(3)))
typedef unsigned short bf16;
typedef unsigned v4u __attribute__((ext_vector_type(4)));
typedef float f32x4 __attribute__((ext_vector_type(4)));
typedef short bf16x8 __attribute__((ext_vector_type(8)));
typedef GAS unsigned gu32;
typedef GAS unsigned long long gu64;
#define RLX_AGENT __ATOMIC_RELAXED, __HIP_MEMORY_SCOPE_AGENT
#define LDS_WAIT() asm volatile("s_waitcnt lgkmcnt(0)" ::: "memory")
#define VM_WAIT() asm volatile("s_waitcnt vmcnt(0)" ::: "memory")
__device__ __forceinline__ unsigned long long rt() { return __builtin_amdgcn_s_memrealtime(); }
__device__ __forceinline__ unsigned f2bf(float f) { unsigned u = __builtin_bit_cast(unsigned, f); return (u + 0x7fffu + ((u >> 16) & 1u)) >> 16; }
__device__ __forceinline__ unsigned pk2(float lo, float hi) { return f2bf(lo) | (f2bf(hi) << 16); }

#define XB_TMO      128
#define XB_XCNT(j)  (256  + 64 * (j))
#define XB_XSUB(j)  (1280 + 64 * (j))
#define XB_XGEN(j)  (2304 + 64 * (j))
#define XB_TOP      3328
#define XB_TOPGEN   3392
#define XCD_BAR_WORDS 3456
#define XB_SPIN_CAP (1u << 18)

__device__ __forceinline__ unsigned xb_ld(unsigned* p)              { return __hip_atomic_load(p, __ATOMIC_RELAXED, __HIP_MEMORY_SCOPE_AGENT); }
__device__ __forceinline__ unsigned xb_add(unsigned* p, unsigned v) { return __hip_atomic_fetch_add(p, v, __ATOMIC_RELAXED, __HIP_MEMORY_SCOPE_AGENT); }
__device__ __forceinline__ unsigned xb_xcc_id() { return (unsigned)__builtin_amdgcn_s_getreg((3 << 11) | 20) & 0xFu; }
#define XB_SPIN(cond, bar) do { unsigned _sp = 0; while (cond) { __builtin_amdgcn_s_sleep(1); \
    if ((++_sp & 255u) == 0u) { if (xb_ld(&(bar)[XB_TMO])) break; if (_sp > XB_SPIN_CAP) { atomicAdd(&(bar)[XB_TMO], 1u); break; } } } } while (0)

struct XcdBarrier {
    unsigned* bar; unsigned x;
    volatile LAS unsigned* st;
};

__device__ __forceinline__ XcdBarrier xcd_barrier_post(unsigned* bar, volatile LAS unsigned* st) {
    XcdBarrier b; b.bar = bar; b.x = xb_xcc_id(); b.st = st;
    if (threadIdx.x == 0) (void)xb_add(&bar[XB_XCNT(b.x)], 1u);
    return b;
}
__device__ __forceinline__ void xcd_barrier_complete(unsigned* bar, unsigned x, unsigned& nloc, unsigned& nx) {
    const unsigned G = gridDim.x * gridDim.y * gridDim.z;
    unsigned sum, cnt, mine, sp = 0u;
    for (;;) {
        sum = 0u; cnt = 0u; mine = 0u;
#pragma unroll
        for (unsigned j = 0; j < 16; ++j) { const unsigned c = xb_ld(&bar[XB_XCNT(j)]); sum += c; cnt += (c > 0u) ? 1u : 0u; mine = (j == x) ? c : mine; }
        if (sum == G) break;
        __builtin_amdgcn_s_sleep(1);
        if ((++sp & 255u) == 0u) { if (xb_ld(&bar[XB_TMO])) break; if (sp > XB_SPIN_CAP) { atomicAdd(&bar[XB_TMO], 1u); break; } }
    }
    nloc = mine > 0u ? mine : 1u; nx = cnt > 0u ? cnt : 1u;
}

__device__ __forceinline__ void xcd_barrier(const XcdBarrier& b) {
    asm volatile("s_waitcnt vmcnt(0)" ::: "memory");
    __syncthreads();
    if (threadIdx.x == 0) {
        unsigned* bar = b.bar;
        __builtin_amdgcn_s_waitcnt(0);
        unsigned nloc = b.st[0], nx = b.st[1];
        if (nloc == 0u) { xcd_barrier_complete(bar, b.x, nloc, nx); b.st[0] = nloc; b.st[1] = nx; }
        const unsigned old = xb_add(&bar[XB_XSUB(b.x)], 1u);
        const unsigned gen = old / nloc;
        if (old + 1u == (gen + 1u) * nloc) {
            __builtin_amdgcn_fence(__ATOMIC_RELEASE, "agent");
            asm volatile("s_waitcnt vmcnt(0)" ::: "memory");
            const unsigned og = xb_add(&bar[XB_TOP], 1u);
            const unsigned tg = og / nx;
            if (og + 1u == (tg + 1u) * nx) xb_add(&bar[XB_TOPGEN], 1u);
            else XB_SPIN(xb_ld(&bar[XB_TOPGEN]) == tg, bar);
            __builtin_amdgcn_fence(__ATOMIC_ACQUIRE, "agent");
            xb_add(&bar[XB_XGEN(b.x)], 1u);
            asm volatile("s_waitcnt vmcnt(0)" ::: "memory");
        } else {
            XB_SPIN(xb_ld(&bar[XB_XGEN(b.x)]) == gen, bar);
            __builtin_amdgcn_fence(__ATOMIC_ACQUIRE, "agent");
            asm volatile("s_waitcnt vmcnt(0)" ::: "memory");
        }
    }
    __syncthreads();
}
constexpr int NWAVES = 8;
constexpr int S_ = 16384, DM = 2048;
constexpr int NPH = 16;
#ifndef MK_PER_PHASE
#define MK_PER_PHASE 0
#endif
constexpr size_t MiB = 1u << 20;
constexpr size_t WS_CTL = 0, CTL_ZERO_BYTES = 1 * MiB;
constexpr size_t WS_WA = 1 * MiB, WS_WB = 5 * MiB, WS_WOUT = 9 * MiB, WS_WS = 17 * MiB, WS_LORA = 25 * MiB;
constexpr size_t WS_WIN = 27 * MiB, WS_PR = 69 * MiB, WS_PD = 181 * MiB, WS_PG = 277 * MiB;
constexpr size_t WS_A = 405 * MiB, WS_E = 437 * MiB, WS_G = 469 * MiB, WS_END = 507 * MiB;
constexpr size_t WS_SCN = 27 * MiB, WS_SCAL = 123 * MiB, WS_SLOC = 127 * MiB, WS_ASEG = 143 * MiB, WS_SIN = 159 * MiB;
constexpr size_t WS_YA = 91 * MiB, WS_OATT = 27 * MiB, WS_YB = 437 * MiB, WS_Z = 405 * MiB  , WS_T1 = 123 * MiB, WS_MERGED = 27 * MiB;
constexpr size_t WS_H2 = 123 * MiB, WS_XN2 = 27 * MiB, WS_UTAB = 251 * MiB, WS_VTAB = 315 * MiB, WS_SCORES = 379 * MiB;
constexpr size_t WS_USCL = WS_UTAB + 16 * MiB, WS_VSCL = WS_VTAB + 16 * MiB;
constexpr size_t OUT_XN = 0, OUT_RKV = 0, OUT_LIN = 96 * MiB, OUT_YLOC = 96 * MiB  ;
constexpr int CW_BAR = 4096;
constexpr int RING_OFF = 0, RING_BYTES = 131072;
constexpr int LDSCTL_OFF = RING_BYTES, MISC_OFF = LDSCTL_OFF + 320;
constexpr int LDS_BYTES = 147456;
constexpr int NSEG = 64, SEGLEN = S_ / NSEG;

struct Args { const float* in[28]; float* out; unsigned char* ws; int ph_lo, ph_hi; };

struct Frame {
    LAS unsigned char* lds; volatile LAS unsigned* MISC; gu32* ctl;
    int tid, lane, wave, vcu, G;
};

__device__ __forceinline__ float bf2f(unsigned short b) { return __uint_as_float((unsigned)b << 16); }
__device__ __forceinline__ float wave_sum(float v) {
#pragma unroll
    for (int o = 1; o < 64; o <<= 1) v += __shfl_xor(v, o);
    return v;
}
__device__ __forceinline__ float wave_max(float v) {
#pragma unroll
    for (int o = 1; o < 64; o <<= 1) v = fmaxf(v, __shfl_xor(v, o));
    return v;
}
template <int CTRL, int RM> __device__ __forceinline__ float dppf(float oldv, float x) { return __builtin_bit_cast(float, __builtin_amdgcn_update_dpp(__builtin_bit_cast(int, oldv), __builtin_bit_cast(int, x), CTRL, RM, 0xf, false)); }
__device__ __forceinline__ float wsum(float v) {
    v += dppf<0xB1, 0xf>(v, v); v += dppf<0x4E, 0xf>(v, v); v += dppf<0x141, 0xf>(v, v); v += dppf<0x140, 0xf>(v, v);
    v += dppf<0x142, 0xa>(0.f, v); v += dppf<0x143, 0xc>(0.f, v);
    return __builtin_bit_cast(float, __builtin_amdgcn_readlane(__builtin_bit_cast(int, v), 63));
}
__device__ __forceinline__ float wmax(float v) {
    v = fmaxf(v, dppf<0xB1, 0xf>(v, v)); v = fmaxf(v, dppf<0x4E, 0xf>(v, v)); v = fmaxf(v, dppf<0x141, 0xf>(v, v)); v = fmaxf(v, dppf<0x140, 0xf>(v, v));
    v = fmaxf(v, dppf<0x142, 0xa>(0.f, v)); v = fmaxf(v, dppf<0x143, 0xc>(0.f, v));
    return __builtin_bit_cast(float, __builtin_amdgcn_readlane(__builtin_bit_cast(int, v), 63));
}
__device__ __forceinline__ float sigmf(float x) { return __builtin_amdgcn_rcpf(1.0f + __expf(-x)); }

__device__ __forceinline__ void transpose_block(const float* W, int ldw, int k0, int n0, int kvalid, bf16* WT, int ldt, int drow0, LAS float* scr, int lane) {
    float tv[32];
#pragma unroll
    for (int i = 0; i < 32; ++i) { const int k = k0 + 2 * i + (lane >> 5); tv[i] = (k < kvalid) ? W[(size_t)k * ldw + n0 + (lane & 31)] : 0.f; }
#pragma unroll
    for (int i = 0; i < 32; ++i) scr[(2 * i + (lane >> 5)) * 33 + (lane & 31)] = tv[i];
    LDS_WAIT(); asm volatile("" ::: "memory");
    const int c = lane & 7;
#pragma unroll
    for (int j = 0; j < 4; ++j) { const int n = (lane >> 3) + 8 * j; const LAS float* s = scr + (8 * c) * 33 + n;
        v4u o; o.x = pk2(s[0 * 33], s[1 * 33]); o.y = pk2(s[2 * 33], s[3 * 33]); o.z = pk2(s[4 * 33], s[5 * 33]); o.w = pk2(s[6 * 33], s[7 * 33]);
        *(GAS v4u*)(WT + (size_t)(drow0 + n) * ldt + k0 + 8 * c) = o; }
    LDS_WAIT(); asm volatile("" ::: "memory");
}
__device__ __forceinline__ void rms_row_to_bf16(const float* xrow, const float* g, bf16* orow, int lane) {
    const GAS f32x4* xr = (const GAS f32x4*)xrow + lane; const f32x4* gr = (const f32x4*)g + lane;
    f32x4 v[8]; float s = 0.f;
#pragma unroll
    for (int j = 0; j < 8; ++j) { v[j] = xr[64 * j]; s += (v[j].x * v[j].x + v[j].y * v[j].y) + (v[j].z * v[j].z + v[j].w * v[j].w); }
    const float rstd = rsqrtf(wave_sum(s) * (1.f / 2048.f) + 1e-6f);
    GAS unsigned long long* o8 = (GAS unsigned long long*)orow + lane;
#pragma unroll
    for (int j = 0; j < 8; ++j) { const f32x4 gg = gr[64 * j];
        o8[64 * j] = (unsigned long long)pk2(v[j].x * rstd * gg.x, v[j].y * rstd * gg.y) | ((unsigned long long)pk2(v[j].z * rstd * gg.z, v[j].w * rstd * gg.w) << 32); }
}

__device__ __forceinline__ void rms_row2_to_bf16(const float* xa, const float* xb, const float* g, bf16* oa, bf16* ob_, int lane) {
    const GAS f32x4* xr = (const GAS f32x4*)xa + lane; const GAS f32x4* yr = (const GAS f32x4*)xb + lane; const f32x4* gr = (const f32x4*)g + lane;
    f32x4 v[8], w[8]; float s = 0.f, t = 0.f;
#pragma unroll
    for (int j = 0; j < 8; ++j) { v[j] = __builtin_nontemporal_load(xr + 64 * j); w[j] = __builtin_nontemporal_load(yr + 64 * j); }
#pragma unroll
    for (int j = 0; j < 8; ++j) { s += (v[j].x * v[j].x + v[j].y * v[j].y) + (v[j].z * v[j].z + v[j].w * v[j].w); t += (w[j].x * w[j].x + w[j].y * w[j].y) + (w[j].z * w[j].z + w[j].w * w[j].w); }
    const float rs = rsqrtf(wsum(s) * (1.f / 2048.f) + 1e-6f), rt = rsqrtf(wsum(t) * (1.f / 2048.f) + 1e-6f);
    GAS unsigned long long* o8 = (GAS unsigned long long*)oa + lane; GAS unsigned long long* p8 = (GAS unsigned long long*)ob_ + lane;
#pragma unroll
    for (int j = 0; j < 8; ++j) { const f32x4 gg = gr[64 * j];
        o8[64 * j] = (unsigned long long)pk2(v[j].x * rs * gg.x, v[j].y * rs * gg.y) | ((unsigned long long)pk2(v[j].z * rs * gg.z, v[j].w * rs * gg.w) << 32);
        p8[64 * j] = (unsigned long long)pk2(w[j].x * rt * gg.x, w[j].y * rt * gg.y) | ((unsigned long long)pk2(w[j].z * rt * gg.z, w[j].w * rt * gg.w) << 32); }
}

template <int K, int VAR = 0> __device__ __forceinline__ void fmac_dpp(float& acc, float op, float s) {
    if (VAR == 0) asm("v_fmac_f32_dpp %0, %1, %2 quad_perm:[%c3,%c3,%c3,%c3] row_mask:0xf bank_mask:0xf" : "+v"(acc) : "v"(op), "v"(s), "i"(K));
    else asm("v_fmac_f32_e32 %0, %1, %2" : "+v"(acc) : "v"(op), "v"(s)); }
template <int K, int VAR = 0> __device__ __forceinline__ void mulip_dpp(float& s, float op) {
    if (VAR == 0) asm("v_mul_f32_dpp %0, %1, %0 quad_perm:[%c2,%c2,%c2,%c2] row_mask:0xf bank_mask:0xf" : "+v"(s) : "v"(op), "i"(K));
    else asm("v_mul_f32_e32 %0, %1, %0" : "+v"(s) : "v"(op)); }
#define SCAN_FOR_C(...) _Pragma("unroll") for (int j = 0; j < 4; ++j) { \
    { constexpr int k = 0; _Pragma("unroll") for (int i = 0; i < 4; ++i) { const int c = 16 * j + 4 * k + i; __VA_ARGS__ } } \
    { constexpr int k = 1; _Pragma("unroll") for (int i = 0; i < 4; ++i) { const int c = 16 * j + 4 * k + i; __VA_ARGS__ } } \
    { constexpr int k = 2; _Pragma("unroll") for (int i = 0; i < 4; ++i) { const int c = 16 * j + 4 * k + i; __VA_ARGS__ } } \
    { constexpr int k = 3; _Pragma("unroll") for (int i = 0; i < 4; ++i) { const int c = 16 * j + 4 * k + i; __VA_ARGS__ } } }

constexpr int SCAN_CH = 4;
constexpr int SC_RING = 0, SC_VG = 2 * SCAN_CH * 320, SC_Y = SC_VG + 2 * SCAN_CH * 64, SC_SLOT_F = SC_Y + 2 * SCAN_CH * 128;
__device__ __forceinline__ void scan4_phase(const int lane, const int wave, const int vcu, const int G, unsigned char* ws, unsigned char* ob, const bf16* RKV, LAS float* ldsf) {
    constexpr int CH = SCAN_CH, NCHUNK = SEGLEN / CH;
#define SCAN_BAR() do { asm volatile("s_waitcnt lgkmcnt(0)" ::: "memory"); __builtin_amdgcn_s_barrier(); asm volatile("" ::: "memory"); } while (0)
    const int slot = wave & 3; LAS float* sl = ldsf + slot * SC_SLOT_F;
    for (int round = 0; round * G * 4 < 16 * NSEG; ++round) {
        const int task = round * G * 4 + vcu * 4 + slot; const bool valid = task < 16 * NSEG; const int h = valid ? task / NSEG : 0, seg = valid ? task % NSEG : 0; const int t0 = seg * SEGLEN;
        if (wave >= 4) {
            const bf16* SCN = (const bf16*)(ws + WS_SCN) + ((size_t)h * S_) * 192; const bf16* Eb = (const bf16*)(ws + WS_E);
            bf16* YL = (bf16*)(ob + OUT_YLOC) + ((size_t)h * S_) * 64 + lane; bf16* ZZ = (bf16*)(ws + WS_Z) + ((size_t)h * S_) * 64 + lane;
            unsigned short pk[CH], pb[CH], pt[CH], pr[CH], pe[CH], pv[CH];
#define SCAN_ISSUE(n) do { const int tc_ = t0 + (n) * CH; \
            _Pragma("unroll") for (int s = 0; s < CH; ++s) { const size_t t = (size_t)(tc_ + s); \
                pk[s] = SCN[t * 192 + lane]; pb[s] = SCN[t * 192 + 64 + lane]; pt[s] = SCN[t * 192 + 128 + lane]; \
                pr[s] = RKV[t * 3072 + h * 64 + lane]; pe[s] = Eb[t * 1024 + h * 64 + lane]; pv[s] = RKV[t * 3072 + 2048 + h * 64 + lane]; } } while (0)
#define SCAN_WRITE(n) do { const int b_ = (n) & 1; \
            _Pragma("unroll") for (int s = 0; s < CH; ++s) { LAS float* q = sl + SC_RING + (b_ * CH + s) * 320; \
                q[lane] = bf2f(pk[s]); q[64 + lane] = bf2f(pr[s]); q[128 + lane] = __expf(-bf2f(pe[s])); q[192 + lane] = bf2f(pb[s]); q[256 + lane] = bf2f(pt[s]); \
                sl[SC_VG + (b_ * CH + s) * 64 + lane] = bf2f(pv[s]); } } while (0)
#define SCAN_YSTORE(n) do { const int tc_ = t0 + (n) * CH; const int b_ = (n) & 1; \
            _Pragma("unroll") for (int s = 0; s < CH; ++s) { YL[(size_t)(tc_ + s) * 64] = (unsigned short)f2bf(sl[SC_Y + (b_ * CH + s) * 128 + lane]); ZZ[(size_t)(tc_ + s) * 64] = (unsigned short)f2bf(sl[SC_Y + (b_ * CH + s) * 128 + 64 + lane]); } } while (0)
            if (valid) { SCAN_ISSUE(0); SCAN_WRITE(0); SCAN_ISSUE(1); }
            SCAN_BAR();
#pragma unroll 1
            for (int n = 0; n < NCHUNK; ++n) {
                if (valid) { if (n + 1 < NCHUNK) SCAN_WRITE(n + 1); if (n >= 1) SCAN_YSTORE(n - 1); if (n + 2 < NCHUNK) SCAN_ISSUE(n + 2); }
                SCAN_BAR();
            }
            if (valid) SCAN_YSTORE(NCHUNK - 1);
#undef SCAN_ISSUE
#undef SCAN_WRITE
#undef SCAN_YSTORE
        } else {
            float S[64], M[64]; int ln_ = lane; asm volatile("" : "+v"(ln_));
#pragma unroll
            for (int c = 0; c < 64; ++c) { S[c] = 0.f; M[c] = (c == ln_) ? 1.f : 0.f; }
            SCAN_BAR();
#pragma unroll 1
            for (int n = 0; n < NCHUNK; ++n) {
                const int b = n & 1;
                if (valid) {
                f32x4 KK[4];
                { const LAS f32x4* q4 = (const LAS f32x4*)(sl + SC_RING + (b * CH) * 320) + (lane & 3);
#pragma unroll
                  for (int j = 0; j < 4; ++j) KK[j] = q4[j * 4]; }
#pragma unroll 1
                for (int s = 0; s < CH; ++s) {
                    const LAS f32x4* q4 = (const LAS f32x4*)(sl + SC_RING + (b * CH + s) * 320) + (lane & 3);
                    f32x4 WW[4], BB[4], KT[4];
#pragma unroll
                    for (int j = 0; j < 4; ++j) { WW[j] = q4[32 + j * 4]; BB[j] = q4[48 + j * 4]; KT[j] = q4[64 + j * 4]; }
                    const float vt = sl[SC_VG + (b * CH + s) * 64 + lane];
                    float saq[4], sbq[4];
#pragma unroll
                    for (int q = 0; q < 4; ++q) { saq[q] = 0.f; sbq[q] = 0.f; }
                    SCAN_FOR_C( fmac_dpp<k>(saq[i], KK[j][i], S[c]); fmac_dpp<k>(sbq[i], KK[j][i], M[c]); )
                    const float sa = (saq[0] + saq[1]) + (saq[2] + saq[3]), sb = (sbq[0] + sbq[1]) + (sbq[2] + sbq[3]);
#pragma unroll
                    for (int j = 0; j < 4; ++j) KK[j] = q4[16 + j * 4];
                    SCAN_FOR_C( mulip_dpp<k>(S[c], WW[j][i]); )
                    SCAN_FOR_C( fmac_dpp<k>(S[c], BB[j][i], sa); )
                    SCAN_FOR_C( fmac_dpp<k>(S[c], KT[j][i], vt); )
                    SCAN_FOR_C( mulip_dpp<k>(M[c], WW[j][i]); )
                    SCAN_FOR_C( fmac_dpp<k>(M[c], BB[j][i], sb); )
                    float ylq[4], zq[4];
#pragma unroll
                    for (int q = 0; q < 4; ++q) { ylq[q] = 0.f; zq[q] = 0.f; }
                    SCAN_FOR_C( fmac_dpp<k>(ylq[i], KK[j][i], S[c]); fmac_dpp<k>(zq[i], KK[j][i], M[c]); )
                    sl[SC_Y + (b * CH + s) * 128 + lane] = (ylq[0] + ylq[1]) + (ylq[2] + ylq[3]);
                    sl[SC_Y + (b * CH + s) * 128 + 64 + lane] = (zq[0] + zq[1]) + (zq[2] + zq[3]);
                    { const LAS f32x4* qn = (const LAS f32x4*)(sl + SC_RING + (b * CH + ((s + 1) & (CH - 1))) * 320) + (lane & 3);
#pragma unroll
                      for (int j = 0; j < 4; ++j) KK[j] = qn[j * 4]; }
                }
                }
                SCAN_BAR();
            }
            if (valid) {
                f32x4* op = (f32x4*)((float*)(ws + WS_SLOC) + (((size_t)h * NSEG + seg) * 64 + lane) * 64);
                bf16* oq = (bf16*)(ws + WS_ASEG) + ((size_t)h * NSEG + seg) * 4096 + lane;
#pragma unroll
                for (int q = 0; q < 16; ++q) op[q] = (f32x4){S[4 * q], S[4 * q + 1], S[4 * q + 2], S[4 * q + 3]};
#pragma unroll
                for (int c2 = 0; c2 < 64; ++c2) oq[c2 * 64] = (unsigned short)f2bf(M[c2]);
            }
        }
        SCAN_BAR();
    }
#undef SCAN_BAR
}

__global__ void __launch_bounds__(NWAVES * 64, 2) mk_fwd(Args args) {
    extern __shared__ __attribute__((aligned(16))) unsigned char lds[];
    Frame F;
    F.lds = (LAS unsigned char*)lds; F.MISC = (volatile LAS unsigned*)(F.lds + MISC_OFF);
    F.tid = threadIdx.x; F.wave = __builtin_amdgcn_readfirstlane(F.tid >> 6);
    F.G = gridDim.x; F.vcu = 0;
    unsigned char* ws = args.ws; F.ctl = (gu32*)(ws + WS_CTL);
    const float* const* in = args.in;
    unsigned char* ob = (unsigned char*)args.out;
    for (int u = threadIdx.x; u < (LDS_BYTES - LDSCTL_OFF) / 4; u += NWAVES * 64) ((LAS unsigned*)(F.lds + LDSCTL_OFF))[u] = 0u;
    __syncthreads();
    XcdBarrier bar; bar.bar = (unsigned*)(F.ctl + CW_BAR); bar.x = 0; bar.st = nullptr;
    int bidv = (int)blockIdx.x;
    if (!MK_PER_PHASE) {
        bar.bar = (unsigned*)(F.ctl + CW_BAR); bar.x = xb_xcc_id(); bar.st = F.MISC + 8;
        if (threadIdx.x == 0) {
            const unsigned rank = xb_add(&bar.bar[XB_XCNT(bar.x)], 1u);
            unsigned cnts[16], sum, sp = 0u;
            for (;;) { sum = 0u;
#pragma unroll
                for (unsigned j = 0; j < 16; ++j) { cnts[j] = xb_ld(&bar.bar[XB_XCNT(j)]); sum += cnts[j]; }
                if (sum == (unsigned)F.G) break;
                __builtin_amdgcn_s_sleep(1);
                if ((++sp & 255u) == 0u) { if (xb_ld(&bar.bar[XB_TMO])) break; if (sp > XB_SPIN_CAP) { atomicAdd(&bar.bar[XB_TMO], 1u); break; } } }
            unsigned nx = 0u, xi = 0u, mine = 0u; bool even = true;
#pragma unroll
            for (unsigned j = 0; j < 16; ++j) { if (cnts[j]) { nx++; if (cnts[j] * 8u != (unsigned)F.G) even = false; } if (j < bar.x && cnts[j]) xi++; if (j == bar.x) mine = cnts[j]; }
            F.MISC[8] = mine ? mine : 1u; F.MISC[9] = nx ? nx : 1u;
            F.MISC[10] = (even && nx == 8u && sum == (unsigned)F.G) ? rank * 8u + xi : (unsigned)blockIdx.x;
        }
        __syncthreads();
        bidv = (int)__builtin_amdgcn_readfirstlane((int)F.MISC[10]);
    }
    F.vcu = (F.G % 8 == 0) ? (bidv % 8) * (F.G / 8) + bidv / 8 : bidv;
    const int lo = args.ph_lo, hi = args.ph_hi;
#ifndef PH_MASK
#define PH_MASK 0xFFFF
#endif
#define IN(k) ((((PH_MASK) >> (k)) & 1) && lo <= (k) && (k) < hi)
#ifndef PROBE_MASK
#define PROBE_MASK 0
#endif
#ifndef PROBE_VARIANT
#define PROBE_VARIANT 0
#endif
#ifndef PROBE_N
#define PROBE_N 1
#endif
#define PHASE_BEGIN(k) if (IN(k)) { for (int rep_ = 0; rep_ < 1 + ((((PROBE_MASK) >> (k)) & 1) ? (PROBE_N) : 0); ++rep_) { if (rep_) xcd_barrier(bar); PHASE_IDS
#define PHASE_END } }
#define SEAM(k) do { if (IN(k) && IN((k) + 1)) xcd_barrier(bar); } while (0)
    const int gw = F.vcu * NWAVES + F.wave, NGW = F.G * NWAVES; const int NGT = F.G * NWAVES * 64;
#define PHASE_IDS const int lane = mk_lane_id(), tid = F.wave * 64 + lane, gt = F.vcu * (NWAVES * 64) + tid; (void)gt; (void)lane;

    bf16* WIN_T = (bf16*)(ws + WS_WIN); bf16* WA_T = (bf16*)(ws + WS_WA); bf16* WB_T = (bf16*)(ws + WS_WB); bf16* WOUT_T = (bf16*)(ws + WS_WOUT);
    bf16* WS_T = (bf16*)(ws + WS_WS); bf16* LORA_T = (bf16*)(ws + WS_LORA);
    bf16* XN = (bf16*)(ob + OUT_XN); bf16* RKV = (bf16*)(ob + OUT_RKV); bf16* LIN = (bf16*)(ob + OUT_LIN);
    bf16* PR = (bf16*)(ws + WS_PR); bf16* PD = (bf16*)(ws + WS_PD); bf16* PG = (bf16*)(ws + WS_PG);

    PHASE_BEGIN(0)
        LAS float* scr = (LAS float*)(F.lds + RING_OFF + F.wave * 16384);
        constexpr int I_IN = 32 * 334, I_A = 16 * 64, I_B = 16 * 64, I_O = 32 * 64, I_L = 4 * 32;
        constexpr int NIT = I_IN + I_A + I_B + I_O + 3 * I_L;
        for (int it = gw; it < NIT; it += NGW) {
            int r = it;
            if (r < I_IN) { const int kb = r / 334, nb = r % 334, n0 = nb * 32; transpose_block(in[2], 10688, kb * 64, n0, 2048, WIN_T, 2048, n0 + (n0 >= 3520 ? 64 : 0), scr, lane); continue; } r -= I_IN;
            if (r < I_A) { const int kb = r / 64, nb = r % 64; transpose_block(in[19], 2048, kb * 64, nb * 32, 1024, WA_T, 1024, nb * 32, scr, lane); continue; } r -= I_A;
            if (r < I_B) { const int kb = r / 64, nb = r % 64; transpose_block(in[20], 2048, kb * 64, nb * 32, 1024, WB_T, 1024, nb * 32, scr, lane); continue; } r -= I_B;
            if (r < I_O) { const int kb = r / 64, nb = r % 64; transpose_block(in[21], 2048, kb * 64, nb * 32, 2048, WOUT_T, 2048, nb * 32, scr, lane); continue; } r -= I_O;
            { const int which = r / I_L, rr = r % I_L, kb = rr / 32, nb = rr % 32; const float* W = which == 0 ? in[5] : (which == 1 ? in[7] : in[8]);
              transpose_block(W, 1024, kb * 64, nb * 32, which == 2 ? 256 : 96, LORA_T + (size_t)which * 1024 * 256, 256, nb * 32, scr, lane); }
        }
        for (int i = gt; i < 16384; i += NGT) *(GAS v4u*)(WIN_T + (size_t)3520 * 2048 + (size_t)i * 8) = (v4u){0u, 0u, 0u, 0u};
        for (int task = gw; task < 16 * 32 * 4; task += NGW) {
            const int hp = task >> 7, kb = (task >> 2) & 31, ng = task & 3; const int k = kb * 64 + lane;
            const f32x4* wq = (const f32x4*)(in[23] + (size_t)k * 2048 + hp * 128);
            f32x4 q[32];
#pragma unroll
            for (int d = 0; d < 32; ++d) q[d] = wq[d];
            const f32x4* sk4 = (const f32x4*)(in[24] + ((size_t)hp * 128 + ng * 32) * 128); LAS f32x4* sks = (LAS f32x4*)scr;
#pragma unroll
            for (int i = 0; i < 16; ++i) sks[i * 64 + lane] = sk4[i * 64 + lane];
            LDS_WAIT(); asm volatile("" ::: "memory");
#pragma unroll 2
            for (int n = 0; n < 32; ++n) { const LAS f32x4* s4 = sks + n * 32; float a0 = 0.f, a1 = 0.f;
#pragma unroll
                for (int d = 0; d < 32; ++d) { const f32x4 s = s4[d]; a0 = fmaf(q[d].x, s.x, a0); a1 = fmaf(q[d].y, s.y, a1); a0 = fmaf(q[d].z, s.z, a0); a1 = fmaf(q[d].w, s.w, a1); }
                WS_T[(size_t)(hp * 128 + ng * 32 + n) * 2048 + k] = (bf16)f2bf(a0 + a1); }
            LDS_WAIT(); asm volatile("" ::: "memory");
        }
        for (int m = gw; m < S_; m += 2 * NGW) rms_row2_to_bf16(in[0] + (size_t)m * DM, in[0] + (size_t)(m + NGW) * DM, in[1], XN + (size_t)m * DM, XN + (size_t)(m + NGW) * DM, lane);
    PHASE_END
    SEAM(0);
    PHASE_BEGIN(1)
        pg8::Gemm g{XN, WIN_T, S_, 10752, 2048, 2048, 2048}; pg8::StaticOrder S; S.init(S_, 10752, F.G, bidv);
        pg8::Epi<pg8::EM_G1> E{PR, PD, PG, nullptr, nullptr, nullptr, attn_body::C2};
        pg8::gemm_phase<pg8::Epi<pg8::EM_G1>, pg8::StaticOrder, true, true>(F.lds + RING_OFF, g, S, E, F.wave);
    PHASE_END
    SEAM(1);
    PHASE_BEGIN(2)
        const float* mu = in[3];
        for (int t = gw; t < S_; t += NGW) {
            const bf16* cur = PR + (size_t)t * 3584; const bf16* prv = cur - 3584;
#pragma unroll 1
            for (int j = 0; j < 7; ++j) { const int ch = lane + 64 * j; if (ch >= 440) break;
                const v4u c4 = *(const GAS v4u*)(cur + ch * 8); v4u p4 = (v4u){0u, 0u, 0u, 0u}; if (t > 0) p4 = *(const GAS v4u*)(prv + ch * 8);
                const f32x4 m0 = *(const f32x4*)(mu + ch * 8), m1 = *(const f32x4*)(mu + ch * 8 + 4);
                float c[8] = {pg8::bflo(c4.x), pg8::bfhi(c4.x), pg8::bflo(c4.y), pg8::bfhi(c4.y), pg8::bflo(c4.z), pg8::bfhi(c4.z), pg8::bflo(c4.w), pg8::bfhi(c4.w)};
                const float p[8] = {pg8::bflo(p4.x), pg8::bfhi(p4.x), pg8::bflo(p4.y), pg8::bfhi(p4.y), pg8::bflo(p4.z), pg8::bfhi(p4.z), pg8::bflo(p4.w), pg8::bfhi(p4.w)};
                const float mm[8] = {m0.x, m0.y, m0.z, m0.w, m1.x, m1.y, m1.z, m1.w};
#pragma unroll
                for (int e = 0; e < 8; ++e) c[e] = c[e] + (p[e] - c[e]) * mm[e];
                bf16* dst;
                if (ch < 384) dst = RKV + (size_t)t * 3072 + ch * 8;
                else { const int col = ch * 8 - 3072;
                    if (col < 96) { dst = LIN + (size_t)t * 768 + col;
#pragma unroll
                        for (int e = 0; e < 8; ++e) c[e] = tanhf(c[e]); }
                    else if (col < 192) dst = LIN + (size_t)t * 768 + 256 + (col - 96);
                    else { dst = LIN + (size_t)t * 768 + 512 + (col - 192);
#pragma unroll
                        for (int e = 0; e < 8; ++e) c[e] = sigmf(c[e]); } }
                *(GAS v4u*)dst = (v4u){pk2(c[0], c[1]), pk2(c[2], c[3]), pk2(c[4], c[5]), pk2(c[6], c[7])};
            }
            if (lane < 40) { const int z = lane < 20 ? 96 + lane * 8 : 352 + (lane - 20) * 8; *(GAS v4u*)(LIN + (size_t)t * 768 + z) = (v4u){0u, 0u, 0u, 0u}; }
        }
    PHASE_END
    SEAM(2);
    PHASE_BEGIN(3)
#pragma unroll 1
        for (int which = 0; which < 3; ++which) {
            int kd = 256; asm volatile("" : "+s"(kd));
            pg8::Gemm g{LIN + which * 256, LORA_T + (size_t)which * 1024 * 256, S_, 1024, kd, 768, 256}; pg8::StaticOrder S; S.init(S_, 1024, F.G, bidv);
            pg8::Epi<pg8::EM_LORA_W> E{ws + (which == 0 ? WS_E : (which == 1 ? WS_A : WS_G)), nullptr, nullptr, nullptr, nullptr, which == 0 ? in[4] : (which == 1 ? in[6] : nullptr), which == 0 ? 0.60653065971f : 1.f};
            pg8::gemm_phase<pg8::Epi<pg8::EM_LORA_W>, pg8::StaticOrder, true, true>(F.lds + RING_OFF, g, S, E, F.wave); }
    PHASE_END
    SEAM(3);
    PHASE_BEGIN(4)
        bf16* SCN = (bf16*)(ws + WS_SCN); float* SCAL = (float*)(ws + WS_SCAL); const bf16* Ab = (const bf16*)(ws + WS_A);
        for (int t = gw; t < S_; t += NGW) {
#pragma unroll 2
            for (int h = 0; h < 16; ++h) { const int cc = h * 64 + lane;
                const float r = bf2f(RKV[(size_t)t * 3072 + cc]), k = bf2f(RKV[(size_t)t * 3072 + 1024 + cc]), a = bf2f(Ab[(size_t)t * 1024 + cc]);
                float kk = k * in[9][cc]; const float nrm = sqrtf(wsum(kk * kk)); kk = kk / fmaxf(nrm, 1e-12f);
                const float kt = k * (1.f + (a - 1.f) * in[10][cc]); const float b = kk * a;
                const unsigned short kkb = (unsigned short)f2bf(-kk), bb = (unsigned short)f2bf(b), ktb = (unsigned short)f2bf(kt);
                bf16* q = SCN + ((size_t)h * S_ + t) * 192; q[lane] = kkb; q[64 + lane] = bb; q[128 + lane] = ktb;
                const float br = wsum(bf2f(bb) * r), kr = wsum(bf2f(ktb) * r), bon = wsum(r * kt * in[11][cc]);
                if (lane == 0) *(f32x4*)(SCAL + ((size_t)h * S_ + t) * 4) = (f32x4){br, kr, bon, 0.f}; }
        }
    PHASE_END
    SEAM(4);
    PHASE_BEGIN(5)
        scan4_phase(lane, F.wave, F.vcu, F.G, ws, ob, RKV, (LAS float*)(F.lds + RING_OFF));
    PHASE_END
    SEAM(5);
    PHASE_BEGIN(6)
        if (F.vcu < 16) { const int h = F.vcu; const int wv = F.wave;
            constexpr int PIT = 72;
            LAS bf16* Sb = (LAS bf16*)(F.lds + RING_OFF);
            LAS bf16* Atb = Sb + 2 * 64 * PIT;
            const float* SL = (const float*)(ws + WS_SLOC) + (size_t)h * NSEG * 4096; const bf16* AT = (const bf16*)(ws + WS_ASEG) + (size_t)h * NSEG * 4096; float* SI = (float*)(ws + WS_SIN) + (size_t)h * NSEG * 4096;
            for (int i = tid; i < 2 * 64 * PIT / 2; i += 512) ((LAS unsigned*)Sb)[i] = 0u;
#define P6_BAR() do { asm volatile("s_waitcnt lgkmcnt(0)" ::: "memory"); __builtin_amdgcn_s_barrier(); asm volatile("" ::: "memory"); } while (0)
            if (wv >= 4) {
                const int li = tid - 256, row = li >> 2, ch = li & 3;
                v4u r0a, r0b, r1a, r1b;
#define P6_LD(p, ra, rb) do { const bf16* s_ = AT + (size_t)(p) * 4096 + row * 64 + ch * 16; ra = *(const GAS v4u*)s_; rb = *(const GAS v4u*)(s_ + 8); } while (0)
#define P6_ST(p, ra, rb) do { LAS bf16* d_ = Atb + ((p) % 3) * 64 * PIT + row * PIT + ch * 16; *(LAS v4u*)d_ = ra; *(LAS v4u*)(d_ + 8) = rb; } while (0)
                P6_LD(0, r0a, r0b); P6_ST(0, r0a, r0b); P6_LD(1, r0a, r0b); P6_LD(2, r1a, r1b);
                P6_BAR();
#pragma unroll 1
                for (int p = 0; p < NSEG - 1; p += 2) {
                    if (p + 1 < NSEG - 1) P6_ST(p + 1, r0a, r0b); if (p + 3 < NSEG - 1) P6_LD(p + 3, r0a, r0b);
                    P6_BAR();
                    if (p + 1 < NSEG - 1) { if (p + 2 < NSEG - 1) P6_ST(p + 2, r1a, r1b); if (p + 4 < NSEG - 1) P6_LD(p + 4, r1a, r1b); P6_BAR(); }
                }
#undef P6_LD
#undef P6_ST
            } else {
                const int vt = wv >> 1, ct = wv & 1, r = lane & 31, hb = lane >> 5;
                typedef float f32x16 __attribute__((ext_vector_type(16)));
                f32x16 nl;
#define P6_LDL(p) do { const float* s_ = SL + (size_t)(p) * 4096 + (32 * vt + 4 * hb) * 64 + 32 * ct + r; _Pragma("unroll") for (int q = 0; q < 16; ++q) nl[q] = s_[((q & 3) + 8 * (q >> 2)) * 64]; } while (0)
                P6_LDL(0);
                { float* o_ = SI + (32 * vt + 4 * hb) * 64 + 32 * ct + r;
#pragma unroll
                  for (int q = 0; q < 16; ++q) o_[((q & 3) + 8 * (q >> 2)) * 64] = 0.f; }
                P6_BAR();
#pragma unroll 1
                for (int p = 0; p < NSEG - 1; ++p) {
                    const LAS bf16* sa_ = Sb + (p & 1) * 64 * PIT + (32 * vt + r) * PIT + 8 * hb; const LAS bf16* at_ = Atb + (p % 3) * 64 * PIT + (32 * ct + r) * PIT + 8 * hb;
                    f32x16 acc = nl; if (p + 1 < NSEG - 1) P6_LDL(p + 1);
#pragma unroll
                    for (int ks = 0; ks < 4; ++ks) { const bf16x8 af = *(const LAS bf16x8*)(sa_ + 16 * ks), bfr = *(const LAS bf16x8*)(at_ + 16 * ks);
                        acc = __builtin_amdgcn_mfma_f32_32x32x16_bf16(af, bfr, acc, 0, 0, 0); }
                    float* o_ = SI + (size_t)(p + 1) * 4096 + (32 * vt + 4 * hb) * 64 + 32 * ct + r; LAS bf16* sn_ = Sb + ((p + 1) & 1) * 64 * PIT + (32 * vt + 4 * hb) * PIT + 32 * ct + r;
#pragma unroll
                    for (int q = 0; q < 16; ++q) { const int rr = (q & 3) + 8 * (q >> 2); o_[rr * 64] = acc[q]; sn_[rr * PIT] = (unsigned short)f2bf(acc[q]); }
                    P6_BAR();
                }
#undef P6_LDL
            }
#undef P6_BAR
        }
    PHASE_END
    SEAM(6);
    PHASE_BEGIN(7)
        typedef float f32x16 __attribute__((ext_vector_type(16)));
        const int r = lane & 31, hb = lane >> 5;
        const bf16* ZZ = (const bf16*)(ws + WS_Z); const bf16* YL = (const bf16*)(ob + OUT_YLOC); const bf16* Gb = (const bf16*)(ws + WS_G); const float* SCAL = (const float*)(ws + WS_SCAL);
        bf16* YA = (bf16*)(ws + WS_YA);
        for (int task = gw; task < 16 * NSEG * 2; task += NGW) { const int h = task >> 7, seg = (task >> 1) & 63, half = task & 1;
            bf16x8 af[2][4];
            { const float* si = (const float*)(ws + WS_SIN) + ((size_t)h * NSEG + seg) * 4096;
#pragma unroll
              for (int vt = 0; vt < 2; ++vt)
#pragma unroll
                  for (int ks = 0; ks < 4; ++ks) { const f32x4 a = *(const f32x4*)(si + (32 * vt + r) * 64 + 16 * ks + 8 * hb), b = *(const f32x4*)(si + (32 * vt + r) * 64 + 16 * ks + 8 * hb + 4);
                      const v4u w = (v4u){pk2(a.x, a.y), pk2(a.z, a.w), pk2(b.x, b.y), pk2(b.z, b.w)}; af[vt][ks] = __builtin_bit_cast(bf16x8, w); } }
            f32x4 lg[2][4], lb[2][4];
#pragma unroll
            for (int vt = 0; vt < 2; ++vt)
#pragma unroll
                for (int qq = 0; qq < 4; ++qq) { lg[vt][qq] = *(const f32x4*)(in[12] + h * 64 + 32 * vt + 8 * qq + 4 * hb); lb[vt][qq] = *(const f32x4*)(in[13] + h * 64 + 32 * vt + 8 * qq + 4 * hb); }
#pragma unroll 1
            for (int tt = 0; tt < 4; ++tt) { const int t = seg * SEGLEN + half * 128 + tt * 32 + r; const size_t ht = (size_t)h * S_ + t;
                bf16x8 zf[4];
#pragma unroll
                for (int ks = 0; ks < 4; ++ks) zf[ks] = *(const bf16x8*)(ZZ + ht * 64 + 16 * ks + 8 * hb);
                f32x16 acc[2];
#pragma unroll
                for (int vt = 0; vt < 2; ++vt)
#pragma unroll
                    for (int qq = 0; qq < 4; ++qq) { const unsigned long long w = *(const GAS unsigned long long*)(YL + ht * 64 + 32 * vt + 8 * qq + 4 * hb);
                        acc[vt][4 * qq] = pg8::bflo((unsigned)w); acc[vt][4 * qq + 1] = pg8::bfhi((unsigned)w); acc[vt][4 * qq + 2] = pg8::bflo((unsigned)(w >> 32)); acc[vt][4 * qq + 3] = pg8::bfhi((unsigned)(w >> 32)); }
#pragma unroll
                for (int vt = 0; vt < 2; ++vt)
#pragma unroll
                    for (int ks = 0; ks < 4; ++ks) acc[vt] = __builtin_amdgcn_mfma_f32_32x32x16_bf16(af[vt][ks], zf[ks], acc[vt], 0, 0, 0);
                float s1 = 0.f;
#pragma unroll
                for (int vt = 0; vt < 2; ++vt)
#pragma unroll
                    for (int q = 0; q < 16; ++q) s1 += acc[vt][q];
                { auto rr = __builtin_amdgcn_permlane32_swap(__float_as_uint(s1), __float_as_uint(s1), false, false); s1 = __uint_as_float(rr[0]) + __uint_as_float(rr[1]); }
                const float mean = s1 * (1.f / 64.f); float s2 = 0.f;
#pragma unroll
                for (int vt = 0; vt < 2; ++vt)
#pragma unroll
                    for (int q = 0; q < 16; ++q) { acc[vt][q] -= mean; s2 += acc[vt][q] * acc[vt][q]; }
                { auto rr = __builtin_amdgcn_permlane32_swap(__float_as_uint(s2), __float_as_uint(s2), false, false); s2 = __uint_as_float(rr[0]) + __uint_as_float(rr[1]); }
                const float rstd = rsqrtf(s2 * (1.f / 64.f) + 64e-5f); const float bon = SCAL[ht * 4 + 2];
#pragma unroll
                for (int vt = 0; vt < 2; ++vt)
#pragma unroll
                    for (int qq = 0; qq < 4; ++qq) { const int vc = 32 * vt + 8 * qq + 4 * hb;
                        const unsigned long long vw = *(const GAS unsigned long long*)(RKV + (size_t)t * 3072 + 2048 + h * 64 + vc), gw_ = *(const GAS unsigned long long*)(Gb + (size_t)t * 1024 + h * 64 + vc);
                        const float vv[4] = {pg8::bflo((unsigned)vw), pg8::bfhi((unsigned)vw), pg8::bflo((unsigned)(vw >> 32)), pg8::bfhi((unsigned)(vw >> 32))};
                        const float gg[4] = {pg8::bflo((unsigned)gw_), pg8::bfhi((unsigned)gw_), pg8::bflo((unsigned)(gw_ >> 32)), pg8::bfhi((unsigned)(gw_ >> 32))};
                        float o[4];
#pragma unroll
                        for (int i = 0; i < 4; ++i) o[i] = (acc[vt][4 * qq + i] * rstd * lg[vt][qq][i] + lb[vt][qq][i] + bon * vv[i]) * gg[i];
                        *(GAS unsigned long long*)(YA + (size_t)t * 1024 + h * 64 + vc) = (unsigned long long)pk2(o[0], o[1]) | ((unsigned long long)pk2(o[2], o[3]) << 32); }
            }
        }
    PHASE_END
    SEAM(7);
    PHASE_BEGIN(8)
        __syncthreads();
        attn_body::attn_phase<8>((char*)lds + RING_OFF, (const attn_body::bf16*)PD, (attn_body::bf16*)(ws + WS_OATT), F.vcu, F.wave);
    PHASE_END
    SEAM(8);
    PHASE_BEGIN(9)
        float d1 = 0.f, d2 = 0.f; d1 = in[14][lane] * in[15][lane]; d2 = in[16][lane] * in[17][lane];
        const float lam = __expf(wave_sum(d1)) - __expf(wave_sum(d2)) + 0.2f;
        const bf16* OA = (const bf16*)(ws + WS_OATT); bf16* YB = (bf16*)(ws + WS_YB);
        f32x4 sg[4];
#pragma unroll
        for (int q = 0; q < 4; ++q) sg[q] = *(const f32x4*)(in[18] + (lane & 7) * 16 + q * 4);
        for (int t = gw; t < S_; t += NGW) {
            const v4u a0 = *(const GAS v4u*)(OA + (size_t)t * 2048 + lane * 16), a1 = *(const GAS v4u*)(OA + (size_t)t * 2048 + lane * 16 + 8);
            const v4u b0 = *(const GAS v4u*)(OA + (size_t)t * 2048 + 1024 + lane * 16), b1 = *(const GAS v4u*)(OA + (size_t)t * 2048 + 1024 + lane * 16 + 8);
            const unsigned aw[8] = {a0.x, a0.y, a0.z, a0.w, a1.x, a1.y, a1.z, a1.w}, bw[8] = {b0.x, b0.y, b0.z, b0.w, b1.x, b1.y, b1.z, b1.w};
            float o[16]; float ss = 0.f;
#pragma unroll
            for (int e = 0; e < 8; ++e) { o[2 * e] = pg8::bflo(aw[e]) - lam * pg8::bflo(bw[e]); o[2 * e + 1] = pg8::bfhi(aw[e]) - lam * pg8::bfhi(bw[e]); ss += o[2 * e] * o[2 * e] + o[2 * e + 1] * o[2 * e + 1]; }
            ss += __shfl_xor(ss, 1); ss += __shfl_xor(ss, 2); ss += __shfl_xor(ss, 4);
            const float rs = rsqrtf(ss * (1.f / 128.f) + 1e-5f) * 0.8f;
            const float gg[16] = {sg[0].x, sg[0].y, sg[0].z, sg[0].w, sg[1].x, sg[1].y, sg[1].z, sg[1].w, sg[2].x, sg[2].y, sg[2].z, sg[2].w, sg[3].x, sg[3].y, sg[3].z, sg[3].w};
#pragma unroll
            for (int e = 0; e < 16; ++e) o[e] = o[e] * rs * gg[e];
            *(GAS v4u*)(YB + (size_t)t * 1024 + lane * 16) = (v4u){pk2(o[0], o[1]), pk2(o[2], o[3]), pk2(o[4], o[5]), pk2(o[6], o[7])};
            *(GAS v4u*)(YB + (size_t)t * 1024 + lane * 16 + 8) = (v4u){pk2(o[8], o[9]), pk2(o[10], o[11]), pk2(o[12], o[13]), pk2(o[14], o[15])};
        }
    PHASE_END
    SEAM(9);
    PHASE_BEGIN(10)
        pg8::Gemm g{(const bf16*)(ws + WS_YA), WA_T, S_, 2048, 1024, 1024, 1024}; pg8::StaticOrder S; S.init(S_, 2048, F.G, bidv);
        pg8::Epi<pg8::EM_PROJA> E{ws + WS_T1, nullptr, nullptr, PG, nullptr, nullptr, 1.f};
        pg8::gemm_phase<pg8::Epi<pg8::EM_PROJA>, pg8::StaticOrder, true, true>(F.lds + RING_OFF, g, S, E, F.wave);
    PHASE_END
    SEAM(10);
    PHASE_BEGIN(11)
        pg8::Gemm g{(const bf16*)(ws + WS_YB), WB_T, S_, 2048, 1024, 1024, 1024}; pg8::StaticOrder S; S.init(S_, 2048, F.G, bidv);
        pg8::Epi<pg8::EM_PROJB> E{ws + WS_MERGED, nullptr, nullptr, PG, ws + WS_T1, nullptr, 1.f};
        pg8::gemm_phase<pg8::Epi<pg8::EM_PROJB>, pg8::StaticOrder, true, true>(F.lds + RING_OFF, g, S, E, F.wave);
    PHASE_END
    SEAM(11);
    PHASE_BEGIN(12)
        pg8::Gemm g{(const bf16*)(ws + WS_MERGED), WOUT_T, S_, 2048, 2048, 2048, 2048}; pg8::StaticOrder S; S.init(S_, 2048, F.G, bidv);
        pg8::Epi<pg8::EM_WOUT> E{ws + WS_H2, nullptr, nullptr, nullptr, in[0], nullptr, 1.f};
        pg8::gemm_phase<pg8::Epi<pg8::EM_WOUT>, pg8::StaticOrder, true, true>(F.lds + RING_OFF, g, S, E, F.wave);
    PHASE_END
    SEAM(12);
    PHASE_BEGIN(13)
        for (int m = gw; m < S_; m += 2 * NGW) rms_row2_to_bf16((const float*)(ws + WS_H2) + (size_t)m * DM, (const float*)(ws + WS_H2) + (size_t)(m + NGW) * DM, in[22], (bf16*)(ws + WS_XN2) + (size_t)m * DM, (bf16*)(ws + WS_XN2) + (size_t)(m + NGW) * DM, lane);
        for (int row = gw; row < 32768; row += NGW) { const int which = row >> 14, r = row & 16383;
            const f32x4* src = (const f32x4*)(in[25 + which] + (size_t)r * 2048) + lane; f32x4 v[8]; float am = 0.f;
#pragma unroll
            for (int j = 0; j < 8; ++j) { v[j] = __builtin_nontemporal_load(src + 64 * j); am = fmaxf(am, fmaxf(fmaxf(fabsf(v[j].x), fabsf(v[j].y)), fmaxf(fabsf(v[j].z), fabsf(v[j].w)))); }
            const unsigned tb = __float_as_uint(am * (1.f / 6.f)); unsigned eb = (tb >> 23) + ((tb & 0x7fffffu) ? 1u : 0u); eb = eb < 1u ? 1u : (eb > 254u ? 254u : eb);
            const float sc = __uint_as_float(eb << 23);
            unsigned wd[4];
#pragma unroll
            for (int w = 0; w < 4; ++w) { unsigned q = 0u;
                q = __builtin_amdgcn_cvt_scalef32_pk_fp4_f32(q, v[2 * w].x, v[2 * w].y, sc, 0); q = __builtin_amdgcn_cvt_scalef32_pk_fp4_f32(q, v[2 * w].z, v[2 * w].w, sc, 1);
                q = __builtin_amdgcn_cvt_scalef32_pk_fp4_f32(q, v[2 * w + 1].x, v[2 * w + 1].y, sc, 2); q = __builtin_amdgcn_cvt_scalef32_pk_fp4_f32(q, v[2 * w + 1].z, v[2 * w + 1].w, sc, 3); wd[w] = q; }
            *(GAS v4u*)(ws + (which ? WS_VTAB : WS_UTAB) + (size_t)r * 1024 + lane * 16) = (v4u){wd[0], wd[1], wd[2], wd[3]};
            ((unsigned char*)(ws + (which ? WS_VSCL : WS_USCL)))[(size_t)r * 64 + lane] = (unsigned char)eb; }
    PHASE_END
    SEAM(13);
    PHASE_BEGIN(14)
        pg8::Gemm g{(const bf16*)(ws + WS_XN2), WS_T, S_, 2048, 2048, 2048, 2048}; pg8::StaticOrder S; S.init(S_, 2048, F.G, bidv);
        pg8::Epi<pg8::EM_SCORES> E{ws + WS_SCORES, nullptr, nullptr, nullptr, nullptr, nullptr, 1.f};
        pg8::gemm_phase<pg8::Epi<pg8::EM_SCORES>, pg8::StaticOrder, true, true>(F.lds + RING_OFF, g, S, E, F.wave);
    PHASE_END
    SEAM(14);
    PHASE_BEGIN(15)
        const float* SC = (const float*)(ws + WS_SCORES); const bf16* XN2 = (const bf16*)(ws + WS_XN2);
        const unsigned char* UT = (const unsigned char*)(ws + WS_UTAB); const unsigned char* VT = (const unsigned char*)(ws + WS_VTAB);
        const unsigned char* USB = (const unsigned char*)(ws + WS_USCL); const unsigned char* VSB = (const unsigned char*)(ws + WS_VSCL);
        LAS unsigned* lst = (LAS unsigned*)(F.lds + RING_OFF + F.wave * 10240);
        for (int tb = gw; tb < S_ / 8; tb += NGW) {
            { const int tl = lane >> 3, h = lane & 7; const float* srow = SC + (size_t)(tb * 8 + tl) * 2048 + h * 256;
              float A[16], B[16];
#pragma unroll
              for (int p = 0; p < 2; ++p) { float top[16];
#pragma unroll
                  for (int k = 0; k < 16; ++k) top[k] = -INFINITY;
#pragma unroll 2
                  for (int i4 = 0; i4 < 32; ++i4) { const f32x4 v = *(const f32x4*)(srow + p * 128 + i4 * 4); const float ve[4] = {v.x, v.y, v.z, v.w};
#pragma unroll
                      for (int e = 0; e < 4; ++e) { float x = __uint_as_float((__float_as_uint(ve[e]) & 0xffffff80u) | (unsigned)(i4 * 4 + e));
#pragma unroll
                          for (int k = 0; k < 16; ++k) { const float hi = fmaxf(top[k], x); x = fminf(top[k], x); top[k] = hi; } } }
#pragma unroll
                  for (int k = 0; k < 16; ++k) { if (p == 0) A[k] = top[k]; else B[k] = top[k]; } }
              LAS unsigned* ixl = (LAS unsigned*)(F.lds + RING_OFF + F.wave * 10240 + 8192) + lane * 8;
              { unsigned wa[4], wb[4];
#pragma unroll
                for (int q = 0; q < 4; ++q) { wa[q] = 0u; wb[q] = 0u;
#pragma unroll
                    for (int e = 0; e < 4; ++e) { wa[q] |= (__float_as_uint(A[q * 4 + e]) & 127u) << (8 * e); wb[q] |= (__float_as_uint(B[q * 4 + e]) & 127u) << (8 * e); } }
                *(LAS v4u*)ixl = (v4u){wa[0], wa[1], wa[2], wa[3]}; *(LAS v4u*)(ixl + 4) = (v4u){wb[0], wb[1], wb[2], wb[3]}; }
              float cs[16];
#pragma unroll
              for (int k = 0; k < 16; ++k) cs[k] = -INFINITY;
#pragma unroll
              for (int i = 0; i < 16; ++i)
#pragma unroll
                  for (int j = 0; j < 16; ++j) if ((i + 1) * (j + 1) <= 16) {
                      float x = __uint_as_float((__float_as_uint(A[i] + B[j]) & 0xffffff00u) | (unsigned)(i * 16 + j));
#pragma unroll
                      for (int k = 0; k < 16; ++k) { const float hi = fmaxf(cs[k], x); x = fminf(cs[k], x); cs[k] = hi; } }
              LDS_WAIT(); asm volatile("" ::: "memory");
              const LAS unsigned char* ixb = (const LAS unsigned char*)ixl;
              unsigned cx[16]; float gsum = 0.f; const float cmax = cs[0];
#pragma unroll
              for (int k = 0; k < 16; ++k) { const unsigned ij = __float_as_uint(cs[k]) & 255u; cx[k] = ((unsigned)ixb[ij >> 4] << 7) | (unsigned)ixb[16 + (ij & 15u)]; cs[k] = __expf(cs[k] - cmax); gsum += cs[k]; }
              const float ginv = 1.f / gsum; LAS unsigned* lp = lst + (tl * 128 + h * 16) * 2;
#pragma unroll
              for (int k = 0; k < 16; k += 2) *(LAS v4u*)(lp + k * 2) = (v4u){cx[k], __float_as_uint(cs[k] * ginv), cx[k + 1], __float_as_uint(cs[k + 1] * ginv)}; }
            LDS_WAIT(); asm volatile("" ::: "memory");
#pragma unroll 1
            for (int tl = 0; tl < 8; ++tl) { const int t = tb * 8 + tl;
                float xf[32];
#pragma unroll
                for (int j = 0; j < 8; ++j) { const unsigned long long w = *(const GAS unsigned long long*)(XN2 + (size_t)t * 2048 + 256 * j + 4 * lane);
                    xf[4 * j] = pg8::bflo((unsigned)w); xf[4 * j + 1] = pg8::bfhi((unsigned)w); xf[4 * j + 2] = pg8::bflo((unsigned)(w >> 32)); xf[4 * j + 3] = pg8::bfhi((unsigned)(w >> 32)); }
                float acc[32];
#pragma unroll
                for (int e = 0; e < 32; ++e) acc[e] = 0.f;
                constexpr int EG = 8;
#pragma unroll 1
                for (int e0 = 0; e0 < 128; e0 += EG) {
                    v4u ur[EG], vr[EG]; float gate[EG]; unsigned char sub[EG], svb[EG];
#pragma unroll
                    for (int q = 0; q < EG; ++q) { const unsigned idx = __builtin_amdgcn_readfirstlane(lst[(tl * 128 + e0 + q) * 2]); gate[q] = __uint_as_float(__builtin_amdgcn_readfirstlane(lst[(tl * 128 + e0 + q) * 2 + 1]));
                        ur[q] = *(const GAS v4u*)(UT + (size_t)idx * 1024 + lane * 16); vr[q] = *(const GAS v4u*)(VT + (size_t)idx * 1024 + lane * 16);
                        sub[q] = USB[(size_t)idx * 64 + lane]; svb[q] = VSB[(size_t)idx * 64 + lane]; }
#pragma unroll
                    for (int q = 0; q < EG; ++q) { float d0 = 0.f, d1 = 0.f; const float su = __uint_as_float((unsigned)sub[q] << 23), sv = __uint_as_float((unsigned)svb[q] << 23);
                        const unsigned uw[4] = {ur[q].x, ur[q].y, ur[q].z, ur[q].w};
#pragma unroll
                        for (int w = 0; w < 4; ++w) {
                            const auto p0 = __builtin_amdgcn_cvt_scalef32_pk_f32_fp4(uw[w], su, 0), p1 = __builtin_amdgcn_cvt_scalef32_pk_f32_fp4(uw[w], su, 1), p2 = __builtin_amdgcn_cvt_scalef32_pk_f32_fp4(uw[w], su, 2), p3 = __builtin_amdgcn_cvt_scalef32_pk_f32_fp4(uw[w], su, 3);
                            d0 = fmaf(xf[8 * w], p0[0], d0); d1 = fmaf(xf[8 * w + 1], p0[1], d1); d0 = fmaf(xf[8 * w + 2], p1[0], d0); d1 = fmaf(xf[8 * w + 3], p1[1], d1);
                            d0 = fmaf(xf[8 * w + 4], p2[0], d0); d1 = fmaf(xf[8 * w + 5], p2[1], d1); d0 = fmaf(xf[8 * w + 6], p3[0], d0); d1 = fmaf(xf[8 * w + 7], p3[1], d1); }
                        const float d = wsum(d0 + d1);
                        const float act = 0.5f * d * (1.f + erff(d * 0.70710678118f)); const float cf = gate[q] * act; const float cs = cf * sv;
                        const unsigned vw[4] = {vr[q].x, vr[q].y, vr[q].z, vr[q].w};
#pragma unroll
                        for (int w = 0; w < 4; ++w) {
                            const auto p0 = __builtin_amdgcn_cvt_scalef32_pk_f32_fp4(vw[w], 1.0f, 0), p1 = __builtin_amdgcn_cvt_scalef32_pk_f32_fp4(vw[w], 1.0f, 1), p2 = __builtin_amdgcn_cvt_scalef32_pk_f32_fp4(vw[w], 1.0f, 2), p3 = __builtin_amdgcn_cvt_scalef32_pk_f32_fp4(vw[w], 1.0f, 3);
                            acc[8 * w] = fmaf(cs, p0[0], acc[8 * w]); acc[8 * w + 1] = fmaf(cs, p0[1], acc[8 * w + 1]); acc[8 * w + 2] = fmaf(cs, p1[0], acc[8 * w + 2]); acc[8 * w + 3] = fmaf(cs, p1[1], acc[8 * w + 3]);
                            acc[8 * w + 4] = fmaf(cs, p2[0], acc[8 * w + 4]); acc[8 * w + 5] = fmaf(cs, p2[1], acc[8 * w + 5]); acc[8 * w + 6] = fmaf(cs, p3[0], acc[8 * w + 6]); acc[8 * w + 7] = fmaf(cs, p3[1], acc[8 * w + 7]); }
                    }
                }
                float* orow = args.out + (size_t)t * 2048; const float* hrow = (const float*)(ws + WS_H2) + (size_t)t * 2048; float ss = 0.f;
#pragma unroll
                for (int j = 0; j < 8; ++j) { const f32x4 a = *(const f32x4*)(hrow + 256 * j + 4 * lane);
                    acc[4 * j] += a.x; acc[4 * j + 1] += a.y; acc[4 * j + 2] += a.z; acc[4 * j + 3] += a.w; }
#pragma unroll
                for (int e = 0; e < 32; ++e) ss += acc[e] * acc[e];
                const float rstd = rsqrtf(wsum(ss) * (1.f / 2048.f) + 1e-6f);
#pragma unroll
                for (int j = 0; j < 8; ++j) { const f32x4 g0 = *(const f32x4*)(in[27] + 256 * j + 4 * lane);
                    *(f32x4*)(orow + 256 * j + 4 * lane) = (f32x4){acc[4 * j] * rstd * g0.x, acc[4 * j + 1] * rstd * g0.y, acc[4 * j + 2] * rstd * g0.z, acc[4 * j + 3] * rstd * g0.w}; }
            }
            LDS_WAIT(); asm volatile("" ::: "memory");
        }
    PHASE_END
#undef IN
#undef SEAM
}

extern "C" void kernel_launch(void* const* d_in, const int* in_sizes, int n_in, void* d_out, int out_size, void* d_ws, size_t ws_size, hipStream_t stream) {
    static int grid = 0;
    if (grid == 0) {
        if (n_in != 28 || in_sizes[0] != S_ * DM || out_size != S_ * DM || ws_size < WS_END) { fprintf(stderr, "kernel_launch: unexpected shapes: n_in %d in0 %d out %d ws %zu (need >= %zu)\n", n_in, n_in > 0 ? in_sizes[0] : -1, out_size, ws_size, (size_t)WS_END); grid = -1; return; }
        if (hipFuncSetAttribute((const void*)mk_fwd, hipFuncAttributeMaxDynamicSharedMemorySize, LDS_BYTES) != hipSuccess) { fprintf(stderr, "kernel_launch: hipFuncSetAttribute failed\n"); grid = -1; return; }
        int per_cu = 0;
        if (hipOccupancyMaxActiveBlocksPerMultiprocessor(&per_cu, (const void*)mk_fwd, NWAVES * 64, LDS_BYTES) != hipSuccess || per_cu < 1) fprintf(stderr, "kernel_launch: note: occupancy query reports %d\n", per_cu);
        (void)hipGetLastError();
        grid = 256;
    }
    if (grid < 0) return;
    (void)hipMemsetAsync((char*)d_ws + WS_CTL, 0, CTL_ZERO_BYTES, stream);
    Args a{};
    for (int i = 0; i < 28; ++i) a.in[i] = (const float*)d_in[i];
    a.out = (float*)d_out; a.ws = (unsigned char*)d_ws;
#if MK_PER_PHASE
    for (int p = 0; p < NPH; ++p) { a.ph_lo = p; a.ph_hi = p + 1; hipLaunchKernelGGL(mk_fwd, dim3(grid), dim3(NWAVES * 64), LDS_BYTES, stream, a); }
#else
    a.ph_lo = 0; a.ph_hi = NPH; hipLaunchKernelGGL(mk_fwd, dim3(grid), dim3(NWAVES * 64), LDS_BYTES, stream, a);
#endif
    const hipError_t le = hipPeekAtLastError();
    if (le != hipSuccess) fprintf(stderr, "kernel_launch: launch failed: %s\n", hipGetErrorName(le));
}
```

```cpp
#include <hip/hip_runtime.h>
#include <cstdio>
#include <cstdint>
__device__ __forceinline__ int mk_lane_id() { int l; asm volatile("v_mbcnt_lo_u32_b32 %0, -1, 0\n\tv_mbcnt_hi_u32_b32 %0, -1, %0" : "=v"(l)); return l; }
namespace pg8 {
#define PG8_LAS __attribute__((address_space(3)))
typedef unsigned short bf16_t;
typedef short bf16x8 __attribute__((ext_vector_type(8)));
typedef float f32x4 __attribute__((ext_vector_type(4)));
typedef unsigned u32x4 __attribute__((ext_vector_type(4)));
constexpr int BM = 256, BK = 64, HALF = 128, HTB = HALF * BK * 2  , STAGE_BYTES = 8 * HTB, NXCD = 8, WGM = 8;

__host__ __device__ __forceinline__ int lds_byte(int r, int c) { const int st = (r >> 4) * 2 + (c >> 5), rr = r & 15, cc = c & 31, ob = rr * 64 + cc * 2; return st * 1024 + (ob ^ (((ob >> 9) & 1) << 5)); }
__host__ __device__ __forceinline__ void stage_rc(int b, int& R, int& C) { const int st = b / 1024, sb = b % 1024, swz = sb ^ (((sb >> 9) & 1) << 5); R = (st >> 1) * 16 + swz / 64; C = (st & 1) * 32 + (swz % 64) / 2; }
__host__ __device__ __forceinline__ int perm32(int rho) { const int n = rho >> 4, i = rho & 15; return 8 * (i >> 2) + 4 * n + (i & 3); }

struct Unit { int pm, pn; };
struct Gemm { const bf16_t* A; const bf16_t* Bt; int M, N, K, lda, ldb; const bf16_t* A2; int ksplit; };

struct StaticOrder {
    int nM, nN, nwg, G, c;
    __host__ __device__ void init(int M, int N, int G_, int c_) { nM = M / BM; nN = N / BM; nwg = nM * nN; G = G_; c = c_; }
    __host__ __device__ bool next(int i, Unit& u) const {
        const long L = (long)i * G + c; if (L >= nwg) return false;
        int wgid = (int)L; { const int q = nwg / NXCD, r = nwg % NXCD, xcd = wgid % NXCD, off = wgid / NXCD; wgid = (xcd < r ? xcd * (q + 1) : r * (q + 1) + (xcd - r) * q) + off; }
        const int nig = WGM * nN, gid = wgid / nig, fm = gid * WGM, gsz = (nM - fm) < WGM ? (nM - fm) : WGM;
        u.pm = fm + ((wgid % nig) % gsz); u.pn = (wgid % nig) / gsz; return true;
    }
    __device__ __forceinline__ void a_ready(const Unit&) const {}
    __device__ __forceinline__ void done(const Unit&) const {}
};

__device__ __forceinline__ unsigned cvt_pk_bf16(float lo, float hi) { unsigned r; asm volatile("v_cvt_pk_bf16_f32 %0, %1, %2" : "=v"(r) : "v"(lo), "v"(hi)); return r; }
__device__ __forceinline__ float sigm(float x) { return __builtin_amdgcn_rcpf(1.0f + __expf(-x)); }
__device__ __forceinline__ float bflo(unsigned w) { return __uint_as_float(w << 16); }
__device__ __forceinline__ float bfhi(unsigned w) { return __uint_as_float(w & 0xffff0000u); }
enum { EM_G1 = 0, EM_LORA_W = 1, EM_LORA_A = 2, EM_LORA_G = 3, EM_PROJA = 4, EM_PROJB = 5, EM_WOUT = 6, EM_SCORES = 7, EM_PROJAB = 8 };
template <int MODE> struct Epi {
    static constexpr bool PERM = true, AFTER_DRAIN = false, HAS_MID = (MODE == EM_PROJAB);
    __device__ __forceinline__ void mid(f32x4 (&acc)[2][2][4][2], const Unit& u, int wr, int wc, int fr, int fq) const {
        asm volatile("" ::: "memory");
        int row0 = u.pm * BM + wr * 64 + fr, col0 = u.pn * BM + wc * 32 + 8 * fq; asm volatile("" : "+v"(row0), "+v"(col0));
#pragma unroll
        for (int ai = 0; ai < 2; ++ai) { asm volatile("" ::: "memory");
#pragma unroll
            for (int m = 0; m < 4; ++m) { const size_t row = (size_t)(row0 + ai * HALF + m * 16);
#pragma unroll
                for (int bj = 0; bj < 2; ++bj) { const int col = col0 + bj * HALF;
                    const u32x4 ga = *(const u32x4*)((const bf16_t*)i0 + row * 4096 + col), gb = *(const u32x4*)((const bf16_t*)i0 + row * 4096 + 2048 + col);
                    const unsigned aw[4] = {ga.x, ga.y, ga.z, ga.w}, bw[4] = {gb.x, gb.y, gb.z, gb.w};
#pragma unroll
                    for (int w = 0; w < 4; ++w) { const float r0 = bflo(aw[w]) * __builtin_amdgcn_rcpf(fmaxf(bflo(bw[w]), 1e-30f)), r1 = bfhi(aw[w]) * __builtin_amdgcn_rcpf(fmaxf(bfhi(bw[w]), 1e-30f));
                        acc[ai][bj][m][w >> 1][2 * (w & 1)] *= r0; acc[ai][bj][m][w >> 1][2 * (w & 1) + 1] *= r1; } } } }
        asm volatile("" ::: "memory");
    }
    void* o0; void* o1; void* o2; const void* i0; const void* i1; const float* vec; float sc;
    __device__ __forceinline__ void operator()(const f32x4 (&acc)[2][2][4][2], const Unit& u, int wr, int wc, int fr, int fq) const {
        asm volatile("" ::: "memory");
        int row0 = u.pm * BM + wr * 64 + fr; asm volatile("" : "+v"(row0));
        int colt = u.pn * BM; int ldc = 2048; int sub = 0;
        bf16_t* ob = (bf16_t*)o0; float scl = 1.f;
        if (MODE == EM_G1) {
            if (u.pn < 14) { ldc = 3584; }
            else if (u.pn < 26) { ob = (bf16_t*)o1; ldc = 3072; colt -= 14 * BM; if (u.pn < 18) scl = sc; }
            else { ob = (bf16_t*)o2; ldc = 4096; colt -= 26 * BM; sub = 1; }
        }
        if (MODE == EM_LORA_W || MODE == EM_LORA_A || MODE == EM_LORA_G) ldc = 1024;
        const int col0 = colt + wc * 32 + 8 * fq;
#pragma unroll
        for (int ai = 0; ai < 2; ++ai)
#pragma unroll
            for (int m = 0; m < 4; ++m) { const size_t row = (size_t)(row0 + ai * HALF + m * 16);
#pragma unroll
                for (int bj = 0; bj < 2; ++bj) { f32x4 v0 = acc[ai][bj][m][0], v1 = acc[ai][bj][m][1]; const int col = col0 + bj * HALF;
                    if (MODE == EM_G1) {
                        if (sub) { v0 = (f32x4){sigm(v0[0]), sigm(v0[1]), sigm(v0[2]), sigm(v0[3])}; v1 = (f32x4){sigm(v1[0]), sigm(v1[1]), sigm(v1[2]), sigm(v1[3])}; }
                        else { v0 = v0 * scl; v1 = v1 * scl; }
                        u32x4 w; w.x = cvt_pk_bf16(v0[0], v0[1]); w.y = cvt_pk_bf16(v0[2], v0[3]); w.z = cvt_pk_bf16(v1[0], v1[1]); w.w = cvt_pk_bf16(v1[2], v1[3]);
                        *(u32x4*)(ob + row * ldc + col) = w;
                    } else if (MODE == EM_LORA_W) {
                        if (vec) { const f32x4 b0 = *(const f32x4*)(vec + col), b1 = *(const f32x4*)(vec + col + 4);
                            v0 = v0 + b0; v1 = v1 + b1;
                            v0 = (f32x4){sigm(v0[0]), sigm(v0[1]), sigm(v0[2]), sigm(v0[3])}; v1 = (f32x4){sigm(v1[0]), sigm(v1[1]), sigm(v1[2]), sigm(v1[3])};
                            v0 = v0 * sc; v1 = v1 * sc; }
                        u32x4 w; w.x = cvt_pk_bf16(v0[0], v0[1]); w.y = cvt_pk_bf16(v0[2], v0[3]); w.z = cvt_pk_bf16(v1[0], v1[1]); w.w = cvt_pk_bf16(v1[2], v1[3]);
                        *(u32x4*)(ob + row * ldc + col) = w;
                    } else if (MODE == EM_PROJA) {
                        const u32x4 g = *(const u32x4*)((const bf16_t*)i0 + row * 4096 + col);
                        float* op = (float*)o0 + row * 2048 + col;
                        *(f32x4*)op = (f32x4){v0[0] * bflo(g.x), v0[1] * bfhi(g.x), v0[2] * bflo(g.y), v0[3] * bfhi(g.y)};
                        *(f32x4*)(op + 4) = (f32x4){v1[0] * bflo(g.z), v1[1] * bfhi(g.z), v1[2] * bflo(g.w), v1[3] * bfhi(g.w)};
                    } else if (MODE == EM_PROJB) {
                        const u32x4 g = *(const u32x4*)((const bf16_t*)i0 + row * 4096 + 2048 + col);
                        const float* tp = (const float*)i1 + row * 2048 + col; const f32x4 t0 = *(const f32x4*)tp, t1 = *(const f32x4*)(tp + 4);
                        v0 = (f32x4){t0[0] + v0[0] * bflo(g.x), t0[1] + v0[1] * bfhi(g.x), t0[2] + v0[2] * bflo(g.y), t0[3] + v0[3] * bfhi(g.y)};
                        v1 = (f32x4){t1[0] + v1[0] * bflo(g.z), t1[1] + v1[1] * bfhi(g.z), t1[2] + v1[2] * bflo(g.w), t1[3] + v1[3] * bfhi(g.w)};
                        u32x4 w; w.x = cvt_pk_bf16(v0[0], v0[1]); w.y = cvt_pk_bf16(v0[2], v0[3]); w.z = cvt_pk_bf16(v1[0], v1[1]); w.w = cvt_pk_bf16(v1[2], v1[3]);
                        *(u32x4*)(ob + row * 2048 + col) = w;
                    } else if (MODE == EM_PROJAB) {
                        const u32x4 g = *(const u32x4*)((const bf16_t*)i0 + row * 4096 + 2048 + col);
                        v0 = (f32x4){v0[0] * bflo(g.x), v0[1] * bfhi(g.x), v0[2] * bflo(g.y), v0[3] * bfhi(g.y)};
                        v1 = (f32x4){v1[0] * bflo(g.z), v1[1] * bfhi(g.z), v1[2] * bflo(g.w), v1[3] * bfhi(g.w)};
                        u32x4 w; w.x = cvt_pk_bf16(v0[0], v0[1]); w.y = cvt_pk_bf16(v0[2], v0[3]); w.z = cvt_pk_bf16(v1[0], v1[1]); w.w = cvt_pk_bf16(v1[2], v1[3]);
                        *(u32x4*)(ob + row * 2048 + col) = w;
                    } else if (MODE == EM_WOUT) {
                        const float* xp = (const float*)i1 + row * 2048 + col; const f32x4 t0 = *(const f32x4*)xp, t1 = *(const f32x4*)(xp + 4);
                        float* op = (float*)o0 + row * 2048 + col; *(f32x4*)op = t0 + v0; *(f32x4*)(op + 4) = t1 + v1;
                    } else {
                        float* op = (float*)o0 + row * 2048 + col; *(f32x4*)op = v0; *(f32x4*)(op + 4) = v1;
                    }
                } }
    }
};

template <class Epi, class Sched, bool ALIGN_EPI = false, bool SP2 = false>
__device__ __forceinline__ void gemm_phase(PG8_LAS unsigned char* lds, const Gemm g, const Sched& S, const Epi& E, const int wid_in) {
    int tid_ = wid_in * 64 + mk_lane_id(); asm volatile("" : "+v"(tid_)); const int tid = tid_, wid = __builtin_amdgcn_readfirstlane(tid >> 6), lane = tid & 63, wr = wid >> 2, wc = wid & 3, fr = lane & 15, fq = lane >> 4;
    const int K = g.K, nt = K / BK;
    unsigned voffA[2], voffB[2];
#pragma unroll
    for (int i = 0; i < 2; ++i) { int R, C; stage_rc(tid * 16 + i * 8192, R, C); const int Rb = Epi::PERM ? ((R & ~31) + perm32(R & 31)) : R;
        voffA[i] = (unsigned)(R * g.lda + C) * 2u; voffB[i] = (unsigned)(Rb * g.ldb + C) * 2u; }
    const size_t kstep = (size_t)(BK * 2);
    const size_t hstepA = (size_t)HALF * g.lda * 2, hstepB = (size_t)HALF * g.ldb * 2;
    const size_t tstepA = 2 * hstepA, tstepB = 2 * hstepB;
    const unsigned ldsw = (unsigned)wid * 1024u;
    const int aoff = lds_byte(wr * 64 + fr, fq * 8), boff = lds_byte(wc * 32 + fr, fq * 8);
#define PG8_SA(b, h) (((b) * 2 + (h)) * HTB)
#define PG8_SB(b, h) ((4 + (b) * 2 + (h)) * HTB)
#define PG8_STAGE(bufoff, gbase, voff) do { _Pragma("unroll") for (int _i = 0; _i < 2; ++_i) \
        __builtin_amdgcn_global_load_lds((const unsigned*)((const char*)(gbase) + (voff)[_i]), (PG8_LAS unsigned*)(lds + (bufoff) + ldsw + _i * 8192), 16, 0, 0); } while (0)
#define PG8_LDA(dst, b, h) do { _Pragma("unroll") for (int m = 0; m < 4; ++m) _Pragma("unroll") for (int k = 0; k < 2; ++k) dst[m][k] = *(const PG8_LAS bf16x8*)(lds + PG8_SA(b, h) + aoff + m * 2048 + k * 1024); } while (0)
#define PG8_LDB(dst, b, h) do { _Pragma("unroll") for (int n = 0; n < 2; ++n) _Pragma("unroll") for (int k = 0; k < 2; ++k) dst[n][k] = *(const PG8_LAS bf16x8*)(lds + PG8_SB(b, h) + boff + n * 2048 + k * 1024); } while (0)
#define PG8_MMA(ai, bj, At, Bt) do { __builtin_amdgcn_s_setprio(1); _Pragma("unroll") for (int m = 0; m < 4; ++m) _Pragma("unroll") for (int n = 0; n < 2; ++n) _Pragma("unroll") for (int k = 0; k < 2; ++k) \
        acc[ai][bj][m][n] = __builtin_amdgcn_mfma_f32_16x16x32_bf16(Bt[n][k], At[m][k], acc[ai][bj][m][n], 0, 0, 0); __builtin_amdgcn_s_setprio(0); } while (0)
#define PG8_WAIT_V(n) asm volatile("s_waitcnt vmcnt(" #n ")" ::: "memory")
#define PG8_WAIT_L(n) asm volatile("s_waitcnt lgkmcnt(" #n ")" ::: "memory")
#define PG8_BAR __builtin_amdgcn_s_barrier()
#define PG8_SCHED __builtin_amdgcn_sched_barrier(0)
    Unit cur, nxt; int ui = 0;
    if (!S.next(0, cur)) return;
    f32x4 acc[2][2][4][2];
#pragma unroll
    for (int a = 0; a < 2; ++a)
#pragma unroll
        for (int b = 0; b < 2; ++b)
#pragma unroll
            for (int m = 0; m < 4; ++m)
#pragma unroll
                for (int n = 0; n < 2; ++n) acc[a][b][m][n] = (f32x4){0.f, 0.f, 0.f, 0.f};
    bf16x8 At[4][2], B0[2][2], B1[2][2];
    const char* cA = (const char*)g.A + (size_t)cur.pm * tstepA; const char* cB = (const char*)g.Bt + (size_t)cur.pn * tstepB;
    const int ksplit = g.A2 ? g.ksplit : 0x40000000;
    const char* cA2 = g.A2 ? (const char*)g.A2 + (size_t)cur.pm * tstepA - (size_t)ksplit * kstep : cA;
    S.a_ready(cur);
    if constexpr (SP2) {
        PG8_STAGE(PG8_SB(0, 0), cB, voffB); PG8_STAGE(PG8_SB(0, 1), cB + hstepB, voffB); PG8_STAGE(PG8_SA(0, 0), cA, voffA); PG8_STAGE(PG8_SA(0, 1), cA + hstepA, voffA);
        if (wr == 1) PG8_BAR;
        PG8_WAIT_V(2); PG8_BAR;
        PG8_STAGE(PG8_SB(1, 0), cB + kstep, voffB); PG8_STAGE(PG8_SA(1, 0), cA + kstep, voffA); PG8_STAGE(PG8_SB(1, 1), cB + hstepB + kstep, voffB);
        PG8_WAIT_V(6); PG8_BAR;
    } else {
        PG8_STAGE(PG8_SB(0, 0), cB, voffB); PG8_STAGE(PG8_SA(0, 0), cA, voffA); PG8_STAGE(PG8_SB(0, 1), cB + hstepB, voffB); PG8_STAGE(PG8_SA(0, 1), cA + hstepA, voffA);
        if (wr == 1) PG8_BAR;
        PG8_WAIT_V(4); PG8_BAR;
        PG8_STAGE(PG8_SB(1, 0), cB + kstep, voffB); PG8_STAGE(PG8_SA(1, 0), cA + kstep, voffA); PG8_STAGE(PG8_SB(1, 1), cB + hstepB + kstep, voffB);
        PG8_WAIT_V(6); PG8_BAR;
    }
    for (;;) {
        const bool has_next = S.next(ui + 1, nxt);
        const char* nA2 = (g.A2 && has_next) ? (const char*)g.A2 + (size_t)nxt.pm * tstepA - (size_t)ksplit * kstep : cA2;
        const char* nA = has_next ? (const char*)g.A + (size_t)nxt.pm * tstepA : cA; const char* nB = has_next ? (const char*)g.Bt + (size_t)nxt.pn * tstepB : cB;
#pragma unroll 1
        for (int part = 0; part < (Epi::HAS_MID ? 2 : 1); ++part) {
        if constexpr (Epi::HAS_MID) { if (part == 1) E.mid(acc, cur, wr, wc, fr, fq); }
        const int tbeg = (Epi::HAS_MID && part == 1) ? ksplit : 0, tend = (Epi::HAS_MID && part == 0) ? (ksplit < nt ? ksplit : nt) : nt;
#pragma unroll 1
        for (int t = tbeg; t < tend; t += 2) {
            const bool last = (t == nt - 2);
            const char* a1 = (t + 1 < ksplit ? cA : cA2) + (size_t)(t + 1) * kstep;
            const char* a2 = last ? nA : (t + 2 < ksplit ? cA : cA2) + (size_t)(t + 2) * kstep; const char* b2 = last ? nB : cB + (size_t)(t + 2) * kstep;
            const char* a3 = a2 + kstep; const char* b3 = b2 + kstep;
            if (last && has_next) S.a_ready(nxt);
            if constexpr (SP2) {
            PG8_LDB(B0, 0, 0); PG8_LDB(B1, 0, 1); PG8_SCHED; PG8_LDA(At, 0, 0); PG8_STAGE(PG8_SA(1, 1), a1 + hstepA, voffA);
            PG8_WAIT_V(8); PG8_WAIT_L(0); PG8_BAR; PG8_MMA(0, 0, At, B0); PG8_MMA(0, 1, At, B1); PG8_BAR; PG8_SCHED;
            PG8_LDA(At, 0, 1); PG8_STAGE(PG8_SB(0, 0), b2, voffB); PG8_STAGE(PG8_SB(0, 1), b2 + hstepB, voffB); PG8_STAGE(PG8_SA(0, 0), a2, voffA);
            PG8_WAIT_V(8); PG8_WAIT_L(0); PG8_BAR; PG8_MMA(1, 0, At, B0); PG8_MMA(1, 1, At, B1); PG8_BAR; PG8_SCHED;
            PG8_LDB(B0, 1, 0); PG8_LDB(B1, 1, 1); PG8_SCHED; PG8_LDA(At, 1, 0); PG8_STAGE(PG8_SA(0, 1), a2 + hstepA, voffA);
            PG8_WAIT_V(8); PG8_WAIT_L(0); PG8_BAR; PG8_MMA(0, 0, At, B0); PG8_MMA(0, 1, At, B1); PG8_BAR; PG8_SCHED;
            PG8_LDA(At, 1, 1); PG8_STAGE(PG8_SB(1, 0), b3, voffB); PG8_STAGE(PG8_SB(1, 1), b3 + hstepB, voffB); PG8_STAGE(PG8_SA(1, 0), a3, voffA);
            PG8_WAIT_V(8); PG8_WAIT_L(0); PG8_BAR; PG8_MMA(1, 0, At, B0); PG8_MMA(1, 1, At, B1); PG8_BAR; PG8_SCHED;
            } else {
            PG8_LDB(B0, 0, 0); PG8_SCHED; PG8_LDA(At, 0, 0); PG8_STAGE(PG8_SA(1, 1), a1 + hstepA, voffA);
            PG8_WAIT_L(8); PG8_BAR; PG8_WAIT_L(0); PG8_MMA(0, 0, At, B0); PG8_BAR; PG8_SCHED;
            PG8_LDB(B1, 0, 1); PG8_STAGE(PG8_SB(0, 0), b2, voffB);
            PG8_BAR; PG8_WAIT_L(0); PG8_MMA(0, 1, At, B1); PG8_BAR;
            PG8_LDA(At, 0, 1); PG8_STAGE(PG8_SA(0, 0), a2, voffA);
            PG8_BAR; PG8_WAIT_L(0); PG8_MMA(1, 0, At, B0); PG8_BAR; PG8_SCHED;
            PG8_STAGE(PG8_SB(0, 1), b2 + hstepB, voffB);
            PG8_WAIT_V(6); PG8_BAR; PG8_MMA(1, 1, At, B1); PG8_BAR;
            PG8_LDB(B0, 1, 0); PG8_SCHED; PG8_LDA(At, 1, 0); PG8_STAGE(PG8_SA(0, 1), a2 + hstepA, voffA);
            PG8_WAIT_L(8); PG8_BAR; PG8_WAIT_L(0); PG8_MMA(0, 0, At, B0); PG8_BAR; PG8_SCHED;
            PG8_LDB(B1, 1, 1); PG8_STAGE(PG8_SB(1, 0), b3, voffB);
            PG8_BAR; PG8_WAIT_L(0); PG8_MMA(0, 1, At, B1); PG8_BAR;
            PG8_LDA(At, 1, 1); PG8_STAGE(PG8_SA(1, 0), a3, voffA);
            PG8_BAR; PG8_WAIT_L(0); PG8_MMA(1, 0, At, B0); PG8_BAR; PG8_SCHED;
            PG8_STAGE(PG8_SB(1, 1), b3 + hstepB, voffB);
            PG8_WAIT_V(6); PG8_BAR; PG8_MMA(1, 1, At, B1); PG8_BAR;
            }
        }
        }
        if constexpr (ALIGN_EPI) { if (wr == 0) PG8_BAR; }
        if constexpr (!Epi::AFTER_DRAIN) { E(acc, cur, wr, wc, fr, fq); S.done(cur); }
        if (!has_next) break;
#pragma unroll
        for (int a = 0; a < 2; ++a)
#pragma unroll
            for (int b = 0; b < 2; ++b)
#pragma unroll
                for (int m = 0; m < 4; ++m)
#pragma unroll
                    for (int n = 0; n < 2; ++n) acc[a][b][m][n] = (f32x4){0.f, 0.f, 0.f, 0.f};
        cur = nxt; cA = nA; cA2 = nA2; cB = nB; ++ui;
        if constexpr (ALIGN_EPI) { if (wr == 1) PG8_BAR; }
    }
    PG8_WAIT_V(0);
    if constexpr (!ALIGN_EPI) { if (wr == 0) PG8_BAR; }
    PG8_BAR;
    if constexpr (Epi::AFTER_DRAIN) { E.fused(acc, cur, wr, wc, fr, fq, lds, wid, lane); S.done(cur); }
#undef PG8_SA
#undef PG8_SB
#undef PG8_STAGE
#undef PG8_LDA
#undef PG8_LDB
#undef PG8_MMA
#undef PG8_WAIT_V
#undef PG8_WAIT_L
#undef PG8_BAR
#undef PG8_SCHED
}
}
#include <hip/hip_bf16.h>
#include <cmath>
namespace attn_body {
using bf16=__hip_bfloat16;
using bf16x8=__attribute__((ext_vector_type(8)))short;
using s16x4=__attribute__((ext_vector_type(4)))short;
using f32x16=__attribute__((ext_vector_type(16)))float;
using u32x4=__attribute__((ext_vector_type(4)))unsigned;
constexpr int SEQ=16384,D=64,PQ=3072,PO=2048;
constexpr int NW=8,QBLK=32,QB=QBLK*NW,KVBLK=64,NQB=SEQ/QB;
constexpr int ATTN_UNIT_ROWS=QB;
__device__ __forceinline__ int crow(int r,int hi){return (r&3)+8*(r>>2)+4*hi;}
#define SBAR() __builtin_amdgcn_sched_barrier(0)
__device__ __forceinline__ void cmask(f32x16&p0,f32x16&p1,int jb,int qrel,int hi){
  const float NEG=-INFINITY; int kb=64*jb+4*hi;
  #pragma unroll
  for(int r=0;r<16;++r){int kv=kb+(r&3)+8*(r>>2); if(kv>qrel)p0[r]=NEG; if(kv+32>qrel)p1[r]=NEG;}
}

constexpr int NSLOT=3, SLOTB=8192, VSLOTB=16384;
constexpr int LDS_K=0, LDS_V=NSLOT*SLOTB, LDS_WS=LDS_V+NSLOT*VSLOTB, LDS_OST=0  , LDS_BYTES=LDS_WS+NW*64*4;
constexpr float C2=0.125f*1.4426950408889634f;
__device__ __forceinline__ void glds16(const void*gsrc,unsigned lds_dst){unsigned keep;
  asm volatile("s_mov_b32 %0, m0\n\ts_mov_b32 m0, %2\n\ts_nop 0\n\tglobal_load_lds_dwordx4 %1, off\n\ts_mov_b32 m0, %0":"=&s"(keep):"v"(gsrc),"s"(lds_dst):"memory");}
__device__ __forceinline__ float max3f(float a,float b,float c){float r;asm("v_max3_f32 %0, %1, %2, %3":"=v"(r):"v"(a),"v"(b),"v"(c));return r;}
__device__ __forceinline__ float max2f(float a,float b){float r;asm("v_max_f32_e32 %0, %1, %2":"=v"(r):"v"(a),"v"(b));return r;}
__device__ __forceinline__ float fadd_s(float a,float b){float r;asm("v_add_f32_e32 %0, %1, %2":"=v"(r):"v"(a),"v"(b));return r;}
__device__ __forceinline__ float fsub_s(float a,float b){float r;asm("v_sub_f32_e32 %0, %1, %2":"=v"(r):"v"(a),"v"(b));return r;}
typedef float f32x2_t __attribute__((ext_vector_type(2))); typedef __bf16 bf16x2_t __attribute__((ext_vector_type(2)));
__device__ __forceinline__ unsigned cvtpk_s(float lo,float hi){f32x2_t v={lo,hi};bf16x2_t b=__builtin_convertvector(v,bf16x2_t);return __builtin_bit_cast(unsigned,b);}
#define WAIT_BAR(N) asm volatile("s_waitcnt vmcnt(" #N ") lgkmcnt(0)\n\ts_barrier":::"memory")

__device__ __forceinline__ void qkt(f32x16&p0,f32x16&p1,const char*Kslot,const bf16x8*qr,const f32x16&negm,int r32,int hi){
  const char*kb=Kslot+hi*1024+r32*16;
  #pragma unroll
  for(int d0=0;d0<4;++d0){
    const bf16x8 b0=*reinterpret_cast<const bf16x8*>(kb+d0*2048);
    const bf16x8 b1=*reinterpret_cast<const bf16x8*>(kb+d0*2048+512);
    if(d0==0){p0=__builtin_amdgcn_mfma_f32_32x32x16_bf16(b0,qr[0],f32x16{},0,0,0);p1=__builtin_amdgcn_mfma_f32_32x32x16_bf16(b1,qr[0],f32x16{},0,0,0);}
    else{p0=__builtin_amdgcn_mfma_f32_32x32x16_bf16(b0,qr[d0],p0,0,0,0);p1=__builtin_amdgcn_mfma_f32_32x32x16_bf16(b1,qr[d0],p1,0,0,0);}}
}
typedef __attribute__((address_space(3))) const char* lds_cptr;
typedef short v4i16_t __attribute__((ext_vector_type(4)));
__device__ __forceinline__ void kload8(bf16x8*kf,lds_cptr kp){
  kf[0]=*(const __attribute__((address_space(3))) bf16x8*)(kp);      kf[1]=*(const __attribute__((address_space(3))) bf16x8*)(kp+512);
  kf[2]=*(const __attribute__((address_space(3))) bf16x8*)(kp+2048); kf[3]=*(const __attribute__((address_space(3))) bf16x8*)(kp+2560);
  kf[4]=*(const __attribute__((address_space(3))) bf16x8*)(kp+4096); kf[5]=*(const __attribute__((address_space(3))) bf16x8*)(kp+4608);
  kf[6]=*(const __attribute__((address_space(3))) bf16x8*)(kp+6144); kf[7]=*(const __attribute__((address_space(3))) bf16x8*)(kp+6656);
}
__device__ __forceinline__ void kload2(bf16x8*kf,lds_cptr kp,int j){ kf[2*j]=*(const __attribute__((address_space(3))) bf16x8*)(kp+j*2048); kf[2*j+1]=*(const __attribute__((address_space(3))) bf16x8*)(kp+j*2048+512); }
__device__ __forceinline__ s16x4 vtr(lds_cptr p){ return __builtin_bit_cast(s16x4,__builtin_amdgcn_ds_read_tr16_b64_v4i16((__attribute__((address_space(3))) v4i16_t*)p)); }
__device__ __forceinline__ float rowmax(const f32x16&p0,const f32x16&p1){
  float a=max3f(p0[0],p0[1],p1[0]),b=max3f(p0[2],p0[3],p1[1]);a=max3f(a,p1[2],p1[3]);
  #pragma unroll
  for(int r=4;r<16;r+=4){a=max3f(a,p0[r],p0[r+1]);b=max3f(b,p0[r+2],p0[r+3]);a=max3f(a,p1[r],p1[r+1]);b=max3f(b,p1[r+2],p1[r+3]);}
  const float m=max2f(a,b);
  auto rr=__builtin_amdgcn_permlane32_swap(__float_as_uint(m),__float_as_uint(m),false,false);
  return max2f(__uint_as_float(rr[0]),__uint_as_float(rr[1]));
}
__device__ __forceinline__ void pv(f32x16*o,int vb,bf16x8 pa0,bf16x8 pa1,bf16x8 pa2,bf16x8 pa3){
  #pragma unroll
  for(int d0=0;d0<4;++d0){s16x4 lo[4],hi[4];
    #pragma unroll
    for(int ks=0;ks<4;++ks){
      asm volatile("ds_read_b64_tr_b16 %0,%1 offset:%c2":"=&v"(lo[ks]):"v"(vb),"i"(d0*4096+ks*1024):"memory");
      asm volatile("ds_read_b64_tr_b16 %0,%1 offset:%c2":"=&v"(hi[ks]):"v"(vb),"i"(d0*4096+ks*1024+512):"memory");}
    asm volatile("s_waitcnt lgkmcnt(0)":::"memory");SBAR();
    #define PK(k) (bf16x8){lo[k][0],lo[k][1],lo[k][2],lo[k][3],hi[k][0],hi[k][1],hi[k][2],hi[k][3]}
    o[d0]=__builtin_amdgcn_mfma_f32_32x32x16_bf16(pa0,PK(0),o[d0],0,0,0);
    o[d0]=__builtin_amdgcn_mfma_f32_32x32x16_bf16(pa1,PK(1),o[d0],0,0,0);
    o[d0]=__builtin_amdgcn_mfma_f32_32x32x16_bf16(pa2,PK(2),o[d0],0,0,0);
    o[d0]=__builtin_amdgcn_mfma_f32_32x32x16_bf16(pa3,PK(3),o[d0],0,0,0);
    #undef PK
  }
}

#ifndef ATTN_STORE16
#define ATTN_STORE16(p,v) (*(u32x4*)(p)=(v))
#endif
template<int THRL> __device__ __forceinline__ void attn_unit(const int wid_in,int qb,const bf16*Q,const bf16*__restrict__ K,const bf16*__restrict__ V,bf16*O,char*shm){
  int tid_=wid_in*64+mk_lane_id(); asm volatile("":"+v"(tid_)); const int tid=tid_,lane=tid&63,r32=lane&31,hi=lane>>5; const int wid=__builtin_amdgcn_readfirstlane(tid>>6);
  const int q0=qb*QB;
  const bf16*Qw=Q+(long)(q0+wid*QBLK)*PQ;
  const bf16*Kh=K,*Vh=V;
  const unsigned lds0=(unsigned)(uintptr_t)shm;
  float*wsf=(float*)(shm+LDS_WS)+wid*64;
  const bf16*ksrc=Kh+(long)lane*PQ+wid*8;
  const bf16*vsrc=Vh+(long)(16*(wid&3)+(lane>>2))*PQ+(wid>>2)*32+(lane&3)*8;
  const unsigned kdst=lds0+LDS_K+wid*1024, vdst=lds0+LDS_V+wid*1024;
  #define DMA_K(t,slot) glds16(ksrc+(long)(t)*KVBLK*PQ,(unsigned)__builtin_amdgcn_readfirstlane(kdst+(slot)))
  #define DMA_V(t,slot) do{ glds16(vsrc+(long)(t)*KVBLK*PQ,(unsigned)__builtin_amdgcn_readfirstlane(vdst+2*(slot))); glds16(vsrc+64+(long)(t)*KVBLK*PQ,(unsigned)__builtin_amdgcn_readfirstlane(vdst+8192+2*(slot))); }while(0)
  const int vb0=(int)(lds0+LDS_V)+((lane>>4)&1)*32+(lane&3)*8+(4*hi+((lane&15)>>2))*64;
  const char*Kbase=shm+LDS_K; bf16x8 kf[8];
  const lds_cptr shm3=(lds_cptr)shm; const lds_cptr kp0=shm3+LDS_K+hi*1024+r32*16; const lds_cptr vp0=shm3+LDS_V+((lane>>4)&1)*32+(lane&3)*8+(4*hi+((lane&15)>>2))*64;
  const int NT=(q0+QB)/KVBLK;
  DMA_K(0,0);DMA_V(0,0);DMA_K(1,SLOTB);
  bf16x8 qr[4];
  #pragma unroll
  for(int d0=0;d0<4;++d0)qr[d0]=*reinterpret_cast<const bf16x8*>(&Qw[(long)r32*PQ+d0*16+hi*8]);
  float mhat=0.f,l_reg=0.f;f32x16 o[4];o[0]=f32x16{};o[1]=f32x16{};o[2]=f32x16{};o[3]=f32x16{};asm volatile("":"+v"(o[0]));asm volatile("":"+v"(o[1]));asm volatile("":"+v"(o[2]));asm volatile("":"+v"(o[3]));
  const int qrel=wid*QBLK+r32;
  #define CMASK(P0,P1,t) do{int jb_=(t)-(NT-4); if(jb_>=0)cmask(P0,P1,jb_,qrel,hi);}while(0)
  bool resc=false;
  #define START(P0,P1) do{ const float rm=rowmax(P0,P1); resc=false; mhat=rm; \
    _Pragma("unroll") for(int r=0;r<16;++r){P0[r]=__builtin_amdgcn_exp2f(fsub_s(P0[r],mhat));} }while(0)
  #define RESC() do{ if(resc){ asm volatile("s_waitcnt lgkmcnt(0)":::"memory"); \
      _Pragma("unroll") for(int d_=0;d_<4;++d_) _Pragma("unroll") for(int r=0;r<16;++r)o[d_][r]*=wsf[crow(r,hi)]; } }while(0)
  f32x16 pA0,pA1,pB0,pB1;
  int sl_prev=0,sl_cur=0,sl_next=SLOTB;
  #define ROT() do{sl_prev=sl_cur;sl_cur=sl_next;sl_next=(sl_next==(NSLOT-1)*SLOTB)?0:sl_next+SLOTB;}while(0)
  DMA_K(2,2*SLOTB);
  WAIT_BAR(4);
  qkt(pA0,pA1,Kbase,qr,f32x16{},r32,hi);asm volatile("s_nop 15\n\ts_nop 7":"+v"(pA0),"+v"(pA1));CMASK(pA0,pA1,0);
  START(pA0,pA1);
  _Pragma("unroll") for(int r=0;r<16;++r)pA1[r]=__builtin_amdgcn_exp2f(fsub_s(pA1[r],mhat));
  WAIT_BAR(0);
  DMA_K(3,0);DMA_V(1,SLOTB);
  ROT();
  kload8(kf,kp0+sl_cur);
  WAIT_BAR(3);
  s16x4 vlo[16],vhi[16]; u32x4 pw0,pw1,pw2,pw3;
  #define PKW(P,B) cvtpk_s(P[B],P[B+1])
  #define PAF(k) __builtin_bit_cast(bf16x8,pw##k)
  #define VFR(i) (bf16x8){vlo[i][0],vlo[i][1],vlo[i][2],vlo[i][3],vhi[i][0],vhi[i][1],vhi[i][2],vhi[i][3]}
  #define PIN(x) asm volatile("":"+v"(x))
  #define MX3(a,b,c) __builtin_fmaxf(__builtin_fmaxf((a),(b)),(c))
  #define GAPA(MF,A0,A1,A2,A3,W0,W1,PW) do{ MF; sacc+=A0; sacc+=A1; sacc+=A2; sacc+=A3; PIN(sacc); W0; W1; PIN(PW); SBAR(); }while(0)
  #define EX(v) __builtin_amdgcn_exp2f(v)
  #define GAPB(MF,X,B) do{ MF; X[B]=EX(X[B]-mhat); X[B+1]=EX(X[B+1]-mhat); PIN(X); SBAR(); }while(0)
  #define VRD(i) do{ vlo[i]=vtr(vp_+(((i)>>2)*4096+((i)&3)*1024)); vhi[i]=vtr(vp_+(((i)>>2)*4096+((i)&3)*1024+512)); }while(0)
  #define KRD(G,j) do{ if(G){ kload2(kf,kp0+sl_next,j); SBAR(); } }while(0)
  #define STEP(C0,C1,P0,P1,t,GK,GV,GL) do{ SBAR(); \
    const lds_cptr vp_=vp0+2*sl_prev; \
    float sacc=(P0[0]+P0[1]); \
    GAPA(C0=__builtin_amdgcn_mfma_f32_32x32x16_bf16(kf[0],qr[0],f32x16{},0,0,0), P0[2],P0[3],P0[4],P0[5],     pw0[0]=PKW(P0,0), pw0[1]=PKW(P0,2), pw0); \
    GAPA(C1=__builtin_amdgcn_mfma_f32_32x32x16_bf16(kf[1],qr[0],f32x16{},0,0,0), P0[6],P0[7],P0[8],P0[9],     pw0[2]=PKW(P0,4), pw0[3]=PKW(P0,6), pw0); \
    GAPA(C0=__builtin_amdgcn_mfma_f32_32x32x16_bf16(kf[2],qr[1],C0,0,0,0),   P0[10],P0[11],P0[12],P0[13], pw1[0]=PKW(P0,8), pw1[1]=PKW(P0,10), pw1); \
    GAPA(C1=__builtin_amdgcn_mfma_f32_32x32x16_bf16(kf[3],qr[1],C1,0,0,0),   P0[14],P0[15],P1[0],P1[1],   pw1[2]=PKW(P0,12),pw1[3]=PKW(P0,14), pw1); \
    VRD(0); SBAR(); GAPA(C0=__builtin_amdgcn_mfma_f32_32x32x16_bf16(kf[4],qr[2],C0,0,0,0),   P1[2],P1[3],P1[4],P1[5],     pw2[0]=PKW(P1,0), pw2[1]=PKW(P1,2), pw2); \
    VRD(4); SBAR(); GAPA(C1=__builtin_amdgcn_mfma_f32_32x32x16_bf16(kf[5],qr[2],C1,0,0,0),   P1[6],P1[7],P1[8],P1[9],     pw2[2]=PKW(P1,4), pw2[3]=PKW(P1,6), pw2); \
    VRD(8); SBAR(); GAPA(C0=__builtin_amdgcn_mfma_f32_32x32x16_bf16(kf[6],qr[3],C0,0,0,0),   P1[10],P1[11],P1[12],P1[13], pw3[0]=PKW(P1,8), pw3[1]=PKW(P1,10), pw3); \
    VRD(12); SBAR(); GAPA(C1=__builtin_amdgcn_mfma_f32_32x32x16_bf16(kf[7],qr[3],C1,0,0,0),   P1[14],P1[15],0.f,0.f,       pw3[2]=PKW(P1,12),pw3[3]=PKW(P1,14), pw3); \
    l_reg+=sacc; \
    if(GK){DMA_K((t)+3,sl_cur);} if(GV){DMA_V((t)+1,sl_next);} \
    CMASK(C0,C1,t); \
    { float a=MX3(C0[0],C0[1],C1[0]),b=MX3(C0[2],C0[3],C1[1]); a=MX3(a,C1[2],C1[3]); \
      _Pragma("unroll") for(int r=4;r<16;r+=4){a=MX3(a,C0[r],C0[r+1]);b=MX3(b,C0[r+2],C0[r+3]);a=MX3(a,C1[r],C1[r+1]);b=MX3(b,C1[r+2],C1[r+3]);} \
      float rm=__builtin_fmaxf(a,b); { auto rr=__builtin_amdgcn_permlane32_swap(__float_as_uint(rm),__float_as_uint(rm),false,false); rm=__builtin_fmaxf(__uint_as_float(rr[0]),__uint_as_float(rr[1])); } \
      rm-=mhat; resc=false; \
      if(__builtin_expect(__any(rm>(float)THRL),0)){ const float dl=__builtin_fmaxf(rm,0.f); mhat+=dl; \
        const float f=__builtin_amdgcn_exp2f(-dl); l_reg*=f; if(hi==0)wsf[r32]=f; resc=true; } } \
    SBAR(); \
    GAPB(o[0]=__builtin_amdgcn_mfma_f32_32x32x16_bf16(PAF(0),VFR(0),o[0],0,0,0), C0,0); VRD(1); SBAR(); \
    GAPB(o[1]=__builtin_amdgcn_mfma_f32_32x32x16_bf16(PAF(0),VFR(4),o[1],0,0,0), C0,2); VRD(5); SBAR(); \
    KRD(GL,0); GAPB(o[2]=__builtin_amdgcn_mfma_f32_32x32x16_bf16(PAF(0),VFR(8),o[2],0,0,0), C0,4); VRD(9); SBAR(); \
    KRD(GL,1); GAPB(o[3]=__builtin_amdgcn_mfma_f32_32x32x16_bf16(PAF(0),VFR(12),o[3],0,0,0), C0,6); VRD(13); SBAR(); \
    KRD(GL,2); GAPB(o[0]=__builtin_amdgcn_mfma_f32_32x32x16_bf16(PAF(1),VFR(1),o[0],0,0,0), C0,8); VRD(2); SBAR(); \
    KRD(GL,3); GAPB(o[1]=__builtin_amdgcn_mfma_f32_32x32x16_bf16(PAF(1),VFR(5),o[1],0,0,0), C0,10); VRD(6); SBAR(); \
    GAPB(o[2]=__builtin_amdgcn_mfma_f32_32x32x16_bf16(PAF(1),VFR(9),o[2],0,0,0), C0,12); VRD(10); SBAR(); \
    GAPB(o[3]=__builtin_amdgcn_mfma_f32_32x32x16_bf16(PAF(1),VFR(13),o[3],0,0,0), C0,14); VRD(14); SBAR(); \
    GAPB(o[0]=__builtin_amdgcn_mfma_f32_32x32x16_bf16(PAF(2),VFR(2),o[0],0,0,0), C1,0); VRD(3); SBAR(); \
    GAPB(o[1]=__builtin_amdgcn_mfma_f32_32x32x16_bf16(PAF(2),VFR(6),o[1],0,0,0), C1,2); VRD(7); SBAR(); \
    GAPB(o[2]=__builtin_amdgcn_mfma_f32_32x32x16_bf16(PAF(2),VFR(10),o[2],0,0,0), C1,4); VRD(11); SBAR(); \
    GAPB(o[3]=__builtin_amdgcn_mfma_f32_32x32x16_bf16(PAF(2),VFR(14),o[3],0,0,0), C1,6); VRD(15); SBAR(); \
    GAPB(o[0]=__builtin_amdgcn_mfma_f32_32x32x16_bf16(PAF(3),VFR(3),o[0],0,0,0), C1,8); \
    GAPB(o[1]=__builtin_amdgcn_mfma_f32_32x32x16_bf16(PAF(3),VFR(7),o[1],0,0,0), C1,10); \
    GAPB(o[2]=__builtin_amdgcn_mfma_f32_32x32x16_bf16(PAF(3),VFR(11),o[2],0,0,0), C1,12); \
    GAPB(o[3]=__builtin_amdgcn_mfma_f32_32x32x16_bf16(PAF(3),VFR(15),o[3],0,0,0), C1,14); \
    }while(0)
  int t=1;
  #undef CMASK
  #define CMASK(P0,P1,t) do{}while(0)
  for(;t+5<NT;t+=2){
    STEP(pB0,pB1,pA0,pA1,t,true,true,true);     WAIT_BAR(3); RESC(); ROT();
    STEP(pA0,pA1,pB0,pB1,t+1,true,true,true);   WAIT_BAR(3); RESC(); ROT();
  }
  #undef CMASK
  #define CMASK(P0,P1,t) do{int jb_=(t)-(NT-4); if(jb_>=0)cmask(P0,P1,jb_,qrel,hi);}while(0)
  #define ENDW(tt) do{ if((tt)+3<NT){WAIT_BAR(3);} else if((tt)+2<NT){WAIT_BAR(2);} else {WAIT_BAR(0);} }while(0)
  for(;t+1<NT;t+=2){
    STEP(pB0,pB1,pA0,pA1,t,(t+3<NT),(t+1<NT),(t+1<NT));       ENDW(t);   RESC(); ROT();
    STEP(pA0,pA1,pB0,pB1,t+1,(t+4<NT),(t+2<NT),(t+2<NT));     ENDW(t+1); RESC(); ROT();
  }
  STEP(pB0,pB1,pA0,pA1,NT-1,false,false,false); RESC();
  { float sacc=pB0[0]+pB0[1]; _Pragma("unroll") for(int r=2;r<16;++r)sacc+=pB0[r]; _Pragma("unroll") for(int r=0;r<16;++r)sacc+=pB1[r]; l_reg+=sacc;
    pw0=(u32x4){PKW(pB0,0),PKW(pB0,2),PKW(pB0,4),PKW(pB0,6)};pw1=(u32x4){PKW(pB0,8),PKW(pB0,10),PKW(pB0,12),PKW(pB0,14)};pw2=(u32x4){PKW(pB1,0),PKW(pB1,2),PKW(pB1,4),PKW(pB1,6)};pw3=(u32x4){PKW(pB1,8),PKW(pB1,10),PKW(pB1,12),PKW(pB1,14)};
    SBAR(); pv(o,vb0+2*sl_cur,PAF(0),PAF(1),PAF(2),PAF(3)); }
  asm volatile("s_waitcnt lgkmcnt(0)\n\ts_barrier":::"memory");
  #undef PKW
  #undef PAF
  #undef VFR
  #undef PIN
  #undef MX3
  #undef GAPA
  #undef GAPB
  #undef EX
  #undef VRD
  #undef KRD
  #undef STEP
  #undef ENDW
  {auto rr=__builtin_amdgcn_permlane32_swap(__float_as_uint(l_reg),__float_as_uint(l_reg),false,false);l_reg=__uint_as_float(rr[0])+__uint_as_float(rr[1]);}
  if(hi==0)wsf[32+r32]=l_reg;asm volatile("s_waitcnt lgkmcnt(0)":::"memory");
  float rli[16];
  #pragma unroll
  for(int r=0;r<16;++r)rli[r]=__builtin_amdgcn_rcpf(wsf[32+crow(r,hi)]);
  bf16*Ow=O+(long)(q0+wid*QBLK)*PO;
  { bf16*stg=(bf16*)(shm+LDS_OST)+wid*4096;
    #pragma unroll
    for(int r=0;r<16;++r){const int orow=crow(r,hi);
      #pragma unroll
      for(int d0=0;d0<4;++d0)stg[orow*128+d0*32+r32]=__float2bfloat16(o[d0][r]*rli[r]);}
    asm volatile("s_waitcnt lgkmcnt(0)":::"memory");
    #pragma unroll
    for(int i=0;i<8;++i){const int row=i*4+(lane>>4),ch=lane&15; const u32x4 v=*(const u32x4*)(stg+row*128+ch*8); ATTN_STORE16(Ow+(long)row*PO+ch*8,v);} }
  asm volatile("s_waitcnt lgkmcnt(0)\n\ts_barrier":::"memory");
  #undef DMA_K
  #undef DMA_V
  #undef CMASK
  #undef START
  #undef RESC
  #undef ROT
}
constexpr int ATTN_LDS_BYTES=LDS_BYTES;
template<int THRL=8> __device__ __forceinline__ void attn_phase(char*lds,const bf16*PD,bf16*O,int vcu,const int wid){
  const int pr=vcu>>4,s=vcu&15,h=pr>>1,m=pr&1;
  const bf16*Q=PD+h*128+m*64,*K=PD+1024+h*128+m*64,*V=PD+2048+h*128; bf16*Op=O+m*1024+h*128;
  _Pragma("unroll 1") for(int i=0;i<4;++i){ const int qb=(i>>1)*32+((i&1)?31-s:s); attn_unit<THRL>(wid,qb,Q,K,V,Op,lds); }
}
#undef SBAR
#undef WAIT_BAR
}
#define GAS __attribute__((address_space(1)))
#define LAS __attribute__((address_space(3)))
typedef unsigned short bf16;
typedef unsigned v4u __attribute__((ext_vector_type(4)));
typedef float f32x4 __attribute__((ext_vector_type(4)));
typedef short bf16x8 __attribute__((ext_vector_type(8)));
typedef GAS unsigned gu32;
typedef GAS unsigned long long gu64;
#define RLX_AGENT __ATOMIC_RELAXED, __HIP_MEMORY_SCOPE_AGENT
#define LDS_WAIT() asm volatile("s_waitcnt lgkmcnt(0)" ::: "memory")
#define VM_WAIT() asm volatile("s_waitcnt vmcnt(0)" ::: "memory")
__device__ __forceinline__ unsigned long long rt() { return __builtin_amdgcn_s_memrealtime(); }
__device__ __forceinline__ unsigned f2bf(float f) { unsigned u = __builtin_bit_cast(unsigned, f); return (u + 0x7fffu + ((u >> 16) & 1u)) >> 16; }
__device__ __forceinline__ unsigned pk2(float lo, float hi) { return f2bf(lo) | (f2bf(hi) << 16); }

#define XB_TMO      128
#define XB_XCNT(j)  (256  + 64 * (j))
#define XB_XSUB(j)  (1280 + 64 * (j))
#define XB_XGEN(j)  (2304 + 64 * (j))
#define XB_TOP      3328
#define XB_TOPGEN   3392
#define XCD_BAR_WORDS 3456
#define XB_SPIN_CAP (1u << 18)

__device__ __forceinline__ unsigned xb_ld(unsigned* p)              { return __hip_atomic_load(p, __ATOMIC_RELAXED, __HIP_MEMORY_SCOPE_AGENT); }
__device__ __forceinline__ unsigned xb_add(unsigned* p, unsigned v) { return __hip_atomic_fetch_add(p, v, __ATOMIC_RELAXED, __HIP_MEMORY_SCOPE_AGENT); }
__device__ __forceinline__ unsigned xb_xcc_id() { return (unsigned)__builtin_amdgcn_s_getreg((3 << 11) | 20) & 0xFu; }
#define XB_SPIN(cond, bar) do { unsigned _sp = 0; while (cond) { __builtin_amdgcn_s_sleep(1); \
    if ((++_sp & 255u) == 0u) { if (xb_ld(&(bar)[XB_TMO])) break; if (_sp > XB_SPIN_CAP) { atomicAdd(&(bar)[XB_TMO], 1u); break; } } } } while (0)

struct XcdBarrier {
    unsigned* bar; unsigned x;
    volatile LAS unsigned* st;
};

__device__ __forceinline__ XcdBarrier xcd_barrier_post(unsigned* bar, volatile LAS unsigned* st) {
    XcdBarrier b; b.bar = bar; b.x = xb_xcc_id(); b.st = st;
    if (threadIdx.x == 0) (void)xb_add(&bar[XB_XCNT(b.x)], 1u);
    return b;
}
__device__ __forceinline__ void xcd_barrier_complete(unsigned* bar, unsigned x, unsigned& nloc, unsigned& nx) {
    const unsigned G = gridDim.x * gridDim.y * gridDim.z;
    unsigned sum, cnt, mine, sp = 0u;
    for (;;) {
        sum = 0u; cnt = 0u; mine = 0u;
#pragma unroll
        for (unsigned j = 0; j < 16; ++j) { const unsigned c = xb_ld(&bar[XB_XCNT(j)]); sum += c; cnt += (c > 0u) ? 1u : 0u; mine = (j == x) ? c : mine; }
        if (sum == G) break;
        __builtin_amdgcn_s_sleep(1);
        if ((++sp & 255u) == 0u) { if (xb_ld(&bar[XB_TMO])) break; if (sp > XB_SPIN_CAP) { atomicAdd(&bar[XB_TMO], 1u); break; } }
    }
    nloc = mine > 0u ? mine : 1u; nx = cnt > 0u ? cnt : 1u;
}

__device__ __forceinline__ void xcd_barrier(const XcdBarrier& b) {
    asm volatile("s_waitcnt vmcnt(0)" ::: "memory");
    __syncthreads();
    if (threadIdx.x == 0) {
        unsigned* bar = b.bar;
        __builtin_amdgcn_s_waitcnt(0);
        unsigned nloc = b.st[0], nx = b.st[1];
        if (nloc == 0u) { xcd_barrier_complete(bar, b.x, nloc, nx); b.st[0] = nloc; b.st[1] = nx; }
        const unsigned old = xb_add(&bar[XB_XSUB(b.x)], 1u);
        const unsigned gen = old / nloc;
        if (old + 1u == (gen + 1u) * nloc) {
            __builtin_amdgcn_fence(__ATOMIC_RELEASE, "agent");
            asm volatile("s_waitcnt vmcnt(0)" ::: "memory");
            const unsigned og = xb_add(&bar[XB_TOP], 1u);
            const unsigned tg = og / nx;
            if (og + 1u == (tg + 1u) * nx) xb_add(&bar[XB_TOPGEN], 1u);
            else XB_SPIN(xb_ld(&bar[XB_TOPGEN]) == tg, bar);
            __builtin_amdgcn_fence(__ATOMIC_ACQUIRE, "agent");
            xb_add(&bar[XB_XGEN(b.x)], 1u);
            asm volatile("s_waitcnt vmcnt(0)" ::: "memory");
        } else {
            XB_SPIN(xb_ld(&bar[XB_XGEN(b.x)]) == gen, bar);
            __builtin_amdgcn_fence(__ATOMIC_ACQUIRE, "agent");
            asm volatile("s_waitcnt vmcnt(0)" ::: "memory");
        }
    }
    __syncthreads();
}
constexpr int NWAVES = 8;
constexpr int S_ = 16384, DM = 2048;
constexpr int NPH = 16;
#ifndef MK_PER_PHASE
#define MK_PER_PHASE 0
#endif
constexpr size_t MiB = 1u << 20;
constexpr size_t WS_CTL = 0, CTL_ZERO_BYTES = 1 * MiB;
constexpr size_t WS_WA = 1 * MiB, WS_WB = 5 * MiB, WS_WOUT = 9 * MiB, WS_WS = 17 * MiB, WS_LORA = 25 * MiB;
constexpr size_t WS_WIN = 27 * MiB, WS_PR = 69 * MiB, WS_PD = 181 * MiB, WS_PG = 277 * MiB;
constexpr size_t WS_A = 405 * MiB, WS_E = 437 * MiB, WS_G = 469 * MiB, WS_END = 507 * MiB;
constexpr size_t WS_SCN = 27 * MiB, WS_SCAL = 123 * MiB, WS_SLOC = 127 * MiB, WS_ASEG = 143 * MiB, WS_SIN = 159 * MiB;
constexpr size_t WS_YA = 91 * MiB, WS_OATT = 27 * MiB, WS_YB = 437 * MiB, WS_Z = 405 * MiB  , WS_T1 = 123 * MiB, WS_MERGED = 27 * MiB;
constexpr size_t WS_H2 = 123 * MiB, WS_XN2 = 27 * MiB, WS_UTAB = 251 * MiB, WS_VTAB = 315 * MiB, WS_SCORES = 379 * MiB;
constexpr size_t WS_USCL = WS_UTAB + 16 * MiB, WS_VSCL = WS_VTAB + 16 * MiB;
constexpr size_t OUT_XN = 0, OUT_RKV = 0, OUT_LIN = 96 * MiB, OUT_YLOC = 96 * MiB  ;
constexpr int CW_BAR = 4096;
constexpr int RING_OFF = 0, RING_BYTES = 131072;
constexpr int LDSCTL_OFF = RING_BYTES, MISC_OFF = LDSCTL_OFF + 320;
constexpr int LDS_BYTES = 147456;
constexpr int NSEG = 64, SEGLEN = S_ / NSEG;

struct Args { const float* in[28]; float* out; unsigned char* ws; int ph_lo, ph_hi; };

struct Frame {
    LAS unsigned char* lds; volatile LAS unsigned* MISC; gu32* ctl;
    int tid, lane, wave, vcu, G;
};

__device__ __forceinline__ float bf2f(unsigned short b) { return __uint_as_float((unsigned)b << 16); }
__device__ __forceinline__ float wave_sum(float v) {
#pragma unroll
    for (int o = 1; o < 64; o <<= 1) v += __shfl_xor(v, o);
    return v;
}
__device__ __forceinline__ float wave_max(float v) {
#pragma unroll
    for (int o = 1; o < 64; o <<= 1) v = fmaxf(v, __shfl_xor(v, o));
    return v;
}
template <int CTRL, int RM> __device__ __forceinline__ float dppf(float oldv, float x) { return __builtin_bit_cast(float, __builtin_amdgcn_update_dpp(__builtin_bit_cast(int, oldv), __builtin_bit_cast(int, x), CTRL, RM, 0xf, false)); }
__device__ __forceinline__ float wsum(float v) {
    v += dppf<0xB1, 0xf>(v, v); v += dppf<0x4E, 0xf>(v, v); v += dppf<0x141, 0xf>(v, v); v += dppf<0x140, 0xf>(v, v);
    v += dppf<0x142, 0xa>(0.f, v); v += dppf<0x143, 0xc>(0.f, v);
    return __builtin_bit_cast(float, __builtin_amdgcn_readlane(__builtin_bit_cast(int, v), 63));
}
__device__ __forceinline__ float wmax(float v) {
    v = fmaxf(v, dppf<0xB1, 0xf>(v, v)); v = fmaxf(v, dppf<0x4E, 0xf>(v, v)); v = fmaxf(v, dppf<0x141, 0xf>(v, v)); v = fmaxf(v, dppf<0x140, 0xf>(v, v));
    v = fmaxf(v, dppf<0x142, 0xa>(0.f, v)); v = fmaxf(v, dppf<0x143, 0xc>(0.f, v));
    return __builtin_bit_cast(float, __builtin_amdgcn_readlane(__builtin_bit_cast(int, v), 63));
}
__device__ __forceinline__ float sigmf(float x) { return __builtin_amdgcn_rcpf(1.0f + __expf(-x)); }

__device__ __forceinline__ void transpose_block(const float* W, int ldw, int k0, int n0, int kvalid, bf16* WT, int ldt, int drow0, LAS float* scr, int lane) {
    float tv[32];
#pragma unroll
    for (int i = 0; i < 32; ++i) { const int k = k0 + 2 * i + (lane >> 5); tv[i] = (k < kvalid) ? W[(size_t)k * ldw + n0 + (lane & 31)] : 0.f; }
#pragma unroll
    for (int i = 0; i < 32; ++i) scr[(2 * i + (lane >> 5)) * 33 + (lane & 31)] = tv[i];
    LDS_WAIT(); asm volatile("" ::: "memory");
    const int c = lane & 7;
#pragma unroll
    for (int j = 0; j < 4; ++j) { const int n = (lane >> 3) + 8 * j; const LAS float* s = scr + (8 * c) * 33 + n;
        v4u o; o.x = pk2(s[0 * 33], s[1 * 33]); o.y = pk2(s[2 * 33], s[3 * 33]); o.z = pk2(s[4 * 33], s[5 * 33]); o.w = pk2(s[6 * 33], s[7 * 33]);
        *(GAS v4u*)(WT + (size_t)(drow0 + n) * ldt + k0 + 8 * c) = o; }
    LDS_WAIT(); asm volatile("" ::: "memory");
}
__device__ __forceinline__ void rms_row_to_bf16(const float* xrow, const float* g, bf16* orow, int lane) {
    const GAS f32x4* xr = (const GAS f32x4*)xrow + lane; const f32x4* gr = (const f32x4*)g + lane;
    f32x4 v[8]; float s = 0.f;
#pragma unroll
    for (int j = 0; j < 8; ++j) { v[j] = xr[64 * j]; s += (v[j].x * v[j].x + v[j].y * v[j].y) + (v[j].z * v[j].z + v[j].w * v[j].w); }
    const float rstd = rsqrtf(wave_sum(s) * (1.f / 2048.f) + 1e-6f);
    GAS unsigned long long* o8 = (GAS unsigned long long*)orow + lane;
#pragma unroll
    for (int j = 0; j < 8; ++j) { const f32x4 gg = gr[64 * j];
        o8[64 * j] = (unsigned long long)pk2(v[j].x * rstd * gg.x, v[j].y * rstd * gg.y) | ((unsigned long long)pk2(v[j].z * rstd * gg.z, v[j].w * rstd * gg.w) << 32); }
}

__device__ __forceinline__ void rms_row2_to_bf16(const float* xa, const float* xb, const float* g, bf16* oa, bf16* ob_, int lane) {
    const GAS f32x4* xr = (const GAS f32x4*)xa + lane; const GAS f32x4* yr = (const GAS f32x4*)xb + lane; const f32x4* gr = (const f32x4*)g + lane;
    f32x4 v[8], w[8]; float s = 0.f, t = 0.f;
#pragma unroll
    for (int j = 0; j < 8; ++j) { v[j] = __builtin_nontemporal_load(xr + 64 * j); w[j] = __builtin_nontemporal_load(yr + 64 * j); }
#pragma unroll
    for (int j = 0; j < 8; ++j) { s += (v[j].x * v[j].x + v[j].y * v[j].y) + (v[j].z * v[j].z + v[j].w * v[j].w); t += (w[j].x * w[j].x + w[j].y * w[j].y) + (w[j].z * w[j].z + w[j].w * w[j].w); }
    const float rs = rsqrtf(wsum(s) * (1.f / 2048.f) + 1e-6f), rt = rsqrtf(wsum(t) * (1.f / 2048.f) + 1e-6f);
    GAS unsigned long long* o8 = (GAS unsigned long long*)oa + lane; GAS unsigned long long* p8 = (GAS unsigned long long*)ob_ + lane;
#pragma unroll
    for (int j = 0; j < 8; ++j) { const f32x4 gg = gr[64 * j];
        o8[64 * j] = (unsigned long long)pk2(v[j].x * rs * gg.x, v[j].y * rs * gg.y) | ((unsigned long long)pk2(v[j].z * rs * gg.z, v[j].w * rs * gg.w) << 32);
        p8[64 * j] = (unsigned long long)pk2(w[j].x * rt * gg.x, w[j].y * rt * gg.y) | ((unsigned long long)pk2(w[j].z * rt * gg.z, w[j].w * rt * gg.w) << 32); }
}

template <int K, int VAR = 0> __device__ __forceinline__ void fmac_dpp(float& acc, float op, float s) {
    if (VAR == 0) asm("v_fmac_f32_dpp %0, %1, %2 quad_perm:[%c3,%c3,%c3,%c3] row_mask:0xf bank_mask:0xf" : "+v"(acc) : "v"(op), "v"(s), "i"(K));
    else asm("v_fmac_f32_e32 %0, %1, %2" : "+v"(acc) : "v"(op), "v"(s)); }
template <int K, int VAR = 0> __device__ __forceinline__ void mulip_dpp(float& s, float op) {
    if (VAR == 0) asm("v_mul_f32_dpp %0, %1, %0 quad_perm:[%c2,%c2,%c2,%c2] row_mask:0xf bank_mask:0xf" : "+v"(s) : "v"(op), "i"(K));
    else asm("v_mul_f32_e32 %0, %1, %0" : "+v"(s) : "v"(op)); }
#define SCAN_FOR_C(...) _Pragma("unroll") for (int j = 0; j < 4; ++j) { \
    { constexpr int k = 0; _Pragma("unroll") for (int i = 0; i < 4; ++i) { const int c = 16 * j + 4 * k + i; __VA_ARGS__ } } \
    { constexpr int k = 1; _Pragma("unroll") for (int i = 0; i < 4; ++i) { const int c = 16 * j + 4 * k + i; __VA_ARGS__ } } \
    { constexpr int k = 2; _Pragma("unroll") for (int i = 0; i < 4; ++i) { const int c = 16 * j + 4 * k + i; __VA_ARGS__ } } \
    { constexpr int k = 3; _Pragma("unroll") for (int i = 0; i < 4; ++i) { const int c = 16 * j + 4 * k + i; __VA_ARGS__ } } }

constexpr int SCAN_CH = 4;
constexpr int SC_RING = 0, SC_VG = 2 * SCAN_CH * 320, SC_Y = SC_VG + 2 * SCAN_CH * 64, SC_SLOT_F = SC_Y + 2 * SCAN_CH * 128;
__device__ __forceinline__ void scan4_phase(const int lane, const int wave, const int vcu, const int G, unsigned char* ws, unsigned char* ob, const bf16* RKV, LAS float* ldsf) {
    constexpr int CH = SCAN_CH, NCHUNK = SEGLEN / CH;
#define SCAN_BAR() do { asm volatile("s_waitcnt lgkmcnt(0)" ::: "memory"); __builtin_amdgcn_s_barrier(); asm volatile("" ::: "memory"); } while (0)
    const int slot = wave & 3; LAS float* sl = ldsf + slot * SC_SLOT_F;
    for (int round = 0; round * G * 4 < 16 * NSEG; ++round) {
        const int task = round * G * 4 + vcu * 4 + slot; const bool valid = task < 16 * NSEG; const int h = valid ? task / NSEG : 0, seg = valid ? task % NSEG : 0; const int t0 = seg * SEGLEN;
        if (wave >= 4) {
            const bf16* SCN = (const bf16*)(ws + WS_SCN) + ((size_t)h * S_) * 192; const bf16* Eb = (const bf16*)(ws + WS_E);
            bf16* YL = (bf16*)(ob + OUT_YLOC) + ((size_t)h * S_) * 64 + lane; bf16* ZZ = (bf16*)(ws + WS_Z) + ((size_t)h * S_) * 64 + lane;
            unsigned short pk[CH], pb[CH], pt[CH], pr[CH], pe[CH], pv[CH];
#define SCAN_ISSUE(n) do { const int tc_ = t0 + (n) * CH; \
            _Pragma("unroll") for (int s = 0; s < CH; ++s) { const size_t t = (size_t)(tc_ + s); \
                pk[s] = SCN[t * 192 + lane]; pb[s] = SCN[t * 192 + 64 + lane]; pt[s] = SCN[t * 192 + 128 + lane]; \
                pr[s] = RKV[t * 3072 + h * 64 + lane]; pe[s] = Eb[t * 1024 + h * 64 + lane]; pv[s] = RKV[t * 3072 + 2048 + h * 64 + lane]; } } while (0)
#define SCAN_WRITE(n) do { const int b_ = (n) & 1; \
            _Pragma("unroll") for (int s = 0; s < CH; ++s) { LAS float* q = sl + SC_RING + (b_ * CH + s) * 320; \
                q[lane] = bf2f(pk[s]); q[64 + lane] = bf2f(pr[s]); q[128 + lane] = __expf(-bf2f(pe[s])); q[192 + lane] = bf2f(pb[s]); q[256 + lane] = bf2f(pt[s]); \
                sl[SC_VG + (b_ * CH + s) * 64 + lane] = bf2f(pv[s]); } } while (0)
#define SCAN_YSTORE(n) do { const int tc_ = t0 + (n) * CH; const int b_ = (n) & 1; \
            _Pragma("unroll") for (int s = 0; s < CH; ++s) { YL[(size_t)(tc_ + s) * 64] = (unsigned short)f2bf(sl[SC_Y + (b_ * CH + s) * 128 + lane]); ZZ[(size_t)(tc_ + s) * 64] = (unsigned short)f2bf(sl[SC_Y + (b_ * CH + s) * 128 + 64 + lane]); } } while (0)
            if (valid) { SCAN_ISSUE(0); SCAN_WRITE(0); SCAN_ISSUE(1); }
            SCAN_BAR();
#pragma unroll 1
            for (int n = 0; n < NCHUNK; ++n) {
                if (valid) { if (n + 1 < NCHUNK) SCAN_WRITE(n + 1); if (n >= 1) SCAN_YSTORE(n - 1); if (n + 2 < NCHUNK) SCAN_ISSUE(n + 2); }
                SCAN_BAR();
            }
            if (valid) SCAN_YSTORE(NCHUNK - 1);
#undef SCAN_ISSUE
#undef SCAN_WRITE
#undef SCAN_YSTORE
        } else {
            float S[64], M[64]; int ln_ = lane; asm volatile("" : "+v"(ln_));
#pragma unroll
            for (int c = 0; c < 64; ++c) { S[c] = 0.f; M[c] = (c == ln_) ? 1.f : 0.f; }
            SCAN_BAR();
#pragma unroll 1
            for (int n = 0; n < NCHUNK; ++n) {
                const int b = n & 1;
                if (valid) {
                f32x4 KK[4];
                { const LAS f32x4* q4 = (const LAS f32x4*)(sl + SC_RING + (b * CH) * 320) + (lane & 3);
#pragma unroll
                  for (int j = 0; j < 4; ++j) KK[j] = q4[j * 4]; }
#pragma unroll 1
                for (int s = 0; s < CH; ++s) {
                    const LAS f32x4* q4 = (const LAS f32x4*)(sl + SC_RING + (b * CH + s) * 320) + (lane & 3);
                    f32x4 WW[4], BB[4], KT[4];
#pragma unroll
                    for (int j = 0; j < 4; ++j) { WW[j] = q4[32 + j * 4]; BB[j] = q4[48 + j * 4]; KT[j] = q4[64 + j * 4]; }
                    const float vt = sl[SC_VG + (b * CH + s) * 64 + lane];
                    float saq[4], sbq[4];
#pragma unroll
                    for (int q = 0; q < 4; ++q) { saq[q] = 0.f; sbq[q] = 0.f; }
                    SCAN_FOR_C( fmac_dpp<k>(saq[i], KK[j][i], S[c]); fmac_dpp<k>(sbq[i], KK[j][i], M[c]); )
                    const float sa = (saq[0] + saq[1]) + (saq[2] + saq[3]), sb = (sbq[0] + sbq[1]) + (sbq[2] + sbq[3]);
#pragma unroll
                    for (int j = 0; j < 4; ++j) KK[j] = q4[16 + j * 4];
                    SCAN_FOR_C( mulip_dpp<k>(S[c], WW[j][i]); )
                    SCAN_FOR_C( fmac_dpp<k>(S[c], BB[j][i], sa); )
                    SCAN_FOR_C( fmac_dpp<k>(S[c], KT[j][i], vt); )
                    SCAN_FOR_C( mulip_dpp<k>(M[c], WW[j][i]); )
                    SCAN_FOR_C( fmac_dpp<k>(M[c], BB[j][i], sb); )
                    float ylq[4], zq[4];
#pragma unroll
                    for (int q = 0; q < 4; ++q) { ylq[q] = 0.f; zq[q] = 0.f; }
                    SCAN_FOR_C( fmac_dpp<k>(ylq[i], KK[j][i], S[c]); fmac_dpp<k>(zq[i], KK[j][i], M[c]); )
                    sl[SC_Y + (b * CH + s) * 128 + lane] = (ylq[0] + ylq[1]) + (ylq[2] + ylq[3]);
                    sl[SC_Y + (b * CH + s) * 128 + 64 + lane] = (zq[0] + zq[1]) + (zq[2] + zq[3]);
                    { const LAS f32x4* qn = (const LAS f32x4*)(sl + SC_RING + (b * CH + ((s + 1) & (CH - 1))) * 320) + (lane & 3);
#pragma unroll
                      for (int j = 0; j < 4; ++j) KK[j] = qn[j * 4]; }
                }
                }
                SCAN_BAR();
            }
            if (valid) {
                f32x4* op = (f32x4*)((float*)(ws + WS_SLOC) + (((size_t)h * NSEG + seg) * 64 + lane) * 64);
                bf16* oq = (bf16*)(ws + WS_ASEG) + ((size_t)h * NSEG + seg) * 4096 + lane;
#pragma unroll
                for (int q = 0; q < 16; ++q) op[q] = (f32x4){S[4 * q], S[4 * q + 1], S[4 * q + 2], S[4 * q + 3]};
#pragma unroll
                for (int c2 = 0; c2 < 64; ++c2) oq[c2 * 64] = (unsigned short)f2bf(M[c2]);
            }
        }
        SCAN_BAR();
    }
#undef SCAN_BAR
}

__global__ void __launch_bounds__(NWAVES * 64, 2) mk_fwd(Args args) {
    extern __shared__ __attribute__((aligned(16))) unsigned char lds[];
    Frame F;
    F.lds = (LAS unsigned char*)lds; F.MISC = (volatile LAS unsigned*)(F.lds + MISC_OFF);
    F.tid = threadIdx.x; F.wave = __builtin_amdgcn_readfirstlane(F.tid >> 6);
    F.G = gridDim.x; F.vcu = 0;
    unsigned char* ws = args.ws; F.ctl = (gu32*)(ws + WS_CTL);
    const float* const* in = args.in;
    unsigned char* ob = (unsigned char*)args.out;
    for (int u = threadIdx.x; u < (LDS_BYTES - LDSCTL_OFF) / 4; u += NWAVES * 64) ((LAS unsigned*)(F.lds + LDSCTL_OFF))[u] = 0u;
    __syncthreads();
    XcdBarrier bar; bar.bar = (unsigned*)(F.ctl + CW_BAR); bar.x = 0; bar.st = nullptr;
    int bidv = (int)blockIdx.x;
    if (!MK_PER_PHASE) {
        bar.bar = (unsigned*)(F.ctl + CW_BAR); bar.x = xb_xcc_id(); bar.st = F.MISC + 8;
        if (threadIdx.x == 0) {
            const unsigned rank = xb_add(&bar.bar[XB_XCNT(bar.x)], 1u);
            unsigned cnts[16], sum, sp = 0u;
            for (;;) { sum = 0u;
#pragma unroll
                for (unsigned j = 0; j < 16; ++j) { cnts[j] = xb_ld(&bar.bar[XB_XCNT(j)]); sum += cnts[j]; }
                if (sum == (unsigned)F.G) break;
                __builtin_amdgcn_s_sleep(1);
                if ((++sp & 255u) == 0u) { if (xb_ld(&bar.bar[XB_TMO])) break; if (sp > XB_SPIN_CAP) { atomicAdd(&bar.bar[XB_TMO], 1u); break; } } }
            unsigned nx = 0u, xi = 0u, mine = 0u; bool even = true;
#pragma unroll
            for (unsigned j = 0; j < 16; ++j) { if (cnts[j]) { nx++; if (cnts[j] * 8u != (unsigned)F.G) even = false; } if (j < bar.x && cnts[j]) xi++; if (j == bar.x) mine = cnts[j]; }
            F.MISC[8] = mine ? mine : 1u; F.MISC[9] = nx ? nx : 1u;
            F.MISC[10] = (even && nx == 8u && sum == (unsigned)F.G) ? rank * 8u + xi : (unsigned)blockIdx.x;
        }
        __syncthreads();
        bidv = (int)__builtin_amdgcn_readfirstlane((int)F.MISC[10]);
    }
    F.vcu = (F.G % 8 == 0) ? (bidv % 8) * (F.G / 8) + bidv / 8 : bidv;
    const int lo = args.ph_lo, hi = args.ph_hi;
#ifndef PH_MASK
#define PH_MASK 0xFFFF
#endif
#define IN(k) ((((PH_MASK) >> (k)) & 1) && lo <= (k) && (k) < hi)
#ifndef PROBE_MASK
#define PROBE_MASK 0
#endif
#ifndef PROBE_VARIANT
#define PROBE_VARIANT 0
#endif
#ifndef PROBE_N
#define PROBE_N 1
#endif
#define PHASE_BEGIN(k) if (IN(k)) { for (int rep_ = 0; rep_ < 1 + ((((PROBE_MASK) >> (k)) & 1) ? (PROBE_N) : 0); ++rep_) { if (rep_) xcd_barrier(bar); PHASE_IDS
#define PHASE_END } }
#define SEAM(k) do { if (IN(k) && IN((k) + 1)) xcd_barrier(bar); } while (0)
    const int gw = F.vcu * NWAVES + F.wave, NGW = F.G * NWAVES; const int NGT = F.G * NWAVES * 64;
#define PHASE_IDS const int lane = mk_lane_id(), tid = F.wave * 64 + lane, gt = F.vcu * (NWAVES * 64) + tid; (void)gt; (void)lane;

    bf16* WIN_T = (bf16*)(ws + WS_WIN); bf16* WA_T = (bf16*)(ws + WS_WA); bf16* WB_T = (bf16*)(ws + WS_WB); bf16* WOUT_T = (bf16*)(ws + WS_WOUT);
    bf16* WS_T = (bf16*)(ws + WS_WS); bf16* LORA_T = (bf16*)(ws + WS_LORA);
    bf16* XN = (bf16*)(ob + OUT_XN); bf16* RKV = (bf16*)(ob + OUT_RKV); bf16* LIN = (bf16*)(ob + OUT_LIN);
    bf16* PR = (bf16*)(ws + WS_PR); bf16* PD = (bf16*)(ws + WS_PD); bf16* PG = (bf16*)(ws + WS_PG);

    PHASE_BEGIN(0)
        LAS float* scr = (LAS float*)(F.lds + RING_OFF + F.wave * 16384);
        constexpr int I_IN = 32 * 334, I_A = 16 * 64, I_B = 16 * 64, I_O = 32 * 64, I_L = 4 * 32;
        constexpr int NIT = I_IN + I_A + I_B + I_O + 3 * I_L;
        for (int it = gw; it < NIT; it += NGW) {
            int r = it;
            if (r < I_IN) { const int kb = r / 334, nb = r % 334, n0 = nb * 32; transpose_block(in[2], 10688, kb * 64, n0, 2048, WIN_T, 2048, n0 + (n0 >= 3520 ? 64 : 0), scr, lane); continue; } r -= I_IN;
            if (r < I_A) { const int kb = r / 64, nb = r % 64; transpose_block(in[19], 2048, kb * 64, nb * 32, 1024, WA_T, 2048, nb * 32, scr, lane); continue; } r -= I_A;
            if (r < I_B) { const int kb = r / 64, nb = r % 64; transpose_block(in[20], 2048, kb * 64, nb * 32, 1024, WA_T + 1024, 2048, nb * 32, scr, lane); continue; } r -= I_B;
            if (r < I_O) { const int kb = r / 64, nb = r % 64; transpose_block(in[21], 2048, kb * 64, nb * 32, 2048, WOUT_T, 2048, nb * 32, scr, lane); continue; } r -= I_O;
            { const int which = r / I_L, rr = r % I_L, kb = rr / 32, nb = rr % 32; const float* W = which == 0 ? in[5] : (which == 1 ? in[7] : in[8]);
              transpose_block(W, 1024, kb * 64, nb * 32, which == 2 ? 256 : 96, LORA_T + (size_t)which * 1024 * 256, 256, nb * 32, scr, lane); }
        }
        for (int i = gt; i < 16384; i += NGT) *(GAS v4u*)(WIN_T + (size_t)3520 * 2048 + (size_t)i * 8) = (v4u){0u, 0u, 0u, 0u};
        for (int task = gw; task < 16 * 32 * 4; task += NGW) {
            const int hp = task >> 7, kb = (task >> 2) & 31, ng = task & 3; const int k = kb * 64 + lane;
            const f32x4* wq = (const f32x4*)(in[23] + (size_t)k * 2048 + hp * 128);
            f32x4 q[32];
#pragma unroll
            for (int d = 0; d < 32; ++d) q[d] = wq[d];
            const f32x4* sk4 = (const f32x4*)(in[24] + ((size_t)hp * 128 + ng * 32) * 128); LAS f32x4* sks = (LAS f32x4*)scr;
#pragma unroll
            for (int i = 0; i < 16; ++i) sks[i * 64 + lane] = sk4[i * 64 + lane];
            LDS_WAIT(); asm volatile("" ::: "memory");
#pragma unroll 2
            for (int n = 0; n < 32; ++n) { const LAS f32x4* s4 = sks + n * 32; float a0 = 0.f, a1 = 0.f;
#pragma unroll
                for (int d = 0; d < 32; ++d) { const f32x4 s = s4[d]; a0 = fmaf(q[d].x, s.x, a0); a1 = fmaf(q[d].y, s.y, a1); a0 = fmaf(q[d].z, s.z, a0); a1 = fmaf(q[d].w, s.w, a1); }
                WS_T[(size_t)(hp * 128 + ng * 32 + n) * 2048 + k] = (bf16)f2bf(a0 + a1); }
            LDS_WAIT(); asm volatile("" ::: "memory");
        }
        for (int m = gw; m < S_; m += 2 * NGW) rms_row2_to_bf16(in[0] + (size_t)m * DM, in[0] + (size_t)(m + NGW) * DM, in[1], XN + (size_t)m * DM, XN + (size_t)(m + NGW) * DM, lane);
    PHASE_END
    SEAM(0);
    PHASE_BEGIN(1)
        pg8::Gemm g{XN, WIN_T, S_, 10752, 2048, 2048, 2048, nullptr, 0}; pg8::StaticOrder S; S.init(S_, 10752, F.G, bidv);
        pg8::Epi<pg8::EM_G1> E{PR, PD, PG, nullptr, nullptr, nullptr, attn_body::C2};
        pg8::gemm_phase<pg8::Epi<pg8::EM_G1>, pg8::StaticOrder, true, true>(F.lds + RING_OFF, g, S, E, F.wave);
    PHASE_END
    SEAM(1);
    PHASE_BEGIN(2)
        const float* mu = in[3];
        for (int t = gw; t < S_; t += NGW) {
            const bf16* cur = PR + (size_t)t * 3584; const bf16* prv = cur - 3584;
#pragma unroll 1
            for (int j = 0; j < 7; ++j) { const int ch = lane + 64 * j; if (ch >= 440) break;
                const v4u c4 = *(const GAS v4u*)(cur + ch * 8); v4u p4 = (v4u){0u, 0u, 0u, 0u}; if (t > 0) p4 = *(const GAS v4u*)(prv + ch * 8);
                const f32x4 m0 = *(const f32x4*)(mu + ch * 8), m1 = *(const f32x4*)(mu + ch * 8 + 4);
                float c[8] = {pg8::bflo(c4.x), pg8::bfhi(c4.x), pg8::bflo(c4.y), pg8::bfhi(c4.y), pg8::bflo(c4.z), pg8::bfhi(c4.z), pg8::bflo(c4.w), pg8::bfhi(c4.w)};
                const float p[8] = {pg8::bflo(p4.x), pg8::bfhi(p4.x), pg8::bflo(p4.y), pg8::bfhi(p4.y), pg8::bflo(p4.z), pg8::bfhi(p4.z), pg8::bflo(p4.w), pg8::bfhi(p4.w)};
                const float mm[8] = {m0.x, m0.y, m0.z, m0.w, m1.x, m1.y, m1.z, m1.w};
#pragma unroll
                for (int e = 0; e < 8; ++e) c[e] = c[e] + (p[e] - c[e]) * mm[e];
                bf16* dst;
                if (ch < 384) dst = RKV + (size_t)t * 3072 + ch * 8;
                else { const int col = ch * 8 - 3072;
                    if (col < 96) { dst = LIN + (size_t)t * 768 + col;
#pragma unroll
                        for (int e = 0; e < 8; ++e) c[e] = tanhf(c[e]); }
                    else if (col < 192) dst = LIN + (size_t)t * 768 + 256 + (col - 96);
                    else { dst = LIN + (size_t)t * 768 + 512 + (col - 192);
#pragma unroll
                        for (int e = 0; e < 8; ++e) c[e] = sigmf(c[e]); } }
                *(GAS v4u*)dst = (v4u){pk2(c[0], c[1]), pk2(c[2], c[3]), pk2(c[4], c[5]), pk2(c[6], c[7])};
            }
            if (lane < 40) { const int z = lane < 20 ? 96 + lane * 8 : 352 + (lane - 20) * 8; *(GAS v4u*)(LIN + (size_t)t * 768 + z) = (v4u){0u, 0u, 0u, 0u}; }
        }
    PHASE_END
    SEAM(2);
    PHASE_BEGIN(3)
#pragma unroll 1
        for (int which = 0; which < 3; ++which) {
            int kd = 256; asm volatile("" : "+s"(kd));
            pg8::Gemm g{LIN + which * 256, LORA_T + (size_t)which * 1024 * 256, S_, 1024, kd, 768, 256, nullptr, 0}; pg8::StaticOrder S; S.init(S_, 1024, F.G, bidv);
            pg8::Epi<pg8::EM_LORA_W> E{ws + (which == 0 ? WS_E : (which == 1 ? WS_A : WS_G)), nullptr, nullptr, nullptr, nullptr, which == 0 ? in[4] : (which == 1 ? in[6] : nullptr), which == 0 ? 0.60653065971f : 1.f};
            pg8::gemm_phase<pg8::Epi<pg8::EM_LORA_W>, pg8::StaticOrder, true, true>(F.lds + RING_OFF, g, S, E, F.wave); }
    PHASE_END
    SEAM(3);
    PHASE_BEGIN(4)
        bf16* SCN = (bf16*)(ws + WS_SCN); float* SCAL = (float*)(ws + WS_SCAL); const bf16* Ab = (const bf16*)(ws + WS_A);
        for (int t = gw; t < S_; t += NGW) {
#pragma unroll 2
            for (int h = 0; h < 16; ++h) { const int cc = h * 64 + lane;
                const float r = bf2f(RKV[(size_t)t * 3072 + cc]), k = bf2f(RKV[(size_t)t * 3072 + 1024 + cc]), a = bf2f(Ab[(size_t)t * 1024 + cc]);
                float kk = k * in[9][cc]; const float nrm = sqrtf(wsum(kk * kk)); kk = kk / fmaxf(nrm, 1e-12f);
                const float kt = k * (1.f + (a - 1.f) * in[10][cc]); const float b = kk * a;
                const unsigned short kkb = (unsigned short)f2bf(-kk), bb = (unsigned short)f2bf(b), ktb = (unsigned short)f2bf(kt);
                bf16* q = SCN + ((size_t)h * S_ + t) * 192; q[lane] = kkb; q[64 + lane] = bb; q[128 + lane] = ktb;
                const float br = wsum(bf2f(bb) * r), kr = wsum(bf2f(ktb) * r), bon = wsum(r * kt * in[11][cc]);
                if (lane == 0) *(f32x4*)(SCAL + ((size_t)h * S_ + t) * 4) = (f32x4){br, kr, bon, 0.f}; }
        }
    PHASE_END
    SEAM(4);
    PHASE_BEGIN(5)
        scan4_phase(lane, F.wave, F.vcu, F.G, ws, ob, RKV, (LAS float*)(F.lds + RING_OFF));
    PHASE_END
    SEAM(5);
    PHASE_BEGIN(6)
        if (F.vcu < 16) { const int h = F.vcu; const int wv = F.wave;
            constexpr int PIT = 72;
            LAS bf16* Sb = (LAS bf16*)(F.lds + RING_OFF);
            LAS bf16* Atb = Sb + 2 * 64 * PIT;
            const float* SL = (const float*)(ws + WS_SLOC) + (size_t)h * NSEG * 4096; const bf16* AT = (const bf16*)(ws + WS_ASEG) + (size_t)h * NSEG * 4096; float* SI = (float*)(ws + WS_SIN) + (size_t)h * NSEG * 4096;
            for (int i = tid; i < 2 * 64 * PIT / 2; i += 512) ((LAS unsigned*)Sb)[i] = 0u;
#define P6_BAR() do { asm volatile("s_waitcnt lgkmcnt(0)" ::: "memory"); __builtin_amdgcn_s_barrier(); asm volatile("" ::: "memory"); } while (0)
            if (wv >= 4) {
                const int li = tid - 256, row = li >> 2, ch = li & 3;
                v4u r0a, r0b, r1a, r1b;
#define P6_LD(p, ra, rb) do { const bf16* s_ = AT + (size_t)(p) * 4096 + row * 64 + ch * 16; ra = *(const GAS v4u*)s_; rb = *(const GAS v4u*)(s_ + 8); } while (0)
#define P6_ST(p, ra, rb) do { LAS bf16* d_ = Atb + ((p) % 3) * 64 * PIT + row * PIT + ch * 16; *(LAS v4u*)d_ = ra; *(LAS v4u*)(d_ + 8) = rb; } while (0)
                P6_LD(0, r0a, r0b); P6_ST(0, r0a, r0b); P6_LD(1, r0a, r0b); P6_LD(2, r1a, r1b);
                P6_BAR();
#pragma unroll 1
                for (int p = 0; p < NSEG - 1; p += 2) {
                    if (p + 1 < NSEG - 1) P6_ST(p + 1, r0a, r0b); if (p + 3 < NSEG - 1) P6_LD(p + 3, r0a, r0b);
                    P6_BAR();
                    if (p + 1 < NSEG - 1) { if (p + 2 < NSEG - 1) P6_ST(p + 2, r1a, r1b); if (p + 4 < NSEG - 1) P6_LD(p + 4, r1a, r1b); P6_BAR(); }
                }
#undef P6_LD
#undef P6_ST
            } else {
                const int vt = wv >> 1, ct = wv & 1, r = lane & 31, hb = lane >> 5;
                typedef float f32x16 __attribute__((ext_vector_type(16)));
                f32x16 nl;
#define P6_LDL(p) do { const float* s_ = SL + (size_t)(p) * 4096 + (32 * vt + 4 * hb) * 64 + 32 * ct + r; _Pragma("unroll") for (int q = 0; q < 16; ++q) nl[q] = s_[((q & 3) + 8 * (q >> 2)) * 64]; } while (0)
                P6_LDL(0);
                { float* o_ = SI + (32 * vt + 4 * hb) * 64 + 32 * ct + r;
#pragma unroll
                  for (int q = 0; q < 16; ++q) o_[((q & 3) + 8 * (q >> 2)) * 64] = 0.f; }
                P6_BAR();
#pragma unroll 1
                for (int p = 0; p < NSEG - 1; ++p) {
                    const LAS bf16* sa_ = Sb + (p & 1) * 64 * PIT + (32 * vt + r) * PIT + 8 * hb; const LAS bf16* at_ = Atb + (p % 3) * 64 * PIT + (32 * ct + r) * PIT + 8 * hb;
                    f32x16 acc = nl; if (p + 1 < NSEG - 1) P6_LDL(p + 1);
#pragma unroll
                    for (int ks = 0; ks < 4; ++ks) { const bf16x8 af = *(const LAS bf16x8*)(sa_ + 16 * ks), bfr = *(const LAS bf16x8*)(at_ + 16 * ks);
                        acc = __builtin_amdgcn_mfma_f32_32x32x16_bf16(af, bfr, acc, 0, 0, 0); }
                    float* o_ = SI + (size_t)(p + 1) * 4096 + (32 * vt + 4 * hb) * 64 + 32 * ct + r; LAS bf16* sn_ = Sb + ((p + 1) & 1) * 64 * PIT + (32 * vt + 4 * hb) * PIT + 32 * ct + r;
#pragma unroll
                    for (int q = 0; q < 16; ++q) { const int rr = (q & 3) + 8 * (q >> 2); o_[rr * 64] = acc[q]; sn_[rr * PIT] = (unsigned short)f2bf(acc[q]); }
                    P6_BAR();
                }
#undef P6_LDL
            }
#undef P6_BAR
        }
    PHASE_END
    SEAM(6);
    PHASE_BEGIN(7)
        typedef float f32x16 __attribute__((ext_vector_type(16)));
        const int r = lane & 31, hb = lane >> 5;
        const bf16* ZZ = (const bf16*)(ws + WS_Z); const bf16* YL = (const bf16*)(ob + OUT_YLOC); const bf16* Gb = (const bf16*)(ws + WS_G); const float* SCAL = (const float*)(ws + WS_SCAL);
        bf16* YA = (bf16*)(ws + WS_YA);
        constexpr int PITB = 144, BLK = 32 * PITB;
        LAS unsigned char* wl = F.lds + RING_OFF + F.wave * (3 * BLK) - BLK;
        const int lr = lane >> 3, lc = lane & 7;
        for (int task = gw; task < 16 * NSEG * 2; task += NGW) { const int h = task >> 7, seg = (task >> 1) & 63, half = task & 1;
            bf16x8 af[2][4];
            { const float* si = (const float*)(ws + WS_SIN) + ((size_t)h * NSEG + seg) * 4096;
#pragma unroll
              for (int vt = 0; vt < 2; ++vt)
#pragma unroll
                  for (int ks = 0; ks < 4; ++ks) { const f32x4 a = *(const f32x4*)(si + (32 * vt + r) * 64 + 16 * ks + 8 * hb), b = *(const f32x4*)(si + (32 * vt + r) * 64 + 16 * ks + 8 * hb + 4);
                      const v4u w = (v4u){pk2(a.x, a.y), pk2(a.z, a.w), pk2(b.x, b.y), pk2(b.z, b.w)}; af[vt][ks] = __builtin_bit_cast(bf16x8, w); } }
            f32x4 lg[2][4], lb[2][4];
#pragma unroll
            for (int vt = 0; vt < 2; ++vt)
#pragma unroll
                for (int qq = 0; qq < 4; ++qq) { lg[vt][qq] = *(const f32x4*)(in[12] + h * 64 + 32 * vt + 8 * qq + 4 * hb); lb[vt][qq] = *(const f32x4*)(in[13] + h * 64 + 32 * vt + 8 * qq + 4 * hb); }
#pragma unroll 1
            for (int tt = 0; tt < 4; ++tt) { const int tb0 = seg * SEGLEN + half * 128 + tt * 32; const size_t hb0 = (size_t)h * S_ + tb0;
                v4u ry[4], rv[4], rg[4];
#pragma unroll
                for (int i = 0; i < 4; ++i) { const int row = lr + 8 * i;
                    ry[i] = *(const GAS v4u*)(YL + (hb0 + row) * 64 + lc * 8);
                    rv[i] = *(const GAS v4u*)(RKV + (size_t)(tb0 + row) * 3072 + 2048 + h * 64 + lc * 8); rg[i] = *(const GAS v4u*)(Gb + (size_t)(tb0 + row) * 1024 + h * 64 + lc * 8); }
                const float bon = SCAL[(hb0 + r) * 4 + 2];
#pragma unroll
                for (int i = 0; i < 4; ++i) { const int o = (lr + 8 * i) * PITB + lc * 16;
                    *(LAS v4u*)(wl + BLK + o) = ry[i]; *(LAS v4u*)(wl + 2 * BLK + o) = rv[i]; *(LAS v4u*)(wl + 3 * BLK + o) = rg[i]; }
                LDS_WAIT(); asm volatile("" ::: "memory");
                bf16x8 zf[4];
#pragma unroll
                for (int ks = 0; ks < 4; ++ks) zf[ks] = *(const bf16x8*)(ZZ + (hb0 + r) * 64 + 16 * ks + 8 * hb);
                f32x16 acc[2];
#pragma unroll
                for (int vt = 0; vt < 2; ++vt)
#pragma unroll
                    for (int qq = 0; qq < 4; ++qq) { const unsigned long long w = *(const LAS unsigned long long*)(wl + BLK + r * PITB + (32 * vt + 8 * qq + 4 * hb) * 2);
                        acc[vt][4 * qq] = pg8::bflo((unsigned)w); acc[vt][4 * qq + 1] = pg8::bfhi((unsigned)w); acc[vt][4 * qq + 2] = pg8::bflo((unsigned)(w >> 32)); acc[vt][4 * qq + 3] = pg8::bfhi((unsigned)(w >> 32)); }
#pragma unroll
                for (int vt = 0; vt < 2; ++vt)
#pragma unroll
                    for (int ks = 0; ks < 4; ++ks) acc[vt] = __builtin_amdgcn_mfma_f32_32x32x16_bf16(af[vt][ks], zf[ks], acc[vt], 0, 0, 0);
                float s1 = 0.f;
#pragma unroll
                for (int vt = 0; vt < 2; ++vt)
#pragma unroll
                    for (int q = 0; q < 16; ++q) s1 += acc[vt][q];
                { auto rr = __builtin_amdgcn_permlane32_swap(__float_as_uint(s1), __float_as_uint(s1), false, false); s1 = __uint_as_float(rr[0]) + __uint_as_float(rr[1]); }
                const float mean = s1 * (1.f / 64.f); float s2 = 0.f;
#pragma unroll
                for (int vt = 0; vt < 2; ++vt)
#pragma unroll
                    for (int q = 0; q < 16; ++q) { acc[vt][q] -= mean; s2 += acc[vt][q] * acc[vt][q]; }
                { auto rr = __builtin_amdgcn_permlane32_swap(__float_as_uint(s2), __float_as_uint(s2), false, false); s2 = __uint_as_float(rr[0]) + __uint_as_float(rr[1]); }
                const float rstd = rsqrtf(s2 * (1.f / 64.f) + 64e-5f);
#pragma unroll
                for (int vt = 0; vt < 2; ++vt)
#pragma unroll
                    for (int qq = 0; qq < 4; ++qq) { const int vo = r * PITB + (32 * vt + 8 * qq + 4 * hb) * 2;
                        const unsigned long long vw = *(const LAS unsigned long long*)(wl + 2 * BLK + vo), gw_ = *(const LAS unsigned long long*)(wl + 3 * BLK + vo);
                        const float vv[4] = {pg8::bflo((unsigned)vw), pg8::bfhi((unsigned)vw), pg8::bflo((unsigned)(vw >> 32)), pg8::bfhi((unsigned)(vw >> 32))};
                        const float gg[4] = {pg8::bflo((unsigned)gw_), pg8::bfhi((unsigned)gw_), pg8::bflo((unsigned)(gw_ >> 32)), pg8::bfhi((unsigned)(gw_ >> 32))};
                        float o[4];
#pragma unroll
                        for (int i = 0; i < 4; ++i) o[i] = (acc[vt][4 * qq + i] * rstd * lg[vt][qq][i] + lb[vt][qq][i] + bon * vv[i]) * gg[i];
                        *(LAS unsigned long long*)(wl + BLK + vo) = (unsigned long long)pk2(o[0], o[1]) | ((unsigned long long)pk2(o[2], o[3]) << 32); }
                LDS_WAIT(); asm volatile("" ::: "memory");
#pragma unroll
                for (int i = 0; i < 4; ++i) { const int row = lr + 8 * i; *(GAS v4u*)(YA + (size_t)(tb0 + row) * 1024 + h * 64 + lc * 8) = *(const LAS v4u*)(wl + BLK + row * PITB + lc * 16); }
                LDS_WAIT(); asm volatile("" ::: "memory");
            }
        }
    PHASE_END
    SEAM(7);
    PHASE_BEGIN(8)
        __syncthreads();
        attn_body::attn_phase<8>((char*)lds + RING_OFF, (const attn_body::bf16*)PD, (attn_body::bf16*)(ws + WS_OATT), F.vcu, F.wave);
    PHASE_END
    SEAM(8);
    PHASE_BEGIN(9)
        float d1 = 0.f, d2 = 0.f; d1 = in[14][lane] * in[15][lane]; d2 = in[16][lane] * in[17][lane];
        const float lam = __expf(wave_sum(d1)) - __expf(wave_sum(d2)) + 0.2f;
        const bf16* OA = (const bf16*)(ws + WS_OATT); bf16* YB = (bf16*)(ws + WS_YB);
        f32x4 sg[4];
#pragma unroll
        for (int q = 0; q < 4; ++q) sg[q] = *(const f32x4*)(in[18] + (lane & 7) * 16 + q * 4);
        for (int t = gw; t < S_; t += NGW) {
            const v4u a0 = *(const GAS v4u*)(OA + (size_t)t * 2048 + lane * 16), a1 = *(const GAS v4u*)(OA + (size_t)t * 2048 + lane * 16 + 8);
            const v4u b0 = *(const GAS v4u*)(OA + (size_t)t * 2048 + 1024 + lane * 16), b1 = *(const GAS v4u*)(OA + (size_t)t * 2048 + 1024 + lane * 16 + 8);
            const unsigned aw[8] = {a0.x, a0.y, a0.z, a0.w, a1.x, a1.y, a1.z, a1.w}, bw[8] = {b0.x, b0.y, b0.z, b0.w, b1.x, b1.y, b1.z, b1.w};
            float o[16]; float ss = 0.f;
#pragma unroll
            for (int e = 0; e < 8; ++e) { o[2 * e] = pg8::bflo(aw[e]) - lam * pg8::bflo(bw[e]); o[2 * e + 1] = pg8::bfhi(aw[e]) - lam * pg8::bfhi(bw[e]); ss += o[2 * e] * o[2 * e] + o[2 * e + 1] * o[2 * e + 1]; }
            ss += __shfl_xor(ss, 1); ss += __shfl_xor(ss, 2); ss += __shfl_xor(ss, 4);
            const float rs = rsqrtf(ss * (1.f / 128.f) + 1e-5f) * 0.8f;
            const float gg[16] = {sg[0].x, sg[0].y, sg[0].z, sg[0].w, sg[1].x, sg[1].y, sg[1].z, sg[1].w, sg[2].x, sg[2].y, sg[2].z, sg[2].w, sg[3].x, sg[3].y, sg[3].z, sg[3].w};
#pragma unroll
            for (int e = 0; e < 16; ++e) o[e] = o[e] * rs * gg[e];
            *(GAS v4u*)(YB + (size_t)t * 1024 + lane * 16) = (v4u){pk2(o[0], o[1]), pk2(o[2], o[3]), pk2(o[4], o[5]), pk2(o[6], o[7])};
            *(GAS v4u*)(YB + (size_t)t * 1024 + lane * 16 + 8) = (v4u){pk2(o[8], o[9]), pk2(o[10], o[11]), pk2(o[12], o[13]), pk2(o[14], o[15])};
        }
    PHASE_END
    SEAM(9);
    PHASE_BEGIN(10)
        pg8::Gemm g{(const bf16*)(ws + WS_YA), WA_T, S_, 2048, 2048, 1024, 2048, (const bf16*)(ws + WS_YB), 16}; pg8::StaticOrder S; S.init(S_, 2048, F.G, bidv);
        pg8::Epi<pg8::EM_PROJAB> E{ws + WS_MERGED, nullptr, nullptr, PG, nullptr, nullptr, 1.f};
        pg8::gemm_phase<pg8::Epi<pg8::EM_PROJAB>, pg8::StaticOrder, true, true>(F.lds + RING_OFF, g, S, E, F.wave);
    PHASE_END
    SEAM(10);
    PHASE_BEGIN(12)
        pg8::Gemm g{(const bf16*)(ws + WS_MERGED), WOUT_T, S_, 2048, 2048, 2048, 2048, nullptr, 0}; pg8::StaticOrder S; S.init(S_, 2048, F.G, bidv);
        pg8::Epi<pg8::EM_WOUT> E{ws + WS_H2, nullptr, nullptr, nullptr, in[0], nullptr, 1.f};
        pg8::gemm_phase<pg8::Epi<pg8::EM_WOUT>, pg8::StaticOrder, true, true>(F.lds + RING_OFF, g, S, E, F.wave);
    PHASE_END
    SEAM(12);
    PHASE_BEGIN(13)
        for (int m = gw; m < S_; m += 2 * NGW) rms_row2_to_bf16((const float*)(ws + WS_H2) + (size_t)m * DM, (const float*)(ws + WS_H2) + (size_t)(m + NGW) * DM, in[22], (bf16*)(ws + WS_XN2) + (size_t)m * DM, (bf16*)(ws + WS_XN2) + (size_t)(m + NGW) * DM, lane);
        for (int row = gw; row < 32768; row += NGW) { const int which = row >> 14, r = row & 16383;
            const f32x4* src = (const f32x4*)(in[25 + which] + (size_t)r * 2048) + lane; f32x4 v[8]; float am = 0.f;
#pragma unroll
            for (int j = 0; j < 8; ++j) { v[j] = __builtin_nontemporal_load(src + 64 * j); am = fmaxf(am, fmaxf(fmaxf(fabsf(v[j].x), fabsf(v[j].y)), fmaxf(fabsf(v[j].z), fabsf(v[j].w)))); }
            const unsigned tb = __float_as_uint(am * (1.f / 6.f)); unsigned eb = (tb >> 23) + ((tb & 0x7fffffu) ? 1u : 0u); eb = eb < 1u ? 1u : (eb > 254u ? 254u : eb);
            const float sc = __uint_as_float(eb << 23);
            unsigned wd[4];
#pragma unroll
            for (int w = 0; w < 4; ++w) { unsigned q = 0u;
                q = __builtin_amdgcn_cvt_scalef32_pk_fp4_f32(q, v[2 * w].x, v[2 * w].y, sc, 0); q = __builtin_amdgcn_cvt_scalef32_pk_fp4_f32(q, v[2 * w].z, v[2 * w].w, sc, 1);
                q = __builtin_amdgcn_cvt_scalef32_pk_fp4_f32(q, v[2 * w + 1].x, v[2 * w + 1].y, sc, 2); q = __builtin_amdgcn_cvt_scalef32_pk_fp4_f32(q, v[2 * w + 1].z, v[2 * w + 1].w, sc, 3); wd[w] = q; }
            *(GAS v4u*)(ws + (which ? WS_VTAB : WS_UTAB) + (size_t)r * 1024 + lane * 16) = (v4u){wd[0], wd[1], wd[2], wd[3]};
            ((unsigned char*)(ws + (which ? WS_VSCL : WS_USCL)))[(size_t)r * 64 + lane] = (unsigned char)eb; }
    PHASE_END
    SEAM(13);
    PHASE_BEGIN(14)
        pg8::Gemm g{(const bf16*)(ws + WS_XN2), WS_T, S_, 2048, 2048, 2048, 2048, nullptr, 0}; pg8::StaticOrder S; S.init(S_, 2048, F.G, bidv);
        pg8::Epi<pg8::EM_SCORES> E{ws + WS_SCORES, nullptr, nullptr, nullptr, nullptr, nullptr, 1.f};
        pg8::gemm_phase<pg8::Epi<pg8::EM_SCORES>, pg8::StaticOrder, true, true>(F.lds + RING_OFF, g, S, E, F.wave);
    PHASE_END
    SEAM(14);
    PHASE_BEGIN(15)
        const float* SC = (const float*)(ws + WS_SCORES); const bf16* XN2 = (const bf16*)(ws + WS_XN2);
        const unsigned char* UT = (const unsigned char*)(ws + WS_UTAB); const unsigned char* VT = (const unsigned char*)(ws + WS_VTAB);
        const unsigned char* USB = (const unsigned char*)(ws + WS_USCL); const unsigned char* VSB = (const unsigned char*)(ws + WS_VSCL);
        LAS unsigned* lst = (LAS unsigned*)(F.lds + RING_OFF + F.wave * 10240);
        for (int tb = gw; tb < S_ / 8; tb += NGW) {
            { const int tl = lane >> 3, h = lane & 7; const float* srow = SC + (size_t)(tb * 8 + tl) * 2048 + h * 256;
              float A[16], B[16];
#pragma unroll
              for (int p = 0; p < 2; ++p) { float top[16];
#pragma unroll
                  for (int k = 0; k < 16; ++k) top[k] = -INFINITY;
#pragma unroll 2
                  for (int i4 = 0; i4 < 32; ++i4) { const f32x4 v = *(const f32x4*)(srow + p * 128 + i4 * 4); const float ve[4] = {v.x, v.y, v.z, v.w};
#pragma unroll
                      for (int e = 0; e < 4; ++e) { float x = __uint_as_float((__float_as_uint(ve[e]) & 0xffffff80u) | (unsigned)(i4 * 4 + e));
#pragma unroll
                          for (int k = 0; k < 16; ++k) { const float hi = fmaxf(top[k], x); x = fminf(top[k], x); top[k] = hi; } } }
#pragma unroll
                  for (int k = 0; k < 16; ++k) { if (p == 0) A[k] = top[k]; else B[k] = top[k]; } }
              LAS unsigned* ixl = (LAS unsigned*)(F.lds + RING_OFF + F.wave * 10240 + 8192) + lane * 8;
              { unsigned wa[4], wb[4];
#pragma unroll
                for (int q = 0; q < 4; ++q) { wa[q] = 0u; wb[q] = 0u;
#pragma unroll
                    for (int e = 0; e < 4; ++e) { wa[q] |= (__float_as_uint(A[q * 4 + e]) & 127u) << (8 * e); wb[q] |= (__float_as_uint(B[q * 4 + e]) & 127u) << (8 * e); } }
                *(LAS v4u*)ixl = (v4u){wa[0], wa[1], wa[2], wa[3]}; *(LAS v4u*)(ixl + 4) = (v4u){wb[0], wb[1], wb[2], wb[3]}; }
              float cs[16];
#pragma unroll
              for (int k = 0; k < 16; ++k) cs[k] = -INFINITY;
#pragma unroll
              for (int i = 0; i < 16; ++i)
#pragma unroll
                  for (int j = 0; j < 16; ++j) if ((i + 1) * (j + 1) <= 16) {
                      float x = __uint_as_float((__float_as_uint(A[i] + B[j]) & 0xffffff00u) | (unsigned)(i * 16 + j));
#pragma unroll
                      for (int k = 0; k < 16; ++k) { const float hi = fmaxf(cs[k], x); x = fminf(cs[k], x); cs[k] = hi; } }
              LDS_WAIT(); asm volatile("" ::: "memory");
              const LAS unsigned char* ixb = (const LAS unsigned char*)ixl;
              unsigned cx[16]; float gsum = 0.f; const float cmax = cs[0];
#pragma unroll
              for (int k = 0; k < 16; ++k) { const unsigned ij = __float_as_uint(cs[k]) & 255u; cx[k] = ((unsigned)ixb[ij >> 4] << 7) | (unsigned)ixb[16 + (ij & 15u)]; cs[k] = __expf(cs[k] - cmax); gsum += cs[k]; }
              const float ginv = 1.f / gsum; LAS unsigned* lp = lst + (tl * 128 + h * 16) * 2;
#pragma unroll
              for (int k = 0; k < 16; k += 2) *(LAS v4u*)(lp + k * 2) = (v4u){cx[k], __float_as_uint(cs[k] * ginv), cx[k + 1], __float_as_uint(cs[k + 1] * ginv)}; }
            LDS_WAIT(); asm volatile("" ::: "memory");
#pragma unroll 1
            for (int tl = 0; tl < 8; ++tl) { const int t = tb * 8 + tl;
                float xf[32];
#pragma unroll
                for (int j = 0; j < 8; ++j) { const unsigned long long w = *(const GAS unsigned long long*)(XN2 + (size_t)t * 2048 + 256 * j + 4 * lane);
                    xf[4 * j] = pg8::bflo((unsigned)w); xf[4 * j + 1] = pg8::bfhi((unsigned)w); xf[4 * j + 2] = pg8::bflo((unsigned)(w >> 32)); xf[4 * j + 3] = pg8::bfhi((unsigned)(w >> 32)); }
                float acc[32];
#pragma unroll
                for (int e = 0; e < 32; ++e) acc[e] = 0.f;
                constexpr int EG = 8;
#pragma unroll 1
                for (int e0 = 0; e0 < 128; e0 += EG) {
                    v4u ur[EG], vr[EG]; float gate[EG]; unsigned char sub[EG], svb[EG];
#pragma unroll
                    for (int q = 0; q < EG; ++q) { const unsigned idx = __builtin_amdgcn_readfirstlane(lst[(tl * 128 + e0 + q) * 2]); gate[q] = __uint_as_float(__builtin_amdgcn_readfirstlane(lst[(tl * 128 + e0 + q) * 2 + 1]));
                        ur[q] = *(const GAS v4u*)(UT + (size_t)idx * 1024 + lane * 16); vr[q] = *(const GAS v4u*)(VT + (size_t)idx * 1024 + lane * 16);
                        sub[q] = USB[(size_t)idx * 64 + lane]; svb[q] = VSB[(size_t)idx * 64 + lane]; }
#pragma unroll
                    for (int q = 0; q < EG; ++q) { float d0 = 0.f, d1 = 0.f; const float su = __uint_as_float((unsigned)sub[q] << 23), sv = __uint_as_float((unsigned)svb[q] << 23);
                        const unsigned uw[4] = {ur[q].x, ur[q].y, ur[q].z, ur[q].w};
#pragma unroll
                        for (int w = 0; w < 4; ++w) {
                            const auto p0 = __builtin_amdgcn_cvt_scalef32_pk_f32_fp4(uw[w], su, 0), p1 = __builtin_amdgcn_cvt_scalef32_pk_f32_fp4(uw[w], su, 1), p2 = __builtin_amdgcn_cvt_scalef32_pk_f32_fp4(uw[w], su, 2), p3 = __builtin_amdgcn_cvt_scalef32_pk_f32_fp4(uw[w], su, 3);
                            d0 = fmaf(xf[8 * w], p0[0], d0); d1 = fmaf(xf[8 * w + 1], p0[1], d1); d0 = fmaf(xf[8 * w + 2], p1[0], d0); d1 = fmaf(xf[8 * w + 3], p1[1], d1);
                            d0 = fmaf(xf[8 * w + 4], p2[0], d0); d1 = fmaf(xf[8 * w + 5], p2[1], d1); d0 = fmaf(xf[8 * w + 6], p3[0], d0); d1 = fmaf(xf[8 * w + 7], p3[1], d1); }
                        const float d = wsum(d0 + d1);
                        const float act = 0.5f * d * (1.f + erff(d * 0.70710678118f)); const float cf = gate[q] * act; const float cs = cf * sv;
                        const unsigned vw[4] = {vr[q].x, vr[q].y, vr[q].z, vr[q].w};
#pragma unroll
                        for (int w = 0; w < 4; ++w) {
                            const auto p0 = __builtin_amdgcn_cvt_scalef32_pk_f32_fp4(vw[w], 1.0f, 0), p1 = __builtin_amdgcn_cvt_scalef32_pk_f32_fp4(vw[w], 1.0f, 1), p2 = __builtin_amdgcn_cvt_scalef32_pk_f32_fp4(vw[w], 1.0f, 2), p3 = __builtin_amdgcn_cvt_scalef32_pk_f32_fp4(vw[w], 1.0f, 3);
                            acc[8 * w] = fmaf(cs, p0[0], acc[8 * w]); acc[8 * w + 1] = fmaf(cs, p0[1], acc[8 * w + 1]); acc[8 * w + 2] = fmaf(cs, p1[0], acc[8 * w + 2]); acc[8 * w + 3] = fmaf(cs, p1[1], acc[8 * w + 3]);
                            acc[8 * w + 4] = fmaf(cs, p2[0], acc[8 * w + 4]); acc[8 * w + 5] = fmaf(cs, p2[1], acc[8 * w + 5]); acc[8 * w + 6] = fmaf(cs, p3[0], acc[8 * w + 6]); acc[8 * w + 7] = fmaf(cs, p3[1], acc[8 * w + 7]); }
                    }
                }
                float* orow = args.out + (size_t)t * 2048; const float* hrow = (const float*)(ws + WS_H2) + (size_t)t * 2048; float ss = 0.f;
#pragma unroll
                for (int j = 0; j < 8; ++j) { const f32x4 a = *(const f32x4*)(hrow + 256 * j + 4 * lane);
                    acc[4 * j] += a.x; acc[4 * j + 1] += a.y; acc[4 * j + 2] += a.z; acc[4 * j + 3] += a.w; }
#pragma unroll
                for (int e = 0; e < 32; ++e) ss += acc[e] * acc[e];
                const float rstd = rsqrtf(wsum(ss) * (1.f / 2048.f) + 1e-6f);
#pragma unroll
                for (int j = 0; j < 8; ++j) { const f32x4 g0 = *(const f32x4*)(in[27] + 256 * j + 4 * lane);
                    *(f32x4*)(orow + 256 * j + 4 * lane) = (f32x4){acc[4 * j] * rstd * g0.x, acc[4 * j + 1] * rstd * g0.y, acc[4 * j + 2] * rstd * g0.z, acc[4 * j + 3] * rstd * g0.w}; }
            }
            LDS_WAIT(); asm volatile("" ::: "memory");
        }
    PHASE_END
#undef IN
#undef SEAM
}

extern "C" void kernel_launch(void* const* d_in, const int* in_sizes, int n_in, void* d_out, int out_size, void* d_ws, size_t ws_size, hipStream_t stream) {
    static int grid = 0;
    if (grid == 0) {
        if (n_in != 28 || in_sizes[0] != S_ * DM || out_size != S_ * DM || ws_size < WS_END) { fprintf(stderr, "kernel_launch: unexpected shapes: n_in %d in0 %d out %d ws %zu (need >= %zu)\n", n_in, n_in > 0 ? in_sizes[0] : -1, out_size, ws_size, (size_t)WS_END); grid = -1; return; }
        if (hipFuncSetAttribute((const void*)mk_fwd, hipFuncAttributeMaxDynamicSharedMemorySize, LDS_BYTES) != hipSuccess) { fprintf(stderr, "kernel_launch: hipFuncSetAttribute failed\n"); grid = -1; return; }
        int per_cu = 0;
        if (hipOccupancyMaxActiveBlocksPerMultiprocessor(&per_cu, (const void*)mk_fwd, NWAVES * 64, LDS_BYTES) != hipSuccess || per_cu < 1) fprintf(stderr, "kernel_launch: note: occupancy query reports %d\n", per_cu);
        (void)hipGetLastError();
        grid = 256;
    }
    if (grid < 0) return;
    (void)hipMemsetAsync((char*)d_ws + WS_CTL, 0, CTL_ZERO_BYTES, stream);
    Args a{};
    for (int i = 0; i < 28; ++i) a.in[i] = (const float*)d_in[i];
    a.out = (float*)d_out; a.ws = (unsigned char*)d_ws;
#if MK_PER_PHASE
    for (int p = 0; p < NPH; ++p) { a.ph_lo = p; a.ph_hi = p + 1; hipLaunchKernelGGL(mk_fwd, dim3(grid), dim3(NWAVES * 64), LDS_BYTES, stream, a); }
#else
    a.ph_lo = 0; a.ph_hi = NPH; hipLaunchKernelGGL(mk_fwd, dim3(grid), dim3(NWAVES * 64), LDS_BYTES, stream, a);
#endif
    const hipError_t le = hipPeekAtLastError();
    if (le != hipSuccess) fprintf(stderr, "kernel_launch: launch failed: %s\n", hipGetErrorName(le));
}
```

```cpp
#include <hip/hip_runtime.h>
#include <cstdio>
#include <cstdint>
__device__ __forceinline__ int mk_lane_id() { int l; asm volatile("v_mbcnt_lo_u32_b32 %0, -1, 0\n\tv_mbcnt_hi_u32_b32 %0, -1, %0" : "=v"(l)); return l; }
namespace pg8 {
#define PG8_LAS __attribute__((address_space(3)))
typedef unsigned short bf16_t;
typedef short bf16x8 __attribute__((ext_vector_type(8)));
typedef float f32x4 __attribute__((ext_vector_type(4)));
typedef unsigned u32x4 __attribute__((ext_vector_type(4)));
constexpr int BM = 256, BK = 64, HALF = 128, HTB = HALF * BK * 2  , STAGE_BYTES = 8 * HTB, NXCD = 8, WGM = 8;

__host__ __device__ __forceinline__ int lds_byte(int r, int c) { const int st = (r >> 4) * 2 + (c >> 5), rr = r & 15, cc = c & 31, ob = rr * 64 + cc * 2; return st * 1024 + (ob ^ (((ob >> 9) & 1) << 5)); }
__host__ __device__ __forceinline__ void stage_rc(int b, int& R, int& C) { const int st = b / 1024, sb = b % 1024, swz = sb ^ (((sb >> 9) & 1) << 5); R = (st >> 1) * 16 + swz / 64; C = (st & 1) * 32 + (swz % 64) / 2; }
__host__ __device__ __forceinline__ int perm32(int rho) { const int n = rho >> 4, i = rho & 15; return 8 * (i >> 2) + 4 * n + (i & 3); }

struct Unit { int pm, pn; };
struct Gemm { const bf16_t* A; const bf16_t* Bt; int M, N, K, lda, ldb; const bf16_t* A2; int ksplit; };

struct StaticOrder {
    int nM, nN, nwg, G, c;
    __host__ __device__ void init(int M, int N, int G_, int c_) { nM = M / BM; nN = N / BM; nwg = nM * nN; G = G_; c = c_; }
    __host__ __device__ bool next(int i, Unit& u) const {
        const long L = (long)i * G + c; if (L >= nwg) return false;
        int wgid = (int)L; { const int q = nwg / NXCD, r = nwg % NXCD, xcd = wgid % NXCD, off = wgid / NXCD; wgid = (xcd < r ? xcd * (q + 1) : r * (q + 1) + (xcd - r) * q) + off; }
        const int nig = WGM * nN, gid = wgid / nig, fm = gid * WGM, gsz = (nM - fm) < WGM ? (nM - fm) : WGM;
        u.pm = fm + ((wgid % nig) % gsz); u.pn = (wgid % nig) / gsz; return true;
    }
    __device__ __forceinline__ void a_ready(const Unit&) const {}
    __device__ __forceinline__ void done(const Unit&) const {}
};

__device__ __forceinline__ unsigned cvt_pk_bf16(float lo, float hi) { unsigned r; asm volatile("v_cvt_pk_bf16_f32 %0, %1, %2" : "=v"(r) : "v"(lo), "v"(hi)); return r; }
__device__ __forceinline__ float sigm(float x) { return __builtin_amdgcn_rcpf(1.0f + __expf(-x)); }
__device__ __forceinline__ float bflo(unsigned w) { return __uint_as_float(w << 16); }
__device__ __forceinline__ float bfhi(unsigned w) { return __uint_as_float(w & 0xffff0000u); }
enum { EM_G1 = 0, EM_LORA_W = 1, EM_LORA_A = 2, EM_LORA_G = 3, EM_PROJA = 4, EM_PROJB = 5, EM_WOUT = 6, EM_SCORES = 7, EM_PROJAB = 8 };
template <int MODE> struct Epi {
    static constexpr bool PERM = true, AFTER_DRAIN = false, HAS_MID = (MODE == EM_PROJAB);
    __device__ __forceinline__ void mid(f32x4 (&acc)[2][2][4][2], const Unit& u, int wr, int wc, int fr, int fq) const {
        asm volatile("" ::: "memory");
        int row0 = u.pm * BM + wr * 64 + fr, col0 = u.pn * BM + wc * 32 + 8 * fq; asm volatile("" : "+v"(row0), "+v"(col0));
#pragma unroll
        for (int ai = 0; ai < 2; ++ai) { asm volatile("" ::: "memory");
#pragma unroll
            for (int m = 0; m < 4; ++m) { const size_t row = (size_t)(row0 + ai * HALF + m * 16);
#pragma unroll
                for (int bj = 0; bj < 2; ++bj) { const int col = col0 + bj * HALF;
                    const u32x4 ga = *(const u32x4*)((const bf16_t*)i0 + row * 4096 + col), gb = *(const u32x4*)((const bf16_t*)i0 + row * 4096 + 2048 + col);
                    const unsigned aw[4] = {ga.x, ga.y, ga.z, ga.w}, bw[4] = {gb.x, gb.y, gb.z, gb.w};
#pragma unroll
                    for (int w = 0; w < 4; ++w) { const float r0 = bflo(aw[w]) * __builtin_amdgcn_rcpf(fmaxf(bflo(bw[w]), 1e-30f)), r1 = bfhi(aw[w]) * __builtin_amdgcn_rcpf(fmaxf(bfhi(bw[w]), 1e-30f));
                        acc[ai][bj][m][w >> 1][2 * (w & 1)] *= r0; acc[ai][bj][m][w >> 1][2 * (w & 1) + 1] *= r1; } } } }
        asm volatile("" ::: "memory");
    }
    void* o0; void* o1; void* o2; const void* i0; const void* i1; const float* vec; float sc;
    __device__ __forceinline__ void operator()(const f32x4 (&acc)[2][2][4][2], const Unit& u, int wr, int wc, int fr, int fq) const {
        asm volatile("" ::: "memory");
        int row0 = u.pm * BM + wr * 64 + fr; asm volatile("" : "+v"(row0));
        int colt = u.pn * BM; int ldc = 2048; int sub = 0;
        bf16_t* ob = (bf16_t*)o0; float scl = 1.f;
        if (MODE == EM_G1) {
            if (u.pn < 14) { ldc = 3584; }
            else if (u.pn < 26) { ob = (bf16_t*)o1; ldc = 3072; colt -= 14 * BM; if (u.pn < 18) scl = sc; }
            else { ob = (bf16_t*)o2; ldc = 4096; colt -= 26 * BM; sub = 1; }
        }
        if (MODE == EM_LORA_W || MODE == EM_LORA_A || MODE == EM_LORA_G) ldc = 1024;
        const int col0 = colt + wc * 32 + 8 * fq;
#pragma unroll
        for (int ai = 0; ai < 2; ++ai)
#pragma unroll
            for (int m = 0; m < 4; ++m) { const size_t row = (size_t)(row0 + ai * HALF + m * 16);
#pragma unroll
                for (int bj = 0; bj < 2; ++bj) { f32x4 v0 = acc[ai][bj][m][0], v1 = acc[ai][bj][m][1]; const int col = col0 + bj * HALF;
                    if (MODE == EM_G1) {
                        if (sub) { v0 = (f32x4){sigm(v0[0]), sigm(v0[1]), sigm(v0[2]), sigm(v0[3])}; v1 = (f32x4){sigm(v1[0]), sigm(v1[1]), sigm(v1[2]), sigm(v1[3])}; }
                        else { v0 = v0 * scl; v1 = v1 * scl; }
                        u32x4 w; w.x = cvt_pk_bf16(v0[0], v0[1]); w.y = cvt_pk_bf16(v0[2], v0[3]); w.z = cvt_pk_bf16(v1[0], v1[1]); w.w = cvt_pk_bf16(v1[2], v1[3]);
                        *(u32x4*)(ob + row * ldc + col) = w;
                    } else if (MODE == EM_LORA_W) {
                        if (vec) { const f32x4 b0 = *(const f32x4*)(vec + col), b1 = *(const f32x4*)(vec + col + 4);
                            v0 = v0 + b0; v1 = v1 + b1;
                            v0 = (f32x4){sigm(v0[0]), sigm(v0[1]), sigm(v0[2]), sigm(v0[3])}; v1 = (f32x4){sigm(v1[0]), sigm(v1[1]), sigm(v1[2]), sigm(v1[3])};
                            v0 = v0 * sc; v1 = v1 * sc; }
                        u32x4 w; w.x = cvt_pk_bf16(v0[0], v0[1]); w.y = cvt_pk_bf16(v0[2], v0[3]); w.z = cvt_pk_bf16(v1[0], v1[1]); w.w = cvt_pk_bf16(v1[2], v1[3]);
                        *(u32x4*)(ob + row * ldc + col) = w;
                    } else if (MODE == EM_PROJA) {
                        const u32x4 g = *(const u32x4*)((const bf16_t*)i0 + row * 4096 + col);
                        float* op = (float*)o0 + row * 2048 + col;
                        *(f32x4*)op = (f32x4){v0[0] * bflo(g.x), v0[1] * bfhi(g.x), v0[2] * bflo(g.y), v0[3] * bfhi(g.y)};
                        *(f32x4*)(op + 4) = (f32x4){v1[0] * bflo(g.z), v1[1] * bfhi(g.z), v1[2] * bflo(g.w), v1[3] * bfhi(g.w)};
                    } else if (MODE == EM_PROJB) {
                        const u32x4 g = *(const u32x4*)((const bf16_t*)i0 + row * 4096 + 2048 + col);
                        const float* tp = (const float*)i1 + row * 2048 + col; const f32x4 t0 = *(const f32x4*)tp, t1 = *(const f32x4*)(tp + 4);
                        v0 = (f32x4){t0[0] + v0[0] * bflo(g.x), t0[1] + v0[1] * bfhi(g.x), t0[2] + v0[2] * bflo(g.y), t0[3] + v0[3] * bfhi(g.y)};
                        v1 = (f32x4){t1[0] + v1[0] * bflo(g.z), t1[1] + v1[1] * bfhi(g.z), t1[2] + v1[2] * bflo(g.w), t1[3] + v1[3] * bfhi(g.w)};
                        u32x4 w; w.x = cvt_pk_bf16(v0[0], v0[1]); w.y = cvt_pk_bf16(v0[2], v0[3]); w.z = cvt_pk_bf16(v1[0], v1[1]); w.w = cvt_pk_bf16(v1[2], v1[3]);
                        *(u32x4*)(ob + row * 2048 + col) = w;
                    } else if (MODE == EM_PROJAB) {
                        const u32x4 g = *(const u32x4*)((const bf16_t*)i0 + row * 4096 + 2048 + col);
                        v0 = (f32x4){v0[0] * bflo(g.x), v0[1] * bfhi(g.x), v0[2] * bflo(g.y), v0[3] * bfhi(g.y)};
                        v1 = (f32x4){v1[0] * bflo(g.z), v1[1] * bfhi(g.z), v1[2] * bflo(g.w), v1[3] * bfhi(g.w)};
                        u32x4 w; w.x = cvt_pk_bf16(v0[0], v0[1]); w.y = cvt_pk_bf16(v0[2], v0[3]); w.z = cvt_pk_bf16(v1[0], v1[1]); w.w = cvt_pk_bf16(v1[2], v1[3]);
                        *(u32x4*)(ob + row * 2048 + col) = w;
                    } else if (MODE == EM_WOUT) {
                        const float* xp = (const float*)i1 + row * 2048 + col; const f32x4 t0 = *(const f32x4*)xp, t1 = *(const f32x4*)(xp + 4);
                        float* op = (float*)o0 + row * 2048 + col; *(f32x4*)op = t0 + v0; *(f32x4*)(op + 4) = t1 + v1;
                    } else {
                        float* op = (float*)o0 + row * 2048 + col; *(f32x4*)op = v0; *(f32x4*)(op + 4) = v1;
                    }
                } }
    }
};

template <class Epi, class Sched, bool ALIGN_EPI = false, bool SP2 = false>
__device__ __forceinline__ void gemm_phase(PG8_LAS unsigned char* lds, const Gemm g, const Sched& S, const Epi& E, const int wid_in) {
    int tid_ = wid_in * 64 + mk_lane_id(); asm volatile("" : "+v"(tid_)); const int tid = tid_, wid = __builtin_amdgcn_readfirstlane(tid >> 6), lane = tid & 63, wr = wid >> 2, wc = wid & 3, fr = lane & 15, fq = lane >> 4;
    const int K = g.K, nt = K / BK;
    unsigned voffA[2], voffB[2];
#pragma unroll
    for (int i = 0; i < 2; ++i) { int R, C; stage_rc(tid * 16 + i * 8192, R, C); const int Rb = Epi::PERM ? ((R & ~31) + perm32(R & 31)) : R;
        voffA[i] = (unsigned)(R * g.lda + C) * 2u; voffB[i] = (unsigned)(Rb * g.ldb + C) * 2u; }
    const size_t kstep = (size_t)(BK * 2);
    const size_t hstepA = (size_t)HALF * g.lda * 2, hstepB = (size_t)HALF * g.ldb * 2;
    const size_t tstepA = 2 * hstepA, tstepB = 2 * hstepB;
    const unsigned ldsw = (unsigned)wid * 1024u;
    const int aoff = lds_byte(wr * 64 + fr, fq * 8), boff = lds_byte(wc * 32 + fr, fq * 8);
#define PG8_SA(b, h) (((b) * 2 + (h)) * HTB)
#define PG8_SB(b, h) ((4 + (b) * 2 + (h)) * HTB)
#define PG8_STAGE(bufoff, gbase, voff) do { _Pragma("unroll") for (int _i = 0; _i < 2; ++_i) \
        __builtin_amdgcn_global_load_lds((const unsigned*)((const char*)(gbase) + (voff)[_i]), (PG8_LAS unsigned*)(lds + (bufoff) + ldsw + _i * 8192), 16, 0, 0); } while (0)
#define PG8_LDA(dst, b, h) do { _Pragma("unroll") for (int m = 0; m < 4; ++m) _Pragma("unroll") for (int k = 0; k < 2; ++k) dst[m][k] = *(const PG8_LAS bf16x8*)(lds + PG8_SA(b, h) + aoff + m * 2048 + k * 1024); } while (0)
#define PG8_LDB(dst, b, h) do { _Pragma("unroll") for (int n = 0; n < 2; ++n) _Pragma("unroll") for (int k = 0; k < 2; ++k) dst[n][k] = *(const PG8_LAS bf16x8*)(lds + PG8_SB(b, h) + boff + n * 2048 + k * 1024); } while (0)
#define PG8_MMA(ai, bj, At, Bt) do { __builtin_amdgcn_s_setprio(1); _Pragma("unroll") for (int m = 0; m < 4; ++m) _Pragma("unroll") for (int n = 0; n < 2; ++n) _Pragma("unroll") for (int k = 0; k < 2; ++k) \
        acc[ai][bj][m][n] = __builtin_amdgcn_mfma_f32_16x16x32_bf16(Bt[n][k], At[m][k], acc[ai][bj][m][n], 0, 0, 0); __builtin_amdgcn_s_setprio(0); } while (0)
#define PG8_WAIT_V(n) asm volatile("s_waitcnt vmcnt(" #n ")" ::: "memory")
#define PG8_WAIT_L(n) asm volatile("s_waitcnt lgkmcnt(" #n ")" ::: "memory")
#define PG8_BAR __builtin_amdgcn_s_barrier()
#define PG8_SCHED __builtin_amdgcn_sched_barrier(0)
    Unit cur, nxt; int ui = 0;
    if (!S.next(0, cur)) return;
    f32x4 acc[2][2][4][2];
#pragma unroll
    for (int a = 0; a < 2; ++a)
#pragma unroll
        for (int b = 0; b < 2; ++b)
#pragma unroll
            for (int m = 0; m < 4; ++m)
#pragma unroll
                for (int n = 0; n < 2; ++n) acc[a][b][m][n] = (f32x4){0.f, 0.f, 0.f, 0.f};
    bf16x8 At[4][2], B0[2][2], B1[2][2];
    const char* cA = (const char*)g.A + (size_t)cur.pm * tstepA; const char* cB = (const char*)g.Bt + (size_t)cur.pn * tstepB;
    const int ksplit = g.A2 ? g.ksplit : 0x40000000;
    const char* cA2 = g.A2 ? (const char*)g.A2 + (size_t)cur.pm * tstepA - (size_t)ksplit * kstep : cA;
    S.a_ready(cur);
    if constexpr (SP2) {
        PG8_STAGE(PG8_SB(0, 0), cB, voffB); PG8_STAGE(PG8_SB(0, 1), cB + hstepB, voffB); PG8_STAGE(PG8_SA(0, 0), cA, voffA); PG8_STAGE(PG8_SA(0, 1), cA + hstepA, voffA);
        if (wr == 1) PG8_BAR;
        PG8_WAIT_V(2); PG8_BAR;
        PG8_STAGE(PG8_SB(1, 0), cB + kstep, voffB); PG8_STAGE(PG8_SA(1, 0), cA + kstep, voffA); PG8_STAGE(PG8_SB(1, 1), cB + hstepB + kstep, voffB);
        PG8_WAIT_V(6); PG8_BAR;
    } else {
        PG8_STAGE(PG8_SB(0, 0), cB, voffB); PG8_STAGE(PG8_SA(0, 0), cA, voffA); PG8_STAGE(PG8_SB(0, 1), cB + hstepB, voffB); PG8_STAGE(PG8_SA(0, 1), cA + hstepA, voffA);
        if (wr == 1) PG8_BAR;
        PG8_WAIT_V(4); PG8_BAR;
        PG8_STAGE(PG8_SB(1, 0), cB + kstep, voffB); PG8_STAGE(PG8_SA(1, 0), cA + kstep, voffA); PG8_STAGE(PG8_SB(1, 1), cB + hstepB + kstep, voffB);
        PG8_WAIT_V(6); PG8_BAR;
    }
    for (;;) {
        const bool has_next = S.next(ui + 1, nxt);
        const char* nA2 = (g.A2 && has_next) ? (const char*)g.A2 + (size_t)nxt.pm * tstepA - (size_t)ksplit * kstep : cA2;
        const char* nA = has_next ? (const char*)g.A + (size_t)nxt.pm * tstepA : cA; const char* nB = has_next ? (const char*)g.Bt + (size_t)nxt.pn * tstepB : cB;
#pragma unroll 1
        for (int part = 0; part < (Epi::HAS_MID ? 2 : 1); ++part) {
        if constexpr (Epi::HAS_MID) { if (part == 1) E.mid(acc, cur, wr, wc, fr, fq); }
        const int tbeg = (Epi::HAS_MID && part == 1) ? ksplit : 0, tend = (Epi::HAS_MID && part == 0) ? (ksplit < nt ? ksplit : nt) : nt;
#pragma unroll 1
        for (int t = tbeg; t < tend; t += 2) {
            const bool last = (t == nt - 2);
            const char* a1 = (t + 1 < ksplit ? cA : cA2) + (size_t)(t + 1) * kstep;
            const char* a2 = last ? nA : (t + 2 < ksplit ? cA : cA2) + (size_t)(t + 2) * kstep; const char* b2 = last ? nB : cB + (size_t)(t + 2) * kstep;
            const char* a3 = a2 + kstep; const char* b3 = b2 + kstep;
            if (last && has_next) S.a_ready(nxt);
            if constexpr (SP2) {
            PG8_LDB(B0, 0, 0); PG8_LDB(B1, 0, 1); PG8_SCHED; PG8_LDA(At, 0, 0); PG8_STAGE(PG8_SA(1, 1), a1 + hstepA, voffA);
            PG8_WAIT_V(8); PG8_WAIT_L(0); PG8_BAR; PG8_MMA(0, 0, At, B0); PG8_MMA(0, 1, At, B1); PG8_BAR; PG8_SCHED;
            PG8_LDA(At, 0, 1); PG8_STAGE(PG8_SB(0, 0), b2, voffB); PG8_STAGE(PG8_SB(0, 1), b2 + hstepB, voffB); PG8_STAGE(PG8_SA(0, 0), a2, voffA);
            PG8_WAIT_V(8); PG8_WAIT_L(0); PG8_BAR; PG8_MMA(1, 0, At, B0); PG8_MMA(1, 1, At, B1); PG8_BAR; PG8_SCHED;
            PG8_LDB(B0, 1, 0); PG8_LDB(B1, 1, 1); PG8_SCHED; PG8_LDA(At, 1, 0); PG8_STAGE(PG8_SA(0, 1), a2 + hstepA, voffA);
            PG8_WAIT_V(8); PG8_WAIT_L(0); PG8_BAR; PG8_MMA(0, 0, At, B0); PG8_MMA(0, 1, At, B1); PG8_BAR; PG8_SCHED;
            PG8_LDA(At, 1, 1); PG8_STAGE(PG8_SB(1, 0), b3, voffB); PG8_STAGE(PG8_SB(1, 1), b3 + hstepB, voffB); PG8_STAGE(PG8_SA(1, 0), a3, voffA);
            PG8_WAIT_V(8); PG8_WAIT_L(0); PG8_BAR; PG8_MMA(1, 0, At, B0); PG8_MMA(1, 1, At, B1); PG8_BAR; PG8_SCHED;
            } else {
            PG8_LDB(B0, 0, 0); PG8_SCHED; PG8_LDA(At, 0, 0); PG8_STAGE(PG8_SA(1, 1), a1 + hstepA, voffA);
            PG8_WAIT_L(8); PG8_BAR; PG8_WAIT_L(0); PG8_MMA(0, 0, At, B0); PG8_BAR; PG8_SCHED;
            PG8_LDB(B1, 0, 1); PG8_STAGE(PG8_SB(0, 0), b2, voffB);
            PG8_BAR; PG8_WAIT_L(0); PG8_MMA(0, 1, At, B1); PG8_BAR;
            PG8_LDA(At, 0, 1); PG8_STAGE(PG8_SA(0, 0), a2, voffA);
            PG8_BAR; PG8_WAIT_L(0); PG8_MMA(1, 0, At, B0); PG8_BAR; PG8_SCHED;
            PG8_STAGE(PG8_SB(0, 1), b2 + hstepB, voffB);
            PG8_WAIT_V(6); PG8_BAR; PG8_MMA(1, 1, At, B1); PG8_BAR;
            PG8_LDB(B0, 1, 0); PG8_SCHED; PG8_LDA(At, 1, 0); PG8_STAGE(PG8_SA(0, 1), a2 + hstepA, voffA);
            PG8_WAIT_L(8); PG8_BAR; PG8_WAIT_L(0); PG8_MMA(0, 0, At, B0); PG8_BAR; PG8_SCHED;
            PG8_LDB(B1, 1, 1); PG8_STAGE(PG8_SB(1, 0), b3, voffB);
            PG8_BAR; PG8_WAIT_L(0); PG8_MMA(0, 1, At, B1); PG8_BAR;
            PG8_LDA(At, 1, 1); PG8_STAGE(PG8_SA(1, 0), a3, voffA);
            PG8_BAR; PG8_WAIT_L(0); PG8_MMA(1, 0, At, B0); PG8_BAR; PG8_SCHED;
            PG8_STAGE(PG8_SB(1, 1), b3 + hstepB, voffB);
            PG8_WAIT_V(6); PG8_BAR; PG8_MMA(1, 1, At, B1); PG8_BAR;
            }
        }
        }
        if constexpr (ALIGN_EPI) { if (wr == 0) PG8_BAR; }
        if constexpr (!Epi::AFTER_DRAIN) { E(acc, cur, wr, wc, fr, fq); S.done(cur); }
        if (!has_next) break;
#pragma unroll
        for (int a = 0; a < 2; ++a)
#pragma unroll
            for (int b = 0; b < 2; ++b)
#pragma unroll
                for (int m = 0; m < 4; ++m)
#pragma unroll
                    for (int n = 0; n < 2; ++n) acc[a][b][m][n] = (f32x4){0.f, 0.f, 0.f, 0.f};
        cur = nxt; cA = nA; cA2 = nA2; cB = nB; ++ui;
        if constexpr (ALIGN_EPI) { if (wr == 1) PG8_BAR; }
    }
    PG8_WAIT_V(0);
    if constexpr (!ALIGN_EPI) { if (wr == 0) PG8_BAR; }
    PG8_BAR;
    if constexpr (Epi::AFTER_DRAIN) { E.fused(acc, cur, wr, wc, fr, fq, lds, wid, lane); S.done(cur); }
#undef PG8_SA
#undef PG8_SB
#undef PG8_STAGE
#undef PG8_LDA
#undef PG8_LDB
#undef PG8_MMA
#undef PG8_WAIT_V
#undef PG8_WAIT_L
#undef PG8_BAR
#undef PG8_SCHED
}
}
#include <hip/hip_bf16.h>
#include <cmath>
namespace attn_body {
using bf16=__hip_bfloat16;
using bf16x8=__attribute__((ext_vector_type(8)))short;
using s16x4=__attribute__((ext_vector_type(4)))short;
using f32x16=__attribute__((ext_vector_type(16)))float;
using u32x4=__attribute__((ext_vector_type(4)))unsigned;
constexpr int SEQ=16384,D=64,PQ=3072,PO=2048;
constexpr int NW=8,QBLK=32,QB=QBLK*NW,KVBLK=64,NQB=SEQ/QB;
constexpr int ATTN_UNIT_ROWS=QB;
__device__ __forceinline__ int crow(int r,int hi){return (r&3)+8*(r>>2)+4*hi;}
#define SBAR() __builtin_amdgcn_sched_barrier(0)
__device__ __forceinline__ void cmask(f32x16&p0,f32x16&p1,int jb,int qrel,int hi){
  const float NEG=-INFINITY; int kb=64*jb+4*hi;
  #pragma unroll
  for(int r=0;r<16;++r){int kv=kb+(r&3)+8*(r>>2); if(kv>qrel)p0[r]=NEG; if(kv+32>qrel)p1[r]=NEG;}
}

constexpr int NSLOT=3, SLOTB=8192, VSLOTB=16384;
constexpr int LDS_K=0, LDS_V=NSLOT*SLOTB, LDS_WS=LDS_V+NSLOT*VSLOTB, LDS_OST=0  , LDS_BYTES=LDS_WS+NW*64*4;
constexpr float C2=0.125f*1.4426950408889634f;
__device__ __forceinline__ void glds16(const void*gsrc,unsigned lds_dst){unsigned keep;
  asm volatile("s_mov_b32 %0, m0\n\ts_mov_b32 m0, %2\n\ts_nop 0\n\tglobal_load_lds_dwordx4 %1, off\n\ts_mov_b32 m0, %0":"=&s"(keep):"v"(gsrc),"s"(lds_dst):"memory");}
__device__ __forceinline__ float max3f(float a,float b,float c){float r;asm("v_max3_f32 %0, %1, %2, %3":"=v"(r):"v"(a),"v"(b),"v"(c));return r;}
__device__ __forceinline__ float max2f(float a,float b){float r;asm("v_max_f32_e32 %0, %1, %2":"=v"(r):"v"(a),"v"(b));return r;}
__device__ __forceinline__ float fadd_s(float a,float b){float r;asm("v_add_f32_e32 %0, %1, %2":"=v"(r):"v"(a),"v"(b));return r;}
__device__ __forceinline__ float fsub_s(float a,float b){float r;asm("v_sub_f32_e32 %0, %1, %2":"=v"(r):"v"(a),"v"(b));return r;}
typedef float f32x2_t __attribute__((ext_vector_type(2))); typedef __bf16 bf16x2_t __attribute__((ext_vector_type(2)));
__device__ __forceinline__ unsigned cvtpk_s(float lo,float hi){f32x2_t v={lo,hi};bf16x2_t b=__builtin_convertvector(v,bf16x2_t);return __builtin_bit_cast(unsigned,b);}
#define WAIT_BAR(N) asm volatile("s_waitcnt vmcnt(" #N ") lgkmcnt(0)\n\ts_barrier":::"memory")

__device__ __forceinline__ void qkt(f32x16&p0,f32x16&p1,const char*Kslot,const bf16x8*qr,const f32x16&negm,int r32,int hi){
  const char*kb=Kslot+hi*1024+r32*16;
  #pragma unroll
  for(int d0=0;d0<4;++d0){
    const bf16x8 b0=*reinterpret_cast<const bf16x8*>(kb+d0*2048);
    const bf16x8 b1=*reinterpret_cast<const bf16x8*>(kb+d0*2048+512);
    if(d0==0){p0=__builtin_amdgcn_mfma_f32_32x32x16_bf16(b0,qr[0],f32x16{},0,0,0);p1=__builtin_amdgcn_mfma_f32_32x32x16_bf16(b1,qr[0],f32x16{},0,0,0);}
    else{p0=__builtin_amdgcn_mfma_f32_32x32x16_bf16(b0,qr[d0],p0,0,0,0);p1=__builtin_amdgcn_mfma_f32_32x32x16_bf16(b1,qr[d0],p1,0,0,0);}}
}
typedef __attribute__((address_space(3))) const char* lds_cptr;
typedef short v4i16_t __attribute__((ext_vector_type(4)));
__device__ __forceinline__ void kload8(bf16x8*kf,lds_cptr kp){
  kf[0]=*(const __attribute__((address_space(3))) bf16x8*)(kp);      kf[1]=*(const __attribute__((address_space(3))) bf16x8*)(kp+512);
  kf[2]=*(const __attribute__((address_space(3))) bf16x8*)(kp+2048); kf[3]=*(const __attribute__((address_space(3))) bf16x8*)(kp+2560);
  kf[4]=*(const __attribute__((address_space(3))) bf16x8*)(kp+4096); kf[5]=*(const __attribute__((address_space(3))) bf16x8*)(kp+4608);
  kf[6]=*(const __attribute__((address_space(3))) bf16x8*)(kp+6144); kf[7]=*(const __attribute__((address_space(3))) bf16x8*)(kp+6656);
}
__device__ __forceinline__ void kload2(bf16x8*kf,lds_cptr kp,int j){ kf[2*j]=*(const __attribute__((address_space(3))) bf16x8*)(kp+j*2048); kf[2*j+1]=*(const __attribute__((address_space(3))) bf16x8*)(kp+j*2048+512); }
__device__ __forceinline__ s16x4 vtr(lds_cptr p){ return __builtin_bit_cast(s16x4,__builtin_amdgcn_ds_read_tr16_b64_v4i16((__attribute__((address_space(3))) v4i16_t*)p)); }
__device__ __forceinline__ float rowmax(const f32x16&p0,const f32x16&p1){
  float a=max3f(p0[0],p0[1],p1[0]),b=max3f(p0[2],p0[3],p1[1]);a=max3f(a,p1[2],p1[3]);
  #pragma unroll
  for(int r=4;r<16;r+=4){a=max3f(a,p0[r],p0[r+1]);b=max3f(b,p0[r+2],p0[r+3]);a=max3f(a,p1[r],p1[r+1]);b=max3f(b,p1[r+2],p1[r+3]);}
  const float m=max2f(a,b);
  auto rr=__builtin_amdgcn_permlane32_swap(__float_as_uint(m),__float_as_uint(m),false,false);
  return max2f(__uint_as_float(rr[0]),__uint_as_float(rr[1]));
}
__device__ __forceinline__ void pv(f32x16*o,int vb,bf16x8 pa0,bf16x8 pa1,bf16x8 pa2,bf16x8 pa3){
  #pragma unroll
  for(int d0=0;d0<4;++d0){s16x4 lo[4],hi[4];
    #pragma unroll
    for(int ks=0;ks<4;++ks){
      asm volatile("ds_read_b64_tr_b16 %0,%1 offset:%c2":"=&v"(lo[ks]):"v"(vb),"i"(d0*4096+ks*1024):"memory");
      asm volatile("ds_read_b64_tr_b16 %0,%1 offset:%c2":"=&v"(hi[ks]):"v"(vb),"i"(d0*4096+ks*1024+512):"memory");}
    asm volatile("s_waitcnt lgkmcnt(0)":::"memory");SBAR();
    #define PK(k) (bf16x8){lo[k][0],lo[k][1],lo[k][2],lo[k][3],hi[k][0],hi[k][1],hi[k][2],hi[k][3]}
    o[d0]=__builtin_amdgcn_mfma_f32_32x32x16_bf16(pa0,PK(0),o[d0],0,0,0);
    o[d0]=__builtin_amdgcn_mfma_f32_32x32x16_bf16(pa1,PK(1),o[d0],0,0,0);
    o[d0]=__builtin_amdgcn_mfma_f32_32x32x16_bf16(pa2,PK(2),o[d0],0,0,0);
    o[d0]=__builtin_amdgcn_mfma_f32_32x32x16_bf16(pa3,PK(3),o[d0],0,0,0);
    #undef PK
  }
}

#ifndef ATTN_STORE16
#define ATTN_STORE16(p,v) (*(u32x4*)(p)=(v))
#endif
template<int THRL> __device__ __forceinline__ void attn_unit(const int wid_in,int qb,const bf16*Q,const bf16*__restrict__ K,const bf16*__restrict__ V,bf16*O,char*shm){
  int tid_=wid_in*64+mk_lane_id(); asm volatile("":"+v"(tid_)); const int tid=tid_,lane=tid&63,r32=lane&31,hi=lane>>5; const int wid=__builtin_amdgcn_readfirstlane(tid>>6);
  const int q0=qb*QB;
  const bf16*Qw=Q+(long)(q0+wid*QBLK)*PQ;
  const bf16*Kh=K,*Vh=V;
  const unsigned lds0=(unsigned)(uintptr_t)shm;
  float*wsf=(float*)(shm+LDS_WS)+wid*64;
  const bf16*ksrc=Kh+(long)lane*PQ+wid*8;
  const bf16*vsrc=Vh+(long)(16*(wid&3)+(lane>>2))*PQ+(wid>>2)*32+(lane&3)*8;
  const unsigned kdst=lds0+LDS_K+wid*1024, vdst=lds0+LDS_V+wid*1024;
  #define DMA_K(t,slot) glds16(ksrc+(long)(t)*KVBLK*PQ,(unsigned)__builtin_amdgcn_readfirstlane(kdst+(slot)))
  #define DMA_V(t,slot) do{ glds16(vsrc+(long)(t)*KVBLK*PQ,(unsigned)__builtin_amdgcn_readfirstlane(vdst+2*(slot))); glds16(vsrc+64+(long)(t)*KVBLK*PQ,(unsigned)__builtin_amdgcn_readfirstlane(vdst+8192+2*(slot))); }while(0)
  const int vb0=(int)(lds0+LDS_V)+((lane>>4)&1)*32+(lane&3)*8+(4*hi+((lane&15)>>2))*64;
  const char*Kbase=shm+LDS_K; bf16x8 kf[8];
  const lds_cptr shm3=(lds_cptr)shm; const lds_cptr kp0=shm3+LDS_K+hi*1024+r32*16; const lds_cptr vp0=shm3+LDS_V+((lane>>4)&1)*32+(lane&3)*8+(4*hi+((lane&15)>>2))*64;
  const int NT=(q0+QB)/KVBLK;
  DMA_K(0,0);DMA_V(0,0);DMA_K(1,SLOTB);
  bf16x8 qr[4];
  #pragma unroll
  for(int d0=0;d0<4;++d0)qr[d0]=*reinterpret_cast<const bf16x8*>(&Qw[(long)r32*PQ+d0*16+hi*8]);
  float mhat=0.f,l_reg=0.f;f32x16 o[4];o[0]=f32x16{};o[1]=f32x16{};o[2]=f32x16{};o[3]=f32x16{};asm volatile("":"+v"(o[0]));asm volatile("":"+v"(o[1]));asm volatile("":"+v"(o[2]));asm volatile("":"+v"(o[3]));
  const int qrel=wid*QBLK+r32;
  #define CMASK(P0,P1,t) do{int jb_=(t)-(NT-4); if(jb_>=0)cmask(P0,P1,jb_,qrel,hi);}while(0)
  bool resc=false;
  #define START(P0,P1) do{ const float rm=rowmax(P0,P1); resc=false; mhat=rm; \
    _Pragma("unroll") for(int r=0;r<16;++r){P0[r]=__builtin_amdgcn_exp2f(fsub_s(P0[r],mhat));} }while(0)
  #define RESC() do{ if(resc){ asm volatile("s_waitcnt lgkmcnt(0)":::"memory"); \
      _Pragma("unroll") for(int d_=0;d_<4;++d_) _Pragma("unroll") for(int r=0;r<16;++r)o[d_][r]*=wsf[crow(r,hi)]; } }while(0)
  f32x16 pA0,pA1,pB0,pB1;
  int sl_prev=0,sl_cur=0,sl_next=SLOTB;
  #define ROT() do{sl_prev=sl_cur;sl_cur=sl_next;sl_next=(sl_next==(NSLOT-1)*SLOTB)?0:sl_next+SLOTB;}while(0)
  DMA_K(2,2*SLOTB);
  WAIT_BAR(4);
  qkt(pA0,pA1,Kbase,qr,f32x16{},r32,hi);asm volatile("s_nop 15\n\ts_nop 7":"+v"(pA0),"+v"(pA1));CMASK(pA0,pA1,0);
  START(pA0,pA1);
  _Pragma("unroll") for(int r=0;r<16;++r)pA1[r]=__builtin_amdgcn_exp2f(fsub_s(pA1[r],mhat));
  WAIT_BAR(0);
  DMA_K(3,0);DMA_V(1,SLOTB);
  ROT();
  kload8(kf,kp0+sl_cur);
  WAIT_BAR(3);
  s16x4 vlo[16],vhi[16]; u32x4 pw0,pw1,pw2,pw3;
  #define PKW(P,B) cvtpk_s(P[B],P[B+1])
  #define PAF(k) __builtin_bit_cast(bf16x8,pw##k)
  #define VFR(i) (bf16x8){vlo[i][0],vlo[i][1],vlo[i][2],vlo[i][3],vhi[i][0],vhi[i][1],vhi[i][2],vhi[i][3]}
  #define PIN(x) asm volatile("":"+v"(x))
  #define MX3(a,b,c) __builtin_fmaxf(__builtin_fmaxf((a),(b)),(c))
  #define GAPA(MF,A0,A1,A2,A3,W0,W1,PW) do{ MF; sacc+=A0; sacc+=A1; sacc+=A2; sacc+=A3; PIN(sacc); W0; W1; PIN(PW); SBAR(); }while(0)
  #define EX(v) __builtin_amdgcn_exp2f(v)
  #define GAPB(MF,X,B) do{ MF; X[B]=EX(X[B]-mhat); X[B+1]=EX(X[B+1]-mhat); PIN(X); SBAR(); }while(0)
  #define VRD(i) do{ vlo[i]=vtr(vp_+(((i)>>2)*4096+((i)&3)*1024)); vhi[i]=vtr(vp_+(((i)>>2)*4096+((i)&3)*1024+512)); }while(0)
  #define KRD(G,j) do{ if(G){ kload2(kf,kp0+sl_next,j); SBAR(); } }while(0)
  #define STEP(C0,C1,P0,P1,t,GK,GV,GL) do{ SBAR(); \
    const lds_cptr vp_=vp0+2*sl_prev; \
    float sacc=(P0[0]+P0[1]); \
    GAPA(C0=__builtin_amdgcn_mfma_f32_32x32x16_bf16(kf[0],qr[0],f32x16{},0,0,0), P0[2],P0[3],P0[4],P0[5],     pw0[0]=PKW(P0,0), pw0[1]=PKW(P0,2), pw0); \
    GAPA(C1=__builtin_amdgcn_mfma_f32_32x32x16_bf16(kf[1],qr[0],f32x16{},0,0,0), P0[6],P0[7],P0[8],P0[9],     pw0[2]=PKW(P0,4), pw0[3]=PKW(P0,6), pw0); \
    GAPA(C0=__builtin_amdgcn_mfma_f32_32x32x16_bf16(kf[2],qr[1],C0,0,0,0),   P0[10],P0[11],P0[12],P0[13], pw1[0]=PKW(P0,8), pw1[1]=PKW(P0,10), pw1); \
    GAPA(C1=__builtin_amdgcn_mfma_f32_32x32x16_bf16(kf[3],qr[1],C1,0,0,0),   P0[14],P0[15],P1[0],P1[1],   pw1[2]=PKW(P0,12),pw1[3]=PKW(P0,14), pw1); \
    VRD(0); SBAR(); GAPA(C0=__builtin_amdgcn_mfma_f32_32x32x16_bf16(kf[4],qr[2],C0,0,0,0),   P1[2],P1[3],P1[4],P1[5],     pw2[0]=PKW(P1,0), pw2[1]=PKW(P1,2), pw2); \
    VRD(4); SBAR(); GAPA(C1=__builtin_amdgcn_mfma_f32_32x32x16_bf16(kf[5],qr[2],C1,0,0,0),   P1[6],P1[7],P1[8],P1[9],     pw2[2]=PKW(P1,4), pw2[3]=PKW(P1,6), pw2); \
    VRD(8); SBAR(); GAPA(C0=__builtin_amdgcn_mfma_f32_32x32x16_bf16(kf[6],qr[3],C0,0,0,0),   P1[10],P1[11],P1[12],P1[13], pw3[0]=PKW(P1,8), pw3[1]=PKW(P1,10), pw3); \
    VRD(12); SBAR(); GAPA(C1=__builtin_amdgcn_mfma_f32_32x32x16_bf16(kf[7],qr[3],C1,0,0,0),   P1[14],P1[15],0.f,0.f,       pw3[2]=PKW(P1,12),pw3[3]=PKW(P1,14), pw3); \
    l_reg+=sacc; \
    if(GK){DMA_K((t)+3,sl_cur);} if(GV){DMA_V((t)+1,sl_next);} \
    CMASK(C0,C1,t); \
    { float a=MX3(C0[0],C0[1],C1[0]),b=MX3(C0[2],C0[3],C1[1]); a=MX3(a,C1[2],C1[3]); \
      _Pragma("unroll") for(int r=4;r<16;r+=4){a=MX3(a,C0[r],C0[r+1]);b=MX3(b,C0[r+2],C0[r+3]);a=MX3(a,C1[r],C1[r+1]);b=MX3(b,C1[r+2],C1[r+3]);} \
      float rm=__builtin_fmaxf(a,b); { auto rr=__builtin_amdgcn_permlane32_swap(__float_as_uint(rm),__float_as_uint(rm),false,false); rm=__builtin_fmaxf(__uint_as_float(rr[0]),__uint_as_float(rr[1])); } \
      rm-=mhat; resc=false; \
      if(__builtin_expect(__any(rm>(float)THRL),0)){ const float dl=__builtin_fmaxf(rm,0.f); mhat+=dl; \
        const float f=__builtin_amdgcn_exp2f(-dl); l_reg*=f; if(hi==0)wsf[r32]=f; resc=true; } } \
    SBAR(); \
    GAPB(o[0]=__builtin_amdgcn_mfma_f32_32x32x16_bf16(PAF(0),VFR(0),o[0],0,0,0), C0,0); VRD(1); SBAR(); \
    GAPB(o[1]=__builtin_amdgcn_mfma_f32_32x32x16_bf16(PAF(0),VFR(4),o[1],0,0,0), C0,2); VRD(5); SBAR(); \
    KRD(GL,0); GAPB(o[2]=__builtin_amdgcn_mfma_f32_32x32x16_bf16(PAF(0),VFR(8),o[2],0,0,0), C0,4); VRD(9); SBAR(); \
    KRD(GL,1); GAPB(o[3]=__builtin_amdgcn_mfma_f32_32x32x16_bf16(PAF(0),VFR(12),o[3],0,0,0), C0,6); VRD(13); SBAR(); \
    KRD(GL,2); GAPB(o[0]=__builtin_amdgcn_mfma_f32_32x32x16_bf16(PAF(1),VFR(1),o[0],0,0,0), C0,8); VRD(2); SBAR(); \
    KRD(GL,3); GAPB(o[1]=__builtin_amdgcn_mfma_f32_32x32x16_bf16(PAF(1),VFR(5),o[1],0,0,0), C0,10); VRD(6); SBAR(); \
    GAPB(o[2]=__builtin_amdgcn_mfma_f32_32x32x16_bf16(PAF(1),VFR(9),o[2],0,0,0), C0,12); VRD(10); SBAR(); \
    GAPB(o[3]=__builtin_amdgcn_mfma_f32_32x32x16_bf16(PAF(1),VFR(13),o[3],0,0,0), C0,14); VRD(14); SBAR(); \
    GAPB(o[0]=__builtin_amdgcn_mfma_f32_32x32x16_bf16(PAF(2),VFR(2),o[0],0,0,0), C1,0); VRD(3); SBAR(); \
    GAPB(o[1]=__builtin_amdgcn_mfma_f32_32x32x16_bf16(PAF(2),VFR(6),o[1],0,0,0), C1,2); VRD(7); SBAR(); \
    GAPB(o[2]=__builtin_amdgcn_mfma_f32_32x32x16_bf16(PAF(2),VFR(10),o[2],0,0,0), C1,4); VRD(11); SBAR(); \
    GAPB(o[3]=__builtin_amdgcn_mfma_f32_32x32x16_bf16(PAF(2),VFR(14),o[3],0,0,0), C1,6); VRD(15); SBAR(); \
    GAPB(o[0]=__builtin_amdgcn_mfma_f32_32x32x16_bf16(PAF(3),VFR(3),o[0],0,0,0), C1,8); \
    GAPB(o[1]=__builtin_amdgcn_mfma_f32_32x32x16_bf16(PAF(3),VFR(7),o[1],0,0,0), C1,10); \
    GAPB(o[2]=__builtin_amdgcn_mfma_f32_32x32x16_bf16(PAF(3),VFR(11),o[2],0,0,0), C1,12); \
    GAPB(o[3]=__builtin_amdgcn_mfma_f32_32x32x16_bf16(PAF(3),VFR(15),o[3],0,0,0), C1,14); \
    }while(0)
  int t=1;
  #undef CMASK
  #define CMASK(P0,P1,t) do{}while(0)
  for(;t+5<NT;t+=2){
    STEP(pB0,pB1,pA0,pA1,t,true,true,true);     WAIT_BAR(3); RESC(); ROT();
    STEP(pA0,pA1,pB0,pB1,t+1,true,true,true);   WAIT_BAR(3); RESC(); ROT();
  }
  #undef CMASK
  #define CMASK(P0,P1,t) do{int jb_=(t)-(NT-4); if(jb_>=0)cmask(P0,P1,jb_,qrel,hi);}while(0)
  #define ENDW(tt) do{ if((tt)+3<NT){WAIT_BAR(3);} else if((tt)+2<NT){WAIT_BAR(2);} else {WAIT_BAR(0);} }while(0)
  for(;t+1<NT;t+=2){
    STEP(pB0,pB1,pA0,pA1,t,(t+3<NT),(t+1<NT),(t+1<NT));       ENDW(t);   RESC(); ROT();
    STEP(pA0,pA1,pB0,pB1,t+1,(t+4<NT),(t+2<NT),(t+2<NT));     ENDW(t+1); RESC(); ROT();
  }
  STEP(pB0,pB1,pA0,pA1,NT-1,false,false,false); RESC();
  { float sacc=pB0[0]+pB0[1]; _Pragma("unroll") for(int r=2;r<16;++r)sacc+=pB0[r]; _Pragma("unroll") for(int r=0;r<16;++r)sacc+=pB1[r]; l_reg+=sacc;
    pw0=(u32x4){PKW(pB0,0),PKW(pB0,2),PKW(pB0,4),PKW(pB0,6)};pw1=(u32x4){PKW(pB0,8),PKW(pB0,10),PKW(pB0,12),PKW(pB0,14)};pw2=(u32x4){PKW(pB1,0),PKW(pB1,2),PKW(pB1,4),PKW(pB1,6)};pw3=(u32x4){PKW(pB1,8),PKW(pB1,10),PKW(pB1,12),PKW(pB1,14)};
    SBAR(); pv(o,vb0+2*sl_cur,PAF(0),PAF(1),PAF(2),PAF(3)); }
  asm volatile("s_waitcnt lgkmcnt(0)\n\ts_barrier":::"memory");
  #undef PKW
  #undef PAF
  #undef VFR
  #undef PIN
  #undef MX3
  #undef GAPA
  #undef GAPB
  #undef EX
  #undef VRD
  #undef KRD
  #undef STEP
  #undef ENDW
  {auto rr=__builtin_amdgcn_permlane32_swap(__float_as_uint(l_reg),__float_as_uint(l_reg),false,false);l_reg=__uint_as_float(rr[0])+__uint_as_float(rr[1]);}
  if(hi==0)wsf[32+r32]=l_reg;asm volatile("s_waitcnt lgkmcnt(0)":::"memory");
  float rli[16];
  #pragma unroll
  for(int r=0;r<16;++r)rli[r]=__builtin_amdgcn_rcpf(wsf[32+crow(r,hi)]);
  bf16*Ow=O+(long)(q0+wid*QBLK)*PO;
  { bf16*stg=(bf16*)(shm+LDS_OST)+wid*4096;
    #pragma unroll
    for(int r=0;r<16;++r){const int orow=crow(r,hi);
      #pragma unroll
      for(int d0=0;d0<4;++d0)stg[orow*128+d0*32+r32]=__float2bfloat16(o[d0][r]*rli[r]);}
    asm volatile("s_waitcnt lgkmcnt(0)":::"memory");
    #pragma unroll
    for(int i=0;i<8;++i){const int row=i*4+(lane>>4),ch=lane&15; const u32x4 v=*(const u32x4*)(stg+row*128+ch*8); ATTN_STORE16(Ow+(long)row*PO+ch*8,v);} }
  asm volatile("s_waitcnt lgkmcnt(0)\n\ts_barrier":::"memory");
  #undef DMA_K
  #undef DMA_V
  #undef CMASK
  #undef START
  #undef RESC
  #undef ROT
}
constexpr int ATTN_LDS_BYTES=LDS_BYTES;
template<int THRL=8> __device__ __forceinline__ void attn_phase(char*lds,const bf16*PD,bf16*O,int vcu,const int wid,unsigned*qhead,volatile __attribute__((address_space(3))) unsigned*bc){
  const int xg=vcu>>5;
  for(;;){
    if(threadIdx.x==0) *bc=__hip_atomic_fetch_add(qhead,1u,__ATOMIC_RELAXED,__HIP_MEMORY_SCOPE_AGENT);
    __syncthreads();
    const int u=(int)__builtin_amdgcn_readfirstlane((int)*bc);
    if(u>=128)break;
    const int pr=2*xg+(u&1),qb=63-(u>>1),h=pr>>1,m=pr&1;
    const bf16*Q=PD+h*128+m*64,*K=PD+1024+h*128+m*64,*V=PD+2048+h*128; bf16*Op=O+m*1024+h*128;
    attn_unit<THRL>(wid,qb,Q,K,V,Op,lds);
  }
}
#undef SBAR
#undef WAIT_BAR
}
#define GAS __attribute__((address_space(1)))
#define LAS __attribute__((address_space(3)))
typedef unsigned short bf16;
typedef unsigned v4u __attribute__((ext_vector_type(4)));
typedef float f32x4 __attribute__((ext_vector_type(4)));
typedef short bf16x8 __attribute__((ext_vector_type(8)));
typedef GAS unsigned gu32;
typedef GAS unsigned long long gu64;
#define RLX_AGENT __ATOMIC_RELAXED, __HIP_MEMORY_SCOPE_AGENT
#define LDS_WAIT() asm volatile("s_waitcnt lgkmcnt(0)" ::: "memory")
#define VM_WAIT() asm volatile("s_waitcnt vmcnt(0)" ::: "memory")
__device__ __forceinline__ unsigned long long rt() { return __builtin_amdgcn_s_memrealtime(); }
__device__ __forceinline__ unsigned f2bf(float f) { unsigned u = __builtin_bit_cast(unsigned, f); return (u + 0x7fffu + ((u >> 16) & 1u)) >> 16; }
__device__ __forceinline__ unsigned pk2(float lo, float hi) { return f2bf(lo) | (f2bf(hi) << 16); }

#define XB_TMO      128
#define XB_XCNT(j)  (256  + 64 * (j))
#define XB_XSUB(j)  (1280 + 64 * (j))
#define XB_XGEN(j)  (2304 + 64 * (j))
#define XB_TOP      3328
#define XB_TOPGEN   3392
#define XCD_BAR_WORDS 3456
#define XB_SPIN_CAP (1u << 18)

__device__ __forceinline__ unsigned xb_ld(unsigned* p)              { return __hip_atomic_load(p, __ATOMIC_RELAXED, __HIP_MEMORY_SCOPE_AGENT); }
__device__ __forceinline__ unsigned xb_add(unsigned* p, unsigned v) { return __hip_atomic_fetch_add(p, v, __ATOMIC_RELAXED, __HIP_MEMORY_SCOPE_AGENT); }
__device__ __forceinline__ unsigned xb_xcc_id() { return (unsigned)__builtin_amdgcn_s_getreg((3 << 11) | 20) & 0xFu; }
#define XB_SPIN(cond, bar) do { unsigned _sp = 0; while (cond) { __builtin_amdgcn_s_sleep(1); \
    if ((++_sp & 255u) == 0u) { if (xb_ld(&(bar)[XB_TMO])) break; if (_sp > XB_SPIN_CAP) { atomicAdd(&(bar)[XB_TMO], 1u); break; } } } } while (0)

struct XcdBarrier {
    unsigned* bar; unsigned x;
    volatile LAS unsigned* st;
};

__device__ __forceinline__ XcdBarrier xcd_barrier_post(unsigned* bar, volatile LAS unsigned* st) {
    XcdBarrier b; b.bar = bar; b.x = xb_xcc_id(); b.st = st;
    if (threadIdx.x == 0) (void)xb_add(&bar[XB_XCNT(b.x)], 1u);
    return b;
}
__device__ __forceinline__ void xcd_barrier_complete(unsigned* bar, unsigned x, unsigned& nloc, unsigned& nx) {
    const unsigned G = gridDim.x * gridDim.y * gridDim.z;
    unsigned sum, cnt, mine, sp = 0u;
    for (;;) {
        sum = 0u; cnt = 0u; mine = 0u;
#pragma unroll
        for (unsigned j = 0; j < 16; ++j) { const unsigned c = xb_ld(&bar[XB_XCNT(j)]); sum += c; cnt += (c > 0u) ? 1u : 0u; mine = (j == x) ? c : mine; }
        if (sum == G) break;
        __builtin_amdgcn_s_sleep(1);
        if ((++sp & 255u) == 0u) { if (xb_ld(&bar[XB_TMO])) break; if (sp > XB_SPIN_CAP) { atomicAdd(&bar[XB_TMO], 1u); break; } }
    }
    nloc = mine > 0u ? mine : 1u; nx = cnt > 0u ? cnt : 1u;
}

__device__ __forceinline__ void xcd_barrier(const XcdBarrier& b) {
    asm volatile("s_waitcnt vmcnt(0)" ::: "memory");
    __syncthreads();
    if (threadIdx.x == 0) {
        unsigned* bar = b.bar;
        __builtin_amdgcn_s_waitcnt(0);
        unsigned nloc = b.st[0], nx = b.st[1];
        if (nloc == 0u) { xcd_barrier_complete(bar, b.x, nloc, nx); b.st[0] = nloc; b.st[1] = nx; }
        const unsigned old = xb_add(&bar[XB_XSUB(b.x)], 1u);
        const unsigned gen = old / nloc;
        if (old + 1u == (gen + 1u) * nloc) {
            __builtin_amdgcn_fence(__ATOMIC_RELEASE, "agent");
            asm volatile("s_waitcnt vmcnt(0)" ::: "memory");
            const unsigned og = xb_add(&bar[XB_TOP], 1u);
            const unsigned tg = og / nx;
            if (og + 1u == (tg + 1u) * nx) xb_add(&bar[XB_TOPGEN], 1u);
            else XB_SPIN(xb_ld(&bar[XB_TOPGEN]) == tg, bar);
            __builtin_amdgcn_fence(__ATOMIC_ACQUIRE, "agent");
            xb_add(&bar[XB_XGEN(b.x)], 1u);
            asm volatile("s_waitcnt vmcnt(0)" ::: "memory");
        } else {
            XB_SPIN(xb_ld(&bar[XB_XGEN(b.x)]) == gen, bar);
            __builtin_amdgcn_fence(__ATOMIC_ACQUIRE, "agent");
            asm volatile("s_waitcnt vmcnt(0)" ::: "memory");
        }
    }
    __syncthreads();
}
constexpr int NWAVES = 8;
constexpr int S_ = 16384, DM = 2048;
constexpr int NPH = 16;
#ifndef MK_PER_PHASE
#define MK_PER_PHASE 0
#endif
constexpr size_t MiB = 1u << 20;
constexpr size_t WS_CTL = 0, CTL_ZERO_BYTES = 1 * MiB;
constexpr size_t WS_WA = 1 * MiB, WS_WB = 5 * MiB, WS_WOUT = 9 * MiB, WS_WS = 17 * MiB, WS_LORA = 25 * MiB;
constexpr size_t WS_WIN = 27 * MiB, WS_PR = 69 * MiB, WS_PD = 181 * MiB, WS_PG = 277 * MiB;
constexpr size_t WS_A = 405 * MiB, WS_E = 437 * MiB, WS_G = 469 * MiB, WS_END = 507 * MiB;
constexpr size_t WS_SCN = 27 * MiB, WS_SCAL = 123 * MiB, WS_SLOC = 127 * MiB, WS_ASEG = 143 * MiB, WS_SIN = 159 * MiB;
constexpr size_t WS_YA = 91 * MiB, WS_OATT = 27 * MiB, WS_YB = 437 * MiB, WS_Z = 405 * MiB  , WS_T1 = 123 * MiB, WS_MERGED = 27 * MiB;
constexpr size_t WS_H2 = 123 * MiB, WS_XN2 = 27 * MiB, WS_UTAB = 251 * MiB, WS_VTAB = 315 * MiB, WS_SCORES = 379 * MiB;
constexpr size_t WS_USCL = WS_UTAB + 16 * MiB, WS_VSCL = WS_VTAB + 16 * MiB;
constexpr size_t OUT_XN = 0, OUT_RKV = 0, OUT_LIN = 96 * MiB, OUT_YLOC = 96 * MiB  ;
constexpr int CW_BAR = 4096;
constexpr int RING_OFF = 0, RING_BYTES = 131072;
constexpr int LDSCTL_OFF = RING_BYTES, MISC_OFF = LDSCTL_OFF + 320;
constexpr int LDS_BYTES = 147456;
constexpr int NSEG = 64, SEGLEN = S_ / NSEG;

struct Args { const float* in[28]; float* out; unsigned char* ws; int ph_lo, ph_hi; };

struct Frame {
    LAS unsigned char* lds; volatile LAS unsigned* MISC; gu32* ctl;
    int tid, lane, wave, vcu, G;
};

__device__ __forceinline__ float bf2f(unsigned short b) { return __uint_as_float((unsigned)b << 16); }
__device__ __forceinline__ float wave_sum(float v) {
#pragma unroll
    for (int o = 1; o < 64; o <<= 1) v += __shfl_xor(v, o);
    return v;
}
__device__ __forceinline__ float wave_max(float v) {
#pragma unroll
    for (int o = 1; o < 64; o <<= 1) v = fmaxf(v, __shfl_xor(v, o));
    return v;
}
template <int CTRL, int RM> __device__ __forceinline__ float dppf(float oldv, float x) { return __builtin_bit_cast(float, __builtin_amdgcn_update_dpp(__builtin_bit_cast(int, oldv), __builtin_bit_cast(int, x), CTRL, RM, 0xf, false)); }
__device__ __forceinline__ float wsum(float v) {
    v += dppf<0xB1, 0xf>(v, v); v += dppf<0x4E, 0xf>(v, v); v += dppf<0x141, 0xf>(v, v); v += dppf<0x140, 0xf>(v, v);
    v += dppf<0x142, 0xa>(0.f, v); v += dppf<0x143, 0xc>(0.f, v);
    return __builtin_bit_cast(float, __builtin_amdgcn_readlane(__builtin_bit_cast(int, v), 63));
}
__device__ __forceinline__ float wmax(float v) {
    v = fmaxf(v, dppf<0xB1, 0xf>(v, v)); v = fmaxf(v, dppf<0x4E, 0xf>(v, v)); v = fmaxf(v, dppf<0x141, 0xf>(v, v)); v = fmaxf(v, dppf<0x140, 0xf>(v, v));
    v = fmaxf(v, dppf<0x142, 0xa>(0.f, v)); v = fmaxf(v, dppf<0x143, 0xc>(0.f, v));
    return __builtin_bit_cast(float, __builtin_amdgcn_readlane(__builtin_bit_cast(int, v), 63));
}
__device__ __forceinline__ float sigmf(float x) { return __builtin_amdgcn_rcpf(1.0f + __expf(-x)); }

__device__ __forceinline__ void transpose_block(const float* W, int ldw, int k0, int n0, int kvalid, bf16* WT, int ldt, int drow0, LAS float* scr, int lane) {
    float tv[32];
#pragma unroll
    for (int i = 0; i < 32; ++i) { const int k = k0 + 2 * i + (lane >> 5); tv[i] = (k < kvalid) ? W[(size_t)k * ldw + n0 + (lane & 31)] : 0.f; }
#pragma unroll
    for (int i = 0; i < 32; ++i) scr[(2 * i + (lane >> 5)) * 33 + (lane & 31)] = tv[i];
    LDS_WAIT(); asm volatile("" ::: "memory");
    const int c = lane & 7;
#pragma unroll
    for (int j = 0; j < 4; ++j) { const int n = (lane >> 3) + 8 * j; const LAS float* s = scr + (8 * c) * 33 + n;
        v4u o; o.x = pk2(s[0 * 33], s[1 * 33]); o.y = pk2(s[2 * 33], s[3 * 33]); o.z = pk2(s[4 * 33], s[5 * 33]); o.w = pk2(s[6 * 33], s[7 * 33]);
        *(GAS v4u*)(WT + (size_t)(drow0 + n) * ldt + k0 + 8 * c) = o; }
    LDS_WAIT(); asm volatile("" ::: "memory");
}
__device__ __forceinline__ void rms_row_to_bf16(const float* xrow, const float* g, bf16* orow, int lane) {
    const GAS f32x4* xr = (const GAS f32x4*)xrow + lane; const f32x4* gr = (const f32x4*)g + lane;
    f32x4 v[8]; float s = 0.f;
#pragma unroll
    for (int j = 0; j < 8; ++j) { v[j] = xr[64 * j]; s += (v[j].x * v[j].x + v[j].y * v[j].y) + (v[j].z * v[j].z + v[j].w * v[j].w); }
    const float rstd = rsqrtf(wave_sum(s) * (1.f / 2048.f) + 1e-6f);
    GAS unsigned long long* o8 = (GAS unsigned long long*)orow + lane;
#pragma unroll
    for (int j = 0; j < 8; ++j) { const f32x4 gg = gr[64 * j];
        o8[64 * j] = (unsigned long long)pk2(v[j].x * rstd * gg.x, v[j].y * rstd * gg.y) | ((unsigned long long)pk2(v[j].z * rstd * gg.z, v[j].w * rstd * gg.w) << 32); }
}

__device__ __forceinline__ void rms_row2_to_bf16(const float* xa, const float* xb, const float* g, bf16* oa, bf16* ob_, int lane) {
    const GAS f32x4* xr = (const GAS f32x4*)xa + lane; const GAS f32x4* yr = (const GAS f32x4*)xb + lane; const f32x4* gr = (const f32x4*)g + lane;
    f32x4 v[8], w[8]; float s = 0.f, t = 0.f;
#pragma unroll
    for (int j = 0; j < 8; ++j) { v[j] = __builtin_nontemporal_load(xr + 64 * j); w[j] = __builtin_nontemporal_load(yr + 64 * j); }
#pragma unroll
    for (int j = 0; j < 8; ++j) { s += (v[j].x * v[j].x + v[j].y * v[j].y) + (v[j].z * v[j].z + v[j].w * v[j].w); t += (w[j].x * w[j].x + w[j].y * w[j].y) + (w[j].z * w[j].z + w[j].w * w[j].w); }
    const float rs = rsqrtf(wsum(s) * (1.f / 2048.f) + 1e-6f), rt = rsqrtf(wsum(t) * (1.f / 2048.f) + 1e-6f);
    GAS unsigned long long* o8 = (GAS unsigned long long*)oa + lane; GAS unsigned long long* p8 = (GAS unsigned long long*)ob_ + lane;
#pragma unroll
    for (int j = 0; j < 8; ++j) { const f32x4 gg = gr[64 * j];
        o8[64 * j] = (unsigned long long)pk2(v[j].x * rs * gg.x, v[j].y * rs * gg.y) | ((unsigned long long)pk2(v[j].z * rs * gg.z, v[j].w * rs * gg.w) << 32);
        p8[64 * j] = (unsigned long long)pk2(w[j].x * rt * gg.x, w[j].y * rt * gg.y) | ((unsigned long long)pk2(w[j].z * rt * gg.z, w[j].w * rt * gg.w) << 32); }
}

template <int K, int VAR = 0> __device__ __forceinline__ void fmac_dpp(float& acc, float op, float s) {
    if (VAR == 0) asm("v_fmac_f32_dpp %0, %1, %2 quad_perm:[%c3,%c3,%c3,%c3] row_mask:0xf bank_mask:0xf" : "+v"(acc) : "v"(op), "v"(s), "i"(K));
    else asm("v_fmac_f32_e32 %0, %1, %2" : "+v"(acc) : "v"(op), "v"(s)); }
template <int K, int VAR = 0> __device__ __forceinline__ void mulip_dpp(float& s, float op) {
    if (VAR == 0) asm("v_mul_f32_dpp %0, %1, %0 quad_perm:[%c2,%c2,%c2,%c2] row_mask:0xf bank_mask:0xf" : "+v"(s) : "v"(op), "i"(K));
    else asm("v_mul_f32_e32 %0, %1, %0" : "+v"(s) : "v"(op)); }
#define SCAN_FOR_C(...) _Pragma("unroll") for (int j = 0; j < 4; ++j) { \
    { constexpr int k = 0; _Pragma("unroll") for (int i = 0; i < 4; ++i) { const int c = 16 * j + 4 * k + i; __VA_ARGS__ } } \
    { constexpr int k = 1; _Pragma("unroll") for (int i = 0; i < 4; ++i) { const int c = 16 * j + 4 * k + i; __VA_ARGS__ } } \
    { constexpr int k = 2; _Pragma("unroll") for (int i = 0; i < 4; ++i) { const int c = 16 * j + 4 * k + i; __VA_ARGS__ } } \
    { constexpr int k = 3; _Pragma("unroll") for (int i = 0; i < 4; ++i) { const int c = 16 * j + 4 * k + i; __VA_ARGS__ } } }

constexpr int SCAN_CH = 4;
constexpr int SC_RING = 0, SC_VG = 2 * SCAN_CH * 320, SC_Y = SC_VG + 2 * SCAN_CH * 64, SC_SLOT_F = SC_Y + 2 * SCAN_CH * 128;
__device__ __forceinline__ void scan4_phase(const int lane, const int wave, const int vcu, const int G, unsigned char* ws, unsigned char* ob, const bf16* RKV, LAS float* ldsf) {
    constexpr int CH = SCAN_CH, NCHUNK = SEGLEN / CH;
#define SCAN_BAR() do { asm volatile("s_waitcnt lgkmcnt(0)" ::: "memory"); __builtin_amdgcn_s_barrier(); asm volatile("" ::: "memory"); } while (0)
    const int slot = wave & 3; LAS float* sl = ldsf + slot * SC_SLOT_F;
    for (int round = 0; round * G * 4 < 16 * NSEG; ++round) {
        const int task = round * G * 4 + vcu * 4 + slot; const bool valid = task < 16 * NSEG; const int h = valid ? task / NSEG : 0, seg = valid ? task % NSEG : 0; const int t0 = seg * SEGLEN;
        if (wave >= 4) {
            const bf16* SCN = (const bf16*)(ws + WS_SCN) + ((size_t)h * S_) * 192; const bf16* Eb = (const bf16*)(ws + WS_E);
            bf16* YL = (bf16*)(ob + OUT_YLOC) + ((size_t)h * S_) * 64 + lane; bf16* ZZ = (bf16*)(ws + WS_Z) + ((size_t)h * S_) * 64 + lane;
            unsigned short pk[CH], pb[CH], pt[CH], pr[CH], pe[CH], pv[CH];
#define SCAN_ISSUE(n) do { const int tc_ = t0 + (n) * CH; \
            _Pragma("unroll") for (int s = 0; s < CH; ++s) { const size_t t = (size_t)(tc_ + s); \
                pk[s] = SCN[t * 192 + lane]; pb[s] = SCN[t * 192 + 64 + lane]; pt[s] = SCN[t * 192 + 128 + lane]; \
                pr[s] = RKV[t * 3072 + h * 64 + lane]; pe[s] = Eb[t * 1024 + h * 64 + lane]; pv[s] = RKV[t * 3072 + 2048 + h * 64 + lane]; } } while (0)
#define SCAN_WRITE(n) do { const int b_ = (n) & 1; \
            _Pragma("unroll") for (int s = 0; s < CH; ++s) { LAS float* q = sl + SC_RING + (b_ * CH + s) * 320; \
                q[lane] = bf2f(pk[s]); q[64 + lane] = bf2f(pr[s]); q[128 + lane] = __expf(-bf2f(pe[s])); q[192 + lane] = bf2f(pb[s]); q[256 + lane] = bf2f(pt[s]); \
                sl[SC_VG + (b_ * CH + s) * 64 + lane] = bf2f(pv[s]); } } while (0)
#define SCAN_YSTORE(n) do { const int tc_ = t0 + (n) * CH; const int b_ = (n) & 1; \
            _Pragma("unroll") for (int s = 0; s < CH; ++s) { YL[(size_t)(tc_ + s) * 64] = (unsigned short)f2bf(sl[SC_Y + (b_ * CH + s) * 128 + lane]); ZZ[(size_t)(tc_ + s) * 64] = (unsigned short)f2bf(sl[SC_Y + (b_ * CH + s) * 128 + 64 + lane]); } } while (0)
            if (valid) { SCAN_ISSUE(0); SCAN_WRITE(0); SCAN_ISSUE(1); }
            SCAN_BAR();
#pragma unroll 1
            for (int n = 0; n < NCHUNK; ++n) {
                if (valid) { if (n + 1 < NCHUNK) SCAN_WRITE(n + 1); if (n >= 1) SCAN_YSTORE(n - 1); if (n + 2 < NCHUNK) SCAN_ISSUE(n + 2); }
                SCAN_BAR();
            }
            if (valid) SCAN_YSTORE(NCHUNK - 1);
#undef SCAN_ISSUE
#undef SCAN_WRITE
#undef SCAN_YSTORE
        } else {
            float S[64], M[64]; int ln_ = lane; asm volatile("" : "+v"(ln_));
#pragma unroll
            for (int c = 0; c < 64; ++c) { S[c] = 0.f; M[c] = (c == ln_) ? 1.f : 0.f; }
            SCAN_BAR();
#pragma unroll 1
            for (int n = 0; n < NCHUNK; ++n) {
                const int b = n & 1;
                if (valid) {
                f32x4 KK[4];
                { const LAS f32x4* q4 = (const LAS f32x4*)(sl + SC_RING + (b * CH) * 320) + (lane & 3);
#pragma unroll
                  for (int j = 0; j < 4; ++j) KK[j] = q4[j * 4]; }
#pragma unroll 1
                for (int s = 0; s < CH; ++s) {
                    const LAS f32x4* q4 = (const LAS f32x4*)(sl + SC_RING + (b * CH + s) * 320) + (lane & 3);
                    f32x4 WW[4], BB[4], KT[4];
#pragma unroll
                    for (int j = 0; j < 4; ++j) { WW[j] = q4[32 + j * 4]; BB[j] = q4[48 + j * 4]; KT[j] = q4[64 + j * 4]; }
                    const float vt = sl[SC_VG + (b * CH + s) * 64 + lane];
                    float saq[4], sbq[4];
#pragma unroll
                    for (int q = 0; q < 4; ++q) { saq[q] = 0.f; sbq[q] = 0.f; }
                    SCAN_FOR_C( fmac_dpp<k>(saq[i], KK[j][i], S[c]); fmac_dpp<k>(sbq[i], KK[j][i], M[c]); )
                    const float sa = (saq[0] + saq[1]) + (saq[2] + saq[3]), sb = (sbq[0] + sbq[1]) + (sbq[2] + sbq[3]);
#pragma unroll
                    for (int j = 0; j < 4; ++j) KK[j] = q4[16 + j * 4];
                    SCAN_FOR_C( mulip_dpp<k>(S[c], WW[j][i]); )
                    SCAN_FOR_C( fmac_dpp<k>(S[c], BB[j][i], sa); )
                    SCAN_FOR_C( fmac_dpp<k>(S[c], KT[j][i], vt); )
                    SCAN_FOR_C( mulip_dpp<k>(M[c], WW[j][i]); )
                    SCAN_FOR_C( fmac_dpp<k>(M[c], BB[j][i], sb); )
                    float ylq[4], zq[4];
#pragma unroll
                    for (int q = 0; q < 4; ++q) { ylq[q] = 0.f; zq[q] = 0.f; }
                    SCAN_FOR_C( fmac_dpp<k>(ylq[i], KK[j][i], S[c]); fmac_dpp<k>(zq[i], KK[j][i], M[c]); )
                    sl[SC_Y + (b * CH + s) * 128 + lane] = (ylq[0] + ylq[1]) + (ylq[2] + ylq[3]);
                    sl[SC_Y + (b * CH + s) * 128 + 64 + lane] = (zq[0] + zq[1]) + (zq[2] + zq[3]);
                    { const LAS f32x4* qn = (const LAS f32x4*)(sl + SC_RING + (b * CH + ((s + 1) & (CH - 1))) * 320) + (lane & 3);
#pragma unroll
                      for (int j = 0; j < 4; ++j) KK[j] = qn[j * 4]; }
                }
                }
                SCAN_BAR();
            }
            if (valid) {
                f32x4* op = (f32x4*)((float*)(ws + WS_SLOC) + (((size_t)h * NSEG + seg) * 64 + lane) * 64);
                bf16* oq = (bf16*)(ws + WS_ASEG) + ((size_t)h * NSEG + seg) * 4096 + lane;
#pragma unroll
                for (int q = 0; q < 16; ++q) op[q] = (f32x4){S[4 * q], S[4 * q + 1], S[4 * q + 2], S[4 * q + 3]};
#pragma unroll
                for (int c2 = 0; c2 < 64; ++c2) oq[c2 * 64] = (unsigned short)f2bf(M[c2]);
            }
        }
        SCAN_BAR();
    }
#undef SCAN_BAR
}

__global__ void __launch_bounds__(NWAVES * 64, 2) mk_fwd(Args args) {
    extern __shared__ __attribute__((aligned(16))) unsigned char lds[];
    Frame F;
    F.lds = (LAS unsigned char*)lds; F.MISC = (volatile LAS unsigned*)(F.lds + MISC_OFF);
    F.tid = threadIdx.x; F.wave = __builtin_amdgcn_readfirstlane(F.tid >> 6);
    F.G = gridDim.x; F.vcu = 0;
    unsigned char* ws = args.ws; F.ctl = (gu32*)(ws + WS_CTL);
    const float* const* in = args.in;
    unsigned char* ob = (unsigned char*)args.out;
    for (int u = threadIdx.x; u < (LDS_BYTES - LDSCTL_OFF) / 4; u += NWAVES * 64) ((LAS unsigned*)(F.lds + LDSCTL_OFF))[u] = 0u;
    __syncthreads();
    XcdBarrier bar; bar.bar = (unsigned*)(F.ctl + CW_BAR); bar.x = 0; bar.st = nullptr;
    int bidv = (int)blockIdx.x;
    if (!MK_PER_PHASE) {
        bar.bar = (unsigned*)(F.ctl + CW_BAR); bar.x = xb_xcc_id(); bar.st = F.MISC + 8;
        if (threadIdx.x == 0) {
            const unsigned rank = xb_add(&bar.bar[XB_XCNT(bar.x)], 1u);
            unsigned cnts[16], sum, sp = 0u;
            for (;;) { sum = 0u;
#pragma unroll
                for (unsigned j = 0; j < 16; ++j) { cnts[j] = xb_ld(&bar.bar[XB_XCNT(j)]); sum += cnts[j]; }
                if (sum == (unsigned)F.G) break;
                __builtin_amdgcn_s_sleep(1);
                if ((++sp & 255u) == 0u) { if (xb_ld(&bar.bar[XB_TMO])) break; if (sp > XB_SPIN_CAP) { atomicAdd(&bar.bar[XB_TMO], 1u); break; } } }
            unsigned nx = 0u, xi = 0u, mine = 0u; bool even = true;
#pragma unroll
            for (unsigned j = 0; j < 16; ++j) { if (cnts[j]) { nx++; if (cnts[j] * 8u != (unsigned)F.G) even = false; } if (j < bar.x && cnts[j]) xi++; if (j == bar.x) mine = cnts[j]; }
            F.MISC[8] = mine ? mine : 1u; F.MISC[9] = nx ? nx : 1u;
            F.MISC[10] = (even && nx == 8u && sum == (unsigned)F.G) ? rank * 8u + xi : (unsigned)blockIdx.x;
        }
        __syncthreads();
        bidv = (int)__builtin_amdgcn_readfirstlane((int)F.MISC[10]);
    }
    F.vcu = (F.G % 8 == 0) ? (bidv % 8) * (F.G / 8) + bidv / 8 : bidv;
    const int lo = args.ph_lo, hi = args.ph_hi;
#ifndef PH_MASK
#define PH_MASK 0xFFFF
#endif
#define IN(k) ((((PH_MASK) >> (k)) & 1) && lo <= (k) && (k) < hi)
#ifndef PROBE_MASK
#define PROBE_MASK 0
#endif
#ifndef PROBE_VARIANT
#define PROBE_VARIANT 0
#endif
#ifndef PROBE_N
#define PROBE_N 1
#endif
#define PHASE_BEGIN(k) if (IN(k)) { for (int rep_ = 0; rep_ < 1 + ((((PROBE_MASK) >> (k)) & 1) ? (PROBE_N) : 0); ++rep_) { if (rep_) xcd_barrier(bar); PHASE_IDS
#define PHASE_END } }
#define SEAM(k) do { if (IN(k) && IN((k) + 1)) xcd_barrier(bar); } while (0)
    const int gw = F.vcu * NWAVES + F.wave, NGW = F.G * NWAVES; const int NGT = F.G * NWAVES * 64;
#define PHASE_IDS const int lane = mk_lane_id(), tid = F.wave * 64 + lane, gt = F.vcu * (NWAVES * 64) + tid; (void)gt; (void)lane;

    bf16* WIN_T = (bf16*)(ws + WS_WIN); bf16* WA_T = (bf16*)(ws + WS_WA); bf16* WB_T = (bf16*)(ws + WS_WB); bf16* WOUT_T = (bf16*)(ws + WS_WOUT);
    bf16* WS_T = (bf16*)(ws + WS_WS); bf16* LORA_T = (bf16*)(ws + WS_LORA);
    bf16* XN = (bf16*)(ob + OUT_XN); bf16* RKV = (bf16*)(ob + OUT_RKV); bf16* LIN = (bf16*)(ob + OUT_LIN);
    bf16* PR = (bf16*)(ws + WS_PR); bf16* PD = (bf16*)(ws + WS_PD); bf16* PG = (bf16*)(ws + WS_PG);

    PHASE_BEGIN(0)
        LAS float* scr = (LAS float*)(F.lds + RING_OFF + F.wave * 16384);
        constexpr int I_IN = 32 * 334, I_L = 4 * 32;
        constexpr int NIT = I_IN + 3 * I_L;
        for (int it = gw; it < NIT; it += NGW) {
            int r = it;
            if (r < I_IN) { const int kb = r / 334, nb = r % 334, n0 = nb * 32; transpose_block(in[2], 10688, kb * 64, n0, 2048, WIN_T, 2048, n0 + (n0 >= 3520 ? 64 : 0), scr, lane); continue; } r -= I_IN;
            { const int which = r / I_L, rr = r % I_L, kb = rr / 32, nb = rr % 32; const float* W = which == 0 ? in[5] : (which == 1 ? in[7] : in[8]);
              transpose_block(W, 1024, kb * 64, nb * 32, which == 2 ? 256 : 96, LORA_T + (size_t)which * 1024 * 256, 256, nb * 32, scr, lane); }
        }
        for (int i = gt; i < 16384; i += NGT) *(GAS v4u*)(WIN_T + (size_t)3520 * 2048 + (size_t)i * 8) = (v4u){0u, 0u, 0u, 0u};
        for (int m = gw; m < S_; m += 2 * NGW) rms_row2_to_bf16(in[0] + (size_t)m * DM, in[0] + (size_t)(m + NGW) * DM, in[1], XN + (size_t)m * DM, XN + (size_t)(m + NGW) * DM, lane);
    PHASE_END
    SEAM(0);
    PHASE_BEGIN(1)
        pg8::Gemm g{XN, WIN_T, S_, 10752, 2048, 2048, 2048, nullptr, 0}; pg8::StaticOrder S; S.init(S_, 10752, F.G, bidv);
        pg8::Epi<pg8::EM_G1> E{PR, PD, PG, nullptr, nullptr, nullptr, attn_body::C2};
        pg8::gemm_phase<pg8::Epi<pg8::EM_G1>, pg8::StaticOrder, true, true>(F.lds + RING_OFF, g, S, E, F.wave);
    PHASE_END
    SEAM(1);
    PHASE_BEGIN(2)
        const float* mu = in[3];
        for (int t = gw; t < S_; t += NGW) {
            const bf16* cur = PR + (size_t)t * 3584; const bf16* prv = cur - 3584;
#pragma unroll 1
            for (int j = 0; j < 7; ++j) { const int ch = lane + 64 * j; if (ch >= 440) break;
                const v4u c4 = *(const GAS v4u*)(cur + ch * 8); v4u p4 = (v4u){0u, 0u, 0u, 0u}; if (t > 0) p4 = *(const GAS v4u*)(prv + ch * 8);
                const f32x4 m0 = *(const f32x4*)(mu + ch * 8), m1 = *(const f32x4*)(mu + ch * 8 + 4);
                float c[8] = {pg8::bflo(c4.x), pg8::bfhi(c4.x), pg8::bflo(c4.y), pg8::bfhi(c4.y), pg8::bflo(c4.z), pg8::bfhi(c4.z), pg8::bflo(c4.w), pg8::bfhi(c4.w)};
                const float p[8] = {pg8::bflo(p4.x), pg8::bfhi(p4.x), pg8::bflo(p4.y), pg8::bfhi(p4.y), pg8::bflo(p4.z), pg8::bfhi(p4.z), pg8::bflo(p4.w), pg8::bfhi(p4.w)};
                const float mm[8] = {m0.x, m0.y, m0.z, m0.w, m1.x, m1.y, m1.z, m1.w};
#pragma unroll
                for (int e = 0; e < 8; ++e) c[e] = c[e] + (p[e] - c[e]) * mm[e];
                bf16* dst;
                if (ch < 384) dst = RKV + (size_t)t * 3072 + ch * 8;
                else { const int col = ch * 8 - 3072;
                    if (col < 96) { dst = LIN + (size_t)t * 768 + col;
#pragma unroll
                        for (int e = 0; e < 8; ++e) c[e] = tanhf(c[e]); }
                    else if (col < 192) dst = LIN + (size_t)t * 768 + 256 + (col - 96);
                    else { dst = LIN + (size_t)t * 768 + 512 + (col - 192);
#pragma unroll
                        for (int e = 0; e < 8; ++e) c[e] = sigmf(c[e]); } }
                *(GAS v4u*)dst = (v4u){pk2(c[0], c[1]), pk2(c[2], c[3]), pk2(c[4], c[5]), pk2(c[6], c[7])};
            }
            if (lane < 40) { const int z = lane < 20 ? 96 + lane * 8 : 352 + (lane - 20) * 8; *(GAS v4u*)(LIN + (size_t)t * 768 + z) = (v4u){0u, 0u, 0u, 0u}; }
        }
    PHASE_END
    SEAM(2);
    PHASE_BEGIN(3)
#pragma unroll 1
        for (int which = 0; which < 3; ++which) {
            int kd = 256; asm volatile("" : "+s"(kd));
            pg8::Gemm g{LIN + which * 256, LORA_T + (size_t)which * 1024 * 256, S_, 1024, kd, 768, 256, nullptr, 0}; pg8::StaticOrder S; S.init(S_, 1024, F.G, bidv);
            pg8::Epi<pg8::EM_LORA_W> E{ws + (which == 0 ? WS_E : (which == 1 ? WS_A : WS_G)), nullptr, nullptr, nullptr, nullptr, which == 0 ? in[4] : (which == 1 ? in[6] : nullptr), which == 0 ? 0.60653065971f : 1.f};
            pg8::gemm_phase<pg8::Epi<pg8::EM_LORA_W>, pg8::StaticOrder, true, true>(F.lds + RING_OFF, g, S, E, F.wave); }
    PHASE_END
    SEAM(3);
    PHASE_BEGIN(4)
        bf16* SCN = (bf16*)(ws + WS_SCN); float* SCAL = (float*)(ws + WS_SCAL); const bf16* Ab = (const bf16*)(ws + WS_A);
        for (int t = gw; t < S_; t += NGW) {
#pragma unroll 2
            for (int h = 0; h < 16; ++h) { const int cc = h * 64 + lane;
                const float r = bf2f(RKV[(size_t)t * 3072 + cc]), k = bf2f(RKV[(size_t)t * 3072 + 1024 + cc]), a = bf2f(Ab[(size_t)t * 1024 + cc]);
                float kk = k * in[9][cc]; const float nrm = sqrtf(wsum(kk * kk)); kk = kk / fmaxf(nrm, 1e-12f);
                const float kt = k * (1.f + (a - 1.f) * in[10][cc]); const float b = kk * a;
                const unsigned short kkb = (unsigned short)f2bf(-kk), bb = (unsigned short)f2bf(b), ktb = (unsigned short)f2bf(kt);
                bf16* q = SCN + ((size_t)h * S_ + t) * 192; q[lane] = kkb; q[64 + lane] = bb; q[128 + lane] = ktb;
                const float br = wsum(bf2f(bb) * r), kr = wsum(bf2f(ktb) * r), bon = wsum(r * kt * in[11][cc]);
                if (lane == 0) *(f32x4*)(SCAL + ((size_t)h * S_ + t) * 4) = (f32x4){br, kr, bon, 0.f}; }
        }
    PHASE_END
    SEAM(4);
    PHASE_BEGIN(5)
        scan4_phase(lane, F.wave, F.vcu, F.G, ws, ob, RKV, (LAS float*)(F.lds + RING_OFF));
    PHASE_END
    SEAM(5);
    PHASE_BEGIN(6)
        if ((F.vcu & 15) == 0) { const int h = F.vcu >> 4; const int wv = F.wave;
            constexpr int PIT = 72;
            LAS bf16* Sb = (LAS bf16*)(F.lds + RING_OFF);
            LAS bf16* Atb = Sb + 2 * 64 * PIT;
            const float* SL = (const float*)(ws + WS_SLOC) + (size_t)h * NSEG * 4096; const bf16* AT = (const bf16*)(ws + WS_ASEG) + (size_t)h * NSEG * 4096; float* SI = (float*)(ws + WS_SIN) + (size_t)h * NSEG * 4096;
            for (int i = tid; i < 2 * 64 * PIT / 2; i += 512) ((LAS unsigned*)Sb)[i] = 0u;
#define P6_BAR() do { asm volatile("s_waitcnt lgkmcnt(0)" ::: "memory"); __builtin_amdgcn_s_barrier(); asm volatile("" ::: "memory"); } while (0)
            if (wv >= 4) {
                const int li = tid - 256, row = li >> 2, ch = li & 3;
                v4u r0a, r0b, r1a, r1b;
#define P6_LD(p, ra, rb) do { const bf16* s_ = AT + (size_t)(p) * 4096 + row * 64 + ch * 16; ra = *(const GAS v4u*)s_; rb = *(const GAS v4u*)(s_ + 8); } while (0)
#define P6_ST(p, ra, rb) do { LAS bf16* d_ = Atb + ((p) % 3) * 64 * PIT + row * PIT + ch * 16; *(LAS v4u*)d_ = ra; *(LAS v4u*)(d_ + 8) = rb; } while (0)
                P6_LD(0, r0a, r0b); P6_ST(0, r0a, r0b); P6_LD(1, r0a, r0b); P6_LD(2, r1a, r1b);
                P6_BAR();
#pragma unroll 1
                for (int p = 0; p < NSEG - 1; p += 2) {
                    if (p + 1 < NSEG - 1) P6_ST(p + 1, r0a, r0b); if (p + 3 < NSEG - 1) P6_LD(p + 3, r0a, r0b);
                    P6_BAR();
                    if (p + 1 < NSEG - 1) { if (p + 2 < NSEG - 1) P6_ST(p + 2, r1a, r1b); if (p + 4 < NSEG - 1) P6_LD(p + 4, r1a, r1b); P6_BAR(); }
                }
#undef P6_LD
#undef P6_ST
            } else {
                const int vt = wv >> 1, ct = wv & 1, r = lane & 31, hb = lane >> 5;
                typedef float f32x16 __attribute__((ext_vector_type(16)));
                f32x16 nl;
#define P6_LDL(p) do { const float* s_ = SL + (size_t)(p) * 4096 + (32 * vt + 4 * hb) * 64 + 32 * ct + r; _Pragma("unroll") for (int q = 0; q < 16; ++q) nl[q] = s_[((q & 3) + 8 * (q >> 2)) * 64]; } while (0)
                P6_LDL(0);
                { float* o_ = SI + (32 * vt + 4 * hb) * 64 + 32 * ct + r;
#pragma unroll
                  for (int q = 0; q < 16; ++q) o_[((q & 3) + 8 * (q >> 2)) * 64] = 0.f; }
                P6_BAR();
#pragma unroll 1
                for (int p = 0; p < NSEG - 1; ++p) {
                    const LAS bf16* sa_ = Sb + (p & 1) * 64 * PIT + (32 * vt + r) * PIT + 8 * hb; const LAS bf16* at_ = Atb + (p % 3) * 64 * PIT + (32 * ct + r) * PIT + 8 * hb;
                    f32x16 acc = nl; if (p + 1 < NSEG - 1) P6_LDL(p + 1);
#pragma unroll
                    for (int ks = 0; ks < 4; ++ks) { const bf16x8 af = *(const LAS bf16x8*)(sa_ + 16 * ks), bfr = *(const LAS bf16x8*)(at_ + 16 * ks);
                        acc = __builtin_amdgcn_mfma_f32_32x32x16_bf16(af, bfr, acc, 0, 0, 0); }
                    float* o_ = SI + (size_t)(p + 1) * 4096 + (32 * vt + 4 * hb) * 64 + 32 * ct + r; LAS bf16* sn_ = Sb + ((p + 1) & 1) * 64 * PIT + (32 * vt + 4 * hb) * PIT + 32 * ct + r;
#pragma unroll
                    for (int q = 0; q < 16; ++q) { const int rr = (q & 3) + 8 * (q >> 2); o_[rr * 64] = acc[q]; sn_[rr * PIT] = (unsigned short)f2bf(acc[q]); }
                    P6_BAR();
                }
#undef P6_LDL
            }
#undef P6_BAR
        } else {
            LAS float* scr = (LAS float*)(F.lds + RING_OFF + F.wave * 16384);
            const int gw2 = (F.vcu - (F.vcu >> 4) - 1) * NWAVES + F.wave, NGW2 = (F.G - 16) * NWAVES;
            constexpr int I_A = 16 * 64, I_B = 16 * 64, I_O = 32 * 64;
            for (int it = gw2; it < I_A + I_B + I_O; it += NGW2) {
                int r = it;
                if (r < I_A) { const int kb = r / 64, nb = r % 64; transpose_block(in[19], 2048, kb * 64, nb * 32, 1024, WA_T, 2048, nb * 32, scr, lane); continue; } r -= I_A;
                if (r < I_B) { const int kb = r / 64, nb = r % 64; transpose_block(in[20], 2048, kb * 64, nb * 32, 1024, WA_T + 1024, 2048, nb * 32, scr, lane); continue; } r -= I_B;
                { const int kb = r / 64, nb = r % 64; transpose_block(in[21], 2048, kb * 64, nb * 32, 2048, WOUT_T, 2048, nb * 32, scr, lane); }
            }
            for (int task = gw2; task < 16 * 32 * 4; task += NGW2) {
                const int hp = task >> 7, kb = (task >> 2) & 31, ng = task & 3; const int k = kb * 64 + lane;
                const f32x4* wq = (const f32x4*)(in[23] + (size_t)k * 2048 + hp * 128);
                f32x4 q[32];
#pragma unroll
                for (int d = 0; d < 32; ++d) q[d] = wq[d];
                const f32x4* sk4 = (const f32x4*)(in[24] + ((size_t)hp * 128 + ng * 32) * 128); LAS f32x4* sks = (LAS f32x4*)scr;
#pragma unroll
                for (int i = 0; i < 16; ++i) sks[i * 64 + lane] = sk4[i * 64 + lane];
                LDS_WAIT(); asm volatile("" ::: "memory");
#pragma unroll 2
                for (int n = 0; n < 32; ++n) { const LAS f32x4* s4 = sks + n * 32; float a0 = 0.f, a1 = 0.f;
#pragma unroll
                    for (int d = 0; d < 32; ++d) { const f32x4 s = s4[d]; a0 = fmaf(q[d].x, s.x, a0); a1 = fmaf(q[d].y, s.y, a1); a0 = fmaf(q[d].z, s.z, a0); a1 = fmaf(q[d].w, s.w, a1); }
                    WS_T[(size_t)(hp * 128 + ng * 32 + n) * 2048 + k] = (bf16)f2bf(a0 + a1); }
                LDS_WAIT(); asm volatile("" ::: "memory");
            }
        }
        __syncthreads();
        attn_body::attn_phase<8>((char*)lds + RING_OFF, (const attn_body::bf16*)PD, (attn_body::bf16*)(ws + WS_OATT), F.vcu, F.wave, (unsigned*)(F.ctl + 2048 + 64 * (F.vcu >> 5)), F.MISC + 12);
    PHASE_END
    SEAM(6);
    PHASE_BEGIN(7)
        typedef float f32x16 __attribute__((ext_vector_type(16)));
        const int r = lane & 31, hb = lane >> 5;
        const bf16* ZZ = (const bf16*)(ws + WS_Z); const bf16* YL = (const bf16*)(ob + OUT_YLOC); const bf16* Gb = (const bf16*)(ws + WS_G); const float* SCAL = (const float*)(ws + WS_SCAL);
        bf16* YA = (bf16*)(ws + WS_YA);
        constexpr int PITB = 144, BLK = 32 * PITB;
        LAS unsigned char* wl = F.lds + RING_OFF + F.wave * (3 * BLK) - BLK;
        const int lr = lane >> 3, lc = lane & 7;
        for (int task = gw; task < 16 * NSEG * 2; task += NGW) { const int h = task >> 7, seg = (task >> 1) & 63, half = task & 1;
            bf16x8 af[2][4];
            { const float* si = (const float*)(ws + WS_SIN) + ((size_t)h * NSEG + seg) * 4096;
#pragma unroll
              for (int vt = 0; vt < 2; ++vt)
#pragma unroll
                  for (int ks = 0; ks < 4; ++ks) { const f32x4 a = *(const f32x4*)(si + (32 * vt + r) * 64 + 16 * ks + 8 * hb), b = *(const f32x4*)(si + (32 * vt + r) * 64 + 16 * ks + 8 * hb + 4);
                      const v4u w = (v4u){pk2(a.x, a.y), pk2(a.z, a.w), pk2(b.x, b.y), pk2(b.z, b.w)}; af[vt][ks] = __builtin_bit_cast(bf16x8, w); } }
            f32x4 lg[2][4], lb[2][4];
#pragma unroll
            for (int vt = 0; vt < 2; ++vt)
#pragma unroll
                for (int qq = 0; qq < 4; ++qq) { lg[vt][qq] = *(const f32x4*)(in[12] + h * 64 + 32 * vt + 8 * qq + 4 * hb); lb[vt][qq] = *(const f32x4*)(in[13] + h * 64 + 32 * vt + 8 * qq + 4 * hb); }
#pragma unroll 1
            for (int tt = 0; tt < 4; ++tt) { const int tb0 = seg * SEGLEN + half * 128 + tt * 32; const size_t hb0 = (size_t)h * S_ + tb0;
                v4u ry[4], rv[4], rg[4];
#pragma unroll
                for (int i = 0; i < 4; ++i) { const int row = lr + 8 * i;
                    ry[i] = *(const GAS v4u*)(YL + (hb0 + row) * 64 + lc * 8);
                    rv[i] = *(const GAS v4u*)(RKV + (size_t)(tb0 + row) * 3072 + 2048 + h * 64 + lc * 8); rg[i] = *(const GAS v4u*)(Gb + (size_t)(tb0 + row) * 1024 + h * 64 + lc * 8); }
                const float bon = SCAL[(hb0 + r) * 4 + 2];
#pragma unroll
                for (int i = 0; i < 4; ++i) { const int o = (lr + 8 * i) * PITB + lc * 16;
                    *(LAS v4u*)(wl + BLK + o) = ry[i]; *(LAS v4u*)(wl + 2 * BLK + o) = rv[i]; *(LAS v4u*)(wl + 3 * BLK + o) = rg[i]; }
                LDS_WAIT(); asm volatile("" ::: "memory");
                bf16x8 zf[4];
#pragma unroll
                for (int ks = 0; ks < 4; ++ks) zf[ks] = *(const bf16x8*)(ZZ + (hb0 + r) * 64 + 16 * ks + 8 * hb);
                f32x16 acc[2];
#pragma unroll
                for (int vt = 0; vt < 2; ++vt)
#pragma unroll
                    for (int qq = 0; qq < 4; ++qq) { const unsigned long long w = *(const LAS unsigned long long*)(wl + BLK + r * PITB + (32 * vt + 8 * qq + 4 * hb) * 2);
                        acc[vt][4 * qq] = pg8::bflo((unsigned)w); acc[vt][4 * qq + 1] = pg8::bfhi((unsigned)w); acc[vt][4 * qq + 2] = pg8::bflo((unsigned)(w >> 32)); acc[vt][4 * qq + 3] = pg8::bfhi((unsigned)(w >> 32)); }
#pragma unroll
                for (int vt = 0; vt < 2; ++vt)
#pragma unroll
                    for (int ks = 0; ks < 4; ++ks) acc[vt] = __builtin_amdgcn_mfma_f32_32x32x16_bf16(af[vt][ks], zf[ks], acc[vt], 0, 0, 0);
                float s1 = 0.f;
#pragma unroll
                for (int vt = 0; vt < 2; ++vt)
#pragma unroll
                    for (int q = 0; q < 16; ++q) s1 += acc[vt][q];
                { auto rr = __builtin_amdgcn_permlane32_swap(__float_as_uint(s1), __float_as_uint(s1), false, false); s1 = __uint_as_float(rr[0]) + __uint_as_float(rr[1]); }
                const float mean = s1 * (1.f / 64.f); float s2 = 0.f;
#pragma unroll
                for (int vt = 0; vt < 2; ++vt)
#pragma unroll
                    for (int q = 0; q < 16; ++q) { acc[vt][q] -= mean; s2 += acc[vt][q] * acc[vt][q]; }
                { auto rr = __builtin_amdgcn_permlane32_swap(__float_as_uint(s2), __float_as_uint(s2), false, false); s2 = __uint_as_float(rr[0]) + __uint_as_float(rr[1]); }
                const float rstd = rsqrtf(s2 * (1.f / 64.f) + 64e-5f);
#pragma unroll
                for (int vt = 0; vt < 2; ++vt)
#pragma unroll
                    for (int qq = 0; qq < 4; ++qq) { const int vo = r * PITB + (32 * vt + 8 * qq + 4 * hb) * 2;
                        const unsigned long long vw = *(const LAS unsigned long long*)(wl + 2 * BLK + vo), gw_ = *(const LAS unsigned long long*)(wl + 3 * BLK + vo);
                        const float vv[4] = {pg8::bflo((unsigned)vw), pg8::bfhi((unsigned)vw), pg8::bflo((unsigned)(vw >> 32)), pg8::bfhi((unsigned)(vw >> 32))};
                        const float gg[4] = {pg8::bflo((unsigned)gw_), pg8::bfhi((unsigned)gw_), pg8::bflo((unsigned)(gw_ >> 32)), pg8::bfhi((unsigned)(gw_ >> 32))};
                        float o[4];
#pragma unroll
                        for (int i = 0; i < 4; ++i) o[i] = (acc[vt][4 * qq + i] * rstd * lg[vt][qq][i] + lb[vt][qq][i] + bon * vv[i]) * gg[i];
                        *(LAS unsigned long long*)(wl + BLK + vo) = (unsigned long long)pk2(o[0], o[1]) | ((unsigned long long)pk2(o[2], o[3]) << 32); }
                LDS_WAIT(); asm volatile("" ::: "memory");
#pragma unroll
                for (int i = 0; i < 4; ++i) { const int row = lr + 8 * i; *(GAS v4u*)(YA + (size_t)(tb0 + row) * 1024 + h * 64 + lc * 8) = *(const LAS v4u*)(wl + BLK + row * PITB + lc * 16); }
                LDS_WAIT(); asm volatile("" ::: "memory");
            }
        }
    PHASE_END
    SEAM(7);
    PHASE_BEGIN(9)
        float d1 = 0.f, d2 = 0.f; d1 = in[14][lane] * in[15][lane]; d2 = in[16][lane] * in[17][lane];
        const float lam = __expf(wave_sum(d1)) - __expf(wave_sum(d2)) + 0.2f;
        const bf16* OA = (const bf16*)(ws + WS_OATT); bf16* YB = (bf16*)(ws + WS_YB);
        f32x4 sg[4];
#pragma unroll
        for (int q = 0; q < 4; ++q) sg[q] = *(const f32x4*)(in[18] + (lane & 7) * 16 + q * 4);
        for (int t = gw; t < S_; t += NGW) {
            const v4u a0 = *(const GAS v4u*)(OA + (size_t)t * 2048 + lane * 16), a1 = *(const GAS v4u*)(OA + (size_t)t * 2048 + lane * 16 + 8);
            const v4u b0 = *(const GAS v4u*)(OA + (size_t)t * 2048 + 1024 + lane * 16), b1 = *(const GAS v4u*)(OA + (size_t)t * 2048 + 1024 + lane * 16 + 8);
            const unsigned aw[8] = {a0.x, a0.y, a0.z, a0.w, a1.x, a1.y, a1.z, a1.w}, bw[8] = {b0.x, b0.y, b0.z, b0.w, b1.x, b1.y, b1.z, b1.w};
            float o[16]; float ss = 0.f;
#pragma unroll
            for (int e = 0; e < 8; ++e) { o[2 * e] = pg8::bflo(aw[e]) - lam * pg8::bflo(bw[e]); o[2 * e + 1] = pg8::bfhi(aw[e]) - lam * pg8::bfhi(bw[e]); ss += o[2 * e] * o[2 * e] + o[2 * e + 1] * o[2 * e + 1]; }
            ss += __shfl_xor(ss, 1); ss += __shfl_xor(ss, 2); ss += __shfl_xor(ss, 4);
            const float rs = rsqrtf(ss * (1.f / 128.f) + 1e-5f) * 0.8f;
            const float gg[16] = {sg[0].x, sg[0].y, sg[0].z, sg[0].w, sg[1].x, sg[1].y, sg[1].z, sg[1].w, sg[2].x, sg[2].y, sg[2].z, sg[2].w, sg[3].x, sg[3].y, sg[3].z, sg[3].w};
#pragma unroll
            for (int e = 0; e < 16; ++e) o[e] = o[e] * rs * gg[e];
            *(GAS v4u*)(YB + (size_t)t * 1024 + lane * 16) = (v4u){pk2(o[0], o[1]), pk2(o[2], o[3]), pk2(o[4], o[5]), pk2(o[6], o[7])};
            *(GAS v4u*)(YB + (size_t)t * 1024 + lane * 16 + 8) = (v4u){pk2(o[8], o[9]), pk2(o[10], o[11]), pk2(o[12], o[13]), pk2(o[14], o[15])};
        }
    PHASE_END
    SEAM(9);
    PHASE_BEGIN(10)
        pg8::Gemm g{(const bf16*)(ws + WS_YA), WA_T, S_, 2048, 2048, 1024, 2048, (const bf16*)(ws + WS_YB), 16}; pg8::StaticOrder S; S.init(S_, 2048, F.G, bidv);
        pg8::Epi<pg8::EM_PROJAB> E{ws + WS_MERGED, nullptr, nullptr, PG, nullptr, nullptr, 1.f};
        pg8::gemm_phase<pg8::Epi<pg8::EM_PROJAB>, pg8::StaticOrder, true, true>(F.lds + RING_OFF, g, S, E, F.wave);
    PHASE_END
    SEAM(10);
    PHASE_BEGIN(12)
        pg8::Gemm g{(const bf16*)(ws + WS_MERGED), WOUT_T, S_, 2048, 2048, 2048, 2048, nullptr, 0}; pg8::StaticOrder S; S.init(S_, 2048, F.G, bidv);
        pg8::Epi<pg8::EM_WOUT> E{ws + WS_H2, nullptr, nullptr, nullptr, in[0], nullptr, 1.f};
        pg8::gemm_phase<pg8::Epi<pg8::EM_WOUT>, pg8::StaticOrder, true, true>(F.lds + RING_OFF, g, S, E, F.wave);
    PHASE_END
    SEAM(12);
    PHASE_BEGIN(13)
        for (int m = gw; m < S_; m += 2 * NGW) rms_row2_to_bf16((const float*)(ws + WS_H2) + (size_t)m * DM, (const float*)(ws + WS_H2) + (size_t)(m + NGW) * DM, in[22], (bf16*)(ws + WS_XN2) + (size_t)m * DM, (bf16*)(ws + WS_XN2) + (size_t)(m + NGW) * DM, lane);
        for (int row = gw; row < 32768; row += NGW) { const int which = row >> 14, r = row & 16383;
            const f32x4* src = (const f32x4*)(in[25 + which] + (size_t)r * 2048) + lane; f32x4 v[8]; float am = 0.f;
#pragma unroll
            for (int j = 0; j < 8; ++j) { v[j] = __builtin_nontemporal_load(src + 64 * j); am = fmaxf(am, fmaxf(fmaxf(fabsf(v[j].x), fabsf(v[j].y)), fmaxf(fabsf(v[j].z), fabsf(v[j].w)))); }
            const unsigned tb = __float_as_uint(am * (1.f / 6.f)); unsigned eb = (tb >> 23) + ((tb & 0x7fffffu) ? 1u : 0u); eb = eb < 1u ? 1u : (eb > 254u ? 254u : eb);
            const float sc = __uint_as_float(eb << 23);
            unsigned wd[4];
#pragma unroll
            for (int w = 0; w < 4; ++w) { unsigned q = 0u;
                q = __builtin_amdgcn_cvt_scalef32_pk_fp4_f32(q, v[2 * w].x, v[2 * w].y, sc, 0); q = __builtin_amdgcn_cvt_scalef32_pk_fp4_f32(q, v[2 * w].z, v[2 * w].w, sc, 1);
                q = __builtin_amdgcn_cvt_scalef32_pk_fp4_f32(q, v[2 * w + 1].x, v[2 * w + 1].y, sc, 2); q = __builtin_amdgcn_cvt_scalef32_pk_fp4_f32(q, v[2 * w + 1].z, v[2 * w + 1].w, sc, 3); wd[w] = q; }
            *(GAS v4u*)(ws + (which ? WS_VTAB : WS_UTAB) + (size_t)r * 1024 + lane * 16) = (v4u){wd[0], wd[1], wd[2], wd[3]};
            ((unsigned char*)(ws + (which ? WS_VSCL : WS_USCL)))[(size_t)r * 64 + lane] = (unsigned char)eb; }
    PHASE_END
    SEAM(13);
    PHASE_BEGIN(14)
        pg8::Gemm g{(const bf16*)(ws + WS_XN2), WS_T, S_, 2048, 2048, 2048, 2048, nullptr, 0}; pg8::StaticOrder S; S.init(S_, 2048, F.G, bidv);
        pg8::Epi<pg8::EM_SCORES> E{ws + WS_SCORES, nullptr, nullptr, nullptr, nullptr, nullptr, 1.f};
        pg8::gemm_phase<pg8::Epi<pg8::EM_SCORES>, pg8::StaticOrder, true, true>(F.lds + RING_OFF, g, S, E, F.wave);
    PHASE_END
    SEAM(14);
    PHASE_BEGIN(15)
        const float* SC = (const float*)(ws + WS_SCORES); const bf16* XN2 = (const bf16*)(ws + WS_XN2);
        const unsigned char* UT = (const unsigned char*)(ws + WS_UTAB); const unsigned char* VT = (const unsigned char*)(ws + WS_VTAB);
        const unsigned char* USB = (const unsigned char*)(ws + WS_USCL); const unsigned char* VSB = (const unsigned char*)(ws + WS_VSCL);
        LAS unsigned* lst = (LAS unsigned*)(F.lds + RING_OFF + F.wave * 10240);
        for (int tb = gw; tb < S_ / 8; tb += NGW) {
            { const int tl = lane >> 3, h = lane & 7; const float* srow = SC + (size_t)(tb * 8 + tl) * 2048 + h * 256;
              float A[16], B[16];
#pragma unroll
              for (int p = 0; p < 2; ++p) { float top[16];
#pragma unroll
                  for (int k = 0; k < 16; ++k) top[k] = -INFINITY;
#pragma unroll 2
                  for (int i4 = 0; i4 < 32; ++i4) { const f32x4 v = *(const f32x4*)(srow + p * 128 + i4 * 4); const float ve[4] = {v.x, v.y, v.z, v.w};
#pragma unroll
                      for (int e = 0; e < 4; ++e) { float x = __uint_as_float((__float_as_uint(ve[e]) & 0xffffff80u) | (unsigned)(i4 * 4 + e));
#pragma unroll
                          for (int k = 0; k < 16; ++k) { const float hi = fmaxf(top[k], x); x = fminf(top[k], x); top[k] = hi; } } }
#pragma unroll
                  for (int k = 0; k < 16; ++k) { if (p == 0) A[k] = top[k]; else B[k] = top[k]; } }
              LAS unsigned* ixl = (LAS unsigned*)(F.lds + RING_OFF + F.wave * 10240 + 8192) + lane * 8;
              { unsigned wa[4], wb[4];
#pragma unroll
                for (int q = 0; q < 4; ++q) { wa[q] = 0u; wb[q] = 0u;
#pragma unroll
                    for (int e = 0; e < 4; ++e) { wa[q] |= (__float_as_uint(A[q * 4 + e]) & 127u) << (8 * e); wb[q] |= (__float_as_uint(B[q * 4 + e]) & 127u) << (8 * e); } }
                *(LAS v4u*)ixl = (v4u){wa[0], wa[1], wa[2], wa[3]}; *(LAS v4u*)(ixl + 4) = (v4u){wb[0], wb[1], wb[2], wb[3]}; }
              float cs[16];
#pragma unroll
              for (int k = 0; k < 16; ++k) cs[k] = -INFINITY;
#pragma unroll
              for (int i = 0; i < 16; ++i)
#pragma unroll
                  for (int j = 0; j < 16; ++j) if ((i + 1) * (j + 1) <= 16) {
                      float x = __uint_as_float((__float_as_uint(A[i] + B[j]) & 0xffffff00u) | (unsigned)(i * 16 + j));
#pragma unroll
                      for (int k = 0; k < 16; ++k) { const float hi = fmaxf(cs[k], x); x = fminf(cs[k], x); cs[k] = hi; } }
              LDS_WAIT(); asm volatile("" ::: "memory");
              const LAS unsigned char* ixb = (const LAS unsigned char*)ixl;
              unsigned cx[16]; float gsum = 0.f; const float cmax = cs[0];
#pragma unroll
              for (int k = 0; k < 16; ++k) { const unsigned ij = __float_as_uint(cs[k]) & 255u; cx[k] = ((unsigned)ixb[ij >> 4] << 7) | (unsigned)ixb[16 + (ij & 15u)]; cs[k] = __expf(cs[k] - cmax); gsum += cs[k]; }
              const float ginv = 1.f / gsum; LAS unsigned* lp = lst + (tl * 128 + h * 16) * 2;
#pragma unroll
              for (int k = 0; k < 16; k += 2) *(LAS v4u*)(lp + k * 2) = (v4u){cx[k], __float_as_uint(cs[k] * ginv), cx[k + 1], __float_as_uint(cs[k + 1] * ginv)}; }
            LDS_WAIT(); asm volatile("" ::: "memory");
#pragma unroll 1
            for (int tl = 0; tl < 8; ++tl) { const int t = tb * 8 + tl;
                float xf[32];
#pragma unroll
                for (int j = 0; j < 8; ++j) { const unsigned long long w = *(const GAS unsigned long long*)(XN2 + (size_t)t * 2048 + 256 * j + 4 * lane);
                    xf[4 * j] = pg8::bflo((unsigned)w); xf[4 * j + 1] = pg8::bfhi((unsigned)w); xf[4 * j + 2] = pg8::bflo((unsigned)(w >> 32)); xf[4 * j + 3] = pg8::bfhi((unsigned)(w >> 32)); }
                float acc[32];
#pragma unroll
                for (int e = 0; e < 32; ++e) acc[e] = 0.f;
                constexpr int EG = 8;
#pragma unroll 1
                for (int e0 = 0; e0 < 128; e0 += EG) {
                    v4u ur[EG], vr[EG]; float gate[EG]; unsigned char sub[EG], svb[EG];
#pragma unroll
                    for (int q = 0; q < EG; ++q) { const unsigned idx = __builtin_amdgcn_readfirstlane(lst[(tl * 128 + e0 + q) * 2]); gate[q] = __uint_as_float(__builtin_amdgcn_readfirstlane(lst[(tl * 128 + e0 + q) * 2 + 1]));
                        ur[q] = *(const GAS v4u*)(UT + (size_t)idx * 1024 + lane * 16); vr[q] = *(const GAS v4u*)(VT + (size_t)idx * 1024 + lane * 16);
                        sub[q] = USB[(size_t)idx * 64 + lane]; svb[q] = VSB[(size_t)idx * 64 + lane]; }
#pragma unroll
                    for (int q = 0; q < EG; ++q) { float d0 = 0.f, d1 = 0.f; const float su = __uint_as_float((unsigned)sub[q] << 23), sv = __uint_as_float((unsigned)svb[q] << 23);
                        const unsigned uw[4] = {ur[q].x, ur[q].y, ur[q].z, ur[q].w};
#pragma unroll
                        for (int w = 0; w < 4; ++w) {
                            const auto p0 = __builtin_amdgcn_cvt_scalef32_pk_f32_fp4(uw[w], su, 0), p1 = __builtin_amdgcn_cvt_scalef32_pk_f32_fp4(uw[w], su, 1), p2 = __builtin_amdgcn_cvt_scalef32_pk_f32_fp4(uw[w], su, 2), p3 = __builtin_amdgcn_cvt_scalef32_pk_f32_fp4(uw[w], su, 3);
                            d0 = fmaf(xf[8 * w], p0[0], d0); d1 = fmaf(xf[8 * w + 1], p0[1], d1); d0 = fmaf(xf[8 * w + 2], p1[0], d0); d1 = fmaf(xf[8 * w + 3], p1[1], d1);
                            d0 = fmaf(xf[8 * w + 4], p2[0], d0); d1 = fmaf(xf[8 * w + 5], p2[1], d1); d0 = fmaf(xf[8 * w + 6], p3[0], d0); d1 = fmaf(xf[8 * w + 7], p3[1], d1); }
                        const float d = wsum(d0 + d1);
                        const float act = 0.5f * d * (1.f + erff(d * 0.70710678118f)); const float cf = gate[q] * act; const float cs = cf * sv;
                        const unsigned vw[4] = {vr[q].x, vr[q].y, vr[q].z, vr[q].w};
#pragma unroll
                        for (int w = 0; w < 4; ++w) {
                            const auto p0 = __builtin_amdgcn_cvt_scalef32_pk_f32_fp4(vw[w], 1.0f, 0), p1 = __builtin_amdgcn_cvt_scalef32_pk_f32_fp4(vw[w], 1.0f, 1), p2 = __builtin_amdgcn_cvt_scalef32_pk_f32_fp4(vw[w], 1.0f, 2), p3 = __builtin_amdgcn_cvt_scalef32_pk_f32_fp4(vw[w], 1.0f, 3);
                            acc[8 * w] = fmaf(cs, p0[0], acc[8 * w]); acc[8 * w + 1] = fmaf(cs, p0[1], acc[8 * w + 1]); acc[8 * w + 2] = fmaf(cs, p1[0], acc[8 * w + 2]); acc[8 * w + 3] = fmaf(cs, p1[1], acc[8 * w + 3]);
                            acc[8 * w + 4] = fmaf(cs, p2[0], acc[8 * w + 4]); acc[8 * w + 5] = fmaf(cs, p2[1], acc[8 * w + 5]); acc[8 * w + 6] = fmaf(cs, p3[0], acc[8 * w + 6]); acc[8 * w + 7] = fmaf(cs, p3[1], acc[8 * w + 7]); }
                    }
                }
                float* orow = args.out + (size_t)t * 2048; const float* hrow = (const float*)(ws + WS_H2) + (size_t)t * 2048; float ss = 0.f;
#pragma unroll
                for (int j = 0; j < 8; ++j) { const f32x4 a = *(const f32x4*)(hrow + 256 * j + 4 * lane);
                    acc[4 * j] += a.x; acc[4 * j + 1] += a.y; acc[4 * j + 2] += a.z; acc[4 * j + 3] += a.w; }
#pragma unroll
                for (int e = 0; e < 32; ++e) ss += acc[e] * acc[e];
                const float rstd = rsqrtf(wsum(ss) * (1.f / 2048.f) + 1e-6f);
#pragma unroll
                for (int j = 0; j < 8; ++j) { const f32x4 g0 = *(const f32x4*)(in[27] + 256 * j + 4 * lane);
                    *(f32x4*)(orow + 256 * j + 4 * lane) = (f32x4){acc[4 * j] * rstd * g0.x, acc[4 * j + 1] * rstd * g0.y, acc[4 * j + 2] * rstd * g0.z, acc[4 * j + 3] * rstd * g0.w}; }
            }
            LDS_WAIT(); asm volatile("" ::: "memory");
        }
    PHASE_END
#undef IN
#undef SEAM
}

extern "C" void kernel_launch(void* const* d_in, const int* in_sizes, int n_in, void* d_out, int out_size, void* d_ws, size_t ws_size, hipStream_t stream) {
    static int grid = 0;
    if (grid == 0) {
        if (n_in != 28 || in_sizes[0] != S_ * DM || out_size != S_ * DM || ws_size < WS_END) { fprintf(stderr, "kernel_launch: unexpected shapes: n_in %d in0 %d out %d ws %zu (need >= %zu)\n", n_in, n_in > 0 ? in_sizes[0] : -1, out_size, ws_size, (size_t)WS_END); grid = -1; return; }
        if (hipFuncSetAttribute((const void*)mk_fwd, hipFuncAttributeMaxDynamicSharedMemorySize, LDS_BYTES) != hipSuccess) { fprintf(stderr, "kernel_launch: hipFuncSetAttribute failed\n"); grid = -1; return; }
        int per_cu = 0;
        if (hipOccupancyMaxActiveBlocksPerMultiprocessor(&per_cu, (const void*)mk_fwd, NWAVES * 64, LDS_BYTES) != hipSuccess || per_cu < 1) fprintf(stderr, "kernel_launch: note: occupancy query reports %d\n", per_cu);
        (void)hipGetLastError();
        grid = 256;
    }
    if (grid < 0) return;
    (void)hipMemsetAsync((char*)d_ws + WS_CTL, 0, CTL_ZERO_BYTES, stream);
    Args a{};
    for (int i = 0; i < 28; ++i) a.in[i] = (const float*)d_in[i];
    a.out = (float*)d_out; a.ws = (unsigned char*)d_ws;
#if MK_PER_PHASE
    for (int p = 0; p < NPH; ++p) { a.ph_lo = p; a.ph_hi = p + 1; hipLaunchKernelGGL(mk_fwd, dim3(grid), dim3(NWAVES * 64), LDS_BYTES, stream, a); }
#else
    a.ph_lo = 0; a.ph_hi = NPH; hipLaunchKernelGGL(mk_fwd, dim3(grid), dim3(NWAVES * 64), LDS_BYTES, stream, a);
#endif
    const hipError_t le = hipPeekAtLastError();
    if (le != hipSuccess) fprintf(stderr, "kernel_launch: launch failed: %s\n", hipGetErrorName(le));
}
```

```cpp
#include <hip/hip_runtime.h>
#include <cstdio>
#include <cstdint>
__device__ __forceinline__ int mk_lane_id() { int l; asm volatile("v_mbcnt_lo_u32_b32 %0, -1, 0\n\tv_mbcnt_hi_u32_b32 %0, -1, %0" : "=v"(l)); return l; }
namespace pg8 {
#define PG8_LAS __attribute__((address_space(3)))
typedef unsigned short bf16_t;
typedef short bf16x8 __attribute__((ext_vector_type(8)));
typedef float f32x4 __attribute__((ext_vector_type(4)));
typedef unsigned u32x4 __attribute__((ext_vector_type(4)));
constexpr int BM = 256, BK = 64, HALF = 128, HTB = HALF * BK * 2  , STAGE_BYTES = 8 * HTB, NXCD = 8, WGM = 8;

__host__ __device__ __forceinline__ int lds_byte(int r, int c) { const int st = (r >> 4) * 2 + (c >> 5), rr = r & 15, cc = c & 31, ob = rr * 64 + cc * 2; return st * 1024 + (ob ^ (((ob >> 9) & 1) << 5)); }
__host__ __device__ __forceinline__ void stage_rc(int b, int& R, int& C) { const int st = b / 1024, sb = b % 1024, swz = sb ^ (((sb >> 9) & 1) << 5); R = (st >> 1) * 16 + swz / 64; C = (st & 1) * 32 + (swz % 64) / 2; }
__host__ __device__ __forceinline__ int perm32(int rho) { const int n = rho >> 4, i = rho & 15; return 8 * (i >> 2) + 4 * n + (i & 3); }

struct Unit { int pm, pn; };
struct Gemm { const bf16_t* A; const bf16_t* Bt; int M, N, K, lda, ldb; const bf16_t* A2; int ksplit; };

struct StaticOrder {
    int nM, nN, nwg, G, c;
    __host__ __device__ void init(int M, int N, int G_, int c_) { nM = M / BM; nN = N / BM; nwg = nM * nN; G = G_; c = c_; }
    __host__ __device__ bool next(int i, Unit& u) const {
        const long L = (long)i * G + c; if (L >= nwg) return false;
        int wgid = (int)L; { const int q = nwg / NXCD, r = nwg % NXCD, xcd = wgid % NXCD, off = wgid / NXCD; wgid = (xcd < r ? xcd * (q + 1) : r * (q + 1) + (xcd - r) * q) + off; }
        const int nig = WGM * nN, gid = wgid / nig, fm = gid * WGM, gsz = (nM - fm) < WGM ? (nM - fm) : WGM;
        u.pm = fm + ((wgid % nig) % gsz); u.pn = (wgid % nig) / gsz; return true;
    }
    __device__ __forceinline__ void a_ready(const Unit&) const {}
    __device__ __forceinline__ void done(const Unit&) const {}
};

__device__ __forceinline__ unsigned cvt_pk_bf16(float lo, float hi) { unsigned r; asm volatile("v_cvt_pk_bf16_f32 %0, %1, %2" : "=v"(r) : "v"(lo), "v"(hi)); return r; }
__device__ __forceinline__ float sigm(float x) { return __builtin_amdgcn_rcpf(1.0f + __expf(-x)); }
__device__ __forceinline__ float bflo(unsigned w) { return __uint_as_float(w << 16); }
__device__ __forceinline__ float bfhi(unsigned w) { return __uint_as_float(w & 0xffff0000u); }
enum { EM_G1 = 0, EM_LORA_W = 1, EM_LORA_A = 2, EM_LORA_G = 3, EM_PROJA = 4, EM_PROJB = 5, EM_WOUT = 6, EM_SCORES = 7, EM_PROJAB = 8 };
template <int MODE> struct Epi {
    static constexpr bool PERM = true, AFTER_DRAIN = false, HAS_MID = (MODE == EM_PROJAB);
    __device__ __forceinline__ void mid(f32x4 (&acc)[2][2][4][2], const Unit& u, int wr, int wc, int fr, int fq) const {
        asm volatile("" ::: "memory");
        int row0 = u.pm * BM + wr * 64 + fr, col0 = u.pn * BM + wc * 32 + 8 * fq; asm volatile("" : "+v"(row0), "+v"(col0));
#pragma unroll
        for (int ai = 0; ai < 2; ++ai) { asm volatile("" ::: "memory");
#pragma unroll
            for (int m = 0; m < 4; ++m) { const size_t row = (size_t)(row0 + ai * HALF + m * 16);
#pragma unroll
                for (int bj = 0; bj < 2; ++bj) { const int col = col0 + bj * HALF;
                    const u32x4 ga = *(const u32x4*)((const bf16_t*)i0 + row * 4096 + col), gb = *(const u32x4*)((const bf16_t*)i0 + row * 4096 + 2048 + col);
                    const unsigned aw[4] = {ga.x, ga.y, ga.z, ga.w}, bw[4] = {gb.x, gb.y, gb.z, gb.w};
#pragma unroll
                    for (int w = 0; w < 4; ++w) { const float r0 = bflo(aw[w]) * __builtin_amdgcn_rcpf(fmaxf(bflo(bw[w]), 1e-30f)), r1 = bfhi(aw[w]) * __builtin_amdgcn_rcpf(fmaxf(bfhi(bw[w]), 1e-30f));
                        acc[ai][bj][m][w >> 1][2 * (w & 1)] *= r0; acc[ai][bj][m][w >> 1][2 * (w & 1) + 1] *= r1; } } } }
        asm volatile("" ::: "memory");
    }
    void* o0; void* o1; void* o2; const void* i0; const void* i1; const float* vec; float sc;
    __device__ __forceinline__ void operator()(const f32x4 (&acc)[2][2][4][2], const Unit& u, int wr, int wc, int fr, int fq) const {
        asm volatile("" ::: "memory");
        int row0 = u.pm * BM + wr * 64 + fr; asm volatile("" : "+v"(row0));
        int colt = u.pn * BM; int ldc = 2048; int sub = 0;
        bf16_t* ob = (bf16_t*)o0; float scl = 1.f;
        if (MODE == EM_G1) {
            if (u.pn < 14) { ldc = 3584; }
            else if (u.pn < 26) { ob = (bf16_t*)o1; ldc = 3072; colt -= 14 * BM; if (u.pn < 18) scl = sc; }
            else { ob = (bf16_t*)o2; ldc = 4096; colt -= 26 * BM; sub = 1; }
        }
        if (MODE == EM_LORA_W || MODE == EM_LORA_A || MODE == EM_LORA_G) ldc = 1024;
        const int col0 = colt + wc * 32 + 8 * fq;
#pragma unroll
        for (int ai = 0; ai < 2; ++ai)
#pragma unroll
            for (int m = 0; m < 4; ++m) { const size_t row = (size_t)(row0 + ai * HALF + m * 16);
#pragma unroll
                for (int bj = 0; bj < 2; ++bj) { f32x4 v0 = acc[ai][bj][m][0], v1 = acc[ai][bj][m][1]; const int col = col0 + bj * HALF;
                    if (MODE == EM_G1) {
                        if (sub) { v0 = (f32x4){sigm(v0[0]), sigm(v0[1]), sigm(v0[2]), sigm(v0[3])}; v1 = (f32x4){sigm(v1[0]), sigm(v1[1]), sigm(v1[2]), sigm(v1[3])}; }
                        else { v0 = v0 * scl; v1 = v1 * scl; }
                        u32x4 w; w.x = cvt_pk_bf16(v0[0], v0[1]); w.y = cvt_pk_bf16(v0[2], v0[3]); w.z = cvt_pk_bf16(v1[0], v1[1]); w.w = cvt_pk_bf16(v1[2], v1[3]);
                        *(u32x4*)(ob + row * ldc + col) = w;
                    } else if (MODE == EM_LORA_W) {
                        if (vec) { const f32x4 b0 = *(const f32x4*)(vec + col), b1 = *(const f32x4*)(vec + col + 4);
                            v0 = v0 + b0; v1 = v1 + b1;
                            v0 = (f32x4){sigm(v0[0]), sigm(v0[1]), sigm(v0[2]), sigm(v0[3])}; v1 = (f32x4){sigm(v1[0]), sigm(v1[1]), sigm(v1[2]), sigm(v1[3])};
                            v0 = v0 * sc; v1 = v1 * sc; }
                        u32x4 w; w.x = cvt_pk_bf16(v0[0], v0[1]); w.y = cvt_pk_bf16(v0[2], v0[3]); w.z = cvt_pk_bf16(v1[0], v1[1]); w.w = cvt_pk_bf16(v1[2], v1[3]);
                        *(u32x4*)(ob + row * ldc + col) = w;
                    } else if (MODE == EM_PROJA) {
                        const u32x4 g = *(const u32x4*)((const bf16_t*)i0 + row * 4096 + col);
                        float* op = (float*)o0 + row * 2048 + col;
                        *(f32x4*)op = (f32x4){v0[0] * bflo(g.x), v0[1] * bfhi(g.x), v0[2] * bflo(g.y), v0[3] * bfhi(g.y)};
                        *(f32x4*)(op + 4) = (f32x4){v1[0] * bflo(g.z), v1[1] * bfhi(g.z), v1[2] * bflo(g.w), v1[3] * bfhi(g.w)};
                    } else if (MODE == EM_PROJB) {
                        const u32x4 g = *(const u32x4*)((const bf16_t*)i0 + row * 4096 + 2048 + col);
                        const float* tp = (const float*)i1 + row * 2048 + col; const f32x4 t0 = *(const f32x4*)tp, t1 = *(const f32x4*)(tp + 4);
                        v0 = (f32x4){t0[0] + v0[0] * bflo(g.x), t0[1] + v0[1] * bfhi(g.x), t0[2] + v0[2] * bflo(g.y), t0[3] + v0[3] * bfhi(g.y)};
                        v1 = (f32x4){t1[0] + v1[0] * bflo(g.z), t1[1] + v1[1] * bfhi(g.z), t1[2] + v1[2] * bflo(g.w), t1[3] + v1[3] * bfhi(g.w)};
                        u32x4 w; w.x = cvt_pk_bf16(v0[0], v0[1]); w.y = cvt_pk_bf16(v0[2], v0[3]); w.z = cvt_pk_bf16(v1[0], v1[1]); w.w = cvt_pk_bf16(v1[2], v1[3]);
                        *(u32x4*)(ob + row * 2048 + col) = w;
                    } else if (MODE == EM_PROJAB) {
                        const u32x4 g = *(const u32x4*)((const bf16_t*)i0 + row * 4096 + 2048 + col);
                        v0 = (f32x4){v0[0] * bflo(g.x), v0[1] * bfhi(g.x), v0[2] * bflo(g.y), v0[3] * bfhi(g.y)};
                        v1 = (f32x4){v1[0] * bflo(g.z), v1[1] * bfhi(g.z), v1[2] * bflo(g.w), v1[3] * bfhi(g.w)};
                        u32x4 w; w.x = cvt_pk_bf16(v0[0], v0[1]); w.y = cvt_pk_bf16(v0[2], v0[3]); w.z = cvt_pk_bf16(v1[0], v1[1]); w.w = cvt_pk_bf16(v1[2], v1[3]);
                        *(u32x4*)(ob + row * 2048 + col) = w;
                    } else if (MODE == EM_WOUT) {
                        const float* xp = (const float*)i1 + row * 2048 + col; const f32x4 t0 = *(const f32x4*)xp, t1 = *(const f32x4*)(xp + 4);
                        float* op = (float*)o0 + row * 2048 + col; *(f32x4*)op = t0 + v0; *(f32x4*)(op + 4) = t1 + v1;
                    } else {
                        float* op = (float*)o0 + row * 2048 + col; *(f32x4*)op = v0; *(f32x4*)(op + 4) = v1;
                    }
                } }
    }
};

template <class Epi, class Sched, bool ALIGN_EPI = false, bool SP2 = false>
__device__ __forceinline__ void gemm_phase(PG8_LAS unsigned char* lds, const Gemm g, const Sched& S, const Epi& E, const int wid_in) {
    int tid_ = wid_in * 64 + mk_lane_id(); asm volatile("" : "+v"(tid_)); const int tid = tid_, wid = __builtin_amdgcn_readfirstlane(tid >> 6), lane = tid & 63, wr = wid >> 2, wc = wid & 3, fr = lane & 15, fq = lane >> 4;
    const int K = g.K, nt = K / BK;
    unsigned voffA[2], voffB[2];
#pragma unroll
    for (int i = 0; i < 2; ++i) { int R, C; stage_rc(tid * 16 + i * 8192, R, C); const int Rb = Epi::PERM ? ((R & ~31) + perm32(R & 31)) : R;
        voffA[i] = (unsigned)(R * g.lda + C) * 2u; voffB[i] = (unsigned)(Rb * g.ldb + C) * 2u; }
    const size_t kstep = (size_t)(BK * 2);
    const size_t hstepA = (size_t)HALF * g.lda * 2, hstepB = (size_t)HALF * g.ldb * 2;
    const size_t tstepA = 2 * hstepA, tstepB = 2 * hstepB;
    const unsigned ldsw = (unsigned)wid * 1024u;
    const int aoff = lds_byte(wr * 64 + fr, fq * 8), boff = lds_byte(wc * 32 + fr, fq * 8);
#define PG8_SA(b, h) (((b) * 2 + (h)) * HTB)
#define PG8_SB(b, h) ((4 + (b) * 2 + (h)) * HTB)
#define PG8_STAGE(bufoff, gbase, voff) do { _Pragma("unroll") for (int _i = 0; _i < 2; ++_i) \
        __builtin_amdgcn_global_load_lds((const unsigned*)((const char*)(gbase) + (voff)[_i]), (PG8_LAS unsigned*)(lds + (bufoff) + ldsw + _i * 8192), 16, 0, 0); } while (0)
#define PG8_LDA(dst, b, h) do { _Pragma("unroll") for (int m = 0; m < 4; ++m) _Pragma("unroll") for (int k = 0; k < 2; ++k) dst[m][k] = *(const PG8_LAS bf16x8*)(lds + PG8_SA(b, h) + aoff + m * 2048 + k * 1024); } while (0)
#define PG8_LDB(dst, b, h) do { _Pragma("unroll") for (int n = 0; n < 2; ++n) _Pragma("unroll") for (int k = 0; k < 2; ++k) dst[n][k] = *(const PG8_LAS bf16x8*)(lds + PG8_SB(b, h) + boff + n * 2048 + k * 1024); } while (0)
#define PG8_MMA(ai, bj, At, Bt) do { __builtin_amdgcn_s_setprio(1); _Pragma("unroll") for (int m = 0; m < 4; ++m) _Pragma("unroll") for (int n = 0; n < 2; ++n) _Pragma("unroll") for (int k = 0; k < 2; ++k) \
        acc[ai][bj][m][n] = __builtin_amdgcn_mfma_f32_16x16x32_bf16(Bt[n][k], At[m][k], acc[ai][bj][m][n], 0, 0, 0); __builtin_amdgcn_s_setprio(0); } while (0)
#define PG8_WAIT_V(n) asm volatile("s_waitcnt vmcnt(" #n ")" ::: "memory")
#define PG8_WAIT_L(n) asm volatile("s_waitcnt lgkmcnt(" #n ")" ::: "memory")
#define PG8_BAR __builtin_amdgcn_s_barrier()
#define PG8_SCHED __builtin_amdgcn_sched_barrier(0)
    Unit cur, nxt; int ui = 0;
    if (!S.next(0, cur)) return;
    f32x4 acc[2][2][4][2];
#pragma unroll
    for (int a = 0; a < 2; ++a)
#pragma unroll
        for (int b = 0; b < 2; ++b)
#pragma unroll
            for (int m = 0; m < 4; ++m)
#pragma unroll
                for (int n = 0; n < 2; ++n) acc[a][b][m][n] = (f32x4){0.f, 0.f, 0.f, 0.f};
    bf16x8 At[4][2], B0[2][2], B1[2][2];
    const char* cA = (const char*)g.A + (size_t)cur.pm * tstepA; const char* cB = (const char*)g.Bt + (size_t)cur.pn * tstepB;
    const int ksplit = g.A2 ? g.ksplit : 0x40000000;
    const char* cA2 = g.A2 ? (const char*)g.A2 + (size_t)cur.pm * tstepA - (size_t)ksplit * kstep : cA;
    S.a_ready(cur);
    if constexpr (SP2) {
        PG8_STAGE(PG8_SB(0, 0), cB, voffB); PG8_STAGE(PG8_SB(0, 1), cB + hstepB, voffB); PG8_STAGE(PG8_SA(0, 0), cA, voffA); PG8_STAGE(PG8_SA(0, 1), cA + hstepA, voffA);
        if (wr == 1) PG8_BAR;
        PG8_WAIT_V(2); PG8_BAR;
        PG8_STAGE(PG8_SB(1, 0), cB + kstep, voffB); PG8_STAGE(PG8_SA(1, 0), cA + kstep, voffA); PG8_STAGE(PG8_SB(1, 1), cB + hstepB + kstep, voffB);
        PG8_WAIT_V(6); PG8_BAR;
    } else {
        PG8_STAGE(PG8_SB(0, 0), cB, voffB); PG8_STAGE(PG8_SA(0, 0), cA, voffA); PG8_STAGE(PG8_SB(0, 1), cB + hstepB, voffB); PG8_STAGE(PG8_SA(0, 1), cA + hstepA, voffA);
        if (wr == 1) PG8_BAR;
        PG8_WAIT_V(4); PG8_BAR;
        PG8_STAGE(PG8_SB(1, 0), cB + kstep, voffB); PG8_STAGE(PG8_SA(1, 0), cA + kstep, voffA); PG8_STAGE(PG8_SB(1, 1), cB + hstepB + kstep, voffB);
        PG8_WAIT_V(6); PG8_BAR;
    }
    for (;;) {
        const bool has_next = S.next(ui + 1, nxt);
        const char* nA2 = (g.A2 && has_next) ? (const char*)g.A2 + (size_t)nxt.pm * tstepA - (size_t)ksplit * kstep : cA2;
        const char* nA = has_next ? (const char*)g.A + (size_t)nxt.pm * tstepA : cA; const char* nB = has_next ? (const char*)g.Bt + (size_t)nxt.pn * tstepB : cB;
#pragma unroll 1
        for (int part = 0; part < (Epi::HAS_MID ? 2 : 1); ++part) {
        if constexpr (Epi::HAS_MID) { if (part == 1) E.mid(acc, cur, wr, wc, fr, fq); }
        const int tbeg = (Epi::HAS_MID && part == 1) ? ksplit : 0, tend = (Epi::HAS_MID && part == 0) ? (ksplit < nt ? ksplit : nt) : nt;
#pragma unroll 1
        for (int t = tbeg; t < tend; t += 2) {
            const bool last = (t == nt - 2);
            const char* a1 = (t + 1 < ksplit ? cA : cA2) + (size_t)(t + 1) * kstep;
            const char* a2 = last ? nA : (t + 2 < ksplit ? cA : cA2) + (size_t)(t + 2) * kstep; const char* b2 = last ? nB : cB + (size_t)(t + 2) * kstep;
            const char* a3 = a2 + kstep; const char* b3 = b2 + kstep;
            if (last && has_next) S.a_ready(nxt);
            if constexpr (SP2) {
            PG8_LDB(B0, 0, 0); PG8_LDB(B1, 0, 1); PG8_SCHED; PG8_LDA(At, 0, 0); PG8_STAGE(PG8_SA(1, 1), a1 + hstepA, voffA);
            PG8_WAIT_V(8); PG8_WAIT_L(0); PG8_BAR; PG8_MMA(0, 0, At, B0); PG8_MMA(0, 1, At, B1); PG8_BAR; PG8_SCHED;
            PG8_LDA(At, 0, 1); PG8_STAGE(PG8_SB(0, 0), b2, voffB); PG8_STAGE(PG8_SB(0, 1), b2 + hstepB, voffB); PG8_STAGE(PG8_SA(0, 0), a2, voffA);
            PG8_WAIT_V(8); PG8_WAIT_L(0); PG8_BAR; PG8_MMA(1, 0, At, B0); PG8_MMA(1, 1, At, B1); PG8_BAR; PG8_SCHED;
            PG8_LDB(B0, 1, 0); PG8_LDB(B1, 1, 1); PG8_SCHED; PG8_LDA(At, 1, 0); PG8_STAGE(PG8_SA(0, 1), a2 + hstepA, voffA);
            PG8_WAIT_V(8); PG8_WAIT_L(0); PG8_BAR; PG8_MMA(0, 0, At, B0); PG8_MMA(0, 1, At, B1); PG8_BAR; PG8_SCHED;
            PG8_LDA(At, 1, 1); PG8_STAGE(PG8_SB(1, 0), b3, voffB); PG8_STAGE(PG8_SB(1, 1), b3 + hstepB, voffB); PG8_STAGE(PG8_SA(1, 0), a3, voffA);
            PG8_WAIT_V(8); PG8_WAIT_L(0); PG8_BAR; PG8_MMA(1, 0, At, B0); PG8_MMA(1, 1, At, B1); PG8_BAR; PG8_SCHED;
            } else {
            PG8_LDB(B0, 0, 0); PG8_SCHED; PG8_LDA(At, 0, 0); PG8_STAGE(PG8_SA(1, 1), a1 + hstepA, voffA);
            PG8_WAIT_L(8); PG8_BAR; PG8_WAIT_L(0); PG8_MMA(0, 0, At, B0); PG8_BAR; PG8_SCHED;
            PG8_LDB(B1, 0, 1); PG8_STAGE(PG8_SB(0, 0), b2, voffB);
            PG8_BAR; PG8_WAIT_L(0); PG8_MMA(0, 1, At, B1); PG8_BAR;
            PG8_LDA(At, 0, 1); PG8_STAGE(PG8_SA(0, 0), a2, voffA);
            PG8_BAR; PG8_WAIT_L(0); PG8_MMA(1, 0, At, B0); PG8_BAR; PG8_SCHED;
            PG8_STAGE(PG8_SB(0, 1), b2 + hstepB, voffB);
            PG8_WAIT_V(6); PG8_BAR; PG8_MMA(1, 1, At, B1); PG8_BAR;
            PG8_LDB(B0, 1, 0); PG8_SCHED; PG8_LDA(At, 1, 0); PG8_STAGE(PG8_SA(0, 1), a2 + hstepA, voffA);
            PG8_WAIT_L(8); PG8_BAR; PG8_WAIT_L(0); PG8_MMA(0, 0, At, B0); PG8_BAR; PG8_SCHED;
            PG8_LDB(B1, 1, 1); PG8_STAGE(PG8_SB(1, 0), b3, voffB);
            PG8_BAR; PG8_WAIT_L(0); PG8_MMA(0, 1, At, B1); PG8_BAR;
            PG8_LDA(At, 1, 1); PG8_STAGE(PG8_SA(1, 0), a3, voffA);
            PG8_BAR; PG8_WAIT_L(0); PG8_MMA(1, 0, At, B0); PG8_BAR; PG8_SCHED;
            PG8_STAGE(PG8_SB(1, 1), b3 + hstepB, voffB);
            PG8_WAIT_V(6); PG8_BAR; PG8_MMA(1, 1, At, B1); PG8_BAR;
            }
        }
        }
        if constexpr (ALIGN_EPI) { if (wr == 0) PG8_BAR; }
        if constexpr (!Epi::AFTER_DRAIN) { E(acc, cur, wr, wc, fr, fq); S.done(cur); }
        if (!has_next) break;
#pragma unroll
        for (int a = 0; a < 2; ++a)
#pragma unroll
            for (int b = 0; b < 2; ++b)
#pragma unroll
                for (int m = 0; m < 4; ++m)
#pragma unroll
                    for (int n = 0; n < 2; ++n) acc[a][b][m][n] = (f32x4){0.f, 0.f, 0.f, 0.f};
        cur = nxt; cA = nA; cA2 = nA2; cB = nB; ++ui;
        if constexpr (ALIGN_EPI) { if (wr == 1) PG8_BAR; }
    }
    PG8_WAIT_V(0);
    if constexpr (!ALIGN_EPI) { if (wr == 0) PG8_BAR; }
    PG8_BAR;
    if constexpr (Epi::AFTER_DRAIN) { E.fused(acc, cur, wr, wc, fr, fq, lds, wid, lane); S.done(cur); }
#undef PG8_SA
#undef PG8_SB
#undef PG8_STAGE
#undef PG8_LDA
#undef PG8_LDB
#undef PG8_MMA
#undef PG8_WAIT_V
#undef PG8_WAIT_L
#undef PG8_BAR
#undef PG8_SCHED
}
}
#include <hip/hip_bf16.h>
#include <cmath>
namespace attn_body {
using bf16=__hip_bfloat16;
using bf16x8=__attribute__((ext_vector_type(8)))short;
using s16x4=__attribute__((ext_vector_type(4)))short;
using f32x16=__attribute__((ext_vector_type(16)))float;
using u32x4=__attribute__((ext_vector_type(4)))unsigned;
constexpr int SEQ=16384,D=64,PQ=3072,PO=2048;
constexpr int NW=8,QBLK=32,QB=QBLK*NW,KVBLK=64,NQB=SEQ/QB;
constexpr int ATTN_UNIT_ROWS=QB;
__device__ __forceinline__ int crow(int r,int hi){return (r&3)+8*(r>>2)+4*hi;}
#define SBAR() __builtin_amdgcn_sched_barrier(0)
__device__ __forceinline__ void cmask(f32x16&p0,f32x16&p1,int jb,int qrel,int hi){
  const float NEG=-INFINITY; int kb=64*jb+4*hi;
  #pragma unroll
  for(int r=0;r<16;++r){int kv=kb+(r&3)+8*(r>>2); if(kv>qrel)p0[r]=NEG; if(kv+32>qrel)p1[r]=NEG;}
}

constexpr int NSLOT=3, SLOTB=8192, VSLOTB=16384;
constexpr int LDS_K=0, LDS_V=NSLOT*SLOTB, LDS_WS=LDS_V+NSLOT*VSLOTB, LDS_OST=0  , LDS_BYTES=LDS_WS+NW*64*4;
constexpr float C2=0.125f*1.4426950408889634f;
__device__ __forceinline__ void glds16(const void*gsrc,unsigned lds_dst){unsigned keep;
  asm volatile("s_mov_b32 %0, m0\n\ts_mov_b32 m0, %2\n\ts_nop 0\n\tglobal_load_lds_dwordx4 %1, off\n\ts_mov_b32 m0, %0":"=&s"(keep):"v"(gsrc),"s"(lds_dst):"memory");}
__device__ __forceinline__ float max3f(float a,float b,float c){float r;asm("v_max3_f32 %0, %1, %2, %3":"=v"(r):"v"(a),"v"(b),"v"(c));return r;}
__device__ __forceinline__ float max2f(float a,float b){float r;asm("v_max_f32_e32 %0, %1, %2":"=v"(r):"v"(a),"v"(b));return r;}
__device__ __forceinline__ float fadd_s(float a,float b){float r;asm("v_add_f32_e32 %0, %1, %2":"=v"(r):"v"(a),"v"(b));return r;}
__device__ __forceinline__ float fsub_s(float a,float b){float r;asm("v_sub_f32_e32 %0, %1, %2":"=v"(r):"v"(a),"v"(b));return r;}
typedef float f32x2_t __attribute__((ext_vector_type(2))); typedef __bf16 bf16x2_t __attribute__((ext_vector_type(2)));
__device__ __forceinline__ unsigned cvtpk_s(float lo,float hi){f32x2_t v={lo,hi};bf16x2_t b=__builtin_convertvector(v,bf16x2_t);return __builtin_bit_cast(unsigned,b);}
#define WAIT_BAR(N) asm volatile("s_waitcnt vmcnt(" #N ") lgkmcnt(0)\n\ts_barrier":::"memory")

__device__ __forceinline__ void qkt(f32x16&p0,f32x16&p1,const char*Kslot,const bf16x8*qr,const f32x16&negm,int r32,int hi){
  const char*kb=Kslot+hi*1024+r32*16;
  #pragma unroll
  for(int d0=0;d0<4;++d0){
    const bf16x8 b0=*reinterpret_cast<const bf16x8*>(kb+d0*2048);
    const bf16x8 b1=*reinterpret_cast<const bf16x8*>(kb+d0*2048+512);
    if(d0==0){p0=__builtin_amdgcn_mfma_f32_32x32x16_bf16(b0,qr[0],f32x16{},0,0,0);p1=__builtin_amdgcn_mfma_f32_32x32x16_bf16(b1,qr[0],f32x16{},0,0,0);}
    else{p0=__builtin_amdgcn_mfma_f32_32x32x16_bf16(b0,qr[d0],p0,0,0,0);p1=__builtin_amdgcn_mfma_f32_32x32x16_bf16(b1,qr[d0],p1,0,0,0);}}
}
typedef __attribute__((address_space(3))) const char* lds_cptr;
typedef short v4i16_t __attribute__((ext_vector_type(4)));
__device__ __forceinline__ void kload8(bf16x8*kf,lds_cptr kp){
  kf[0]=*(const __attribute__((address_space(3))) bf16x8*)(kp);      kf[1]=*(const __attribute__((address_space(3))) bf16x8*)(kp+512);
  kf[2]=*(const __attribute__((address_space(3))) bf16x8*)(kp+2048); kf[3]=*(const __attribute__((address_space(3))) bf16x8*)(kp+2560);
  kf[4]=*(const __attribute__((address_space(3))) bf16x8*)(kp+4096); kf[5]=*(const __attribute__((address_space(3))) bf16x8*)(kp+4608);
  kf[6]=*(const __attribute__((address_space(3))) bf16x8*)(kp+6144); kf[7]=*(const __attribute__((address_space(3))) bf16x8*)(kp+6656);
}
__device__ __forceinline__ void kload2(bf16x8*kf,lds_cptr kp,int j){ kf[2*j]=*(const __attribute__((address_space(3))) bf16x8*)(kp+j*2048); kf[2*j+1]=*(const __attribute__((address_space(3))) bf16x8*)(kp+j*2048+512); }
__device__ __forceinline__ s16x4 vtr(lds_cptr p){ return __builtin_bit_cast(s16x4,__builtin_amdgcn_ds_read_tr16_b64_v4i16((__attribute__((address_space(3))) v4i16_t*)p)); }
__device__ __forceinline__ float rowmax(const f32x16&p0,const f32x16&p1){
  float a=max3f(p0[0],p0[1],p1[0]),b=max3f(p0[2],p0[3],p1[1]);a=max3f(a,p1[2],p1[3]);
  #pragma unroll
  for(int r=4;r<16;r+=4){a=max3f(a,p0[r],p0[r+1]);b=max3f(b,p0[r+2],p0[r+3]);a=max3f(a,p1[r],p1[r+1]);b=max3f(b,p1[r+2],p1[r+3]);}
  const float m=max2f(a,b);
  auto rr=__builtin_amdgcn_permlane32_swap(__float_as_uint(m),__float_as_uint(m),false,false);
  return max2f(__uint_as_float(rr[0]),__uint_as_float(rr[1]));
}
__device__ __forceinline__ void pv(f32x16*o,int vb,bf16x8 pa0,bf16x8 pa1,bf16x8 pa2,bf16x8 pa3){
  #pragma unroll
  for(int d0=0;d0<4;++d0){s16x4 lo[4],hi[4];
    #pragma unroll
    for(int ks=0;ks<4;++ks){
      asm volatile("ds_read_b64_tr_b16 %0,%1 offset:%c2":"=&v"(lo[ks]):"v"(vb),"i"(d0*4096+ks*1024):"memory");
      asm volatile("ds_read_b64_tr_b16 %0,%1 offset:%c2":"=&v"(hi[ks]):"v"(vb),"i"(d0*4096+ks*1024+512):"memory");}
    asm volatile("s_waitcnt lgkmcnt(0)":::"memory");SBAR();
    #define PK(k) (bf16x8){lo[k][0],lo[k][1],lo[k][2],lo[k][3],hi[k][0],hi[k][1],hi[k][2],hi[k][3]}
    o[d0]=__builtin_amdgcn_mfma_f32_32x32x16_bf16(pa0,PK(0),o[d0],0,0,0);
    o[d0]=__builtin_amdgcn_mfma_f32_32x32x16_bf16(pa1,PK(1),o[d0],0,0,0);
    o[d0]=__builtin_amdgcn_mfma_f32_32x32x16_bf16(pa2,PK(2),o[d0],0,0,0);
    o[d0]=__builtin_amdgcn_mfma_f32_32x32x16_bf16(pa3,PK(3),o[d0],0,0,0);
    #undef PK
  }
}

#ifndef ATTN_STORE16
#define ATTN_STORE16(p,v) (*(u32x4*)(p)=(v))
#endif
template<int THRL> __device__ __forceinline__ void attn_unit(const int wid_in,int qb,const bf16*Q,const bf16*__restrict__ K,const bf16*__restrict__ V,bf16*O,char*shm){
  int tid_=wid_in*64+mk_lane_id(); asm volatile("":"+v"(tid_)); const int tid=tid_,lane=tid&63,r32=lane&31,hi=lane>>5; const int wid=__builtin_amdgcn_readfirstlane(tid>>6);
  const int q0=qb*QB;
  const bf16*Qw=Q+(long)(q0+wid*QBLK)*PQ;
  const bf16*Kh=K,*Vh=V;
  const unsigned lds0=(unsigned)(uintptr_t)shm;
  float*wsf=(float*)(shm+LDS_WS)+wid*64;
  const bf16*ksrc=Kh+(long)lane*PQ+wid*8;
  const bf16*vsrc=Vh+(long)(16*(wid&3)+(lane>>2))*PQ+(wid>>2)*32+(lane&3)*8;
  const unsigned kdst=lds0+LDS_K+wid*1024, vdst=lds0+LDS_V+wid*1024;
  #define DMA_K(t,slot) glds16(ksrc+(long)(t)*KVBLK*PQ,(unsigned)__builtin_amdgcn_readfirstlane(kdst+(slot)))
  #define DMA_V(t,slot) do{ glds16(vsrc+(long)(t)*KVBLK*PQ,(unsigned)__builtin_amdgcn_readfirstlane(vdst+2*(slot))); glds16(vsrc+64+(long)(t)*KVBLK*PQ,(unsigned)__builtin_amdgcn_readfirstlane(vdst+8192+2*(slot))); }while(0)
  const int vb0=(int)(lds0+LDS_V)+((lane>>4)&1)*32+(lane&3)*8+(4*hi+((lane&15)>>2))*64;
  const char*Kbase=shm+LDS_K; bf16x8 kf[8];
  const lds_cptr shm3=(lds_cptr)shm; const lds_cptr kp0=shm3+LDS_K+hi*1024+r32*16; const lds_cptr vp0=shm3+LDS_V+((lane>>4)&1)*32+(lane&3)*8+(4*hi+((lane&15)>>2))*64;
  const int NT=(q0+QB)/KVBLK;
  DMA_K(0,0);DMA_V(0,0);DMA_K(1,SLOTB);
  bf16x8 qr[4];
  #pragma unroll
  for(int d0=0;d0<4;++d0)qr[d0]=*reinterpret_cast<const bf16x8*>(&Qw[(long)r32*PQ+d0*16+hi*8]);
  float mhat=0.f,l_reg=0.f;f32x16 o[4];o[0]=f32x16{};o[1]=f32x16{};o[2]=f32x16{};o[3]=f32x16{};asm volatile("":"+v"(o[0]));asm volatile("":"+v"(o[1]));asm volatile("":"+v"(o[2]));asm volatile("":"+v"(o[3]));
  const int qrel=wid*QBLK+r32;
  #define CMASK(P0,P1,t) do{int jb_=(t)-(NT-4); if(jb_>=0)cmask(P0,P1,jb_,qrel,hi);}while(0)
  bool resc=false;
  #define START(P0,P1) do{ const float rm=rowmax(P0,P1); resc=false; mhat=rm; \
    _Pragma("unroll") for(int r=0;r<16;++r){P0[r]=__builtin_amdgcn_exp2f(fsub_s(P0[r],mhat));} }while(0)
  #define RESC() do{ if(resc){ asm volatile("s_waitcnt lgkmcnt(0)":::"memory"); \
      _Pragma("unroll") for(int d_=0;d_<4;++d_) _Pragma("unroll") for(int r=0;r<16;++r)o[d_][r]*=wsf[crow(r,hi)]; } }while(0)
  f32x16 pA0,pA1,pB0,pB1;
  int sl_prev=0,sl_cur=0,sl_next=SLOTB;
  #define ROT() do{sl_prev=sl_cur;sl_cur=sl_next;sl_next=(sl_next==(NSLOT-1)*SLOTB)?0:sl_next+SLOTB;}while(0)
  DMA_K(2,2*SLOTB);
  WAIT_BAR(4);
  qkt(pA0,pA1,Kbase,qr,f32x16{},r32,hi);asm volatile("s_nop 15\n\ts_nop 7":"+v"(pA0),"+v"(pA1));CMASK(pA0,pA1,0);
  START(pA0,pA1);
  _Pragma("unroll") for(int r=0;r<16;++r)pA1[r]=__builtin_amdgcn_exp2f(fsub_s(pA1[r],mhat));
  WAIT_BAR(0);
  DMA_K(3,0);DMA_V(1,SLOTB);
  ROT();
  kload8(kf,kp0+sl_cur);
  WAIT_BAR(3);
  s16x4 vlo[16],vhi[16]; u32x4 pw0,pw1,pw2,pw3;
  #define PKW(P,B) cvtpk_s(P[B],P[B+1])
  #define PAF(k) __builtin_bit_cast(bf16x8,pw##k)
  #define VFR(i) (bf16x8){vlo[i][0],vlo[i][1],vlo[i][2],vlo[i][3],vhi[i][0],vhi[i][1],vhi[i][2],vhi[i][3]}
  #define PIN(x) asm volatile("":"+v"(x))
  #define MX3(a,b,c) __builtin_fmaxf(__builtin_fmaxf((a),(b)),(c))
  #define GAPA(MF,A0,A1,A2,A3,W0,W1,PW) do{ MF; sacc+=A0; sacc+=A1; sacc+=A2; sacc+=A3; PIN(sacc); W0; W1; PIN(PW); SBAR(); }while(0)
  #define EX(v) __builtin_amdgcn_exp2f(v)
  #define GAPB(MF,X,B) do{ MF; X[B]=EX(X[B]-mhat); X[B+1]=EX(X[B+1]-mhat); PIN(X); SBAR(); }while(0)
  #define VRD(i) do{ vlo[i]=vtr(vp_+(((i)>>2)*4096+((i)&3)*1024)); vhi[i]=vtr(vp_+(((i)>>2)*4096+((i)&3)*1024+512)); }while(0)
  #define KRD(G,j) do{ if(G){ kload2(kf,kp0+sl_next,j); SBAR(); } }while(0)
  #define STEP(C0,C1,P0,P1,t,GK,GV,GL) do{ SBAR(); \
    const lds_cptr vp_=vp0+2*sl_prev; \
    float sacc=(P0[0]+P0[1]); \
    GAPA(C0=__builtin_amdgcn_mfma_f32_32x32x16_bf16(kf[0],qr[0],f32x16{},0,0,0), P0[2],P0[3],P0[4],P0[5],     pw0[0]=PKW(P0,0), pw0[1]=PKW(P0,2), pw0); \
    GAPA(C1=__builtin_amdgcn_mfma_f32_32x32x16_bf16(kf[1],qr[0],f32x16{},0,0,0), P0[6],P0[7],P0[8],P0[9],     pw0[2]=PKW(P0,4), pw0[3]=PKW(P0,6), pw0); \
    GAPA(C0=__builtin_amdgcn_mfma_f32_32x32x16_bf16(kf[2],qr[1],C0,0,0,0),   P0[10],P0[11],P0[12],P0[13], pw1[0]=PKW(P0,8), pw1[1]=PKW(P0,10), pw1); \
    GAPA(C1=__builtin_amdgcn_mfma_f32_32x32x16_bf16(kf[3],qr[1],C1,0,0,0),   P0[14],P0[15],P1[0],P1[1],   pw1[2]=PKW(P0,12),pw1[3]=PKW(P0,14), pw1); \
    VRD(0); SBAR(); GAPA(C0=__builtin_amdgcn_mfma_f32_32x32x16_bf16(kf[4],qr[2],C0,0,0,0),   P1[2],P1[3],P1[4],P1[5],     pw2[0]=PKW(P1,0), pw2[1]=PKW(P1,2), pw2); \
    VRD(4); SBAR(); GAPA(C1=__builtin_amdgcn_mfma_f32_32x32x16_bf16(kf[5],qr[2],C1,0,0,0),   P1[6],P1[7],P1[8],P1[9],     pw2[2]=PKW(P1,4), pw2[3]=PKW(P1,6), pw2); \
    VRD(8); SBAR(); GAPA(C0=__builtin_amdgcn_mfma_f32_32x32x16_bf16(kf[6],qr[3],C0,0,0,0),   P1[10],P1[11],P1[12],P1[13], pw3[0]=PKW(P1,8), pw3[1]=PKW(P1,10), pw3); \
    VRD(12); SBAR(); GAPA(C1=__builtin_amdgcn_mfma_f32_32x32x16_bf16(kf[7],qr[3],C1,0,0,0),   P1[14],P1[15],0.f,0.f,       pw3[2]=PKW(P1,12),pw3[3]=PKW(P1,14), pw3); \
    l_reg+=sacc; \
    if(GK){DMA_K((t)+3,sl_cur);} if(GV){DMA_V((t)+1,sl_next);} \
    CMASK(C0,C1,t); \
    { float a=MX3(C0[0],C0[1],C1[0]),b=MX3(C0[2],C0[3],C1[1]); a=MX3(a,C1[2],C1[3]); \
      _Pragma("unroll") for(int r=4;r<16;r+=4){a=MX3(a,C0[r],C0[r+1]);b=MX3(b,C0[r+2],C0[r+3]);a=MX3(a,C1[r],C1[r+1]);b=MX3(b,C1[r+2],C1[r+3]);} \
      float rm=__builtin_fmaxf(a,b); { auto rr=__builtin_amdgcn_permlane32_swap(__float_as_uint(rm),__float_as_uint(rm),false,false); rm=__builtin_fmaxf(__uint_as_float(rr[0]),__uint_as_float(rr[1])); } \
      rm-=mhat; resc=false; \
      if(__builtin_expect(__any(rm>(float)THRL),0)){ const float dl=__builtin_fmaxf(rm,0.f); mhat+=dl; \
        const float f=__builtin_amdgcn_exp2f(-dl); l_reg*=f; if(hi==0)wsf[r32]=f; resc=true; } } \
    SBAR(); \
    GAPB(o[0]=__builtin_amdgcn_mfma_f32_32x32x16_bf16(PAF(0),VFR(0),o[0],0,0,0), C0,0); VRD(1); SBAR(); \
    GAPB(o[1]=__builtin_amdgcn_mfma_f32_32x32x16_bf16(PAF(0),VFR(4),o[1],0,0,0), C0,2); VRD(5); SBAR(); \
    KRD(GL,0); GAPB(o[2]=__builtin_amdgcn_mfma_f32_32x32x16_bf16(PAF(0),VFR(8),o[2],0,0,0), C0,4); VRD(9); SBAR(); \
    KRD(GL,1); GAPB(o[3]=__builtin_amdgcn_mfma_f32_32x32x16_bf16(PAF(0),VFR(12),o[3],0,0,0), C0,6); VRD(13); SBAR(); \
    KRD(GL,2); GAPB(o[0]=__builtin_amdgcn_mfma_f32_32x32x16_bf16(PAF(1),VFR(1),o[0],0,0,0), C0,8); VRD(2); SBAR(); \
    KRD(GL,3); GAPB(o[1]=__builtin_amdgcn_mfma_f32_32x32x16_bf16(PAF(1),VFR(5),o[1],0,0,0), C0,10); VRD(6); SBAR(); \
    GAPB(o[2]=__builtin_amdgcn_mfma_f32_32x32x16_bf16(PAF(1),VFR(9),o[2],0,0,0), C0,12); VRD(10); SBAR(); \
    GAPB(o[3]=__builtin_amdgcn_mfma_f32_32x32x16_bf16(PAF(1),VFR(13),o[3],0,0,0), C0,14); VRD(14); SBAR(); \
    GAPB(o[0]=__builtin_amdgcn_mfma_f32_32x32x16_bf16(PAF(2),VFR(2),o[0],0,0,0), C1,0); VRD(3); SBAR(); \
    GAPB(o[1]=__builtin_amdgcn_mfma_f32_32x32x16_bf16(PAF(2),VFR(6),o[1],0,0,0), C1,2); VRD(7); SBAR(); \
    GAPB(o[2]=__builtin_amdgcn_mfma_f32_32x32x16_bf16(PAF(2),VFR(10),o[2],0,0,0), C1,4); VRD(11); SBAR(); \
    GAPB(o[3]=__builtin_amdgcn_mfma_f32_32x32x16_bf16(PAF(2),VFR(14),o[3],0,0,0), C1,6); VRD(15); SBAR(); \
    GAPB(o[0]=__builtin_amdgcn_mfma_f32_32x32x16_bf16(PAF(3),VFR(3),o[0],0,0,0), C1,8); \
    GAPB(o[1]=__builtin_amdgcn_mfma_f32_32x32x16_bf16(PAF(3),VFR(7),o[1],0,0,0), C1,10); \
    GAPB(o[2]=__builtin_amdgcn_mfma_f32_32x32x16_bf16(PAF(3),VFR(11),o[2],0,0,0), C1,12); \
    GAPB(o[3]=__builtin_amdgcn_mfma_f32_32x32x16_bf16(PAF(3),VFR(15),o[3],0,0,0), C1,14); \
    }while(0)
  int t=1;
  #undef CMASK
  #define CMASK(P0,P1,t) do{}while(0)
  for(;t+5<NT;t+=2){
    STEP(pB0,pB1,pA0,pA1,t,true,true,true);     WAIT_BAR(3); RESC(); ROT();
    STEP(pA0,pA1,pB0,pB1,t+1,true,true,true);   WAIT_BAR(3); RESC(); ROT();
  }
  #undef CMASK
  #define CMASK(P0,P1,t) do{int jb_=(t)-(NT-4); if(jb_>=0)cmask(P0,P1,jb_,qrel,hi);}while(0)
  #define ENDW(tt) do{ if((tt)+3<NT){WAIT_BAR(3);} else if((tt)+2<NT){WAIT_BAR(2);} else {WAIT_BAR(0);} }while(0)
  for(;t+1<NT;t+=2){
    STEP(pB0,pB1,pA0,pA1,t,(t+3<NT),(t+1<NT),(t+1<NT));       ENDW(t);   RESC(); ROT();
    STEP(pA0,pA1,pB0,pB1,t+1,(t+4<NT),(t+2<NT),(t+2<NT));     ENDW(t+1); RESC(); ROT();
  }
  STEP(pB0,pB1,pA0,pA1,NT-1,false,false,false); RESC();
  { float sacc=pB0[0]+pB0[1]; _Pragma("unroll") for(int r=2;r<16;++r)sacc+=pB0[r]; _Pragma("unroll") for(int r=0;r<16;++r)sacc+=pB1[r]; l_reg+=sacc;
    pw0=(u32x4){PKW(pB0,0),PKW(pB0,2),PKW(pB0,4),PKW(pB0,6)};pw1=(u32x4){PKW(pB0,8),PKW(pB0,10),PKW(pB0,12),PKW(pB0,14)};pw2=(u32x4){PKW(pB1,0),PKW(pB1,2),PKW(pB1,4),PKW(pB1,6)};pw3=(u32x4){PKW(pB1,8),PKW(pB1,10),PKW(pB1,12),PKW(pB1,14)};
    SBAR(); pv(o,vb0+2*sl_cur,PAF(0),PAF(1),PAF(2),PAF(3)); }
  asm volatile("s_waitcnt lgkmcnt(0)\n\ts_barrier":::"memory");
  #undef PKW
  #undef PAF
  #undef VFR
  #undef PIN
  #undef MX3
  #undef GAPA
  #undef GAPB
  #undef EX
  #undef VRD
  #undef KRD
  #undef STEP
  #undef ENDW
  {auto rr=__builtin_amdgcn_permlane32_swap(__float_as_uint(l_reg),__float_as_uint(l_reg),false,false);l_reg=__uint_as_float(rr[0])+__uint_as_float(rr[1]);}
  if(hi==0)wsf[32+r32]=l_reg;asm volatile("s_waitcnt lgkmcnt(0)":::"memory");
  float rli[16];
  #pragma unroll
  for(int r=0;r<16;++r)rli[r]=__builtin_amdgcn_rcpf(wsf[32+crow(r,hi)]);
  bf16*Ow=O+(long)(q0+wid*QBLK)*PO;
  { bf16*stg=(bf16*)(shm+LDS_OST)+wid*4096;
    #pragma unroll
    for(int r=0;r<16;++r){const int orow=crow(r,hi);
      #pragma unroll
      for(int d0=0;d0<4;++d0)stg[orow*128+d0*32+r32]=__float2bfloat16(o[d0][r]*rli[r]);}
    asm volatile("s_waitcnt lgkmcnt(0)":::"memory");
    #pragma unroll
    for(int i=0;i<8;++i){const int row=i*4+(lane>>4),ch=lane&15; const u32x4 v=*(const u32x4*)(stg+row*128+ch*8); ATTN_STORE16(Ow+(long)row*PO+ch*8,v);} }
  asm volatile("s_waitcnt lgkmcnt(0)\n\ts_barrier":::"memory");
  #undef DMA_K
  #undef DMA_V
  #undef CMASK
  #undef START
  #undef RESC
  #undef ROT
}
constexpr int ATTN_LDS_BYTES=LDS_BYTES;
template<int THRL=8> __device__ __forceinline__ void attn_phase(char*lds,const bf16*PD,bf16*O,int vcu,const int wid,unsigned*qhead,volatile __attribute__((address_space(3))) unsigned*bc){
  const int xg=vcu>>5;
  for(;;){
    if(threadIdx.x==0) *bc=__hip_atomic_fetch_add(qhead,1u,__ATOMIC_RELAXED,__HIP_MEMORY_SCOPE_AGENT);
    __syncthreads();
    const int u=(int)__builtin_amdgcn_readfirstlane((int)*bc);
    if(u>=128)break;
    const int pr=2*xg+(u&1),qb=63-(u>>1),h=pr>>1,m=pr&1;
    const bf16*Q=PD+h*128+m*64,*K=PD+1024+h*128+m*64,*V=PD+2048+h*128; bf16*Op=O+m*1024+h*128;
    attn_unit<THRL>(wid,qb,Q,K,V,Op,lds);
  }
}
#undef SBAR
#undef WAIT_BAR
}
#define GAS __attribute__((address_space(1)))
#define LAS __attribute__((address_space(3)))
typedef unsigned short bf16;
typedef unsigned v4u __attribute__((ext_vector_type(4)));
typedef float f32x4 __attribute__((ext_vector_type(4)));
typedef short bf16x8 __attribute__((ext_vector_type(8)));
typedef GAS unsigned gu32;
typedef GAS unsigned long long gu64;
#define RLX_AGENT __ATOMIC_RELAXED, __HIP_MEMORY_SCOPE_AGENT
#define LDS_WAIT() asm volatile("s_waitcnt lgkmcnt(0)" ::: "memory")
#define VM_WAIT() asm volatile("s_waitcnt vmcnt(0)" ::: "memory")
__device__ __forceinline__ unsigned long long rt() { return __builtin_amdgcn_s_memrealtime(); }
__device__ __forceinline__ unsigned f2bf(float f) { unsigned u = __builtin_bit_cast(unsigned, f); return (u + 0x7fffu + ((u >> 16) & 1u)) >> 16; }
__device__ __forceinline__ unsigned pk2(float lo, float hi) { return f2bf(lo) | (f2bf(hi) << 16); }

#define XB_TMO      128
#define XB_XCNT(j)  (256  + 64 * (j))
#define XB_XSUB(j)  (1280 + 64 * (j))
#define XB_XGEN(j)  (2304 + 64 * (j))
#define XB_TOP      3328
#define XB_TOPGEN   3392
#define XCD_BAR_WORDS 3456
#define XB_SPIN_CAP (1u << 18)

__device__ __forceinline__ unsigned xb_ld(unsigned* p)              { return __hip_atomic_load(p, __ATOMIC_RELAXED, __HIP_MEMORY_SCOPE_AGENT); }
__device__ __forceinline__ unsigned xb_add(unsigned* p, unsigned v) { return __hip_atomic_fetch_add(p, v, __ATOMIC_RELAXED, __HIP_MEMORY_SCOPE_AGENT); }
__device__ __forceinline__ unsigned xb_xcc_id() { return (unsigned)__builtin_amdgcn_s_getreg((3 << 11) | 20) & 0xFu; }
#define XB_SPIN(cond, bar) do { unsigned _sp = 0; while (cond) { __builtin_amdgcn_s_sleep(1); \
    if ((++_sp & 255u) == 0u) { if (xb_ld(&(bar)[XB_TMO])) break; if (_sp > XB_SPIN_CAP) { atomicAdd(&(bar)[XB_TMO], 1u); break; } } } } while (0)

struct XcdBarrier {
    unsigned* bar; unsigned x;
    volatile LAS unsigned* st;
};

__device__ __forceinline__ XcdBarrier xcd_barrier_post(unsigned* bar, volatile LAS unsigned* st) {
    XcdBarrier b; b.bar = bar; b.x = xb_xcc_id(); b.st = st;
    if (threadIdx.x == 0) (void)xb_add(&bar[XB_XCNT(b.x)], 1u);
    return b;
}
__device__ __forceinline__ void xcd_barrier_complete(unsigned* bar, unsigned x, unsigned& nloc, unsigned& nx) {
    const unsigned G = gridDim.x * gridDim.y * gridDim.z;
    unsigned sum, cnt, mine, sp = 0u;
    for (;;) {
        sum = 0u; cnt = 0u; mine = 0u;
#pragma unroll
        for (unsigned j = 0; j < 16; ++j) { const unsigned c = xb_ld(&bar[XB_XCNT(j)]); sum += c; cnt += (c > 0u) ? 1u : 0u; mine = (j == x) ? c : mine; }
        if (sum == G) break;
        __builtin_amdgcn_s_sleep(1);
        if ((++sp & 255u) == 0u) { if (xb_ld(&bar[XB_TMO])) break; if (sp > XB_SPIN_CAP) { atomicAdd(&bar[XB_TMO], 1u); break; } }
    }
    nloc = mine > 0u ? mine : 1u; nx = cnt > 0u ? cnt : 1u;
}

__device__ __forceinline__ void xcd_barrier(const XcdBarrier& b) {
    asm volatile("s_waitcnt vmcnt(0)" ::: "memory");
    __syncthreads();
    if (threadIdx.x == 0) {
        unsigned* bar = b.bar;
        __builtin_amdgcn_s_waitcnt(0);
        unsigned nloc = b.st[0], nx = b.st[1];
        if (nloc == 0u) { xcd_barrier_complete(bar, b.x, nloc, nx); b.st[0] = nloc; b.st[1] = nx; }
        const unsigned old = xb_add(&bar[XB_XSUB(b.x)], 1u);
        const unsigned gen = old / nloc;
        if (old + 1u == (gen + 1u) * nloc) {
            __builtin_amdgcn_fence(__ATOMIC_RELEASE, "agent");
            asm volatile("s_waitcnt vmcnt(0)" ::: "memory");
            const unsigned og = xb_add(&bar[XB_TOP], 1u);
            const unsigned tg = og / nx;
            if (og + 1u == (tg + 1u) * nx) xb_add(&bar[XB_TOPGEN], 1u);
            else XB_SPIN(xb_ld(&bar[XB_TOPGEN]) == tg, bar);
            __builtin_amdgcn_fence(__ATOMIC_ACQUIRE, "agent");
            xb_add(&bar[XB_XGEN(b.x)], 1u);
            asm volatile("s_waitcnt vmcnt(0)" ::: "memory");
        } else {
            XB_SPIN(xb_ld(&bar[XB_XGEN(b.x)]) == gen, bar);
            __builtin_amdgcn_fence(__ATOMIC_ACQUIRE, "agent");
            asm volatile("s_waitcnt vmcnt(0)" ::: "memory");
        }
    }
    __syncthreads();
}
constexpr int NWAVES = 8;
constexpr int S_ = 16384, DM = 2048;
constexpr int NPH = 16;
#ifndef MK_PER_PHASE
#define MK_PER_PHASE 0
#endif
constexpr size_t MiB = 1u << 20;
constexpr size_t WS_CTL = 0, CTL_ZERO_BYTES = 1 * MiB;
constexpr size_t WS_WA = 1 * MiB, WS_WB = 5 * MiB, WS_WOUT = 9 * MiB, WS_WS = 17 * MiB, WS_LORA = 25 * MiB;
constexpr size_t WS_WIN = 27 * MiB, WS_PR = 69 * MiB, WS_PD = 181 * MiB, WS_PG = 277 * MiB;
constexpr size_t WS_A = 405 * MiB, WS_E = 437 * MiB, WS_G = 469 * MiB, WS_END = 507 * MiB;
constexpr size_t WS_SCN = 27 * MiB, WS_SCAL = 123 * MiB, WS_SLOC = 127 * MiB, WS_ASEG = 143 * MiB, WS_SIN = 159 * MiB;
constexpr size_t WS_YA = 91 * MiB, WS_OATT = 27 * MiB, WS_YB = 437 * MiB, WS_Z = 405 * MiB  , WS_T1 = 123 * MiB, WS_MERGED = 27 * MiB;
constexpr size_t WS_H2 = 123 * MiB, WS_XN2 = 27 * MiB, WS_UTAB = 251 * MiB, WS_VTAB = 315 * MiB, WS_SCORES = 379 * MiB;
constexpr size_t WS_USCL = WS_UTAB + 16 * MiB, WS_VSCL = WS_VTAB + 16 * MiB;
constexpr size_t OUT_XN = 0, OUT_RKV = 0, OUT_LIN = 96 * MiB, OUT_YLOC = 96 * MiB  ;
constexpr int CW_BAR = 4096;
constexpr int RING_OFF = 0, RING_BYTES = 131072;
constexpr int LDSCTL_OFF = RING_BYTES, MISC_OFF = LDSCTL_OFF + 320;
constexpr int LDS_BYTES = 147456;
constexpr int NSEG = 64, SEGLEN = S_ / NSEG;
static_assert(WS_END <= 512 * MiB && LDS_BYTES <= 160 * 1024 && MISC_OFF + 128 <= LDS_BYTES, "workspace / LDS map");

struct Args { const float* in[28]; float* out; unsigned char* ws; int ph_lo, ph_hi; };

struct Frame {
    LAS unsigned char* lds; volatile LAS unsigned* MISC; gu32* ctl;
    int tid, lane, wave, vcu, G;
};

__device__ __forceinline__ float bf2f(unsigned short b) { return __uint_as_float((unsigned)b << 16); }
__device__ __forceinline__ float wave_sum(float v) {
#pragma unroll
    for (int o = 1; o < 64; o <<= 1) v += __shfl_xor(v, o);
    return v;
}
__device__ __forceinline__ float wave_max(float v) {
#pragma unroll
    for (int o = 1; o < 64; o <<= 1) v = fmaxf(v, __shfl_xor(v, o));
    return v;
}
template <int CTRL, int RM> __device__ __forceinline__ float dppf(float oldv, float x) { return __builtin_bit_cast(float, __builtin_amdgcn_update_dpp(__builtin_bit_cast(int, oldv), __builtin_bit_cast(int, x), CTRL, RM, 0xf, false)); }
__device__ __forceinline__ float wsum(float v) {
    v += dppf<0xB1, 0xf>(v, v); v += dppf<0x4E, 0xf>(v, v); v += dppf<0x141, 0xf>(v, v); v += dppf<0x140, 0xf>(v, v);
    v += dppf<0x142, 0xa>(0.f, v); v += dppf<0x143, 0xc>(0.f, v);
    return __builtin_bit_cast(float, __builtin_amdgcn_readlane(__builtin_bit_cast(int, v), 63));
}
__device__ __forceinline__ float wmax(float v) {
    v = fmaxf(v, dppf<0xB1, 0xf>(v, v)); v = fmaxf(v, dppf<0x4E, 0xf>(v, v)); v = fmaxf(v, dppf<0x141, 0xf>(v, v)); v = fmaxf(v, dppf<0x140, 0xf>(v, v));
    v = fmaxf(v, dppf<0x142, 0xa>(0.f, v)); v = fmaxf(v, dppf<0x143, 0xc>(0.f, v));
    return __builtin_bit_cast(float, __builtin_amdgcn_readlane(__builtin_bit_cast(int, v), 63));
}
__device__ __forceinline__ float sigmf(float x) { return __builtin_amdgcn_rcpf(1.0f + __expf(-x)); }

__device__ __forceinline__ void transpose_block(const float* W, int ldw, int k0, int n0, int kvalid, bf16* WT, int ldt, int drow0, LAS float* scr, int lane) {
    float tv[32];
#pragma unroll
    for (int i = 0; i < 32; ++i) { const int k = k0 + 2 * i + (lane >> 5); tv[i] = (k < kvalid) ? W[(size_t)k * ldw + n0 + (lane & 31)] : 0.f; }
#pragma unroll
    for (int i = 0; i < 32; ++i) scr[(2 * i + (lane >> 5)) * 33 + (lane & 31)] = tv[i];
    LDS_WAIT(); asm volatile("" ::: "memory");
    const int c = lane & 7;
#pragma unroll
    for (int j = 0; j < 4; ++j) { const int n = (lane >> 3) + 8 * j; const LAS float* s = scr + (8 * c) * 33 + n;
        v4u o; o.x = pk2(s[0 * 33], s[1 * 33]); o.y = pk2(s[2 * 33], s[3 * 33]); o.z = pk2(s[4 * 33], s[5 * 33]); o.w = pk2(s[6 * 33], s[7 * 33]);
        *(GAS v4u*)(WT + (size_t)(drow0 + n) * ldt + k0 + 8 * c) = o; }
    LDS_WAIT(); asm volatile("" ::: "memory");
}
__device__ __forceinline__ void rms_row_to_bf16(const float* xrow, const float* g, bf16* orow, int lane) {
    const GAS f32x4* xr = (const GAS f32x4*)xrow + lane; const f32x4* gr = (const f32x4*)g + lane;
    f32x4 v[8]; float s = 0.f;
#pragma unroll
    for (int j = 0; j < 8; ++j) { v[j] = xr[64 * j]; s += (v[j].x * v[j].x + v[j].y * v[j].y) + (v[j].z * v[j].z + v[j].w * v[j].w); }
    const float rstd = rsqrtf(wave_sum(s) * (1.f / 2048.f) + 1e-6f);
    GAS unsigned long long* o8 = (GAS unsigned long long*)orow + lane;
#pragma unroll
    for (int j = 0; j < 8; ++j) { const f32x4 gg = gr[64 * j];
        o8[64 * j] = (unsigned long long)pk2(v[j].x * rstd * gg.x, v[j].y * rstd * gg.y) | ((unsigned long long)pk2(v[j].z * rstd * gg.z, v[j].w * rstd * gg.w) << 32); }
}

__device__ __forceinline__ void rms_row2_to_bf16(const float* xa, const float* xb, const float* g, bf16* oa, bf16* ob_, int lane) {
    const GAS f32x4* xr = (const GAS f32x4*)xa + lane; const GAS f32x4* yr = (const GAS f32x4*)xb + lane; const f32x4* gr = (const f32x4*)g + lane;
    f32x4 v[8], w[8]; float s = 0.f, t = 0.f;
#pragma unroll
    for (int j = 0; j < 8; ++j) { v[j] = __builtin_nontemporal_load(xr + 64 * j); w[j] = __builtin_nontemporal_load(yr + 64 * j); }
#pragma unroll
    for (int j = 0; j < 8; ++j) { s += (v[j].x * v[j].x + v[j].y * v[j].y) + (v[j].z * v[j].z + v[j].w * v[j].w); t += (w[j].x * w[j].x + w[j].y * w[j].y) + (w[j].z * w[j].z + w[j].w * w[j].w); }
    const float rs = rsqrtf(wsum(s) * (1.f / 2048.f) + 1e-6f), rt = rsqrtf(wsum(t) * (1.f / 2048.f) + 1e-6f);
    GAS unsigned long long* o8 = (GAS unsigned long long*)oa + lane; GAS unsigned long long* p8 = (GAS unsigned long long*)ob_ + lane;
#pragma unroll
    for (int j = 0; j < 8; ++j) { const f32x4 gg = gr[64 * j];
        o8[64 * j] = (unsigned long long)pk2(v[j].x * rs * gg.x, v[j].y * rs * gg.y) | ((unsigned long long)pk2(v[j].z * rs * gg.z, v[j].w * rs * gg.w) << 32);
        p8[64 * j] = (unsigned long long)pk2(w[j].x * rt * gg.x, w[j].y * rt * gg.y) | ((unsigned long long)pk2(w[j].z * rt * gg.z, w[j].w * rt * gg.w) << 32); }
}

template <int K, int VAR = 0> __device__ __forceinline__ void fmac_dpp(float& acc, float op, float s) {
    if (VAR == 0) asm("v_fmac_f32_dpp %0, %1, %2 quad_perm:[%c3,%c3,%c3,%c3] row_mask:0xf bank_mask:0xf" : "+v"(acc) : "v"(op), "v"(s), "i"(K));
    else asm("v_fmac_f32_e32 %0, %1, %2" : "+v"(acc) : "v"(op), "v"(s)); }
template <int K, int VAR = 0> __device__ __forceinline__ void mulip_dpp(float& s, float op) {
    if (VAR == 0) asm("v_mul_f32_dpp %0, %1, %0 quad_perm:[%c2,%c2,%c2,%c2] row_mask:0xf bank_mask:0xf" : "+v"(s) : "v"(op), "i"(K));
    else asm("v_mul_f32_e32 %0, %1, %0" : "+v"(s) : "v"(op)); }
#define SCAN_FOR_C(...) _Pragma("unroll") for (int j = 0; j < 4; ++j) { \
    { constexpr int k = 0; _Pragma("unroll") for (int i = 0; i < 4; ++i) { const int c = 16 * j + 4 * k + i; __VA_ARGS__ } } \
    { constexpr int k = 1; _Pragma("unroll") for (int i = 0; i < 4; ++i) { const int c = 16 * j + 4 * k + i; __VA_ARGS__ } } \
    { constexpr int k = 2; _Pragma("unroll") for (int i = 0; i < 4; ++i) { const int c = 16 * j + 4 * k + i; __VA_ARGS__ } } \
    { constexpr int k = 3; _Pragma("unroll") for (int i = 0; i < 4; ++i) { const int c = 16 * j + 4 * k + i; __VA_ARGS__ } } }

constexpr int SCAN_CH = 4;
constexpr int SC_RING = 0, SC_VG = 2 * SCAN_CH * 320, SC_Y = SC_VG + 2 * SCAN_CH * 64, SC_SLOT_F = SC_Y + 2 * SCAN_CH * 128;
static_assert(4 * SC_SLOT_F * 4 <= RING_BYTES && 8 * 3 * 32 * 144 <= RING_BYTES && 8 * 10240 <= RING_BYTES && 8 * 16384 <= RING_BYTES, "per-wave LDS regions of the scan / scan-output / PEER / prologue phases fit the ring");
__device__ __forceinline__ void scan4_phase(const int lane, const int wave, const int vcu, const int G, unsigned char* ws, unsigned char* ob, const bf16* RKV, LAS float* ldsf) {
    constexpr int CH = SCAN_CH, NCHUNK = SEGLEN / CH;
#define SCAN_BAR() do { asm volatile("s_waitcnt lgkmcnt(0)" ::: "memory"); __builtin_amdgcn_s_barrier(); asm volatile("" ::: "memory"); } while (0)
    const int slot = wave & 3; LAS float* sl = ldsf + slot * SC_SLOT_F;
    for (int round = 0; round * G * 4 < 16 * NSEG; ++round) {
        const int task = round * G * 4 + vcu * 4 + slot; const bool valid = task < 16 * NSEG; const int h = valid ? task / NSEG : 0, seg = valid ? task % NSEG : 0; const int t0 = seg * SEGLEN;
        if (wave >= 4) {
            const bf16* SCN = (const bf16*)(ws + WS_SCN) + ((size_t)h * S_) * 192; const bf16* Eb = (const bf16*)(ws + WS_E);
            bf16* YL = (bf16*)(ob + OUT_YLOC) + ((size_t)h * S_) * 64 + lane; bf16* ZZ = (bf16*)(ws + WS_Z) + ((size_t)h * S_) * 64 + lane;
            unsigned short pk[CH], pb[CH], pt[CH], pr[CH], pe[CH], pv[CH];
#define SCAN_ISSUE(n) do { const int tc_ = t0 + (n) * CH; \
            _Pragma("unroll") for (int s = 0; s < CH; ++s) { const size_t t = (size_t)(tc_ + s); \
                pk[s] = SCN[t * 192 + lane]; pb[s] = SCN[t * 192 + 64 + lane]; pt[s] = SCN[t * 192 + 128 + lane]; \
                pr[s] = RKV[t * 3072 + h * 64 + lane]; pe[s] = Eb[t * 1024 + h * 64 + lane]; pv[s] = RKV[t * 3072 + 2048 + h * 64 + lane]; } } while (0)
#define SCAN_WRITE(n) do { const int b_ = (n) & 1; \
            _Pragma("unroll") for (int s = 0; s < CH; ++s) { LAS float* q = sl + SC_RING + (b_ * CH + s) * 320; \
                q[lane] = bf2f(pk[s]); q[64 + lane] = bf2f(pr[s]); q[128 + lane] = __expf(-bf2f(pe[s])); q[192 + lane] = bf2f(pb[s]); q[256 + lane] = bf2f(pt[s]); \
                sl[SC_VG + (b_ * CH + s) * 64 + lane] = bf2f(pv[s]); } } while (0)
#define SCAN_YSTORE(n) do { const int tc_ = t0 + (n) * CH; const int b_ = (n) & 1; \
            _Pragma("unroll") for (int s = 0; s < CH; ++s) { YL[(size_t)(tc_ + s) * 64] = (unsigned short)f2bf(sl[SC_Y + (b_ * CH + s) * 128 + lane]); ZZ[(size_t)(tc_ + s) * 64] = (unsigned short)f2bf(sl[SC_Y + (b_ * CH + s) * 128 + 64 + lane]); } } while (0)
            if (valid) { SCAN_ISSUE(0); SCAN_WRITE(0); SCAN_ISSUE(1); }
            SCAN_BAR();
#pragma unroll 1
            for (int n = 0; n < NCHUNK; ++n) {
                if (valid) { if (n + 1 < NCHUNK) SCAN_WRITE(n + 1); if (n >= 1) SCAN_YSTORE(n - 1); if (n + 2 < NCHUNK) SCAN_ISSUE(n + 2); }
                SCAN_BAR();
            }
            if (valid) SCAN_YSTORE(NCHUNK - 1);
#undef SCAN_ISSUE
#undef SCAN_WRITE
#undef SCAN_YSTORE
        } else {
            float S[64], M[64]; int ln_ = lane; asm volatile("" : "+v"(ln_));
#pragma unroll
            for (int c = 0; c < 64; ++c) { S[c] = 0.f; M[c] = (c == ln_) ? 1.f : 0.f; }
            SCAN_BAR();
#pragma unroll 1
            for (int n = 0; n < NCHUNK; ++n) {
                const int b = n & 1;
                if (valid) {
                f32x4 KK[4];
                { const LAS f32x4* q4 = (const LAS f32x4*)(sl + SC_RING + (b * CH) * 320) + (lane & 3);
#pragma unroll
                  for (int j = 0; j < 4; ++j) KK[j] = q4[j * 4]; }
#pragma unroll 1
                for (int s = 0; s < CH; ++s) {
                    const LAS f32x4* q4 = (const LAS f32x4*)(sl + SC_RING + (b * CH + s) * 320) + (lane & 3);
                    f32x4 WW[4], BB[4], KT[4];
#pragma unroll
                    for (int j = 0; j < 4; ++j) { WW[j] = q4[32 + j * 4]; BB[j] = q4[48 + j * 4]; KT[j] = q4[64 + j * 4]; }
                    const float vt = sl[SC_VG + (b * CH + s) * 64 + lane];
                    float saq[4], sbq[4];
#pragma unroll
                    for (int q = 0; q < 4; ++q) { saq[q] = 0.f; sbq[q] = 0.f; }
                    SCAN_FOR_C( fmac_dpp<k>(saq[i], KK[j][i], S[c]); fmac_dpp<k>(sbq[i], KK[j][i], M[c]); )
                    const float sa = (saq[0] + saq[1]) + (saq[2] + saq[3]), sb = (sbq[0] + sbq[1]) + (sbq[2] + sbq[3]);
#pragma unroll
                    for (int j = 0; j < 4; ++j) KK[j] = q4[16 + j * 4];
                    SCAN_FOR_C( mulip_dpp<k>(S[c], WW[j][i]); )
                    SCAN_FOR_C( fmac_dpp<k>(S[c], BB[j][i], sa); )
                    SCAN_FOR_C( fmac_dpp<k>(S[c], KT[j][i], vt); )
                    SCAN_FOR_C( mulip_dpp<k>(M[c], WW[j][i]); )
                    SCAN_FOR_C( fmac_dpp<k>(M[c], BB[j][i], sb); )
                    float ylq[4], zq[4];
#pragma unroll
                    for (int q = 0; q < 4; ++q) { ylq[q] = 0.f; zq[q] = 0.f; }
                    SCAN_FOR_C( fmac_dpp<k>(ylq[i], KK[j][i], S[c]); fmac_dpp<k>(zq[i], KK[j][i], M[c]); )
                    sl[SC_Y + (b * CH + s) * 128 + lane] = (ylq[0] + ylq[1]) + (ylq[2] + ylq[3]);
                    sl[SC_Y + (b * CH + s) * 128 + 64 + lane] = (zq[0] + zq[1]) + (zq[2] + zq[3]);
                    { const LAS f32x4* qn = (const LAS f32x4*)(sl + SC_RING + (b * CH + ((s + 1) & (CH - 1))) * 320) + (lane & 3);
#pragma unroll
                      for (int j = 0; j < 4; ++j) KK[j] = qn[j * 4]; }
                }
                }
                SCAN_BAR();
            }
            if (valid) {
                f32x4* op = (f32x4*)((float*)(ws + WS_SLOC) + (((size_t)h * NSEG + seg) * 64 + lane) * 64);
                bf16* oq = (bf16*)(ws + WS_ASEG) + ((size_t)h * NSEG + seg) * 4096 + lane;
#pragma unroll
                for (int q = 0; q < 16; ++q) op[q] = (f32x4){S[4 * q], S[4 * q + 1], S[4 * q + 2], S[4 * q + 3]};
#pragma unroll
                for (int c2 = 0; c2 < 64; ++c2) oq[c2 * 64] = (unsigned short)f2bf(M[c2]);
            }
        }
        SCAN_BAR();
    }
#undef SCAN_BAR
}

__global__ void __launch_bounds__(NWAVES * 64, 2) mk_fwd(Args args) {
    extern __shared__ __attribute__((aligned(16))) unsigned char lds[];
    Frame F;
    F.lds = (LAS unsigned char*)lds; F.MISC = (volatile LAS unsigned*)(F.lds + MISC_OFF);
    F.tid = threadIdx.x; F.wave = __builtin_amdgcn_readfirstlane(F.tid >> 6);
    F.G = gridDim.x; F.vcu = 0;
    unsigned char* ws = args.ws; F.ctl = (gu32*)(ws + WS_CTL);
    const float* const* in = args.in;
    unsigned char* ob = (unsigned char*)args.out;
    for (int u = threadIdx.x; u < (LDS_BYTES - LDSCTL_OFF) / 4; u += NWAVES * 64) ((LAS unsigned*)(F.lds + LDSCTL_OFF))[u] = 0u;
    __syncthreads();
    XcdBarrier bar; bar.bar = (unsigned*)(F.ctl + CW_BAR); bar.x = 0; bar.st = nullptr;
    int bidv = (int)blockIdx.x;
    if (!MK_PER_PHASE) {
        bar.bar = (unsigned*)(F.ctl + CW_BAR); bar.x = xb_xcc_id(); bar.st = F.MISC + 8;
        if (threadIdx.x == 0) {
            const unsigned rank = xb_add(&bar.bar[XB_XCNT(bar.x)], 1u);
            unsigned cnts[16], sum, sp = 0u;
            for (;;) { sum = 0u;
#pragma unroll
                for (unsigned j = 0; j < 16; ++j) { cnts[j] = xb_ld(&bar.bar[XB_XCNT(j)]); sum += cnts[j]; }
                if (sum == (unsigned)F.G) break;
                __builtin_amdgcn_s_sleep(1);
                if ((++sp & 255u) == 0u) { if (xb_ld(&bar.bar[XB_TMO])) break; if (sp > XB_SPIN_CAP) { atomicAdd(&bar.bar[XB_TMO], 1u); break; } } }
            unsigned nx = 0u, xi = 0u, mine = 0u; bool even = true;
#pragma unroll
            for (unsigned j = 0; j < 16; ++j) { if (cnts[j]) { nx++; if (cnts[j] * 8u != (unsigned)F.G) even = false; } if (j < bar.x && cnts[j]) xi++; if (j == bar.x) mine = cnts[j]; }
            F.MISC[8] = mine ? mine : 1u; F.MISC[9] = nx ? nx : 1u;
            F.MISC[10] = (even && nx == 8u && sum == (unsigned)F.G) ? rank * 8u + xi : (unsigned)blockIdx.x;
        }
        __syncthreads();
        bidv = (int)__builtin_amdgcn_readfirstlane((int)F.MISC[10]);
    }
    F.vcu = (F.G % 8 == 0) ? (bidv % 8) * (F.G / 8) + bidv / 8 : bidv;
    const int lo = args.ph_lo, hi = args.ph_hi;
#ifndef PH_MASK
#define PH_MASK 0xFFFF
#endif
#define IN(k) ((((PH_MASK) >> (k)) & 1) && lo <= (k) && (k) < hi)
#ifndef PROBE_MASK
#define PROBE_MASK 0
#endif
#ifndef PROBE_VARIANT
#define PROBE_VARIANT 0
#endif
#ifndef PROBE_N
#define PROBE_N 1
#endif
#define PHASE_BEGIN(k) if (IN(k)) { for (int rep_ = 0; rep_ < 1 + ((((PROBE_MASK) >> (k)) & 1) ? (PROBE_N) : 0); ++rep_) { if (rep_) xcd_barrier(bar); PHASE_IDS
#define PHASE_END } }
#define SEAM(k) do { if (IN(k) && IN((k) + 1)) xcd_barrier(bar); } while (0)
    const int gw = F.vcu * NWAVES + F.wave, NGW = F.G * NWAVES; const int NGT = F.G * NWAVES * 64;
#define PHASE_IDS const int lane = mk_lane_id(), tid = F.wave * 64 + lane, gt = F.vcu * (NWAVES * 64) + tid; (void)gt; (void)lane;

    bf16* WIN_T = (bf16*)(ws + WS_WIN); bf16* WA_T = (bf16*)(ws + WS_WA); bf16* WB_T = (bf16*)(ws + WS_WB); bf16* WOUT_T = (bf16*)(ws + WS_WOUT);
    bf16* WS_T = (bf16*)(ws + WS_WS); bf16* LORA_T = (bf16*)(ws + WS_LORA);
    bf16* XN = (bf16*)(ob + OUT_XN); bf16* RKV = (bf16*)(ob + OUT_RKV); bf16* LIN = (bf16*)(ob + OUT_LIN);
    bf16* PR = (bf16*)(ws + WS_PR); bf16* PD = (bf16*)(ws + WS_PD); bf16* PG = (bf16*)(ws + WS_PG);

    PHASE_BEGIN(0)
        LAS float* scr = (LAS float*)(F.lds + RING_OFF + F.wave * 16384);
        constexpr int I_IN = 32 * 334, I_L = 4 * 32;
        constexpr int NIT = I_IN + 3 * I_L;
        for (int it = gw; it < NIT; it += NGW) {
            int r = it;
            if (r < I_IN) { const int kb = r / 334, nb = r % 334, n0 = nb * 32; transpose_block(in[2], 10688, kb * 64, n0, 2048, WIN_T, 2048, n0 + (n0 >= 3520 ? 64 : 0), scr, lane); continue; } r -= I_IN;
            { const int which = r / I_L, rr = r % I_L, kb = rr / 32, nb = rr % 32; const float* W = which == 0 ? in[5] : (which == 1 ? in[7] : in[8]);
              transpose_block(W, 1024, kb * 64, nb * 32, which == 2 ? 256 : 96, LORA_T + (size_t)which * 1024 * 256, 256, nb * 32, scr, lane); }
        }
        for (int i = gt; i < 16384; i += NGT) *(GAS v4u*)(WIN_T + (size_t)3520 * 2048 + (size_t)i * 8) = (v4u){0u, 0u, 0u, 0u};
        for (int m = gw; m < S_; m += 2 * NGW) rms_row2_to_bf16(in[0] + (size_t)m * DM, in[0] + (size_t)(m + NGW) * DM, in[1], XN + (size_t)m * DM, XN + (size_t)(m + NGW) * DM, lane);
    PHASE_END
    SEAM(0);
    PHASE_BEGIN(1)
        pg8::Gemm g{XN, WIN_T, S_, 10752, 2048, 2048, 2048, nullptr, 0}; pg8::StaticOrder S; S.init(S_, 10752, F.G, bidv);
        pg8::Epi<pg8::EM_G1> E{PR, PD, PG, nullptr, nullptr, nullptr, attn_body::C2};
        pg8::gemm_phase<pg8::Epi<pg8::EM_G1>, pg8::StaticOrder, true, true>(F.lds + RING_OFF, g, S, E, F.wave);
    PHASE_END
    SEAM(1);
    PHASE_BEGIN(2)
        const float* mu = in[3];
        for (int t = gw; t < S_; t += NGW) {
            const bf16* cur = PR + (size_t)t * 3584; const bf16* prv = cur - 3584;
#pragma unroll 1
            for (int j = 0; j < 7; ++j) { const int ch = lane + 64 * j; if (ch >= 440) break;
                const v4u c4 = *(const GAS v4u*)(cur + ch * 8); v4u p4 = (v4u){0u, 0u, 0u, 0u}; if (t > 0) p4 = *(const GAS v4u*)(prv + ch * 8);
                const f32x4 m0 = *(const f32x4*)(mu + ch * 8), m1 = *(const f32x4*)(mu + ch * 8 + 4);
                float c[8] = {pg8::bflo(c4.x), pg8::bfhi(c4.x), pg8::bflo(c4.y), pg8::bfhi(c4.y), pg8::bflo(c4.z), pg8::bfhi(c4.z), pg8::bflo(c4.w), pg8::bfhi(c4.w)};
                const float p[8] = {pg8::bflo(p4.x), pg8::bfhi(p4.x), pg8::bflo(p4.y), pg8::bfhi(p4.y), pg8::bflo(p4.z), pg8::bfhi(p4.z), pg8::bflo(p4.w), pg8::bfhi(p4.w)};
                const float mm[8] = {m0.x, m0.y, m0.z, m0.w, m1.x, m1.y, m1.z, m1.w};
#pragma unroll
                for (int e = 0; e < 8; ++e) c[e] = c[e] + (p[e] - c[e]) * mm[e];
                bf16* dst;
                if (ch < 384) dst = RKV + (size_t)t * 3072 + ch * 8;
                else { const int col = ch * 8 - 3072;
                    if (col < 96) { dst = LIN + (size_t)t * 768 + col;
#pragma unroll
                        for (int e = 0; e < 8; ++e) c[e] = tanhf(c[e]); }
                    else if (col < 192) dst = LIN + (size_t)t * 768 + 256 + (col - 96);
                    else { dst = LIN + (size_t)t * 768 + 512 + (col - 192);
#pragma unroll
                        for (int e = 0; e < 8; ++e) c[e] = sigmf(c[e]); } }
                *(GAS v4u*)dst = (v4u){pk2(c[0], c[1]), pk2(c[2], c[3]), pk2(c[4], c[5]), pk2(c[6], c[7])};
            }
            if (lane < 40) { const int z = lane < 20 ? 96 + lane * 8 : 352 + (lane - 20) * 8; *(GAS v4u*)(LIN + (size_t)t * 768 + z) = (v4u){0u, 0u, 0u, 0u}; }
        }
    PHASE_END
    SEAM(2);
    PHASE_BEGIN(3)
#pragma unroll 1
        for (int which = 0; which < 3; ++which) {
            int kd = 256; asm volatile("" : "+s"(kd));
            pg8::Gemm g{LIN + which * 256, LORA_T + (size_t)which * 1024 * 256, S_, 1024, kd, 768, 256, nullptr, 0}; pg8::StaticOrder S; S.init(S_, 1024, F.G, bidv);
            pg8::Epi<pg8::EM_LORA_W> E{ws + (which == 0 ? WS_E : (which == 1 ? WS_A : WS_G)), nullptr, nullptr, nullptr, nullptr, which == 0 ? in[4] : (which == 1 ? in[6] : nullptr), which == 0 ? 0.60653065971f : 1.f};
            pg8::gemm_phase<pg8::Epi<pg8::EM_LORA_W>, pg8::StaticOrder, true, true>(F.lds + RING_OFF, g, S, E, F.wave); }
    PHASE_END
    SEAM(3);
    PHASE_BEGIN(4)
        bf16* SCN = (bf16*)(ws + WS_SCN); float* SCAL = (float*)(ws + WS_SCAL); const bf16* Ab = (const bf16*)(ws + WS_A);
        for (int t = gw; t < S_; t += NGW) {
#pragma unroll 2
            for (int h = 0; h < 16; ++h) { const int cc = h * 64 + lane;
                const float r = bf2f(RKV[(size_t)t * 3072 + cc]), k = bf2f(RKV[(size_t)t * 3072 + 1024 + cc]), a = bf2f(Ab[(size_t)t * 1024 + cc]);
                float kk = k * in[9][cc]; const float nrm = sqrtf(wsum(kk * kk)); kk = kk / fmaxf(nrm, 1e-12f);
                const float kt = k * (1.f + (a - 1.f) * in[10][cc]); const float b = kk * a;
                const unsigned short kkb = (unsigned short)f2bf(-kk), bb = (unsigned short)f2bf(b), ktb = (unsigned short)f2bf(kt);
                bf16* q = SCN + ((size_t)h * S_ + t) * 192; q[lane] = kkb; q[64 + lane] = bb; q[128 + lane] = ktb;
                const float br = wsum(bf2f(bb) * r), kr = wsum(bf2f(ktb) * r), bon = wsum(r * kt * in[11][cc]);
                if (lane == 0) *(f32x4*)(SCAL + ((size_t)h * S_ + t) * 4) = (f32x4){br, kr, bon, 0.f}; }
        }
    PHASE_END
    SEAM(4);
    PHASE_BEGIN(5)
        scan4_phase(lane, F.wave, F.vcu, F.G, ws, ob, RKV, (LAS float*)(F.lds + RING_OFF));
    PHASE_END
    SEAM(5);
    PHASE_BEGIN(6)
        if ((F.vcu & 15) == 0) { const int h = F.vcu >> 4; const int wv = F.wave;
            constexpr int PIT = 72;
            LAS bf16* Sb = (LAS bf16*)(F.lds + RING_OFF);
            LAS bf16* Atb = Sb + 2 * 64 * PIT;
            const float* SL = (const float*)(ws + WS_SLOC) + (size_t)h * NSEG * 4096; const bf16* AT = (const bf16*)(ws + WS_ASEG) + (size_t)h * NSEG * 4096; float* SI = (float*)(ws + WS_SIN) + (size_t)h * NSEG * 4096;
            for (int i = tid; i < 2 * 64 * PIT / 2; i += 512) ((LAS unsigned*)Sb)[i] = 0u;
#define P6_BAR() do { asm volatile("s_waitcnt lgkmcnt(0)" ::: "memory"); __builtin_amdgcn_s_barrier(); asm volatile("" ::: "memory"); } while (0)
            if (wv >= 4) {
                const int li = tid - 256, row = li >> 2, ch = li & 3;
                v4u r0a, r0b, r1a, r1b;
#define P6_LD(p, ra, rb) do { const bf16* s_ = AT + (size_t)(p) * 4096 + row * 64 + ch * 16; ra = *(const GAS v4u*)s_; rb = *(const GAS v4u*)(s_ + 8); } while (0)
#define P6_ST(p, ra, rb) do { LAS bf16* d_ = Atb + ((p) % 3) * 64 * PIT + row * PIT + ch * 16; *(LAS v4u*)d_ = ra; *(LAS v4u*)(d_ + 8) = rb; } while (0)
                P6_LD(0, r0a, r0b); P6_ST(0, r0a, r0b); P6_LD(1, r0a, r0b); P6_LD(2, r1a, r1b);
                P6_BAR();
#pragma unroll 1
                for (int p = 0; p < NSEG - 1; p += 2) {
                    if (p + 1 < NSEG - 1) P6_ST(p + 1, r0a, r0b); if (p + 3 < NSEG - 1) P6_LD(p + 3, r0a, r0b);
                    P6_BAR();
                    if (p + 1 < NSEG - 1) { if (p + 2 < NSEG - 1) P6_ST(p + 2, r1a, r1b); if (p + 4 < NSEG - 1) P6_LD(p + 4, r1a, r1b); P6_BAR(); }
                }
#undef P6_LD
#undef P6_ST
            } else {
                const int vt = wv >> 1, ct = wv & 1, r = lane & 31, hb = lane >> 5;
                typedef float f32x16 __attribute__((ext_vector_type(16)));
                f32x16 nl;
#define P6_LDL(p) do { const float* s_ = SL + (size_t)(p) * 4096 + (32 * vt + 4 * hb) * 64 + 32 * ct + r; _Pragma("unroll") for (int q = 0; q < 16; ++q) nl[q] = s_[((q & 3) + 8 * (q >> 2)) * 64]; } while (0)
                P6_LDL(0);
                { float* o_ = SI + (32 * vt + 4 * hb) * 64 + 32 * ct + r;
#pragma unroll
                  for (int q = 0; q < 16; ++q) o_[((q & 3) + 8 * (q >> 2)) * 64] = 0.f; }
                P6_BAR();
#pragma unroll 1
                for (int p = 0; p < NSEG - 1; ++p) {
                    const LAS bf16* sa_ = Sb + (p & 1) * 64 * PIT + (32 * vt + r) * PIT + 8 * hb; const LAS bf16* at_ = Atb + (p % 3) * 64 * PIT + (32 * ct + r) * PIT + 8 * hb;
                    f32x16 acc = nl; if (p + 1 < NSEG - 1) P6_LDL(p + 1);
#pragma unroll
                    for (int ks = 0; ks < 4; ++ks) { const bf16x8 af = *(const LAS bf16x8*)(sa_ + 16 * ks), bfr = *(const LAS bf16x8*)(at_ + 16 * ks);
                        acc = __builtin_amdgcn_mfma_f32_32x32x16_bf16(af, bfr, acc, 0, 0, 0); }
                    float* o_ = SI + (size_t)(p + 1) * 4096 + (32 * vt + 4 * hb) * 64 + 32 * ct + r; LAS bf16* sn_ = Sb + ((p + 1) & 1) * 64 * PIT + (32 * vt + 4 * hb) * PIT + 32 * ct + r;
#pragma unroll
                    for (int q = 0; q < 16; ++q) { const int rr = (q & 3) + 8 * (q >> 2); o_[rr * 64] = acc[q]; sn_[rr * PIT] = (unsigned short)f2bf(acc[q]); }
                    P6_BAR();
                }
#undef P6_LDL
            }
#undef P6_BAR
        } else {
            LAS float* scr = (LAS float*)(F.lds + RING_OFF + F.wave * 16384);
            const int gw2 = (F.vcu - (F.vcu >> 4) - 1) * NWAVES + F.wave, NGW2 = (F.G - 16) * NWAVES;
            constexpr int I_A = 16 * 64, I_B = 16 * 64, I_O = 32 * 64;
            for (int it = gw2; it < I_A + I_B + I_O; it += NGW2) {
                int r = it;
                if (r < I_A) { const int kb = r / 64, nb = r % 64; transpose_block(in[19], 2048, kb * 64, nb * 32, 1024, WA_T, 2048, nb * 32, scr, lane); continue; } r -= I_A;
                if (r < I_B) { const int kb = r / 64, nb = r % 64; transpose_block(in[20], 2048, kb * 64, nb * 32, 1024, WA_T + 1024, 2048, nb * 32, scr, lane); continue; } r -= I_B;
                { const int kb = r / 64, nb = r % 64; transpose_block(in[21], 2048, kb * 64, nb * 32, 2048, WOUT_T, 2048, nb * 32, scr, lane); }
            }
            for (int task = gw2; task < 16 * 32 * 4; task += NGW2) {
                const int hp = task >> 7, kb = (task >> 2) & 31, ng = task & 3; const int k = kb * 64 + lane;
                const f32x4* wq = (const f32x4*)(in[23] + (size_t)k * 2048 + hp * 128);
                f32x4 q[32];
#pragma unroll
                for (int d = 0; d < 32; ++d) q[d] = wq[d];
                const f32x4* sk4 = (const f32x4*)(in[24] + ((size_t)hp * 128 + ng * 32) * 128); LAS f32x4* sks = (LAS f32x4*)scr;
#pragma unroll
                for (int i = 0; i < 16; ++i) sks[i * 64 + lane] = sk4[i * 64 + lane];
                LDS_WAIT(); asm volatile("" ::: "memory");
#pragma unroll 2
                for (int n = 0; n < 32; ++n) { const LAS f32x4* s4 = sks + n * 32; float a0 = 0.f, a1 = 0.f;
#pragma unroll
                    for (int d = 0; d < 32; ++d) { const f32x4 s = s4[d]; a0 = fmaf(q[d].x, s.x, a0); a1 = fmaf(q[d].y, s.y, a1); a0 = fmaf(q[d].z, s.z, a0); a1 = fmaf(q[d].w, s.w, a1); }
                    WS_T[(size_t)(hp * 128 + ng * 32 + n) * 2048 + k] = (bf16)f2bf(a0 + a1); }
                LDS_WAIT(); asm volatile("" ::: "memory");
            }
        }
        __syncthreads();
        attn_body::attn_phase<8>((char*)lds + RING_OFF, (const attn_body::bf16*)PD, (attn_body::bf16*)(ws + WS_OATT), F.vcu, F.wave, (unsigned*)(F.ctl + 2048 + 64 * (F.vcu >> 5)), F.MISC + 12);
    PHASE_END
    SEAM(6);
    PHASE_BEGIN(7)
        typedef float f32x16 __attribute__((ext_vector_type(16)));
        const int r = lane & 31, hb = lane >> 5;
        const bf16* ZZ = (const bf16*)(ws + WS_Z); const bf16* YL = (const bf16*)(ob + OUT_YLOC); const bf16* Gb = (const bf16*)(ws + WS_G); const float* SCAL = (const float*)(ws + WS_SCAL);
        bf16* YA = (bf16*)(ws + WS_YA);
        constexpr int PITB = 144, BLK = 32 * PITB;
        LAS unsigned char* wl = F.lds + RING_OFF + F.wave * (3 * BLK) - BLK;
        const int lr = lane >> 3, lc = lane & 7;
        for (int task = gw; task < 16 * NSEG * 2; task += NGW) { const int h = task >> 7, seg = (task >> 1) & 63, half = task & 1;
            bf16x8 af[2][4];
            { const float* si = (const float*)(ws + WS_SIN) + ((size_t)h * NSEG + seg) * 4096;
#pragma unroll
              for (int vt = 0; vt < 2; ++vt)
#pragma unroll
                  for (int ks = 0; ks < 4; ++ks) { const f32x4 a = *(const f32x4*)(si + (32 * vt + r) * 64 + 16 * ks + 8 * hb), b = *(const f32x4*)(si + (32 * vt + r) * 64 + 16 * ks + 8 * hb + 4);
                      const v4u w = (v4u){pk2(a.x, a.y), pk2(a.z, a.w), pk2(b.x, b.y), pk2(b.z, b.w)}; af[vt][ks] = __builtin_bit_cast(bf16x8, w); } }
            f32x4 lg[2][4], lb[2][4];
#pragma unroll
            for (int vt = 0; vt < 2; ++vt)
#pragma unroll
                for (int qq = 0; qq < 4; ++qq) { lg[vt][qq] = *(const f32x4*)(in[12] + h * 64 + 32 * vt + 8 * qq + 4 * hb); lb[vt][qq] = *(const f32x4*)(in[13] + h * 64 + 32 * vt + 8 * qq + 4 * hb); }
#pragma unroll 1
            for (int tt = 0; tt < 4; ++tt) { const int tb0 = seg * SEGLEN + half * 128 + tt * 32; const size_t hb0 = (size_t)h * S_ + tb0;
                v4u ry[4], rv[4], rg[4];
#pragma unroll
                for (int i = 0; i < 4; ++i) { const int row = lr + 8 * i;
                    ry[i] = *(const GAS v4u*)(YL + (hb0 + row) * 64 + lc * 8);
                    rv[i] = *(const GAS v4u*)(RKV + (size_t)(tb0 + row) * 3072 + 2048 + h * 64 + lc * 8); rg[i] = *(const GAS v4u*)(Gb + (size_t)(tb0 + row) * 1024 + h * 64 + lc * 8); }
                const float bon = SCAL[(hb0 + r) * 4 + 2];
#pragma unroll
                for (int i = 0; i < 4; ++i) { const int o = (lr + 8 * i) * PITB + lc * 16;
                    *(LAS v4u*)(wl + BLK + o) = ry[i]; *(LAS v4u*)(wl + 2 * BLK + o) = rv[i]; *(LAS v4u*)(wl + 3 * BLK + o) = rg[i]; }
                LDS_WAIT(); asm volatile("" ::: "memory");
                bf16x8 zf[4];
#pragma unroll
                for (int ks = 0; ks < 4; ++ks) zf[ks] = *(const bf16x8*)(ZZ + (hb0 + r) * 64 + 16 * ks + 8 * hb);
                f32x16 acc[2];
#pragma unroll
                for (int vt = 0; vt < 2; ++vt)
#pragma unroll
                    for (int qq = 0; qq < 4; ++qq) { const unsigned long long w = *(const LAS unsigned long long*)(wl + BLK + r * PITB + (32 * vt + 8 * qq + 4 * hb) * 2);
                        acc[vt][4 * qq] = pg8::bflo((unsigned)w); acc[vt][4 * qq + 1] = pg8::bfhi((unsigned)w); acc[vt][4 * qq + 2] = pg8::bflo((unsigned)(w >> 32)); acc[vt][4 * qq + 3] = pg8::bfhi((unsigned)(w >> 32)); }
#pragma unroll
                for (int vt = 0; vt < 2; ++vt)
#pragma unroll
                    for (int ks = 0; ks < 4; ++ks) acc[vt] = __builtin_amdgcn_mfma_f32_32x32x16_bf16(af[vt][ks], zf[ks], acc[vt], 0, 0, 0);
                float s1 = 0.f;
#pragma unroll
                for (int vt = 0; vt < 2; ++vt)
#pragma unroll
                    for (int q = 0; q < 16; ++q) s1 += acc[vt][q];
                { auto rr = __builtin_amdgcn_permlane32_swap(__float_as_uint(s1), __float_as_uint(s1), false, false); s1 = __uint_as_float(rr[0]) + __uint_as_float(rr[1]); }
                const float mean = s1 * (1.f / 64.f); float s2 = 0.f;
#pragma unroll
                for (int vt = 0; vt < 2; ++vt)
#pragma unroll
                    for (int q = 0; q < 16; ++q) { acc[vt][q] -= mean; s2 += acc[vt][q] * acc[vt][q]; }
                { auto rr = __builtin_amdgcn_permlane32_swap(__float_as_uint(s2), __float_as_uint(s2), false, false); s2 = __uint_as_float(rr[0]) + __uint_as_float(rr[1]); }
                const float rstd = rsqrtf(s2 * (1.f / 64.f) + 64e-5f);
#pragma unroll
                for (int vt = 0; vt < 2; ++vt)
#pragma unroll
                    for (int qq = 0; qq < 4; ++qq) { const int vo = r * PITB + (32 * vt + 8 * qq + 4 * hb) * 2;
                        const unsigned long long vw = *(const LAS unsigned long long*)(wl + 2 * BLK + vo), gw_ = *(const LAS unsigned long long*)(wl + 3 * BLK + vo);
                        const float vv[4] = {pg8::bflo((unsigned)vw), pg8::bfhi((unsigned)vw), pg8::bflo((unsigned)(vw >> 32)), pg8::bfhi((unsigned)(vw >> 32))};
                        const float gg[4] = {pg8::bflo((unsigned)gw_), pg8::bfhi((unsigned)gw_), pg8::bflo((unsigned)(gw_ >> 32)), pg8::bfhi((unsigned)(gw_ >> 32))};
                        float o[4];
#pragma unroll
                        for (int i = 0; i < 4; ++i) o[i] = (acc[vt][4 * qq + i] * rstd * lg[vt][qq][i] + lb[vt][qq][i] + bon * vv[i]) * gg[i];
                        *(LAS unsigned long long*)(wl + BLK + vo) = (unsigned long long)pk2(o[0], o[1]) | ((unsigned long long)pk2(o[2], o[3]) << 32); }
                LDS_WAIT(); asm volatile("" ::: "memory");
#pragma unroll
                for (int i = 0; i < 4; ++i) { const int row = lr + 8 * i; *(GAS v4u*)(YA + (size_t)(tb0 + row) * 1024 + h * 64 + lc * 8) = *(const LAS v4u*)(wl + BLK + row * PITB + lc * 16); }
                LDS_WAIT(); asm volatile("" ::: "memory");
            }
        }
    PHASE_END
    SEAM(7);
    PHASE_BEGIN(9)
        float d1 = 0.f, d2 = 0.f; d1 = in[14][lane] * in[15][lane]; d2 = in[16][lane] * in[17][lane];
        const float lam = __expf(wave_sum(d1)) - __expf(wave_sum(d2)) + 0.2f;
        const bf16* OA = (const bf16*)(ws + WS_OATT); bf16* YB = (bf16*)(ws + WS_YB);
        f32x4 sg[4];
#pragma unroll
        for (int q = 0; q < 4; ++q) sg[q] = *(const f32x4*)(in[18] + (lane & 7) * 16 + q * 4);
        for (int t = gw; t < S_; t += NGW) {
            const v4u a0 = *(const GAS v4u*)(OA + (size_t)t * 2048 + lane * 16), a1 = *(const GAS v4u*)(OA + (size_t)t * 2048 + lane * 16 + 8);
            const v4u b0 = *(const GAS v4u*)(OA + (size_t)t * 2048 + 1024 + lane * 16), b1 = *(const GAS v4u*)(OA + (size_t)t * 2048 + 1024 + lane * 16 + 8);
            const unsigned aw[8] = {a0.x, a0.y, a0.z, a0.w, a1.x, a1.y, a1.z, a1.w}, bw[8] = {b0.x, b0.y, b0.z, b0.w, b1.x, b1.y, b1.z, b1.w};
            float o[16]; float ss = 0.f;
#pragma unroll
            for (int e = 0; e < 8; ++e) { o[2 * e] = pg8::bflo(aw[e]) - lam * pg8::bflo(bw[e]); o[2 * e + 1] = pg8::bfhi(aw[e]) - lam * pg8::bfhi(bw[e]); ss += o[2 * e] * o[2 * e] + o[2 * e + 1] * o[2 * e + 1]; }
            ss += __shfl_xor(ss, 1); ss += __shfl_xor(ss, 2); ss += __shfl_xor(ss, 4);
            const float rs = rsqrtf(ss * (1.f / 128.f) + 1e-5f) * 0.8f;
            const float gg[16] = {sg[0].x, sg[0].y, sg[0].z, sg[0].w, sg[1].x, sg[1].y, sg[1].z, sg[1].w, sg[2].x, sg[2].y, sg[2].z, sg[2].w, sg[3].x, sg[3].y, sg[3].z, sg[3].w};
#pragma unroll
            for (int e = 0; e < 16; ++e) o[e] = o[e] * rs * gg[e];
            *(GAS v4u*)(YB + (size_t)t * 1024 + lane * 16) = (v4u){pk2(o[0], o[1]), pk2(o[2], o[3]), pk2(o[4], o[5]), pk2(o[6], o[7])};
            *(GAS v4u*)(YB + (size_t)t * 1024 + lane * 16 + 8) = (v4u){pk2(o[8], o[9]), pk2(o[10], o[11]), pk2(o[12], o[13]), pk2(o[14], o[15])};
        }
    PHASE_END
    SEAM(9);
    PHASE_BEGIN(10)
        pg8::Gemm g{(const bf16*)(ws + WS_YA), WA_T, S_, 2048, 2048, 1024, 2048, (const bf16*)(ws + WS_YB), 16}; pg8::StaticOrder S; S.init(S_, 2048, F.G, bidv);
        pg8::Epi<pg8::EM_PROJAB> E{ws + WS_MERGED, nullptr, nullptr, PG, nullptr, nullptr, 1.f};
        pg8::gemm_phase<pg8::Epi<pg8::EM_PROJAB>, pg8::StaticOrder, true, true>(F.lds + RING_OFF, g, S, E, F.wave);
    PHASE_END
    SEAM(10);
    PHASE_BEGIN(12)
        pg8::Gemm g{(const bf16*)(ws + WS_MERGED), WOUT_T, S_, 2048, 2048, 2048, 2048, nullptr, 0}; pg8::StaticOrder S; S.init(S_, 2048, F.G, bidv);
        pg8::Epi<pg8::EM_WOUT> E{ws + WS_H2, nullptr, nullptr, nullptr, in[0], nullptr, 1.f};
        pg8::gemm_phase<pg8::Epi<pg8::EM_WOUT>, pg8::StaticOrder, true, true>(F.lds + RING_OFF, g, S, E, F.wave);
    PHASE_END
    SEAM(12);
    PHASE_BEGIN(13)
        for (int m = gw; m < S_; m += 2 * NGW) rms_row2_to_bf16((const float*)(ws + WS_H2) + (size_t)m * DM, (const float*)(ws + WS_H2) + (size_t)(m + NGW) * DM, in[22], (bf16*)(ws + WS_XN2) + (size_t)m * DM, (bf16*)(ws + WS_XN2) + (size_t)(m + NGW) * DM, lane);
        for (int row = gw; row < 32768; row += NGW) { const int which = row >> 14, r = row & 16383;
            const f32x4* src = (const f32x4*)(in[25 + which] + (size_t)r * 2048) + lane; f32x4 v[8]; float am = 0.f;
#pragma unroll
            for (int j = 0; j < 8; ++j) { v[j] = __builtin_nontemporal_load(src + 64 * j); am = fmaxf(am, fmaxf(fmaxf(fabsf(v[j].x), fabsf(v[j].y)), fmaxf(fabsf(v[j].z), fabsf(v[j].w)))); }
            const unsigned tb = __float_as_uint(am * (1.f / 6.f)); unsigned eb = (tb >> 23) + ((tb & 0x7fffffu) ? 1u : 0u); eb = eb < 1u ? 1u : (eb > 254u ? 254u : eb);
            const float sc = __uint_as_float(eb << 23);
            unsigned wd[4];
#pragma unroll
            for (int w = 0; w < 4; ++w) { unsigned q = 0u;
                q = __builtin_amdgcn_cvt_scalef32_pk_fp4_f32(q, v[2 * w].x, v[2 * w].y, sc, 0); q = __builtin_amdgcn_cvt_scalef32_pk_fp4_f32(q, v[2 * w].z, v[2 * w].w, sc, 1);
                q = __builtin_amdgcn_cvt_scalef32_pk_fp4_f32(q, v[2 * w + 1].x, v[2 * w + 1].y, sc, 2); q = __builtin_amdgcn_cvt_scalef32_pk_fp4_f32(q, v[2 * w + 1].z, v[2 * w + 1].w, sc, 3); wd[w] = q; }
            *(GAS v4u*)(ws + (which ? WS_VTAB : WS_UTAB) + (size_t)r * 1024 + lane * 16) = (v4u){wd[0], wd[1], wd[2], wd[3]};
            ((unsigned char*)(ws + (which ? WS_VSCL : WS_USCL)))[(size_t)r * 64 + lane] = (unsigned char)eb; }
    PHASE_END
    SEAM(13);
    PHASE_BEGIN(14)
        pg8::Gemm g{(const bf16*)(ws + WS_XN2), WS_T, S_, 2048, 2048, 2048, 2048, nullptr, 0}; pg8::StaticOrder S; S.init(S_, 2048, F.G, bidv);
        pg8::Epi<pg8::EM_SCORES> E{ws + WS_SCORES, nullptr, nullptr, nullptr, nullptr, nullptr, 1.f};
        pg8::gemm_phase<pg8::Epi<pg8::EM_SCORES>, pg8::StaticOrder, true, true>(F.lds + RING_OFF, g, S, E, F.wave);
    PHASE_END
    SEAM(14);
    PHASE_BEGIN(15)
        const float* SC = (const float*)(ws + WS_SCORES); const bf16* XN2 = (const bf16*)(ws + WS_XN2);
        const unsigned char* UT = (const unsigned char*)(ws + WS_UTAB); const unsigned char* VT = (const unsigned char*)(ws + WS_VTAB);
        const unsigned char* USB = (const unsigned char*)(ws + WS_USCL); const unsigned char* VSB = (const unsigned char*)(ws + WS_VSCL);
        LAS unsigned* lst = (LAS unsigned*)(F.lds + RING_OFF + F.wave * 10240);
        for (int tb = gw; tb < S_ / 8; tb += NGW) {
            { const int tl = lane >> 3, h = lane & 7; const float* srow = SC + (size_t)(tb * 8 + tl) * 2048 + h * 256;
              float A[16], B[16];
#pragma unroll
              for (int p = 0; p < 2; ++p) { float top[16];
#pragma unroll
                  for (int k = 0; k < 16; ++k) top[k] = -INFINITY;
#pragma unroll 2
                  for (int i4 = 0; i4 < 32; ++i4) { const f32x4 v = *(const f32x4*)(srow + p * 128 + i4 * 4); const float ve[4] = {v.x, v.y, v.z, v.w};
#pragma unroll
                      for (int e = 0; e < 4; ++e) { float x = __uint_as_float((__float_as_uint(ve[e]) & 0xffffff80u) | (unsigned)(i4 * 4 + e));
#pragma unroll
                          for (int k = 0; k < 16; ++k) { const float hi = fmaxf(top[k], x); x = fminf(top[k], x); top[k] = hi; } } }
#pragma unroll
                  for (int k = 0; k < 16; ++k) { if (p == 0) A[k] = top[k]; else B[k] = top[k]; } }
              LAS unsigned* ixl = (LAS unsigned*)(F.lds + RING_OFF + F.wave * 10240 + 8192) + lane * 8;
              { unsigned wa[4], wb[4];
#pragma unroll
                for (int q = 0; q < 4; ++q) { wa[q] = 0u; wb[q] = 0u;
#pragma unroll
                    for (int e = 0; e < 4; ++e) { wa[q] |= (__float_as_uint(A[q * 4 + e]) & 127u) << (8 * e); wb[q] |= (__float_as_uint(B[q * 4 + e]) & 127u) << (8 * e); } }
                *(LAS v4u*)ixl = (v4u){wa[0], wa[1], wa[2], wa[3]}; *(LAS v4u*)(ixl + 4) = (v4u){wb[0], wb[1], wb[2], wb[3]}; }
              float cs[16];
#pragma unroll
              for (int k = 0; k < 16; ++k) cs[k] = -INFINITY;
#pragma unroll
              for (int i = 0; i < 16; ++i)
#pragma unroll
                  for (int j = 0; j < 16; ++j) if ((i + 1) * (j + 1) <= 16) {
                      float x = __uint_as_float((__float_as_uint(A[i] + B[j]) & 0xffffff00u) | (unsigned)(i * 16 + j));
#pragma unroll
                      for (int k = 0; k < 16; ++k) { const float hi = fmaxf(cs[k], x); x = fminf(cs[k], x); cs[k] = hi; } }
              LDS_WAIT(); asm volatile("" ::: "memory");
              const LAS unsigned char* ixb = (const LAS unsigned char*)ixl;
              unsigned cx[16]; float gsum = 0.f; const float cmax = cs[0];
#pragma unroll
              for (int k = 0; k < 16; ++k) { const unsigned ij = __float_as_uint(cs[k]) & 255u; cx[k] = ((unsigned)ixb[ij >> 4] << 7) | (unsigned)ixb[16 + (ij & 15u)]; cs[k] = __expf(cs[k] - cmax); gsum += cs[k]; }
              const float ginv = 1.f / gsum; LAS unsigned* lp = lst + (tl * 128 + h * 16) * 2;
#pragma unroll
              for (int k = 0; k < 16; k += 2) *(LAS v4u*)(lp + k * 2) = (v4u){cx[k], __float_as_uint(cs[k] * ginv), cx[k + 1], __float_as_uint(cs[k + 1] * ginv)}; }
            LDS_WAIT(); asm volatile("" ::: "memory");
#pragma unroll 1
            for (int tl = 0; tl < 8; ++tl) { const int t = tb * 8 + tl;
                float xf[32];
#pragma unroll
                for (int j = 0; j < 8; ++j) { const unsigned long long w = *(const GAS unsigned long long*)(XN2 + (size_t)t * 2048 + 256 * j + 4 * lane);
                    xf[4 * j] = pg8::bflo((unsigned)w); xf[4 * j + 1] = pg8::bfhi((unsigned)w); xf[4 * j + 2] = pg8::bflo((unsigned)(w >> 32)); xf[4 * j + 3] = pg8::bfhi((unsigned)(w >> 32)); }
                float acc[32];
#pragma unroll
                for (int e = 0; e < 32; ++e) acc[e] = 0.f;
                constexpr int EG = 8;
#pragma unroll 1
                for (int e0 = 0; e0 < 128; e0 += EG) {
                    v4u ur[EG], vr[EG]; float gate[EG]; unsigned char sub[EG], svb[EG];
#pragma unroll
                    for (int q = 0; q < EG; ++q) { const unsigned idx = __builtin_amdgcn_readfirstlane(lst[(tl * 128 + e0 + q) * 2]); gate[q] = __uint_as_float(__builtin_amdgcn_readfirstlane(lst[(tl * 128 + e0 + q) * 2 + 1]));
                        ur[q] = *(const GAS v4u*)(UT + (size_t)idx * 1024 + lane * 16); vr[q] = *(const GAS v4u*)(VT + (size_t)idx * 1024 + lane * 16);
                        sub[q] = USB[(size_t)idx * 64 + lane]; svb[q] = VSB[(size_t)idx * 64 + lane]; }
#pragma unroll
                    for (int q = 0; q < EG; ++q) { float d0 = 0.f, d1 = 0.f; const float su = __uint_as_float((unsigned)sub[q] << 23), sv = __uint_as_float((unsigned)svb[q] << 23);
                        const unsigned uw[4] = {ur[q].x, ur[q].y, ur[q].z, ur[q].w};
#pragma unroll
                        for (int w = 0; w < 4; ++w) {
                            const auto p0 = __builtin_amdgcn_cvt_scalef32_pk_f32_fp4(uw[w], su, 0), p1 = __builtin_amdgcn_cvt_scalef32_pk_f32_fp4(uw[w], su, 1), p2 = __builtin_amdgcn_cvt_scalef32_pk_f32_fp4(uw[w], su, 2), p3 = __builtin_amdgcn_cvt_scalef32_pk_f32_fp4(uw[w], su, 3);
                            d0 = fmaf(xf[8 * w], p0[0], d0); d1 = fmaf(xf[8 * w + 1], p0[1], d1); d0 = fmaf(xf[8 * w + 2], p1[0], d0); d1 = fmaf(xf[8 * w + 3], p1[1], d1);
                            d0 = fmaf(xf[8 * w + 4], p2[0], d0); d1 = fmaf(xf[8 * w + 5], p2[1], d1); d0 = fmaf(xf[8 * w + 6], p3[0], d0); d1 = fmaf(xf[8 * w + 7], p3[1], d1); }
                        const float d = wsum(d0 + d1);
                        const float act = 0.5f * d * (1.f + erff(d * 0.70710678118f)); const float cf = gate[q] * act; const float cs = cf * sv;
                        const unsigned vw[4] = {vr[q].x, vr[q].y, vr[q].z, vr[q].w};
#pragma unroll
                        for (int w = 0; w < 4; ++w) {
                            const auto p0 = __builtin_amdgcn_cvt_scalef32_pk_f32_fp4(vw[w], 1.0f, 0), p1 = __builtin_amdgcn_cvt_scalef32_pk_f32_fp4(vw[w], 1.0f, 1), p2 = __builtin_amdgcn_cvt_scalef32_pk_f32_fp4(vw[w], 1.0f, 2), p3 = __builtin_amdgcn_cvt_scalef32_pk_f32_fp4(vw[w], 1.0f, 3);
                            acc[8 * w] = fmaf(cs, p0[0], acc[8 * w]); acc[8 * w + 1] = fmaf(cs, p0[1], acc[8 * w + 1]); acc[8 * w + 2] = fmaf(cs, p1[0], acc[8 * w + 2]); acc[8 * w + 3] = fmaf(cs, p1[1], acc[8 * w + 3]);
                            acc[8 * w + 4] = fmaf(cs, p2[0], acc[8 * w + 4]); acc[8 * w + 5] = fmaf(cs, p2[1], acc[8 * w + 5]); acc[8 * w + 6] = fmaf(cs, p3[0], acc[8 * w + 6]); acc[8 * w + 7] = fmaf(cs, p3[1], acc[8 * w + 7]); }
                    }
                }
                float* orow = args.out + (size_t)t * 2048; const float* hrow = (const float*)(ws + WS_H2) + (size_t)t * 2048; float ss = 0.f;
#pragma unroll
                for (int j = 0; j < 8; ++j) { const f32x4 a = *(const f32x4*)(hrow + 256 * j + 4 * lane);
                    acc[4 * j] += a.x; acc[4 * j + 1] += a.y; acc[4 * j + 2] += a.z; acc[4 * j + 3] += a.w; }
#pragma unroll
                for (int e = 0; e < 32; ++e) ss += acc[e] * acc[e];
                const float rstd = rsqrtf(wsum(ss) * (1.f / 2048.f) + 1e-6f);
#pragma unroll
                for (int j = 0; j < 8; ++j) { const f32x4 g0 = *(const f32x4*)(in[27] + 256 * j + 4 * lane);
                    *(f32x4*)(orow + 256 * j + 4 * lane) = (f32x4){acc[4 * j] * rstd * g0.x, acc[4 * j + 1] * rstd * g0.y, acc[4 * j + 2] * rstd * g0.z, acc[4 * j + 3] * rstd * g0.w}; }
            }
            LDS_WAIT(); asm volatile("" ::: "memory");
        }
    PHASE_END
#undef IN
#undef SEAM
}

extern "C" void kernel_launch(void* const* d_in, const int* in_sizes, int n_in, void* d_out, int out_size, void* d_ws, size_t ws_size, hipStream_t stream) {
    static int grid = 0;
    if (grid == 0) {
        if (n_in != 28 || in_sizes[0] != S_ * DM || out_size != S_ * DM || ws_size < WS_END) { fprintf(stderr, "kernel_launch: unexpected shapes: n_in %d in0 %d out %d ws %zu (need >= %zu)\n", n_in, n_in > 0 ? in_sizes[0] : -1, out_size, ws_size, (size_t)WS_END); grid = -1; return; }
        if (hipFuncSetAttribute((const void*)mk_fwd, hipFuncAttributeMaxDynamicSharedMemorySize, LDS_BYTES) != hipSuccess) { fprintf(stderr, "kernel_launch: hipFuncSetAttribute failed\n"); grid = -1; return; }
        int per_cu = 0;
        if (hipOccupancyMaxActiveBlocksPerMultiprocessor(&per_cu, (const void*)mk_fwd, NWAVES * 64, LDS_BYTES) != hipSuccess || per_cu < 1) fprintf(stderr, "kernel_launch: note: occupancy query reports %d\n", per_cu);
        (void)hipGetLastError();
        grid = 256;
    }
    if (grid < 0) return;
    (void)hipMemsetAsync((char*)d_ws + WS_CTL, 0, CTL_ZERO_BYTES, stream);
    Args a{};
    for (int i = 0; i < 28; ++i) a.in[i] = (const float*)d_in[i];
    a.out = (float*)d_out; a.ws = (unsigned char*)d_ws;
#if MK_PER_PHASE
    for (int p = 0; p < NPH; ++p) { a.ph_lo = p; a.ph_hi = p + 1; hipLaunchKernelGGL(mk_fwd, dim3(grid), dim3(NWAVES * 64), LDS_BYTES, stream, a); }
#else
    a.ph_lo = 0; a.ph_hi = NPH; hipLaunchKernelGGL(mk_fwd, dim3(grid), dim3(NWAVES * 64), LDS_BYTES, stream, a);
#endif
    const hipError_t le = hipPeekAtLastError();
    if (le != hipSuccess) fprintf(stderr, "kernel_launch: launch failed: %s\n", hipGetErrorName(le));
}
```

```cpp
#include <hip/hip_runtime.h>
#include <cstdio>
#include <cstdint>
__device__ __forceinline__ int mk_lane_id() { int l; asm volatile("v_mbcnt_lo_u32_b32 %0, -1, 0\n\tv_mbcnt_hi_u32_b32 %0, -1, %0" : "=v"(l)); return l; }
namespace pg8 {
#define PG8_LAS __attribute__((address_space(3)))
typedef unsigned short bf16_t;
typedef short bf16x8 __attribute__((ext_vector_type(8)));
typedef float f32x4 __attribute__((ext_vector_type(4)));
typedef unsigned u32x4 __attribute__((ext_vector_type(4)));
constexpr int BM = 256, BK = 64, HALF = 128, HTB = HALF * BK * 2  , STAGE_BYTES = 8 * HTB, NXCD = 8, WGM = 8;

__host__ __device__ __forceinline__ int lds_byte(int r, int c) { const int st = (r >> 4) * 2 + (c >> 5), rr = r & 15, cc = c & 31, ob = rr * 64 + cc * 2; return st * 1024 + (ob ^ (((ob >> 9) & 1) << 5)); }
__host__ __device__ __forceinline__ void stage_rc(int b, int& R, int& C) { const int st = b / 1024, sb = b % 1024, swz = sb ^ (((sb >> 9) & 1) << 5); R = (st >> 1) * 16 + swz / 64; C = (st & 1) * 32 + (swz % 64) / 2; }
__host__ __device__ __forceinline__ int perm32(int rho) { const int n = rho >> 4, i = rho & 15; return 8 * (i >> 2) + 4 * n + (i & 3); }

struct Unit { int pm, pn; };
struct Gemm { const bf16_t* A; const bf16_t* Bt; int M, N, K, lda, ldb; const bf16_t* A2; int ksplit; };

struct StaticOrder {
    int nM, nN, nwg, G, c;
    __host__ __device__ void init(int M, int N, int G_, int c_) { nM = M / BM; nN = N / BM; nwg = nM * nN; G = G_; c = c_; }
    __host__ __device__ bool next(int i, Unit& u) const {
        const long L = (long)i * G + c; if (L >= nwg) return false;
        int wgid = (int)L; { const int q = nwg / NXCD, r = nwg % NXCD, xcd = wgid % NXCD, off = wgid / NXCD; wgid = (xcd < r ? xcd * (q + 1) : r * (q + 1) + (xcd - r) * q) + off; }
        const int nig = WGM * nN, gid = wgid / nig, fm = gid * WGM, gsz = (nM - fm) < WGM ? (nM - fm) : WGM;
        u.pm = fm + ((wgid % nig) % gsz); u.pn = (wgid % nig) / gsz; return true;
    }
    __device__ __forceinline__ void a_ready(const Unit&) const {}
    __device__ __forceinline__ void done(const Unit&) const {}
};

__device__ __forceinline__ unsigned cvt_pk_bf16(float lo, float hi) { unsigned r; asm volatile("v_cvt_pk_bf16_f32 %0, %1, %2" : "=v"(r) : "v"(lo), "v"(hi)); return r; }
__device__ __forceinline__ float sigm(float x) { return __builtin_amdgcn_rcpf(1.0f + __expf(-x)); }
__device__ __forceinline__ float bflo(unsigned w) { return __uint_as_float(w << 16); }
__device__ __forceinline__ float bfhi(unsigned w) { return __uint_as_float(w & 0xffff0000u); }
enum { EM_G1 = 0, EM_LORA_W = 1, EM_LORA_A = 2, EM_LORA_G = 3, EM_PROJA = 4, EM_PROJB = 5, EM_WOUT = 6, EM_SCORES = 7, EM_PROJAB = 8 };
template <int MODE> struct Epi {
    static constexpr bool PERM = true, AFTER_DRAIN = false, HAS_MID = (MODE == EM_PROJAB);
    __device__ __forceinline__ void mid(f32x4 (&acc)[2][2][4][2], const Unit& u, int wr, int wc, int fr, int fq) const {
        asm volatile("" ::: "memory");
        int row0 = u.pm * BM + wr * 64 + fr, col0 = u.pn * BM + wc * 32 + 8 * fq; asm volatile("" : "+v"(row0), "+v"(col0));
#pragma unroll
        for (int ai = 0; ai < 2; ++ai) { asm volatile("" ::: "memory");
#pragma unroll
            for (int m = 0; m < 4; ++m) { const size_t row = (size_t)(row0 + ai * HALF + m * 16);
#pragma unroll
                for (int bj = 0; bj < 2; ++bj) { const int col = col0 + bj * HALF;
                    const u32x4 ga = *(const u32x4*)((const bf16_t*)i0 + row * 4096 + col), gb = *(const u32x4*)((const bf16_t*)i0 + row * 4096 + 2048 + col);
                    const unsigned aw[4] = {ga.x, ga.y, ga.z, ga.w}, bw[4] = {gb.x, gb.y, gb.z, gb.w};
#pragma unroll
                    for (int w = 0; w < 4; ++w) { const float r0 = bflo(aw[w]) * __builtin_amdgcn_rcpf(fmaxf(bflo(bw[w]), 1e-30f)), r1 = bfhi(aw[w]) * __builtin_amdgcn_rcpf(fmaxf(bfhi(bw[w]), 1e-30f));
                        acc[ai][bj][m][w >> 1][2 * (w & 1)] *= r0; acc[ai][bj][m][w >> 1][2 * (w & 1) + 1] *= r1; } } } }
        asm volatile("" ::: "memory");
    }
    void* o0; void* o1; void* o2; const void* i0; const void* i1; const float* vec; float sc;
    __device__ __forceinline__ void operator()(const f32x4 (&acc)[2][2][4][2], const Unit& u, int wr, int wc, int fr, int fq) const {
        asm volatile("" ::: "memory");
        int row0 = u.pm * BM + wr * 64 + fr; asm volatile("" : "+v"(row0));
        int colt = u.pn * BM; int ldc = 2048; int sub = 0;
        bf16_t* ob = (bf16_t*)o0; float scl = 1.f;
        if (MODE == EM_G1) {
            if (u.pn < 14) { ldc = 3584; }
            else if (u.pn < 26) { ob = (bf16_t*)o1; ldc = 3072; colt -= 14 * BM; if (u.pn < 18) scl = sc; }
            else { ob = (bf16_t*)o2; ldc = 4096; colt -= 26 * BM; sub = 1; }
        }
        if (MODE == EM_LORA_W || MODE == EM_LORA_A || MODE == EM_LORA_G) ldc = 1024;
        const int col0 = colt + wc * 32 + 8 * fq;
        float ssq[2][4] = {{0.f, 0.f, 0.f, 0.f}, {0.f, 0.f, 0.f, 0.f}}; (void)ssq;
#pragma unroll
        for (int ai = 0; ai < 2; ++ai)
#pragma unroll
            for (int m = 0; m < 4; ++m) { const size_t row = (size_t)(row0 + ai * HALF + m * 16);
#pragma unroll
                for (int bj = 0; bj < 2; ++bj) { f32x4 v0 = acc[ai][bj][m][0], v1 = acc[ai][bj][m][1]; const int col = col0 + bj * HALF;
                    if (MODE == EM_G1) {
                        if (sub) { v0 = (f32x4){sigm(v0[0]), sigm(v0[1]), sigm(v0[2]), sigm(v0[3])}; v1 = (f32x4){sigm(v1[0]), sigm(v1[1]), sigm(v1[2]), sigm(v1[3])}; }
                        else { v0 = v0 * scl; v1 = v1 * scl; }
                        u32x4 w; w.x = cvt_pk_bf16(v0[0], v0[1]); w.y = cvt_pk_bf16(v0[2], v0[3]); w.z = cvt_pk_bf16(v1[0], v1[1]); w.w = cvt_pk_bf16(v1[2], v1[3]);
                        *(u32x4*)(ob + row * ldc + col) = w;
                    } else if (MODE == EM_LORA_W) {
                        if (vec) { const f32x4 b0 = *(const f32x4*)(vec + col), b1 = *(const f32x4*)(vec + col + 4);
                            v0 = v0 + b0; v1 = v1 + b1;
                            v0 = (f32x4){sigm(v0[0]), sigm(v0[1]), sigm(v0[2]), sigm(v0[3])}; v1 = (f32x4){sigm(v1[0]), sigm(v1[1]), sigm(v1[2]), sigm(v1[3])};
                            v0 = v0 * sc; v1 = v1 * sc; }
                        u32x4 w; w.x = cvt_pk_bf16(v0[0], v0[1]); w.y = cvt_pk_bf16(v0[2], v0[3]); w.z = cvt_pk_bf16(v1[0], v1[1]); w.w = cvt_pk_bf16(v1[2], v1[3]);
                        *(u32x4*)(ob + row * ldc + col) = w;
                    } else if (MODE == EM_PROJA) {
                        const u32x4 g = *(const u32x4*)((const bf16_t*)i0 + row * 4096 + col);
                        float* op = (float*)o0 + row * 2048 + col;
                        *(f32x4*)op = (f32x4){v0[0] * bflo(g.x), v0[1] * bfhi(g.x), v0[2] * bflo(g.y), v0[3] * bfhi(g.y)};
                        *(f32x4*)(op + 4) = (f32x4){v1[0] * bflo(g.z), v1[1] * bfhi(g.z), v1[2] * bflo(g.w), v1[3] * bfhi(g.w)};
                    } else if (MODE == EM_PROJB) {
                        const u32x4 g = *(const u32x4*)((const bf16_t*)i0 + row * 4096 + 2048 + col);
                        const float* tp = (const float*)i1 + row * 2048 + col; const f32x4 t0 = *(const f32x4*)tp, t1 = *(const f32x4*)(tp + 4);
                        v0 = (f32x4){t0[0] + v0[0] * bflo(g.x), t0[1] + v0[1] * bfhi(g.x), t0[2] + v0[2] * bflo(g.y), t0[3] + v0[3] * bfhi(g.y)};
                        v1 = (f32x4){t1[0] + v1[0] * bflo(g.z), t1[1] + v1[1] * bfhi(g.z), t1[2] + v1[2] * bflo(g.w), t1[3] + v1[3] * bfhi(g.w)};
                        u32x4 w; w.x = cvt_pk_bf16(v0[0], v0[1]); w.y = cvt_pk_bf16(v0[2], v0[3]); w.z = cvt_pk_bf16(v1[0], v1[1]); w.w = cvt_pk_bf16(v1[2], v1[3]);
                        *(u32x4*)(ob + row * 2048 + col) = w;
                    } else if (MODE == EM_PROJAB) {
                        const u32x4 g = *(const u32x4*)((const bf16_t*)i0 + row * 4096 + 2048 + col);
                        v0 = (f32x4){v0[0] * bflo(g.x), v0[1] * bfhi(g.x), v0[2] * bflo(g.y), v0[3] * bfhi(g.y)};
                        v1 = (f32x4){v1[0] * bflo(g.z), v1[1] * bfhi(g.z), v1[2] * bflo(g.w), v1[3] * bfhi(g.w)};
                        u32x4 w; w.x = cvt_pk_bf16(v0[0], v0[1]); w.y = cvt_pk_bf16(v0[2], v0[3]); w.z = cvt_pk_bf16(v1[0], v1[1]); w.w = cvt_pk_bf16(v1[2], v1[3]);
                        *(u32x4*)(ob + row * 2048 + col) = w;
                    } else if (MODE == EM_WOUT) {
                        const float* xp = (const float*)i1 + row * 2048 + col; const f32x4 t0 = *(const f32x4*)xp, t1 = *(const f32x4*)(xp + 4);
                        const f32x4 h0 = t0 + v0, h1 = t1 + v1;
                        float* op = (float*)o0 + row * 2048 + col; *(f32x4*)op = h0; *(f32x4*)(op + 4) = h1;
                        const f32x4 g0 = *(const f32x4*)(vec + col), g1 = *(const f32x4*)(vec + col + 4);
                        u32x4 w; w.x = cvt_pk_bf16(h0[0] * g0[0], h0[1] * g0[1]); w.y = cvt_pk_bf16(h0[2] * g0[2], h0[3] * g0[3]); w.z = cvt_pk_bf16(h1[0] * g1[0], h1[1] * g1[1]); w.w = cvt_pk_bf16(h1[2] * g1[2], h1[3] * g1[3]);
                        *(u32x4*)((bf16_t*)o1 + row * 2048 + col) = w;
                        ssq[ai][m] += ((h0[0] * h0[0] + h0[1] * h0[1]) + (h0[2] * h0[2] + h0[3] * h0[3])) + ((h1[0] * h1[0] + h1[1] * h1[1]) + (h1[2] * h1[2] + h1[3] * h1[3]));
                    } else {
                        const float rs = ((const float*)i1)[row];
                        float* op = (float*)o0 + row * 2048 + col; *(f32x4*)op = v0 * rs; *(f32x4*)(op + 4) = v1 * rs;
                    }
                } }
        if (MODE == EM_WOUT) {
#pragma unroll
            for (int ai = 0; ai < 2; ++ai)
#pragma unroll
                for (int m = 0; m < 4; ++m) { float v = ssq[ai][m]; v += __shfl_xor(v, 16); v += __shfl_xor(v, 32);
                    if (fq == 0) ((float*)o2)[(size_t)(row0 + ai * HALF + m * 16) * 32 + u.pn * 4 + wc] = v; }
        }
    }
};

template <class Epi, class Sched, bool ALIGN_EPI = false, bool SP2 = false>
__device__ __forceinline__ void gemm_phase(PG8_LAS unsigned char* lds, const Gemm g, const Sched& S, const Epi& E, const int wid_in) {
    int tid_ = wid_in * 64 + mk_lane_id(); asm volatile("" : "+v"(tid_)); const int tid = tid_, wid = __builtin_amdgcn_readfirstlane(tid >> 6), lane = tid & 63, wr = wid >> 2, wc = wid & 3, fr = lane & 15, fq = lane >> 4;
    const int K = g.K, nt = K / BK;
    unsigned voffA[2], voffB[2];
#pragma unroll
    for (int i = 0; i < 2; ++i) { int R, C; stage_rc(tid * 16 + i * 8192, R, C); const int Rb = Epi::PERM ? ((R & ~31) + perm32(R & 31)) : R;
        voffA[i] = (unsigned)(R * g.lda + C) * 2u; voffB[i] = (unsigned)(Rb * g.ldb + C) * 2u; }
    const size_t kstep = (size_t)(BK * 2);
    const size_t hstepA = (size_t)HALF * g.lda * 2, hstepB = (size_t)HALF * g.ldb * 2;
    const size_t tstepA = 2 * hstepA, tstepB = 2 * hstepB;
    const unsigned ldsw = (unsigned)wid * 1024u;
    const int aoff = lds_byte(wr * 64 + fr, fq * 8), boff = lds_byte(wc * 32 + fr, fq * 8);
#define PG8_SA(b, h) (((b) * 2 + (h)) * HTB)
#define PG8_SB(b, h) ((4 + (b) * 2 + (h)) * HTB)
#define PG8_STAGE(bufoff, gbase, voff) do { _Pragma("unroll") for (int _i = 0; _i < 2; ++_i) \
        __builtin_amdgcn_global_load_lds((const unsigned*)((const char*)(gbase) + (voff)[_i]), (PG8_LAS unsigned*)(lds + (bufoff) + ldsw + _i * 8192), 16, 0, 0); } while (0)
#define PG8_LDA(dst, b, h) do { _Pragma("unroll") for (int m = 0; m < 4; ++m) _Pragma("unroll") for (int k = 0; k < 2; ++k) dst[m][k] = *(const PG8_LAS bf16x8*)(lds + PG8_SA(b, h) + aoff + m * 2048 + k * 1024); } while (0)
#define PG8_LDB(dst, b, h) do { _Pragma("unroll") for (int n = 0; n < 2; ++n) _Pragma("unroll") for (int k = 0; k < 2; ++k) dst[n][k] = *(const PG8_LAS bf16x8*)(lds + PG8_SB(b, h) + boff + n * 2048 + k * 1024); } while (0)
#define PG8_MMA(ai, bj, At, Bt) do { __builtin_amdgcn_s_setprio(1); _Pragma("unroll") for (int m = 0; m < 4; ++m) _Pragma("unroll") for (int n = 0; n < 2; ++n) _Pragma("unroll") for (int k = 0; k < 2; ++k) \
        acc[ai][bj][m][n] = __builtin_amdgcn_mfma_f32_16x16x32_bf16(Bt[n][k], At[m][k], acc[ai][bj][m][n], 0, 0, 0); __builtin_amdgcn_s_setprio(0); } while (0)
#define PG8_WAIT_V(n) asm volatile("s_waitcnt vmcnt(" #n ")" ::: "memory")
#define PG8_WAIT_L(n) asm volatile("s_waitcnt lgkmcnt(" #n ")" ::: "memory")
#define PG8_BAR __builtin_amdgcn_s_barrier()
#define PG8_SCHED __builtin_amdgcn_sched_barrier(0)
    Unit cur, nxt; int ui = 0;
    if (!S.next(0, cur)) return;
    f32x4 acc[2][2][4][2];
#pragma unroll
    for (int a = 0; a < 2; ++a)
#pragma unroll
        for (int b = 0; b < 2; ++b)
#pragma unroll
            for (int m = 0; m < 4; ++m)
#pragma unroll
                for (int n = 0; n < 2; ++n) acc[a][b][m][n] = (f32x4){0.f, 0.f, 0.f, 0.f};
    bf16x8 At[4][2], B0[2][2], B1[2][2];
    const char* cA = (const char*)g.A + (size_t)cur.pm * tstepA; const char* cB = (const char*)g.Bt + (size_t)cur.pn * tstepB;
    const int ksplit = g.A2 ? g.ksplit : 0x40000000;
    const char* cA2 = g.A2 ? (const char*)g.A2 + (size_t)cur.pm * tstepA - (size_t)ksplit * kstep : cA;
    S.a_ready(cur);
    if constexpr (SP2) {
        PG8_STAGE(PG8_SB(0, 0), cB, voffB); PG8_STAGE(PG8_SB(0, 1), cB + hstepB, voffB); PG8_STAGE(PG8_SA(0, 0), cA, voffA); PG8_STAGE(PG8_SA(0, 1), cA + hstepA, voffA);
        if (wr == 1) PG8_BAR;
        PG8_WAIT_V(2); PG8_BAR;
        PG8_STAGE(PG8_SB(1, 0), cB + kstep, voffB); PG8_STAGE(PG8_SA(1, 0), cA + kstep, voffA); PG8_STAGE(PG8_SB(1, 1), cB + hstepB + kstep, voffB);
        PG8_WAIT_V(6); PG8_BAR;
    } else {
        PG8_STAGE(PG8_SB(0, 0), cB, voffB); PG8_STAGE(PG8_SA(0, 0), cA, voffA); PG8_STAGE(PG8_SB(0, 1), cB + hstepB, voffB); PG8_STAGE(PG8_SA(0, 1), cA + hstepA, voffA);
        if (wr == 1) PG8_BAR;
        PG8_WAIT_V(4); PG8_BAR;
        PG8_STAGE(PG8_SB(1, 0), cB + kstep, voffB); PG8_STAGE(PG8_SA(1, 0), cA + kstep, voffA); PG8_STAGE(PG8_SB(1, 1), cB + hstepB + kstep, voffB);
        PG8_WAIT_V(6); PG8_BAR;
    }
    for (;;) {
        const bool has_next = S.next(ui + 1, nxt);
        const char* nA2 = (g.A2 && has_next) ? (const char*)g.A2 + (size_t)nxt.pm * tstepA - (size_t)ksplit * kstep : cA2;
        const char* nA = has_next ? (const char*)g.A + (size_t)nxt.pm * tstepA : cA; const char* nB = has_next ? (const char*)g.Bt + (size_t)nxt.pn * tstepB : cB;
#pragma unroll 1
        for (int part = 0; part < (Epi::HAS_MID ? 2 : 1); ++part) {
        if constexpr (Epi::HAS_MID) { if (part == 1) E.mid(acc, cur, wr, wc, fr, fq); }
        const int tbeg = (Epi::HAS_MID && part == 1) ? ksplit : 0, tend = (Epi::HAS_MID && part == 0) ? (ksplit < nt ? ksplit : nt) : nt;
#pragma unroll 1
        for (int t = tbeg; t < tend; t += 2) {
            const bool last = (t == nt - 2);
            const char* a1 = (t + 1 < ksplit ? cA : cA2) + (size_t)(t + 1) * kstep;
            const char* a2 = last ? nA : (t + 2 < ksplit ? cA : cA2) + (size_t)(t + 2) * kstep; const char* b2 = last ? nB : cB + (size_t)(t + 2) * kstep;
            const char* a3 = a2 + kstep; const char* b3 = b2 + kstep;
            if (last && has_next) S.a_ready(nxt);
            if constexpr (SP2) {
            PG8_LDB(B0, 0, 0); PG8_LDB(B1, 0, 1); PG8_SCHED; PG8_LDA(At, 0, 0); PG8_STAGE(PG8_SA(1, 1), a1 + hstepA, voffA);
            PG8_WAIT_V(8); PG8_WAIT_L(0); PG8_BAR; PG8_MMA(0, 0, At, B0); PG8_MMA(0, 1, At, B1); PG8_BAR; PG8_SCHED;
            PG8_LDA(At, 0, 1); PG8_STAGE(PG8_SB(0, 0), b2, voffB); PG8_STAGE(PG8_SB(0, 1), b2 + hstepB, voffB); PG8_STAGE(PG8_SA(0, 0), a2, voffA);
            PG8_WAIT_V(8); PG8_WAIT_L(0); PG8_BAR; PG8_MMA(1, 0, At, B0); PG8_MMA(1, 1, At, B1); PG8_BAR; PG8_SCHED;
            PG8_LDB(B0, 1, 0); PG8_LDB(B1, 1, 1); PG8_SCHED; PG8_LDA(At, 1, 0); PG8_STAGE(PG8_SA(0, 1), a2 + hstepA, voffA);
            PG8_WAIT_V(8); PG8_WAIT_L(0); PG8_BAR; PG8_MMA(0, 0, At, B0); PG8_MMA(0, 1, At, B1); PG8_BAR; PG8_SCHED;
            PG8_LDA(At, 1, 1); PG8_STAGE(PG8_SB(1, 0), b3, voffB); PG8_STAGE(PG8_SB(1, 1), b3 + hstepB, voffB); PG8_STAGE(PG8_SA(1, 0), a3, voffA);
            PG8_WAIT_V(8); PG8_WAIT_L(0); PG8_BAR; PG8_MMA(1, 0, At, B0); PG8_MMA(1, 1, At, B1); PG8_BAR; PG8_SCHED;
            } else {
            PG8_LDB(B0, 0, 0); PG8_SCHED; PG8_LDA(At, 0, 0); PG8_STAGE(PG8_SA(1, 1), a1 + hstepA, voffA);
            PG8_WAIT_L(8); PG8_BAR; PG8_WAIT_L(0); PG8_MMA(0, 0, At, B0); PG8_BAR; PG8_SCHED;
            PG8_LDB(B1, 0, 1); PG8_STAGE(PG8_SB(0, 0), b2, voffB);
            PG8_BAR; PG8_WAIT_L(0); PG8_MMA(0, 1, At, B1); PG8_BAR;
            PG8_LDA(At, 0, 1); PG8_STAGE(PG8_SA(0, 0), a2, voffA);
            PG8_BAR; PG8_WAIT_L(0); PG8_MMA(1, 0, At, B0); PG8_BAR; PG8_SCHED;
            PG8_STAGE(PG8_SB(0, 1), b2 + hstepB, voffB);
            PG8_WAIT_V(6); PG8_BAR; PG8_MMA(1, 1, At, B1); PG8_BAR;
            PG8_LDB(B0, 1, 0); PG8_SCHED; PG8_LDA(At, 1, 0); PG8_STAGE(PG8_SA(0, 1), a2 + hstepA, voffA);
            PG8_WAIT_L(8); PG8_BAR; PG8_WAIT_L(0); PG8_MMA(0, 0, At, B0); PG8_BAR; PG8_SCHED;
            PG8_LDB(B1, 1, 1); PG8_STAGE(PG8_SB(1, 0), b3, voffB);
            PG8_BAR; PG8_WAIT_L(0); PG8_MMA(0, 1, At, B1); PG8_BAR;
            PG8_LDA(At, 1, 1); PG8_STAGE(PG8_SA(1, 0), a3, voffA);
            PG8_BAR; PG8_WAIT_L(0); PG8_MMA(1, 0, At, B0); PG8_BAR; PG8_SCHED;
            PG8_STAGE(PG8_SB(1, 1), b3 + hstepB, voffB);
            PG8_WAIT_V(6); PG8_BAR; PG8_MMA(1, 1, At, B1); PG8_BAR;
            }
        }
        }
        if constexpr (ALIGN_EPI) { if (wr == 0) PG8_BAR; }
        if constexpr (!Epi::AFTER_DRAIN) { E(acc, cur, wr, wc, fr, fq); S.done(cur); }
        if (!has_next) break;
#pragma unroll
        for (int a = 0; a < 2; ++a)
#pragma unroll
            for (int b = 0; b < 2; ++b)
#pragma unroll
                for (int m = 0; m < 4; ++m)
#pragma unroll
                    for (int n = 0; n < 2; ++n) acc[a][b][m][n] = (f32x4){0.f, 0.f, 0.f, 0.f};
        cur = nxt; cA = nA; cA2 = nA2; cB = nB; ++ui;
        if constexpr (ALIGN_EPI) { if (wr == 1) PG8_BAR; }
    }
    PG8_WAIT_V(0);
    if constexpr (!ALIGN_EPI) { if (wr == 0) PG8_BAR; }
    PG8_BAR;
    if constexpr (Epi::AFTER_DRAIN) { E.fused(acc, cur, wr, wc, fr, fq, lds, wid, lane); S.done(cur); }
#undef PG8_SA
#undef PG8_SB
#undef PG8_STAGE
#undef PG8_LDA
#undef PG8_LDB
#undef PG8_MMA
#undef PG8_WAIT_V
#undef PG8_WAIT_L
#undef PG8_BAR
#undef PG8_SCHED
}
}
#include <hip/hip_bf16.h>
#include <cmath>
namespace attn_body {
using bf16=__hip_bfloat16;
using bf16x8=__attribute__((ext_vector_type(8)))short;
using s16x4=__attribute__((ext_vector_type(4)))short;
using f32x16=__attribute__((ext_vector_type(16)))float;
using u32x4=__attribute__((ext_vector_type(4)))unsigned;
constexpr int SEQ=16384,D=64,PQ=3072,PO=2048;
constexpr int NW=8,QBLK=32,QB=QBLK*NW,KVBLK=64,NQB=SEQ/QB;
constexpr int ATTN_UNIT_ROWS=QB;
__device__ __forceinline__ int crow(int r,int hi){return (r&3)+8*(r>>2)+4*hi;}
#define SBAR() __builtin_amdgcn_sched_barrier(0)
__device__ __forceinline__ void cmask(f32x16&p0,f32x16&p1,int jb,int qrel,int hi){
  const float NEG=-INFINITY; int kb=64*jb+4*hi;
  #pragma unroll
  for(int r=0;r<16;++r){int kv=kb+(r&3)+8*(r>>2); if(kv>qrel)p0[r]=NEG; if(kv+32>qrel)p1[r]=NEG;}
}

constexpr int NSLOT=3, SLOTB=8192, VSLOTB=16384;
constexpr int LDS_K=0, LDS_V=NSLOT*SLOTB, LDS_WS=LDS_V+NSLOT*VSLOTB, LDS_OST=0  , LDS_BYTES=LDS_WS+NW*64*4;
constexpr float C2=0.125f*1.4426950408889634f;
__device__ __forceinline__ void glds16(const void*gsrc,unsigned lds_dst){unsigned keep;
  asm volatile("s_mov_b32 %0, m0\n\ts_mov_b32 m0, %2\n\ts_nop 0\n\tglobal_load_lds_dwordx4 %1, off\n\ts_mov_b32 m0, %0":"=&s"(keep):"v"(gsrc),"s"(lds_dst):"memory");}
__device__ __forceinline__ float max3f(float a,float b,float c){float r;asm("v_max3_f32 %0, %1, %2, %3":"=v"(r):"v"(a),"v"(b),"v"(c));return r;}
__device__ __forceinline__ float max2f(float a,float b){float r;asm("v_max_f32_e32 %0, %1, %2":"=v"(r):"v"(a),"v"(b));return r;}
__device__ __forceinline__ float fadd_s(float a,float b){float r;asm("v_add_f32_e32 %0, %1, %2":"=v"(r):"v"(a),"v"(b));return r;}
__device__ __forceinline__ float fsub_s(float a,float b){float r;asm("v_sub_f32_e32 %0, %1, %2":"=v"(r):"v"(a),"v"(b));return r;}
typedef float f32x2_t __attribute__((ext_vector_type(2))); typedef __bf16 bf16x2_t __attribute__((ext_vector_type(2)));
__device__ __forceinline__ unsigned cvtpk_s(float lo,float hi){f32x2_t v={lo,hi};bf16x2_t b=__builtin_convertvector(v,bf16x2_t);return __builtin_bit_cast(unsigned,b);}
#define WAIT_BAR(N) asm volatile("s_waitcnt vmcnt(" #N ") lgkmcnt(0)\n\ts_barrier":::"memory")

__device__ __forceinline__ void qkt(f32x16&p0,f32x16&p1,const char*Kslot,const bf16x8*qr,const f32x16&negm,int r32,int hi){
  const char*kb=Kslot+hi*1024+r32*16;
  #pragma unroll
  for(int d0=0;d0<4;++d0){
    const bf16x8 b0=*reinterpret_cast<const bf16x8*>(kb+d0*2048);
    const bf16x8 b1=*reinterpret_cast<const bf16x8*>(kb+d0*2048+512);
    if(d0==0){p0=__builtin_amdgcn_mfma_f32_32x32x16_bf16(b0,qr[0],f32x16{},0,0,0);p1=__builtin_amdgcn_mfma_f32_32x32x16_bf16(b1,qr[0],f32x16{},0,0,0);}
    else{p0=__builtin_amdgcn_mfma_f32_32x32x16_bf16(b0,qr[d0],p0,0,0,0);p1=__builtin_amdgcn_mfma_f32_32x32x16_bf16(b1,qr[d0],p1,0,0,0);}}
}
typedef __attribute__((address_space(3))) const char* lds_cptr;
typedef short v4i16_t __attribute__((ext_vector_type(4)));
__device__ __forceinline__ void kload8(bf16x8*kf,lds_cptr kp){
  kf[0]=*(const __attribute__((address_space(3))) bf16x8*)(kp);      kf[1]=*(const __attribute__((address_space(3))) bf16x8*)(kp+512);
  kf[2]=*(const __attribute__((address_space(3))) bf16x8*)(kp+2048); kf[3]=*(const __attribute__((address_space(3))) bf16x8*)(kp+2560);
  kf[4]=*(const __attribute__((address_space(3))) bf16x8*)(kp+4096); kf[5]=*(const __attribute__((address_space(3))) bf16x8*)(kp+4608);
  kf[6]=*(const __attribute__((address_space(3))) bf16x8*)(kp+6144); kf[7]=*(const __attribute__((address_space(3))) bf16x8*)(kp+6656);
}
__device__ __forceinline__ void kload2(bf16x8*kf,lds_cptr kp,int j){ kf[2*j]=*(const __attribute__((address_space(3))) bf16x8*)(kp+j*2048); kf[2*j+1]=*(const __attribute__((address_space(3))) bf16x8*)(kp+j*2048+512); }
__device__ __forceinline__ s16x4 vtr(lds_cptr p){ return __builtin_bit_cast(s16x4,__builtin_amdgcn_ds_read_tr16_b64_v4i16((__attribute__((address_space(3))) v4i16_t*)p)); }
__device__ __forceinline__ float rowmax(const f32x16&p0,const f32x16&p1){
  float a=max3f(p0[0],p0[1],p1[0]),b=max3f(p0[2],p0[3],p1[1]);a=max3f(a,p1[2],p1[3]);
  #pragma unroll
  for(int r=4;r<16;r+=4){a=max3f(a,p0[r],p0[r+1]);b=max3f(b,p0[r+2],p0[r+3]);a=max3f(a,p1[r],p1[r+1]);b=max3f(b,p1[r+2],p1[r+3]);}
  const float m=max2f(a,b);
  auto rr=__builtin_amdgcn_permlane32_swap(__float_as_uint(m),__float_as_uint(m),false,false);
  return max2f(__uint_as_float(rr[0]),__uint_as_float(rr[1]));
}
__device__ __forceinline__ void pv(f32x16*o,int vb,bf16x8 pa0,bf16x8 pa1,bf16x8 pa2,bf16x8 pa3){
  #pragma unroll
  for(int d0=0;d0<4;++d0){s16x4 lo[4],hi[4];
    #pragma unroll
    for(int ks=0;ks<4;++ks){
      asm volatile("ds_read_b64_tr_b16 %0,%1 offset:%c2":"=&v"(lo[ks]):"v"(vb),"i"(d0*4096+ks*1024):"memory");
      asm volatile("ds_read_b64_tr_b16 %0,%1 offset:%c2":"=&v"(hi[ks]):"v"(vb),"i"(d0*4096+ks*1024+512):"memory");}
    asm volatile("s_waitcnt lgkmcnt(0)":::"memory");SBAR();
    #define PK(k) (bf16x8){lo[k][0],lo[k][1],lo[k][2],lo[k][3],hi[k][0],hi[k][1],hi[k][2],hi[k][3]}
    o[d0]=__builtin_amdgcn_mfma_f32_32x32x16_bf16(pa0,PK(0),o[d0],0,0,0);
    o[d0]=__builtin_amdgcn_mfma_f32_32x32x16_bf16(pa1,PK(1),o[d0],0,0,0);
    o[d0]=__builtin_amdgcn_mfma_f32_32x32x16_bf16(pa2,PK(2),o[d0],0,0,0);
    o[d0]=__builtin_amdgcn_mfma_f32_32x32x16_bf16(pa3,PK(3),o[d0],0,0,0);
    #undef PK
  }
}

#ifndef ATTN_STORE16
#define ATTN_STORE16(p,v) (*(u32x4*)(p)=(v))
#endif
template<int THRL> __device__ __forceinline__ void attn_unit(const int wid_in,int qb,const bf16*Q,const bf16*__restrict__ K,const bf16*__restrict__ V,bf16*O,char*shm){
  int tid_=wid_in*64+mk_lane_id(); asm volatile("":"+v"(tid_)); const int tid=tid_,lane=tid&63,r32=lane&31,hi=lane>>5; const int wid=__builtin_amdgcn_readfirstlane(tid>>6);
  const int q0=qb*QB;
  const bf16*Qw=Q+(long)(q0+wid*QBLK)*PQ;
  const bf16*Kh=K,*Vh=V;
  const unsigned lds0=(unsigned)(uintptr_t)shm;
  float*wsf=(float*)(shm+LDS_WS)+wid*64;
  const bf16*ksrc=Kh+(long)lane*PQ+wid*8;
  const bf16*vsrc=Vh+(long)(16*(wid&3)+(lane>>2))*PQ+(wid>>2)*32+(lane&3)*8;
  const unsigned kdst=lds0+LDS_K+wid*1024, vdst=lds0+LDS_V+wid*1024;
  #define DMA_K(t,slot) glds16(ksrc+(long)(t)*KVBLK*PQ,(unsigned)__builtin_amdgcn_readfirstlane(kdst+(slot)))
  #define DMA_V(t,slot) do{ glds16(vsrc+(long)(t)*KVBLK*PQ,(unsigned)__builtin_amdgcn_readfirstlane(vdst+2*(slot))); glds16(vsrc+64+(long)(t)*KVBLK*PQ,(unsigned)__builtin_amdgcn_readfirstlane(vdst+8192+2*(slot))); }while(0)
  const int vb0=(int)(lds0+LDS_V)+((lane>>4)&1)*32+(lane&3)*8+(4*hi+((lane&15)>>2))*64;
  const char*Kbase=shm+LDS_K; bf16x8 kf[8];
  const lds_cptr shm3=(lds_cptr)shm; const lds_cptr kp0=shm3+LDS_K+hi*1024+r32*16; const lds_cptr vp0=shm3+LDS_V+((lane>>4)&1)*32+(lane&3)*8+(4*hi+((lane&15)>>2))*64;
  const int NT=(q0+QB)/KVBLK;
  DMA_K(0,0);DMA_V(0,0);DMA_K(1,SLOTB);
  bf16x8 qr[4];
  #pragma unroll
  for(int d0=0;d0<4;++d0)qr[d0]=*reinterpret_cast<const bf16x8*>(&Qw[(long)r32*PQ+d0*16+hi*8]);
  float mhat=0.f,l_reg=0.f;f32x16 o[4];o[0]=f32x16{};o[1]=f32x16{};o[2]=f32x16{};o[3]=f32x16{};asm volatile("":"+v"(o[0]));asm volatile("":"+v"(o[1]));asm volatile("":"+v"(o[2]));asm volatile("":"+v"(o[3]));
  const int qrel=wid*QBLK+r32;
  #define CMASK(P0,P1,t) do{int jb_=(t)-(NT-4); if(jb_>=0)cmask(P0,P1,jb_,qrel,hi);}while(0)
  bool resc=false;
  #define START(P0,P1) do{ const float rm=rowmax(P0,P1); resc=false; mhat=rm; \
    _Pragma("unroll") for(int r=0;r<16;++r){P0[r]=__builtin_amdgcn_exp2f(fsub_s(P0[r],mhat));} }while(0)
  #define RESC() do{ if(resc){ asm volatile("s_waitcnt lgkmcnt(0)":::"memory"); \
      _Pragma("unroll") for(int d_=0;d_<4;++d_) _Pragma("unroll") for(int r=0;r<16;++r)o[d_][r]*=wsf[crow(r,hi)]; } }while(0)
  f32x16 pA0,pA1,pB0,pB1;
  int sl_prev=0,sl_cur=0,sl_next=SLOTB;
  #define ROT() do{sl_prev=sl_cur;sl_cur=sl_next;sl_next=(sl_next==(NSLOT-1)*SLOTB)?0:sl_next+SLOTB;}while(0)
  DMA_K(2,2*SLOTB);
  WAIT_BAR(4);
  qkt(pA0,pA1,Kbase,qr,f32x16{},r32,hi);asm volatile("s_nop 15\n\ts_nop 7":"+v"(pA0),"+v"(pA1));CMASK(pA0,pA1,0);
  START(pA0,pA1);
  _Pragma("unroll") for(int r=0;r<16;++r)pA1[r]=__builtin_amdgcn_exp2f(fsub_s(pA1[r],mhat));
  WAIT_BAR(0);
  DMA_K(3,0);DMA_V(1,SLOTB);
  ROT();
  kload8(kf,kp0+sl_cur);
  WAIT_BAR(3);
  s16x4 vlo[16],vhi[16]; u32x4 pw0,pw1,pw2,pw3;
  #define PKW(P,B) cvtpk_s(P[B],P[B+1])
  #define PAF(k) __builtin_bit_cast(bf16x8,pw##k)
  #define VFR(i) (bf16x8){vlo[i][0],vlo[i][1],vlo[i][2],vlo[i][3],vhi[i][0],vhi[i][1],vhi[i][2],vhi[i][3]}
  #define PIN(x) asm volatile("":"+v"(x))
  #define MX3(a,b,c) __builtin_fmaxf(__builtin_fmaxf((a),(b)),(c))
  #define GAPA(MF,A0,A1,A2,A3,W0,W1,PW) do{ MF; sacc+=A0; sacc+=A1; sacc+=A2; sacc+=A3; PIN(sacc); W0; W1; PIN(PW); SBAR(); }while(0)
  #define EX(v) __builtin_amdgcn_exp2f(v)
  #define GAPB(MF,X,B) do{ MF; X[B]=EX(X[B]-mhat); X[B+1]=EX(X[B+1]-mhat); PIN(X); SBAR(); }while(0)
  #define VRD(i) do{ vlo[i]=vtr(vp_+(((i)>>2)*4096+((i)&3)*1024)); vhi[i]=vtr(vp_+(((i)>>2)*4096+((i)&3)*1024+512)); }while(0)
  #define KRD(G,j) do{ if(G){ kload2(kf,kp0+sl_next,j); SBAR(); } }while(0)
  #define STEP(C0,C1,P0,P1,t,GK,GV,GL) do{ SBAR(); \
    const lds_cptr vp_=vp0+2*sl_prev; \
    float sacc=(P0[0]+P0[1]); \
    GAPA(C0=__builtin_amdgcn_mfma_f32_32x32x16_bf16(kf[0],qr[0],f32x16{},0,0,0), P0[2],P0[3],P0[4],P0[5],     pw0[0]=PKW(P0,0), pw0[1]=PKW(P0,2), pw0); \
    GAPA(C1=__builtin_amdgcn_mfma_f32_32x32x16_bf16(kf[1],qr[0],f32x16{},0,0,0), P0[6],P0[7],P0[8],P0[9],     pw0[2]=PKW(P0,4), pw0[3]=PKW(P0,6), pw0); \
    GAPA(C0=__builtin_amdgcn_mfma_f32_32x32x16_bf16(kf[2],qr[1],C0,0,0,0),   P0[10],P0[11],P0[12],P0[13], pw1[0]=PKW(P0,8), pw1[1]=PKW(P0,10), pw1); \
    GAPA(C1=__builtin_amdgcn_mfma_f32_32x32x16_bf16(kf[3],qr[1],C1,0,0,0),   P0[14],P0[15],P1[0],P1[1],   pw1[2]=PKW(P0,12),pw1[3]=PKW(P0,14), pw1); \
    VRD(0); SBAR(); GAPA(C0=__builtin_amdgcn_mfma_f32_32x32x16_bf16(kf[4],qr[2],C0,0,0,0),   P1[2],P1[3],P1[4],P1[5],     pw2[0]=PKW(P1,0), pw2[1]=PKW(P1,2), pw2); \
    VRD(4); SBAR(); GAPA(C1=__builtin_amdgcn_mfma_f32_32x32x16_bf16(kf[5],qr[2],C1,0,0,0),   P1[6],P1[7],P1[8],P1[9],     pw2[2]=PKW(P1,4), pw2[3]=PKW(P1,6), pw2); \
    VRD(8); SBAR(); GAPA(C0=__builtin_amdgcn_mfma_f32_32x32x16_bf16(kf[6],qr[3],C0,0,0,0),   P1[10],P1[11],P1[12],P1[13], pw3[0]=PKW(P1,8), pw3[1]=PKW(P1,10), pw3); \
    VRD(12); SBAR(); GAPA(C1=__builtin_amdgcn_mfma_f32_32x32x16_bf16(kf[7],qr[3],C1,0,0,0),   P1[14],P1[15],0.f,0.f,       pw3[2]=PKW(P1,12),pw3[3]=PKW(P1,14), pw3); \
    l_reg+=sacc; \
    if(GK){DMA_K((t)+3,sl_cur);} if(GV){DMA_V((t)+1,sl_next);} \
    CMASK(C0,C1,t); \
    { float a=MX3(C0[0],C0[1],C1[0]),b=MX3(C0[2],C0[3],C1[1]); a=MX3(a,C1[2],C1[3]); \
      _Pragma("unroll") for(int r=4;r<16;r+=4){a=MX3(a,C0[r],C0[r+1]);b=MX3(b,C0[r+2],C0[r+3]);a=MX3(a,C1[r],C1[r+1]);b=MX3(b,C1[r+2],C1[r+3]);} \
      float rm=__builtin_fmaxf(a,b); { auto rr=__builtin_amdgcn_permlane32_swap(__float_as_uint(rm),__float_as_uint(rm),false,false); rm=__builtin_fmaxf(__uint_as_float(rr[0]),__uint_as_float(rr[1])); } \
      rm-=mhat; resc=false; \
      if(__builtin_expect(__any(rm>(float)THRL),0)){ const float dl=__builtin_fmaxf(rm,0.f); mhat+=dl; \
        const float f=__builtin_amdgcn_exp2f(-dl); l_reg*=f; if(hi==0)wsf[r32]=f; resc=true; } } \
    SBAR(); \
    GAPB(o[0]=__builtin_amdgcn_mfma_f32_32x32x16_bf16(PAF(0),VFR(0),o[0],0,0,0), C0,0); VRD(1); SBAR(); \
    GAPB(o[1]=__builtin_amdgcn_mfma_f32_32x32x16_bf16(PAF(0),VFR(4),o[1],0,0,0), C0,2); VRD(5); SBAR(); \
    KRD(GL,0); GAPB(o[2]=__builtin_amdgcn_mfma_f32_32x32x16_bf16(PAF(0),VFR(8),o[2],0,0,0), C0,4); VRD(9); SBAR(); \
    KRD(GL,1); GAPB(o[3]=__builtin_amdgcn_mfma_f32_32x32x16_bf16(PAF(0),VFR(12),o[3],0,0,0), C0,6); VRD(13); SBAR(); \
    KRD(GL,2); GAPB(o[0]=__builtin_amdgcn_mfma_f32_32x32x16_bf16(PAF(1),VFR(1),o[0],0,0,0), C0,8); VRD(2); SBAR(); \
    KRD(GL,3); GAPB(o[1]=__builtin_amdgcn_mfma_f32_32x32x16_bf16(PAF(1),VFR(5),o[1],0,0,0), C0,10); VRD(6); SBAR(); \
    GAPB(o[2]=__builtin_amdgcn_mfma_f32_32x32x16_bf16(PAF(1),VFR(9),o[2],0,0,0), C0,12); VRD(10); SBAR(); \
    GAPB(o[3]=__builtin_amdgcn_mfma_f32_32x32x16_bf16(PAF(1),VFR(13),o[3],0,0,0), C0,14); VRD(14); SBAR(); \
    GAPB(o[0]=__builtin_amdgcn_mfma_f32_32x32x16_bf16(PAF(2),VFR(2),o[0],0,0,0), C1,0); VRD(3); SBAR(); \
    GAPB(o[1]=__builtin_amdgcn_mfma_f32_32x32x16_bf16(PAF(2),VFR(6),o[1],0,0,0), C1,2); VRD(7); SBAR(); \
    GAPB(o[2]=__builtin_amdgcn_mfma_f32_32x32x16_bf16(PAF(2),VFR(10),o[2],0,0,0), C1,4); VRD(11); SBAR(); \
    GAPB(o[3]=__builtin_amdgcn_mfma_f32_32x32x16_bf16(PAF(2),VFR(14),o[3],0,0,0), C1,6); VRD(15); SBAR(); \
    GAPB(o[0]=__builtin_amdgcn_mfma_f32_32x32x16_bf16(PAF(3),VFR(3),o[0],0,0,0), C1,8); \
    GAPB(o[1]=__builtin_amdgcn_mfma_f32_32x32x16_bf16(PAF(3),VFR(7),o[1],0,0,0), C1,10); \
    GAPB(o[2]=__builtin_amdgcn_mfma_f32_32x32x16_bf16(PAF(3),VFR(11),o[2],0,0,0), C1,12); \
    GAPB(o[3]=__builtin_amdgcn_mfma_f32_32x32x16_bf16(PAF(3),VFR(15),o[3],0,0,0), C1,14); \
    }while(0)
  int t=1;
  #undef CMASK
  #define CMASK(P0,P1,t) do{}while(0)
  for(;t+5<NT;t+=2){
    STEP(pB0,pB1,pA0,pA1,t,true,true,true);     WAIT_BAR(3); RESC(); ROT();
    STEP(pA0,pA1,pB0,pB1,t+1,true,true,true);   WAIT_BAR(3); RESC(); ROT();
  }
  #undef CMASK
  #define CMASK(P0,P1,t) do{int jb_=(t)-(NT-4); if(jb_>=0)cmask(P0,P1,jb_,qrel,hi);}while(0)
  #define ENDW(tt) do{ if((tt)+3<NT){WAIT_BAR(3);} else if((tt)+2<NT){WAIT_BAR(2);} else {WAIT_BAR(0);} }while(0)
  for(;t+1<NT;t+=2){
    STEP(pB0,pB1,pA0,pA1,t,(t+3<NT),(t+1<NT),(t+1<NT));       ENDW(t);   RESC(); ROT();
    STEP(pA0,pA1,pB0,pB1,t+1,(t+4<NT),(t+2<NT),(t+2<NT));     ENDW(t+1); RESC(); ROT();
  }
  STEP(pB0,pB1,pA0,pA1,NT-1,false,false,false); RESC();
  { float sacc=pB0[0]+pB0[1]; _Pragma("unroll") for(int r=2;r<16;++r)sacc+=pB0[r]; _Pragma("unroll") for(int r=0;r<16;++r)sacc+=pB1[r]; l_reg+=sacc;
    pw0=(u32x4){PKW(pB0,0),PKW(pB0,2),PKW(pB0,4),PKW(pB0,6)};pw1=(u32x4){PKW(pB0,8),PKW(pB0,10),PKW(pB0,12),PKW(pB0,14)};pw2=(u32x4){PKW(pB1,0),PKW(pB1,2),PKW(pB1,4),PKW(pB1,6)};pw3=(u32x4){PKW(pB1,8),PKW(pB1,10),PKW(pB1,12),PKW(pB1,14)};
    SBAR(); pv(o,vb0+2*sl_cur,PAF(0),PAF(1),PAF(2),PAF(3)); }
  asm volatile("s_waitcnt lgkmcnt(0)\n\ts_barrier":::"memory");
  #undef PKW
  #undef PAF
  #undef VFR
  #undef PIN
  #undef MX3
  #undef GAPA
  #undef GAPB
  #undef EX
  #undef VRD
  #undef KRD
  #undef STEP
  #undef ENDW
  {auto rr=__builtin_amdgcn_permlane32_swap(__float_as_uint(l_reg),__float_as_uint(l_reg),false,false);l_reg=__uint_as_float(rr[0])+__uint_as_float(rr[1]);}
  if(hi==0)wsf[32+r32]=l_reg;asm volatile("s_waitcnt lgkmcnt(0)":::"memory");
  float rli[16];
  #pragma unroll
  for(int r=0;r<16;++r)rli[r]=__builtin_amdgcn_rcpf(wsf[32+crow(r,hi)]);
  bf16*Ow=O+(long)(q0+wid*QBLK)*PO;
  { bf16*stg=(bf16*)(shm+LDS_OST)+wid*4096;
    #pragma unroll
    for(int r=0;r<16;++r){const int orow=crow(r,hi);
      #pragma unroll
      for(int d0=0;d0<4;++d0)stg[orow*128+d0*32+r32]=__float2bfloat16(o[d0][r]*rli[r]);}
    asm volatile("s_waitcnt lgkmcnt(0)":::"memory");
    #pragma unroll
    for(int i=0;i<8;++i){const int row=i*4+(lane>>4),ch=lane&15; const u32x4 v=*(const u32x4*)(stg+row*128+ch*8); ATTN_STORE16(Ow+(long)row*PO+ch*8,v);} }
  asm volatile("s_waitcnt lgkmcnt(0)\n\ts_barrier":::"memory");
  #undef DMA_K
  #undef DMA_V
  #undef CMASK
  #undef START
  #undef RESC
  #undef ROT
}
constexpr int ATTN_LDS_BYTES=LDS_BYTES;
template<int THRL=8> __device__ __forceinline__ void attn_phase(char*lds,const bf16*PD,bf16*O,int vcu,const int wid,unsigned*qhead,volatile __attribute__((address_space(3))) unsigned*bc){
  const int xg=vcu>>5;
  for(;;){
    if(threadIdx.x==0) *bc=__hip_atomic_fetch_add(qhead,1u,__ATOMIC_RELAXED,__HIP_MEMORY_SCOPE_AGENT);
    __syncthreads();
    const int u=(int)__builtin_amdgcn_readfirstlane((int)*bc);
    if(u>=128)break;
    const int pr=2*xg+(u&1),qb=63-(u>>1),h=pr>>1,m=pr&1;
    const bf16*Q=PD+h*128+m*64,*K=PD+1024+h*128+m*64,*V=PD+2048+h*128; bf16*Op=O+m*1024+h*128;
    attn_unit<THRL>(wid,qb,Q,K,V,Op,lds);
  }
}
#undef SBAR
#undef WAIT_BAR
}
#define GAS __attribute__((address_space(1)))
#define LAS __attribute__((address_space(3)))
typedef unsigned short bf16;
typedef unsigned v4u __attribute__((ext_vector_type(4)));
typedef float f32x4 __attribute__((ext_vector_type(4)));
typedef short bf16x8 __attribute__((ext_vector_type(8)));
typedef GAS unsigned gu32;
typedef GAS unsigned long long gu64;
#define RLX_AGENT __ATOMIC_RELAXED, __HIP_MEMORY_SCOPE_AGENT
#define LDS_WAIT() asm volatile("s_waitcnt lgkmcnt(0)" ::: "memory")
#define VM_WAIT() asm volatile("s_waitcnt vmcnt(0)" ::: "memory")
__device__ __forceinline__ unsigned long long rt() { return __builtin_amdgcn_s_memrealtime(); }
__device__ __forceinline__ unsigned f2bf(float f) { unsigned u = __builtin_bit_cast(unsigned, f); return (u + 0x7fffu + ((u >> 16) & 1u)) >> 16; }
__device__ __forceinline__ unsigned pk2(float lo, float hi) { return f2bf(lo) | (f2bf(hi) << 16); }

#define XB_TMO      128
#define XB_XCNT(j)  (256  + 64 * (j))
#define XB_XSUB(j)  (1280 + 64 * (j))
#define XB_XGEN(j)  (2304 + 64 * (j))
#define XB_TOP      3328
#define XB_TOPGEN   3392
#define XCD_BAR_WORDS 3456
#define XB_SPIN_CAP (1u << 18)

__device__ __forceinline__ unsigned xb_ld(unsigned* p)              { return __hip_atomic_load(p, __ATOMIC_RELAXED, __HIP_MEMORY_SCOPE_AGENT); }
__device__ __forceinline__ unsigned xb_add(unsigned* p, unsigned v) { return __hip_atomic_fetch_add(p, v, __ATOMIC_RELAXED, __HIP_MEMORY_SCOPE_AGENT); }
__device__ __forceinline__ unsigned xb_xcc_id() { return (unsigned)__builtin_amdgcn_s_getreg((3 << 11) | 20) & 0xFu; }
#define XB_SPIN(cond, bar) do { unsigned _sp = 0; while (cond) { __builtin_amdgcn_s_sleep(1); \
    if ((++_sp & 255u) == 0u) { if (xb_ld(&(bar)[XB_TMO])) break; if (_sp > XB_SPIN_CAP) { atomicAdd(&(bar)[XB_TMO], 1u); break; } } } } while (0)

struct XcdBarrier {
    unsigned* bar; unsigned x;
    volatile LAS unsigned* st;
};

__device__ __forceinline__ XcdBarrier xcd_barrier_post(unsigned* bar, volatile LAS unsigned* st) {
    XcdBarrier b; b.bar = bar; b.x = xb_xcc_id(); b.st = st;
    if (threadIdx.x == 0) (void)xb_add(&bar[XB_XCNT(b.x)], 1u);
    return b;
}
__device__ __forceinline__ void xcd_barrier_complete(unsigned* bar, unsigned x, unsigned& nloc, unsigned& nx) {
    const unsigned G = gridDim.x * gridDim.y * gridDim.z;
    unsigned sum, cnt, mine, sp = 0u;
    for (;;) {
        sum = 0u; cnt = 0u; mine = 0u;
#pragma unroll
        for (unsigned j = 0; j < 16; ++j) { const unsigned c = xb_ld(&bar[XB_XCNT(j)]); sum += c; cnt += (c > 0u) ? 1u : 0u; mine = (j == x) ? c : mine; }
        if (sum == G) break;
        __builtin_amdgcn_s_sleep(1);
        if ((++sp & 255u) == 0u) { if (xb_ld(&bar[XB_TMO])) break; if (sp > XB_SPIN_CAP) { atomicAdd(&bar[XB_TMO], 1u); break; } }
    }
    nloc = mine > 0u ? mine : 1u; nx = cnt > 0u ? cnt : 1u;
}

__device__ __forceinline__ void xcd_barrier(const XcdBarrier& b) {
    asm volatile("s_waitcnt vmcnt(0)" ::: "memory");
    __syncthreads();
    if (threadIdx.x == 0) {
        unsigned* bar = b.bar;
        __builtin_amdgcn_s_waitcnt(0);
        unsigned nloc = b.st[0], nx = b.st[1];
        if (nloc == 0u) { xcd_barrier_complete(bar, b.x, nloc, nx); b.st[0] = nloc; b.st[1] = nx; }
        const unsigned old = xb_add(&bar[XB_XSUB(b.x)], 1u);
        const unsigned gen = old / nloc;
        if (old + 1u == (gen + 1u) * nloc) {
            __builtin_amdgcn_fence(__ATOMIC_RELEASE, "agent");
            asm volatile("s_waitcnt vmcnt(0)" ::: "memory");
            const unsigned og = xb_add(&bar[XB_TOP], 1u);
            const unsigned tg = og / nx;
            if (og + 1u == (tg + 1u) * nx) xb_add(&bar[XB_TOPGEN], 1u);
            else XB_SPIN(xb_ld(&bar[XB_TOPGEN]) == tg, bar);
            __builtin_amdgcn_fence(__ATOMIC_ACQUIRE, "agent");
            xb_add(&bar[XB_XGEN(b.x)], 1u);
            asm volatile("s_waitcnt vmcnt(0)" ::: "memory");
        } else {
            XB_SPIN(xb_ld(&bar[XB_XGEN(b.x)]) == gen, bar);
            __builtin_amdgcn_fence(__ATOMIC_ACQUIRE, "agent");
            asm volatile("s_waitcnt vmcnt(0)" ::: "memory");
        }
    }
    __syncthreads();
}
constexpr int NWAVES = 8;
constexpr int S_ = 16384, DM = 2048;
constexpr int NPH = 16;
#ifndef MK_PER_PHASE
#define MK_PER_PHASE 0
#endif
constexpr size_t MiB = 1u << 20;
constexpr size_t WS_CTL = 0, CTL_ZERO_BYTES = 1 * MiB;
constexpr size_t WS_WA = 1 * MiB, WS_WB = 5 * MiB, WS_WOUT = 9 * MiB, WS_WS = 17 * MiB, WS_LORA = 25 * MiB;
constexpr size_t WS_WIN = 27 * MiB, WS_PR = 69 * MiB, WS_PD = 181 * MiB, WS_PG = 277 * MiB;
constexpr size_t WS_A = 405 * MiB, WS_E = 437 * MiB, WS_G = 469 * MiB, WS_END = 507 * MiB;
constexpr size_t WS_SCN = 27 * MiB, WS_SCAL = 123 * MiB, WS_SLOC = 127 * MiB, WS_ASEG = 143 * MiB, WS_SIN = 159 * MiB;
constexpr size_t WS_YA = 91 * MiB, WS_OATT = 27 * MiB, WS_YB = 437 * MiB, WS_Z = 405 * MiB  , WS_T1 = 123 * MiB, WS_MERGED = 27 * MiB;
constexpr size_t WS_H2 = 123 * MiB, WS_XN2 = 288 * MiB  , WS_UTAB = 251 * MiB, WS_SCORES = 379 * MiB;
constexpr size_t WS_PART = 1 * MiB  , WS_RSTD = 3 * MiB  ;
constexpr int TAB_REC = 2304, TAB_V = 1024, TAB_US = 2048, TAB_VS = 2112;
constexpr size_t OUT_XN = 0, OUT_RKV = 0, OUT_LIN = 96 * MiB, OUT_YLOC = 96 * MiB  ;
constexpr int CW_BAR = 4096;
constexpr int RING_OFF = 0, RING_BYTES = 131072;
constexpr int LDSCTL_OFF = RING_BYTES, MISC_OFF = LDSCTL_OFF + 320;
constexpr int LDS_BYTES = 147456;
constexpr int NSEG = 64, SEGLEN = S_ / NSEG;
static_assert(WS_END <= 512 * MiB && LDS_BYTES <= 160 * 1024 && MISC_OFF + 128 <= LDS_BYTES, "workspace / LDS map");

typedef float f32x2 __attribute__((ext_vector_type(2)));
struct Args { const float* in[28]; float* out; unsigned char* ws; int ph_lo, ph_hi; };

struct Frame {
    LAS unsigned char* lds; volatile LAS unsigned* MISC; gu32* ctl;
    int tid, lane, wave, vcu, G;
};

__device__ __forceinline__ float bf2f(unsigned short b) { return __uint_as_float((unsigned)b << 16); }
__device__ __forceinline__ float wave_sum(float v) {
#pragma unroll
    for (int o = 1; o < 64; o <<= 1) v += __shfl_xor(v, o);
    return v;
}
__device__ __forceinline__ float wave_max(float v) {
#pragma unroll
    for (int o = 1; o < 64; o <<= 1) v = fmaxf(v, __shfl_xor(v, o));
    return v;
}
template <int CTRL, int RM> __device__ __forceinline__ float dppf(float oldv, float x) { return __builtin_bit_cast(float, __builtin_amdgcn_update_dpp(__builtin_bit_cast(int, oldv), __builtin_bit_cast(int, x), CTRL, RM, 0xf, false)); }
__device__ __forceinline__ float wsum(float v) {
    v += dppf<0xB1, 0xf>(v, v); v += dppf<0x4E, 0xf>(v, v); v += dppf<0x141, 0xf>(v, v); v += dppf<0x140, 0xf>(v, v);
    v += dppf<0x142, 0xa>(0.f, v); v += dppf<0x143, 0xc>(0.f, v);
    return __builtin_bit_cast(float, __builtin_amdgcn_readlane(__builtin_bit_cast(int, v), 63));
}
__device__ __forceinline__ float wmax(float v) {
    v = fmaxf(v, dppf<0xB1, 0xf>(v, v)); v = fmaxf(v, dppf<0x4E, 0xf>(v, v)); v = fmaxf(v, dppf<0x141, 0xf>(v, v)); v = fmaxf(v, dppf<0x140, 0xf>(v, v));
    v = fmaxf(v, dppf<0x142, 0xa>(0.f, v)); v = fmaxf(v, dppf<0x143, 0xc>(0.f, v));
    return __builtin_bit_cast(float, __builtin_amdgcn_readlane(__builtin_bit_cast(int, v), 63));
}
__device__ __forceinline__ float sigmf(float x) { return __builtin_amdgcn_rcpf(1.0f + __expf(-x)); }

__device__ __forceinline__ void transpose_block(const float* W, int ldw, int k0, int n0, int kvalid, bf16* WT, int ldt, int drow0, LAS float* scr, int lane) {
    float tv[32];
#pragma unroll
    for (int i = 0; i < 32; ++i) { const int k = k0 + 2 * i + (lane >> 5); tv[i] = (k < kvalid) ? W[(size_t)k * ldw + n0 + (lane & 31)] : 0.f; }
#pragma unroll
    for (int i = 0; i < 32; ++i) scr[(2 * i + (lane >> 5)) * 33 + (lane & 31)] = tv[i];
    LDS_WAIT(); asm volatile("" ::: "memory");
    const int c = lane & 7;
#pragma unroll
    for (int j = 0; j < 4; ++j) { const int n = (lane >> 3) + 8 * j; const LAS float* s = scr + (8 * c) * 33 + n;
        v4u o; o.x = pk2(s[0 * 33], s[1 * 33]); o.y = pk2(s[2 * 33], s[3 * 33]); o.z = pk2(s[4 * 33], s[5 * 33]); o.w = pk2(s[6 * 33], s[7 * 33]);
        *(GAS v4u*)(WT + (size_t)(drow0 + n) * ldt + k0 + 8 * c) = o; }
    LDS_WAIT(); asm volatile("" ::: "memory");
}
__device__ __forceinline__ void rms_row_to_bf16(const float* xrow, const float* g, bf16* orow, int lane) {
    const GAS f32x4* xr = (const GAS f32x4*)xrow + lane; const f32x4* gr = (const f32x4*)g + lane;
    f32x4 v[8]; float s = 0.f;
#pragma unroll
    for (int j = 0; j < 8; ++j) { v[j] = xr[64 * j]; s += (v[j].x * v[j].x + v[j].y * v[j].y) + (v[j].z * v[j].z + v[j].w * v[j].w); }
    const float rstd = rsqrtf(wave_sum(s) * (1.f / 2048.f) + 1e-6f);
    GAS unsigned long long* o8 = (GAS unsigned long long*)orow + lane;
#pragma unroll
    for (int j = 0; j < 8; ++j) { const f32x4 gg = gr[64 * j];
        o8[64 * j] = (unsigned long long)pk2(v[j].x * rstd * gg.x, v[j].y * rstd * gg.y) | ((unsigned long long)pk2(v[j].z * rstd * gg.z, v[j].w * rstd * gg.w) << 32); }
}

__device__ __forceinline__ void rms_row2_to_bf16(const float* xa, const float* xb, const float* g, bf16* oa, bf16* ob_, int lane) {
    const GAS f32x4* xr = (const GAS f32x4*)xa + lane; const GAS f32x4* yr = (const GAS f32x4*)xb + lane; const f32x4* gr = (const f32x4*)g + lane;
    f32x4 v[8], w[8]; float s = 0.f, t = 0.f;
#pragma unroll
    for (int j = 0; j < 8; ++j) { v[j] = __builtin_nontemporal_load(xr + 64 * j); w[j] = __builtin_nontemporal_load(yr + 64 * j); }
#pragma unroll
    for (int j = 0; j < 8; ++j) { s += (v[j].x * v[j].x + v[j].y * v[j].y) + (v[j].z * v[j].z + v[j].w * v[j].w); t += (w[j].x * w[j].x + w[j].y * w[j].y) + (w[j].z * w[j].z + w[j].w * w[j].w); }
    const float rs = rsqrtf(wsum(s) * (1.f / 2048.f) + 1e-6f), rt = rsqrtf(wsum(t) * (1.f / 2048.f) + 1e-6f);
    GAS unsigned long long* o8 = (GAS unsigned long long*)oa + lane; GAS unsigned long long* p8 = (GAS unsigned long long*)ob_ + lane;
#pragma unroll
    for (int j = 0; j < 8; ++j) { const f32x4 gg = gr[64 * j];
        o8[64 * j] = (unsigned long long)pk2(v[j].x * rs * gg.x, v[j].y * rs * gg.y) | ((unsigned long long)pk2(v[j].z * rs * gg.z, v[j].w * rs * gg.w) << 32);
        p8[64 * j] = (unsigned long long)pk2(w[j].x * rt * gg.x, w[j].y * rt * gg.y) | ((unsigned long long)pk2(w[j].z * rt * gg.z, w[j].w * rt * gg.w) << 32); }
}

template <int K, int VAR = 0> __device__ __forceinline__ void fmac_dpp(float& acc, float op, float s) {
    if (VAR == 0) asm("v_fmac_f32_dpp %0, %1, %2 quad_perm:[%c3,%c3,%c3,%c3] row_mask:0xf bank_mask:0xf" : "+v"(acc) : "v"(op), "v"(s), "i"(K));
    else asm("v_fmac_f32_e32 %0, %1, %2" : "+v"(acc) : "v"(op), "v"(s)); }
template <int K, int VAR = 0> __device__ __forceinline__ void mulip_dpp(float& s, float op) {
    if (VAR == 0) asm("v_mul_f32_dpp %0, %1, %0 quad_perm:[%c2,%c2,%c2,%c2] row_mask:0xf bank_mask:0xf" : "+v"(s) : "v"(op), "i"(K));
    else asm("v_mul_f32_e32 %0, %1, %0" : "+v"(s) : "v"(op)); }
#define SCAN_FOR_C(...) _Pragma("unroll") for (int j = 0; j < 4; ++j) { \
    { constexpr int k = 0; _Pragma("unroll") for (int i = 0; i < 4; ++i) { const int c = 16 * j + 4 * k + i; __VA_ARGS__ } } \
    { constexpr int k = 1; _Pragma("unroll") for (int i = 0; i < 4; ++i) { const int c = 16 * j + 4 * k + i; __VA_ARGS__ } } \
    { constexpr int k = 2; _Pragma("unroll") for (int i = 0; i < 4; ++i) { const int c = 16 * j + 4 * k + i; __VA_ARGS__ } } \
    { constexpr int k = 3; _Pragma("unroll") for (int i = 0; i < 4; ++i) { const int c = 16 * j + 4 * k + i; __VA_ARGS__ } } }

constexpr int SCAN_CH = 4;
constexpr int SC_RING = 0, SC_VG = 2 * SCAN_CH * 320, SC_Y = SC_VG + 2 * SCAN_CH * 64, SC_SLOT_F = SC_Y + 2 * SCAN_CH * 128;
static_assert(4 * SC_SLOT_F * 4 <= RING_BYTES && 8 * 3 * 32 * 144 <= RING_BYTES && 8 * 10240 <= RING_BYTES && 8 * 16384 <= RING_BYTES, "per-wave LDS regions of the scan / scan-output / PEER / prologue phases fit the ring");
__device__ __forceinline__ void scan4_phase(const int lane, const int wave, const int vcu, const int G, unsigned char* ws, unsigned char* ob, const bf16* RKV, LAS float* ldsf) {
    constexpr int CH = SCAN_CH, NCHUNK = SEGLEN / CH;
#define SCAN_BAR() do { asm volatile("s_waitcnt lgkmcnt(0)" ::: "memory"); __builtin_amdgcn_s_barrier(); asm volatile("" ::: "memory"); } while (0)
    const int slot = wave & 3; LAS float* sl = ldsf + slot * SC_SLOT_F;
    for (int round = 0; round * G * 4 < 16 * NSEG; ++round) {
        const int task = round * G * 4 + vcu * 4 + slot; const bool valid = task < 16 * NSEG; const int h = valid ? task / NSEG : 0, seg = valid ? task % NSEG : 0; const int t0 = seg * SEGLEN;
        if (wave >= 4) {
            const bf16* SCN = (const bf16*)(ws + WS_SCN) + ((size_t)h * S_) * 192; const bf16* Eb = (const bf16*)(ws + WS_E);
            bf16* YL = (bf16*)(ob + OUT_YLOC) + ((size_t)h * S_) * 64 + lane; bf16* ZZ = (bf16*)(ws + WS_Z) + ((size_t)h * S_) * 64 + lane;
            unsigned short pk[CH], pb[CH], pt[CH], pr[CH], pe[CH], pv[CH];
#define SCAN_ISSUE(n) do { const int tc_ = t0 + (n) * CH; \
            _Pragma("unroll") for (int s = 0; s < CH; ++s) { const size_t t = (size_t)(tc_ + s); \
                pk[s] = SCN[t * 192 + lane]; pb[s] = SCN[t * 192 + 64 + lane]; pt[s] = SCN[t * 192 + 128 + lane]; \
                pr[s] = RKV[t * 3072 + h * 64 + lane]; pe[s] = Eb[t * 1024 + h * 64 + lane]; pv[s] = RKV[t * 3072 + 2048 + h * 64 + lane]; } } while (0)
#define SCAN_WRITE(n) do { const int b_ = (n) & 1; \
            _Pragma("unroll") for (int s = 0; s < CH; ++s) { LAS float* q = sl + SC_RING + (b_ * CH + s) * 320; \
                q[lane] = bf2f(pk[s]); q[64 + lane] = bf2f(pr[s]); q[128 + lane] = __expf(-bf2f(pe[s])); q[192 + lane] = bf2f(pb[s]); q[256 + lane] = bf2f(pt[s]); \
                sl[SC_VG + (b_ * CH + s) * 64 + lane] = bf2f(pv[s]); } } while (0)
#define SCAN_YSTORE(n) do { const int tc_ = t0 + (n) * CH; const int b_ = (n) & 1; \
            _Pragma("unroll") for (int s = 0; s < CH; ++s) { YL[(size_t)(tc_ + s) * 64] = (unsigned short)f2bf(sl[SC_Y + (b_ * CH + s) * 128 + lane]); ZZ[(size_t)(tc_ + s) * 64] = (unsigned short)f2bf(sl[SC_Y + (b_ * CH + s) * 128 + 64 + lane]); } } while (0)
            if (valid) { SCAN_ISSUE(0); SCAN_WRITE(0); SCAN_ISSUE(1); }
            SCAN_BAR();
#pragma unroll 1
            for (int n = 0; n < NCHUNK; ++n) {
                if (valid) { if (n + 1 < NCHUNK) SCAN_WRITE(n + 1); if (n >= 1) SCAN_YSTORE(n - 1); if (n + 2 < NCHUNK) SCAN_ISSUE(n + 2); }
                SCAN_BAR();
            }
            if (valid) SCAN_YSTORE(NCHUNK - 1);
#undef SCAN_ISSUE
#undef SCAN_WRITE
#undef SCAN_YSTORE
        } else {
            float S[64], M[64]; int ln_ = lane; asm volatile("" : "+v"(ln_));
#pragma unroll
            for (int c = 0; c < 64; ++c) { S[c] = 0.f; M[c] = (c == ln_) ? 1.f : 0.f; }
            SCAN_BAR();
#pragma unroll 1
            for (int n = 0; n < NCHUNK; ++n) {
                const int b = n & 1;
                if (valid) {
                f32x4 KK[4];
                { const LAS f32x4* q4 = (const LAS f32x4*)(sl + SC_RING + (b * CH) * 320) + (lane & 3);
#pragma unroll
                  for (int j = 0; j < 4; ++j) KK[j] = q4[j * 4]; }
#pragma unroll 1
                for (int s = 0; s < CH; ++s) {
                    const LAS f32x4* q4 = (const LAS f32x4*)(sl + SC_RING + (b * CH + s) * 320) + (lane & 3);
                    f32x4 WW[4], BB[4], KT[4];
#pragma unroll
                    for (int j = 0; j < 4; ++j) { WW[j] = q4[32 + j * 4]; BB[j] = q4[48 + j * 4]; KT[j] = q4[64 + j * 4]; }
                    const float vt = sl[SC_VG + (b * CH + s) * 64 + lane];
                    float saq[4], sbq[4];
#pragma unroll
                    for (int q = 0; q < 4; ++q) { saq[q] = 0.f; sbq[q] = 0.f; }
                    SCAN_FOR_C( fmac_dpp<k>(saq[i], KK[j][i], S[c]); fmac_dpp<k>(sbq[i], KK[j][i], M[c]); )
                    const float sa = (saq[0] + saq[1]) + (saq[2] + saq[3]), sb = (sbq[0] + sbq[1]) + (sbq[2] + sbq[3]);
#pragma unroll
                    for (int j = 0; j < 4; ++j) KK[j] = q4[16 + j * 4];
                    SCAN_FOR_C( mulip_dpp<k>(S[c], WW[j][i]); )
                    SCAN_FOR_C( fmac_dpp<k>(S[c], BB[j][i], sa); )
                    SCAN_FOR_C( fmac_dpp<k>(S[c], KT[j][i], vt); )
                    SCAN_FOR_C( mulip_dpp<k>(M[c], WW[j][i]); )
                    SCAN_FOR_C( fmac_dpp<k>(M[c], BB[j][i], sb); )
                    float ylq[4], zq[4];
#pragma unroll
                    for (int q = 0; q < 4; ++q) { ylq[q] = 0.f; zq[q] = 0.f; }
                    SCAN_FOR_C( fmac_dpp<k>(ylq[i], KK[j][i], S[c]); fmac_dpp<k>(zq[i], KK[j][i], M[c]); )
                    sl[SC_Y + (b * CH + s) * 128 + lane] = (ylq[0] + ylq[1]) + (ylq[2] + ylq[3]);
                    sl[SC_Y + (b * CH + s) * 128 + 64 + lane] = (zq[0] + zq[1]) + (zq[2] + zq[3]);
                    { const LAS f32x4* qn = (const LAS f32x4*)(sl + SC_RING + (b * CH + ((s + 1) & (CH - 1))) * 320) + (lane & 3);
#pragma unroll
                      for (int j = 0; j < 4; ++j) KK[j] = qn[j * 4]; }
                }
                }
                SCAN_BAR();
            }
            if (valid) {
                f32x4* op = (f32x4*)((float*)(ws + WS_SLOC) + (((size_t)h * NSEG + seg) * 64 + lane) * 64);
                bf16* oq = (bf16*)(ws + WS_ASEG) + ((size_t)h * NSEG + seg) * 4096 + lane;
#pragma unroll
                for (int q = 0; q < 16; ++q) op[q] = (f32x4){S[4 * q], S[4 * q + 1], S[4 * q + 2], S[4 * q + 3]};
#pragma unroll
                for (int c2 = 0; c2 < 64; ++c2) oq[c2 * 64] = (unsigned short)f2bf(M[c2]);
            }
        }
        SCAN_BAR();
    }
#undef SCAN_BAR
}

__global__ void __launch_bounds__(NWAVES * 64, 2) mk_fwd(Args args) {
    extern __shared__ __attribute__((aligned(16))) unsigned char lds[];
    Frame F;
    F.lds = (LAS unsigned char*)lds; F.MISC = (volatile LAS unsigned*)(F.lds + MISC_OFF);
    F.tid = threadIdx.x; F.wave = __builtin_amdgcn_readfirstlane(F.tid >> 6);
    F.G = gridDim.x; F.vcu = 0;
    unsigned char* ws = args.ws; F.ctl = (gu32*)(ws + WS_CTL);
    const float* const* in = args.in;
    unsigned char* ob = (unsigned char*)args.out;
    for (int u = threadIdx.x; u < (LDS_BYTES - LDSCTL_OFF) / 4; u += NWAVES * 64) ((LAS unsigned*)(F.lds + LDSCTL_OFF))[u] = 0u;
    __syncthreads();
    XcdBarrier bar; bar.bar = (unsigned*)(F.ctl + CW_BAR); bar.x = 0; bar.st = nullptr;
    int bidv = (int)blockIdx.x;
    if (!MK_PER_PHASE) {
        bar.bar = (unsigned*)(F.ctl + CW_BAR); bar.x = xb_xcc_id(); bar.st = F.MISC + 8;
        if (threadIdx.x == 0) {
            const unsigned rank = xb_add(&bar.bar[XB_XCNT(bar.x)], 1u);
            unsigned cnts[16], sum, sp = 0u;
            for (;;) { sum = 0u;
#pragma unroll
                for (unsigned j = 0; j < 16; ++j) { cnts[j] = xb_ld(&bar.bar[XB_XCNT(j)]); sum += cnts[j]; }
                if (sum == (unsigned)F.G) break;
                __builtin_amdgcn_s_sleep(1);
                if ((++sp & 255u) == 0u) { if (xb_ld(&bar.bar[XB_TMO])) break; if (sp > XB_SPIN_CAP) { atomicAdd(&bar.bar[XB_TMO], 1u); break; } } }
            unsigned nx = 0u, xi = 0u, mine = 0u; bool even = true;
#pragma unroll
            for (unsigned j = 0; j < 16; ++j) { if (cnts[j]) { nx++; if (cnts[j] * 8u != (unsigned)F.G) even = false; } if (j < bar.x && cnts[j]) xi++; if (j == bar.x) mine = cnts[j]; }
            F.MISC[8] = mine ? mine : 1u; F.MISC[9] = nx ? nx : 1u;
            F.MISC[10] = (even && nx == 8u && sum == (unsigned)F.G) ? rank * 8u + xi : (unsigned)blockIdx.x;
        }
        __syncthreads();
        bidv = (int)__builtin_amdgcn_readfirstlane((int)F.MISC[10]);
    }
    F.vcu = (F.G % 8 == 0) ? (bidv % 8) * (F.G / 8) + bidv / 8 : bidv;
    const int lo = args.ph_lo, hi = args.ph_hi;
#ifndef PH_MASK
#define PH_MASK 0xFFFF
#endif
#define IN(k) ((((PH_MASK) >> (k)) & 1) && lo <= (k) && (k) < hi)
#ifndef PROBE_MASK
#define PROBE_MASK 0
#endif
#ifndef PROBE_VARIANT
#define PROBE_VARIANT 0
#endif
#ifndef PROBE_N
#define PROBE_N 1
#endif
#define PHASE_BEGIN(k) if (IN(k)) { for (int rep_ = 0; rep_ < 1 + ((((PROBE_MASK) >> (k)) & 1) ? (PROBE_N) : 0); ++rep_) { if (rep_) xcd_barrier(bar); PHASE_IDS
#define PHASE_END } }
#define SEAM(k) do { if (IN(k) && IN((k) + 1)) xcd_barrier(bar); } while (0)
    const int gw = F.vcu * NWAVES + F.wave, NGW = F.G * NWAVES; const int NGT = F.G * NWAVES * 64;
#define MK_STR2(x) #x
#define MK_STR(x) MK_STR2(x)
#define PHASE_ALIGN(n) asm volatile(".p2align 8\n .rept " MK_STR(n) "\n s_nop 0\n .endr")
#ifndef PAD0
#define PAD0 0
#endif
#ifndef PAD2
#define PAD2 0
#endif
#ifndef PAD3
#define PAD3 0
#endif
#ifndef PAD4
#define PAD4 0
#endif
#ifndef PAD7
#define PAD7 0
#endif
#ifndef PAD9
#define PAD9 0
#endif
#ifndef PAD13
#define PAD13 0
#endif
#ifndef PAD1
#define PAD1 0
#endif
#ifndef PAD5
#define PAD5 0
#endif
#ifndef PAD6
#define PAD6 8
#endif
#ifndef PAD10
#define PAD10 0
#endif
#ifndef PAD12
#define PAD12 0
#endif
#ifndef PAD14
#define PAD14 0
#endif
#ifndef PAD15
#define PAD15 0
#endif
#define PHASE_IDS const int lane = mk_lane_id(), tid = F.wave * 64 + lane, gt = F.vcu * (NWAVES * 64) + tid; (void)gt; (void)lane;

    bf16* WIN_T = (bf16*)(ws + WS_WIN); bf16* WA_T = (bf16*)(ws + WS_WA); bf16* WB_T = (bf16*)(ws + WS_WB); bf16* WOUT_T = (bf16*)(ws + WS_WOUT);
    bf16* WS_T = (bf16*)(ws + WS_WS); bf16* LORA_T = (bf16*)(ws + WS_LORA);
    bf16* XN = (bf16*)(ob + OUT_XN); bf16* RKV = (bf16*)(ob + OUT_RKV); bf16* LIN = (bf16*)(ob + OUT_LIN);
    bf16* PR = (bf16*)(ws + WS_PR); bf16* PD = (bf16*)(ws + WS_PD); bf16* PG = (bf16*)(ws + WS_PG);

    PHASE_BEGIN(0)
        PHASE_ALIGN(PAD0);
        LAS float* scr = (LAS float*)(F.lds + RING_OFF + F.wave * 16384);
        constexpr int I_IN = 32 * 334, I_L = 4 * 32;
        constexpr int NIT = I_IN + 3 * I_L;
        for (int it = gw; it < NIT; it += NGW) {
            int r = it;
            if (r < I_IN) { const int kb = r / 334, nb = r % 334, n0 = nb * 32; transpose_block(in[2], 10688, kb * 64, n0, 2048, WIN_T, 2048, n0 + (n0 >= 3520 ? 64 : 0), scr, lane); continue; } r -= I_IN;
            { const int which = r / I_L, rr = r % I_L, kb = rr / 32, nb = rr % 32; const float* W = which == 0 ? in[5] : (which == 1 ? in[7] : in[8]);
              transpose_block(W, 1024, kb * 64, nb * 32, which == 2 ? 256 : 96, LORA_T + (size_t)which * 1024 * 256, 256, nb * 32, scr, lane); }
        }
        for (int i = gt; i < 16384; i += NGT) *(GAS v4u*)(WIN_T + (size_t)3520 * 2048 + (size_t)i * 8) = (v4u){0u, 0u, 0u, 0u};
        for (int m = gw; m < S_; m += 2 * NGW) rms_row2_to_bf16(in[0] + (size_t)m * DM, in[0] + (size_t)(m + NGW) * DM, in[1], XN + (size_t)m * DM, XN + (size_t)(m + NGW) * DM, lane);
    PHASE_END
    SEAM(0);
    PHASE_BEGIN(1)
        PHASE_ALIGN(PAD1);
        pg8::Gemm g{XN, WIN_T, S_, 10752, 2048, 2048, 2048, nullptr, 0}; pg8::StaticOrder S; S.init(S_, 10752, F.G, bidv);
        pg8::Epi<pg8::EM_G1> E{PR, PD, PG, nullptr, nullptr, nullptr, attn_body::C2};
        pg8::gemm_phase<pg8::Epi<pg8::EM_G1>, pg8::StaticOrder, true, true>(F.lds + RING_OFF, g, S, E, F.wave);
    PHASE_END
    SEAM(1);
    PHASE_BEGIN(2)
        PHASE_ALIGN(PAD2);
        const float* mu = in[3];
        for (int t = gw; t < S_; t += NGW) {
            const bf16* cur = PR + (size_t)t * 3584; const bf16* prv = cur - 3584;
#pragma unroll 1
            for (int j = 0; j < 7; ++j) { const int ch = lane + 64 * j; if (ch >= 440) break;
                const v4u c4 = *(const GAS v4u*)(cur + ch * 8); v4u p4 = (v4u){0u, 0u, 0u, 0u}; if (t > 0) p4 = *(const GAS v4u*)(prv + ch * 8);
                const f32x4 m0 = *(const f32x4*)(mu + ch * 8), m1 = *(const f32x4*)(mu + ch * 8 + 4);
                float c[8] = {pg8::bflo(c4.x), pg8::bfhi(c4.x), pg8::bflo(c4.y), pg8::bfhi(c4.y), pg8::bflo(c4.z), pg8::bfhi(c4.z), pg8::bflo(c4.w), pg8::bfhi(c4.w)};
                const float p[8] = {pg8::bflo(p4.x), pg8::bfhi(p4.x), pg8::bflo(p4.y), pg8::bfhi(p4.y), pg8::bflo(p4.z), pg8::bfhi(p4.z), pg8::bflo(p4.w), pg8::bfhi(p4.w)};
                const float mm[8] = {m0.x, m0.y, m0.z, m0.w, m1.x, m1.y, m1.z, m1.w};
#pragma unroll
                for (int e = 0; e < 8; ++e) c[e] = c[e] + (p[e] - c[e]) * mm[e];
                bf16* dst;
                if (ch < 384) dst = RKV + (size_t)t * 3072 + ch * 8;
                else { const int col = ch * 8 - 3072;
                    if (col < 96) { dst = LIN + (size_t)t * 768 + col;
#pragma unroll
                        for (int e = 0; e < 8; ++e) c[e] = tanhf(c[e]); }
                    else if (col < 192) dst = LIN + (size_t)t * 768 + 256 + (col - 96);
                    else { dst = LIN + (size_t)t * 768 + 512 + (col - 192);
#pragma unroll
                        for (int e = 0; e < 8; ++e) c[e] = sigmf(c[e]); } }
                *(GAS v4u*)dst = (v4u){pk2(c[0], c[1]), pk2(c[2], c[3]), pk2(c[4], c[5]), pk2(c[6], c[7])};
            }
            if (lane < 40) { const int z = lane < 20 ? 96 + lane * 8 : 352 + (lane - 20) * 8; *(GAS v4u*)(LIN + (size_t)t * 768 + z) = (v4u){0u, 0u, 0u, 0u}; }
        }
    PHASE_END
    SEAM(2);
    PHASE_BEGIN(3)
        PHASE_ALIGN(PAD3);
#pragma unroll 1
        for (int which = 0; which < 3; ++which) {
            int kd = 256; asm volatile("" : "+s"(kd));
            pg8::Gemm g{LIN + which * 256, LORA_T + (size_t)which * 1024 * 256, S_, 1024, kd, 768, 256, nullptr, 0}; pg8::StaticOrder S; S.init(S_, 1024, F.G, bidv);
            pg8::Epi<pg8::EM_LORA_W> E{ws + (which == 0 ? WS_E : (which == 1 ? WS_A : WS_G)), nullptr, nullptr, nullptr, nullptr, which == 0 ? in[4] : (which == 1 ? in[6] : nullptr), which == 0 ? 0.60653065971f : 1.f};
            pg8::gemm_phase<pg8::Epi<pg8::EM_LORA_W>, pg8::StaticOrder, true, true>(F.lds + RING_OFF, g, S, E, F.wave); }
    PHASE_END
    SEAM(3);
    PHASE_BEGIN(4)
        PHASE_ALIGN(PAD4);
        bf16* SCN = (bf16*)(ws + WS_SCN); float* SCAL = (float*)(ws + WS_SCAL); const bf16* Ab = (const bf16*)(ws + WS_A);
        for (int t = gw; t < S_; t += NGW) {
#pragma unroll 2
            for (int h = 0; h < 16; ++h) { const int cc = h * 64 + lane;
                const float r = bf2f(RKV[(size_t)t * 3072 + cc]), k = bf2f(RKV[(size_t)t * 3072 + 1024 + cc]), a = bf2f(Ab[(size_t)t * 1024 + cc]);
                float kk = k * in[9][cc]; const float nrm = sqrtf(wsum(kk * kk)); kk = kk / fmaxf(nrm, 1e-12f);
                const float kt = k * (1.f + (a - 1.f) * in[10][cc]); const float b = kk * a;
                const unsigned short kkb = (unsigned short)f2bf(-kk), bb = (unsigned short)f2bf(b), ktb = (unsigned short)f2bf(kt);
                bf16* q = SCN + ((size_t)h * S_ + t) * 192; q[lane] = kkb; q[64 + lane] = bb; q[128 + lane] = ktb;
                const float br = wsum(bf2f(bb) * r), kr = wsum(bf2f(ktb) * r), bon = wsum(r * kt * in[11][cc]);
                if (lane == 0) *(f32x4*)(SCAL + ((size_t)h * S_ + t) * 4) = (f32x4){br, kr, bon, 0.f}; }
        }
    PHASE_END
    SEAM(4);
    PHASE_BEGIN(5)
        PHASE_ALIGN(PAD5);
        scan4_phase(lane, F.wave, F.vcu, F.G, ws, ob, RKV, (LAS float*)(F.lds + RING_OFF));
    PHASE_END
    SEAM(5);
    PHASE_BEGIN(6)
        PHASE_ALIGN(PAD6);
        if ((F.vcu & 15) == 0) { const int h = F.vcu >> 4; const int wv = F.wave;
            constexpr int PIT = 72;
            LAS bf16* Sb = (LAS bf16*)(F.lds + RING_OFF);
            LAS bf16* Atb = Sb + 2 * 64 * PIT;
            const float* SL = (const float*)(ws + WS_SLOC) + (size_t)h * NSEG * 4096; const bf16* AT = (const bf16*)(ws + WS_ASEG) + (size_t)h * NSEG * 4096; float* SI = (float*)(ws + WS_SIN) + (size_t)h * NSEG * 4096;
            for (int i = tid; i < 2 * 64 * PIT / 2; i += 512) ((LAS unsigned*)Sb)[i] = 0u;
#define P6_BAR() do { asm volatile("s_waitcnt lgkmcnt(0)" ::: "memory"); __builtin_amdgcn_s_barrier(); asm volatile("" ::: "memory"); } while (0)
            if (wv >= 4) {
                const int li = tid - 256, row = li >> 2, ch = li & 3;
                v4u r0a, r0b, r1a, r1b;
#define P6_LD(p, ra, rb) do { const bf16* s_ = AT + (size_t)(p) * 4096 + row * 64 + ch * 16; ra = *(const GAS v4u*)s_; rb = *(const GAS v4u*)(s_ + 8); } while (0)
#define P6_ST(p, ra, rb) do { LAS bf16* d_ = Atb + ((p) % 3) * 64 * PIT + row * PIT + ch * 16; *(LAS v4u*)d_ = ra; *(LAS v4u*)(d_ + 8) = rb; } while (0)
                P6_LD(0, r0a, r0b); P6_ST(0, r0a, r0b); P6_LD(1, r0a, r0b); P6_LD(2, r1a, r1b);
                P6_BAR();
#pragma unroll 1
                for (int p = 0; p < NSEG - 1; p += 2) {
                    if (p + 1 < NSEG - 1) P6_ST(p + 1, r0a, r0b); if (p + 3 < NSEG - 1) P6_LD(p + 3, r0a, r0b);
                    P6_BAR();
                    if (p + 1 < NSEG - 1) { if (p + 2 < NSEG - 1) P6_ST(p + 2, r1a, r1b); if (p + 4 < NSEG - 1) P6_LD(p + 4, r1a, r1b); P6_BAR(); }
                }
#undef P6_LD
#undef P6_ST
            } else {
                const int vt = wv >> 1, ct = wv & 1, r = lane & 31, hb = lane >> 5;
                typedef float f32x16 __attribute__((ext_vector_type(16)));
                f32x16 nl;
#define P6_LDL(p) do { const float* s_ = SL + (size_t)(p) * 4096 + (32 * vt + 4 * hb) * 64 + 32 * ct + r; _Pragma("unroll") for (int q = 0; q < 16; ++q) nl[q] = s_[((q & 3) + 8 * (q >> 2)) * 64]; } while (0)
                P6_LDL(0);
                { float* o_ = SI + (32 * vt + 4 * hb) * 64 + 32 * ct + r;
#pragma unroll
                  for (int q = 0; q < 16; ++q) o_[((q & 3) + 8 * (q >> 2)) * 64] = 0.f; }
                P6_BAR();
#pragma unroll 1
                for (int p = 0; p < NSEG - 1; ++p) {
                    const LAS bf16* sa_ = Sb + (p & 1) * 64 * PIT + (32 * vt + r) * PIT + 8 * hb; const LAS bf16* at_ = Atb + (p % 3) * 64 * PIT + (32 * ct + r) * PIT + 8 * hb;
                    f32x16 acc = nl; if (p + 1 < NSEG - 1) P6_LDL(p + 1);
#pragma unroll
                    for (int ks = 0; ks < 4; ++ks) { const bf16x8 af = *(const LAS bf16x8*)(sa_ + 16 * ks), bfr = *(const LAS bf16x8*)(at_ + 16 * ks);
                        acc = __builtin_amdgcn_mfma_f32_32x32x16_bf16(af, bfr, acc, 0, 0, 0); }
                    float* o_ = SI + (size_t)(p + 1) * 4096 + (32 * vt + 4 * hb) * 64 + 32 * ct + r; LAS bf16* sn_ = Sb + ((p + 1) & 1) * 64 * PIT + (32 * vt + 4 * hb) * PIT + 32 * ct + r;
#pragma unroll
                    for (int q = 0; q < 16; ++q) { const int rr = (q & 3) + 8 * (q >> 2); o_[rr * 64] = acc[q]; sn_[rr * PIT] = (unsigned short)f2bf(acc[q]); }
                    P6_BAR();
                }
#undef P6_LDL
            }
#undef P6_BAR
        } else {
            LAS float* scr = (LAS float*)(F.lds + RING_OFF + F.wave * 16384);
            const int gw2 = (F.vcu - (F.vcu >> 4) - 1) * NWAVES + F.wave, NGW2 = (F.G - 16) * NWAVES;
            constexpr int I_A = 16 * 64, I_B = 16 * 64, I_O = 32 * 64;
            for (int it = gw2; it < I_A + I_B + I_O; it += NGW2) {
                int r = it;
                if (r < I_A) { const int kb = r / 64, nb = r % 64; transpose_block(in[19], 2048, kb * 64, nb * 32, 1024, WA_T, 2048, nb * 32, scr, lane); continue; } r -= I_A;
                if (r < I_B) { const int kb = r / 64, nb = r % 64; transpose_block(in[20], 2048, kb * 64, nb * 32, 1024, WA_T + 1024, 2048, nb * 32, scr, lane); continue; } r -= I_B;
                { const int kb = r / 64, nb = r % 64; transpose_block(in[21], 2048, kb * 64, nb * 32, 2048, WOUT_T, 2048, nb * 32, scr, lane); }
            }
            for (int task = gw2; task < 16 * 32 * 4; task += NGW2) {
                const int hp = task >> 7, kb = (task >> 2) & 31, ng = task & 3; const int k = kb * 64 + lane;
                const f32x4* wq = (const f32x4*)(in[23] + (size_t)k * 2048 + hp * 128);
                f32x4 q[32];
#pragma unroll
                for (int d = 0; d < 32; ++d) q[d] = wq[d];
                const f32x4* sk4 = (const f32x4*)(in[24] + ((size_t)hp * 128 + ng * 32) * 128); LAS f32x4* sks = (LAS f32x4*)scr;
#pragma unroll
                for (int i = 0; i < 16; ++i) sks[i * 64 + lane] = sk4[i * 64 + lane];
                LDS_WAIT(); asm volatile("" ::: "memory");
#pragma unroll 2
                for (int n = 0; n < 32; ++n) { const LAS f32x4* s4 = sks + n * 32; float a0 = 0.f, a1 = 0.f;
#pragma unroll
                    for (int d = 0; d < 32; ++d) { const f32x4 s = s4[d]; a0 = fmaf(q[d].x, s.x, a0); a1 = fmaf(q[d].y, s.y, a1); a0 = fmaf(q[d].z, s.z, a0); a1 = fmaf(q[d].w, s.w, a1); }
                    WS_T[(size_t)(hp * 128 + ng * 32 + n) * 2048 + k] = (bf16)f2bf(a0 + a1); }
                LDS_WAIT(); asm volatile("" ::: "memory");
            }
        }
        __syncthreads();
        attn_body::attn_phase<8>((char*)lds + RING_OFF, (const attn_body::bf16*)PD, (attn_body::bf16*)(ws + WS_OATT), F.vcu, F.wave, (unsigned*)(F.ctl + 2048 + 64 * (F.vcu >> 5)), F.MISC + 12);
    PHASE_END
    SEAM(6);
    PHASE_BEGIN(7)
        PHASE_ALIGN(PAD7);
        typedef float f32x16 __attribute__((ext_vector_type(16)));
        const int r = lane & 31, hb = lane >> 5;
        const bf16* ZZ = (const bf16*)(ws + WS_Z); const bf16* YL = (const bf16*)(ob + OUT_YLOC); const bf16* Gb = (const bf16*)(ws + WS_G); const float* SCAL = (const float*)(ws + WS_SCAL);
        bf16* YA = (bf16*)(ws + WS_YA);
        constexpr int PITB = 144, BLK = 32 * PITB;
        LAS unsigned char* wl = F.lds + RING_OFF + F.wave * (3 * BLK) - BLK;
        const int lr = lane >> 3, lc = lane & 7;
        for (int task = gw; task < 16 * NSEG * 2; task += NGW) { const int h = task >> 7, seg = (task >> 1) & 63, half = task & 1;
            bf16x8 af[2][4];
            { const float* si = (const float*)(ws + WS_SIN) + ((size_t)h * NSEG + seg) * 4096;
#pragma unroll
              for (int vt = 0; vt < 2; ++vt)
#pragma unroll
                  for (int ks = 0; ks < 4; ++ks) { const f32x4 a = *(const f32x4*)(si + (32 * vt + r) * 64 + 16 * ks + 8 * hb), b = *(const f32x4*)(si + (32 * vt + r) * 64 + 16 * ks + 8 * hb + 4);
                      const v4u w = (v4u){pk2(a.x, a.y), pk2(a.z, a.w), pk2(b.x, b.y), pk2(b.z, b.w)}; af[vt][ks] = __builtin_bit_cast(bf16x8, w); } }
            f32x4 lg[2][4], lb[2][4];
#pragma unroll
            for (int vt = 0; vt < 2; ++vt)
#pragma unroll
                for (int qq = 0; qq < 4; ++qq) { lg[vt][qq] = *(const f32x4*)(in[12] + h * 64 + 32 * vt + 8 * qq + 4 * hb); lb[vt][qq] = *(const f32x4*)(in[13] + h * 64 + 32 * vt + 8 * qq + 4 * hb); }
#pragma unroll 1
            for (int tt = 0; tt < 4; ++tt) { const int tb0 = seg * SEGLEN + half * 128 + tt * 32; const size_t hb0 = (size_t)h * S_ + tb0;
                v4u ry[4], rv[4], rg[4];
#pragma unroll
                for (int i = 0; i < 4; ++i) { const int row = lr + 8 * i;
                    ry[i] = *(const GAS v4u*)(YL + (hb0 + row) * 64 + lc * 8);
                    rv[i] = *(const GAS v4u*)(RKV + (size_t)(tb0 + row) * 3072 + 2048 + h * 64 + lc * 8); rg[i] = *(const GAS v4u*)(Gb + (size_t)(tb0 + row) * 1024 + h * 64 + lc * 8); }
                const float bon = SCAL[(hb0 + r) * 4 + 2];
#pragma unroll
                for (int i = 0; i < 4; ++i) { const int o = (lr + 8 * i) * PITB + lc * 16;
                    *(LAS v4u*)(wl + BLK + o) = ry[i]; *(LAS v4u*)(wl + 2 * BLK + o) = rv[i]; *(LAS v4u*)(wl + 3 * BLK + o) = rg[i]; }
                LDS_WAIT(); asm volatile("" ::: "memory");
                bf16x8 zf[4];
#pragma unroll
                for (int ks = 0; ks < 4; ++ks) zf[ks] = *(const bf16x8*)(ZZ + (hb0 + r) * 64 + 16 * ks + 8 * hb);
                f32x16 acc[2];
#pragma unroll
                for (int vt = 0; vt < 2; ++vt)
#pragma unroll
                    for (int qq = 0; qq < 4; ++qq) { const unsigned long long w = *(const LAS unsigned long long*)(wl + BLK + r * PITB + (32 * vt + 8 * qq + 4 * hb) * 2);
                        acc[vt][4 * qq] = pg8::bflo((unsigned)w); acc[vt][4 * qq + 1] = pg8::bfhi((unsigned)w); acc[vt][4 * qq + 2] = pg8::bflo((unsigned)(w >> 32)); acc[vt][4 * qq + 3] = pg8::bfhi((unsigned)(w >> 32)); }
#pragma unroll
                for (int vt = 0; vt < 2; ++vt)
#pragma unroll
                    for (int ks = 0; ks < 4; ++ks) acc[vt] = __builtin_amdgcn_mfma_f32_32x32x16_bf16(af[vt][ks], zf[ks], acc[vt], 0, 0, 0);
                float s1 = 0.f;
#pragma unroll
                for (int vt = 0; vt < 2; ++vt)
#pragma unroll
                    for (int q = 0; q < 16; ++q) s1 += acc[vt][q];
                { auto rr = __builtin_amdgcn_permlane32_swap(__float_as_uint(s1), __float_as_uint(s1), false, false); s1 = __uint_as_float(rr[0]) + __uint_as_float(rr[1]); }
                const float mean = s1 * (1.f / 64.f); float s2 = 0.f;
#pragma unroll
                for (int vt = 0; vt < 2; ++vt)
#pragma unroll
                    for (int q = 0; q < 16; ++q) { acc[vt][q] -= mean; s2 += acc[vt][q] * acc[vt][q]; }
                { auto rr = __builtin_amdgcn_permlane32_swap(__float_as_uint(s2), __float_as_uint(s2), false, false); s2 = __uint_as_float(rr[0]) + __uint_as_float(rr[1]); }
                const float rstd = rsqrtf(s2 * (1.f / 64.f) + 64e-5f);
#pragma unroll
                for (int vt = 0; vt < 2; ++vt)
#pragma unroll
                    for (int qq = 0; qq < 4; ++qq) { const int vo = r * PITB + (32 * vt + 8 * qq + 4 * hb) * 2;
                        const unsigned long long vw = *(const LAS unsigned long long*)(wl + 2 * BLK + vo), gw_ = *(const LAS unsigned long long*)(wl + 3 * BLK + vo);
                        const float vv[4] = {pg8::bflo((unsigned)vw), pg8::bfhi((unsigned)vw), pg8::bflo((unsigned)(vw >> 32)), pg8::bfhi((unsigned)(vw >> 32))};
                        const float gg[4] = {pg8::bflo((unsigned)gw_), pg8::bfhi((unsigned)gw_), pg8::bflo((unsigned)(gw_ >> 32)), pg8::bfhi((unsigned)(gw_ >> 32))};
                        float o[4];
#pragma unroll
                        for (int i = 0; i < 4; ++i) o[i] = (acc[vt][4 * qq + i] * rstd * lg[vt][qq][i] + lb[vt][qq][i] + bon * vv[i]) * gg[i];
                        *(LAS unsigned long long*)(wl + BLK + vo) = (unsigned long long)pk2(o[0], o[1]) | ((unsigned long long)pk2(o[2], o[3]) << 32); }
                LDS_WAIT(); asm volatile("" ::: "memory");
#pragma unroll
                for (int i = 0; i < 4; ++i) { const int row = lr + 8 * i; *(GAS v4u*)(YA + (size_t)(tb0 + row) * 1024 + h * 64 + lc * 8) = *(const LAS v4u*)(wl + BLK + row * PITB + lc * 16); }
                LDS_WAIT(); asm volatile("" ::: "memory");
            }
        }
    PHASE_END
    SEAM(7);
    PHASE_BEGIN(9)
        PHASE_ALIGN(PAD9);
        float d1 = 0.f, d2 = 0.f; d1 = in[14][lane] * in[15][lane]; d2 = in[16][lane] * in[17][lane];
        const float lam = __expf(wave_sum(d1)) - __expf(wave_sum(d2)) + 0.2f;
        const bf16* OA = (const bf16*)(ws + WS_OATT); bf16* YB = (bf16*)(ws + WS_YB);
        f32x4 sg[4];
#pragma unroll
        for (int q = 0; q < 4; ++q) sg[q] = *(const f32x4*)(in[18] + (lane & 7) * 16 + q * 4);
        for (int t = gw; t < S_; t += NGW) {
            const v4u a0 = *(const GAS v4u*)(OA + (size_t)t * 2048 + lane * 16), a1 = *(const GAS v4u*)(OA + (size_t)t * 2048 + lane * 16 + 8);
            const v4u b0 = *(const GAS v4u*)(OA + (size_t)t * 2048 + 1024 + lane * 16), b1 = *(const GAS v4u*)(OA + (size_t)t * 2048 + 1024 + lane * 16 + 8);
            const unsigned aw[8] = {a0.x, a0.y, a0.z, a0.w, a1.x, a1.y, a1.z, a1.w}, bw[8] = {b0.x, b0.y, b0.z, b0.w, b1.x, b1.y, b1.z, b1.w};
            float o[16]; float ss = 0.f;
#pragma unroll
            for (int e = 0; e < 8; ++e) { o[2 * e] = pg8::bflo(aw[e]) - lam * pg8::bflo(bw[e]); o[2 * e + 1] = pg8::bfhi(aw[e]) - lam * pg8::bfhi(bw[e]); ss += o[2 * e] * o[2 * e] + o[2 * e + 1] * o[2 * e + 1]; }
            ss += __shfl_xor(ss, 1); ss += __shfl_xor(ss, 2); ss += __shfl_xor(ss, 4);
            const float rs = rsqrtf(ss * (1.f / 128.f) + 1e-5f) * 0.8f;
            const float gg[16] = {sg[0].x, sg[0].y, sg[0].z, sg[0].w, sg[1].x, sg[1].y, sg[1].z, sg[1].w, sg[2].x, sg[2].y, sg[2].z, sg[2].w, sg[3].x, sg[3].y, sg[3].z, sg[3].w};
#pragma unroll
            for (int e = 0; e < 16; ++e) o[e] = o[e] * rs * gg[e];
            *(GAS v4u*)(YB + (size_t)t * 1024 + lane * 16) = (v4u){pk2(o[0], o[1]), pk2(o[2], o[3]), pk2(o[4], o[5]), pk2(o[6], o[7])};
            *(GAS v4u*)(YB + (size_t)t * 1024 + lane * 16 + 8) = (v4u){pk2(o[8], o[9]), pk2(o[10], o[11]), pk2(o[12], o[13]), pk2(o[14], o[15])};
        }
    PHASE_END
    SEAM(9);
    PHASE_BEGIN(10)
        PHASE_ALIGN(PAD10);
        pg8::Gemm g{(const bf16*)(ws + WS_YA), WA_T, S_, 2048, 2048, 1024, 2048, (const bf16*)(ws + WS_YB), 16}; pg8::StaticOrder S; S.init(S_, 2048, F.G, bidv);
        pg8::Epi<pg8::EM_PROJAB> E{ws + WS_MERGED, nullptr, nullptr, PG, nullptr, nullptr, 1.f};
        pg8::gemm_phase<pg8::Epi<pg8::EM_PROJAB>, pg8::StaticOrder, true, true>(F.lds + RING_OFF, g, S, E, F.wave);
    PHASE_END
    SEAM(10);
    PHASE_BEGIN(12)
        PHASE_ALIGN(PAD12);
        pg8::Gemm g{(const bf16*)(ws + WS_MERGED), WOUT_T, S_, 2048, 2048, 2048, 2048, nullptr, 0}; pg8::StaticOrder S; S.init(S_, 2048, F.G, bidv);
        pg8::Epi<pg8::EM_WOUT> E{ws + WS_H2, ws + WS_XN2, ws + WS_PART, nullptr, in[0], in[22], 1.f};
        pg8::gemm_phase<pg8::Epi<pg8::EM_WOUT>, pg8::StaticOrder, true, true>(F.lds + RING_OFF, g, S, E, F.wave);
    PHASE_END
    SEAM(12);
    PHASE_BEGIN(13)
        PHASE_ALIGN(PAD13);
        for (int row = gt; row < S_; row += NGT) { const f32x4* pp = (const f32x4*)((const float*)(ws + WS_PART) + (size_t)row * 32); float sacc = 0.f;
#pragma unroll
            for (int j = 0; j < 8; ++j) { const f32x4 q = pp[j]; sacc += (q.x + q.y) + (q.z + q.w); }
            ((float*)(ws + WS_RSTD))[row] = rsqrtf(sacc * (1.f / 2048.f) + 1e-6f); }
        for (int row = gw; row < 32768; row += NGW) { const int which = row >> 14, r = row & 16383;
            const f32x4* src = (const f32x4*)(in[25 + which] + (size_t)r * 2048) + lane; f32x4 v[8]; float am = 0.f;
#pragma unroll
            for (int j = 0; j < 8; ++j) { v[j] = __builtin_nontemporal_load(src + 64 * j); am = fmaxf(am, fmaxf(fmaxf(fabsf(v[j].x), fabsf(v[j].y)), fmaxf(fabsf(v[j].z), fabsf(v[j].w)))); }
            const unsigned tb = __float_as_uint(am * (1.f / 6.f)); unsigned eb = (tb >> 23) + ((tb & 0x7fffffu) ? 1u : 0u); eb = eb < 1u ? 1u : (eb > 254u ? 254u : eb);
            const float sc = __uint_as_float(eb << 23);
            unsigned wd[4];
#pragma unroll
            for (int w = 0; w < 4; ++w) { unsigned q = 0u;
                q = __builtin_amdgcn_cvt_scalef32_pk_fp4_f32(q, v[2 * w].x, v[2 * w].y, sc, 0); q = __builtin_amdgcn_cvt_scalef32_pk_fp4_f32(q, v[2 * w].z, v[2 * w].w, sc, 1);
                q = __builtin_amdgcn_cvt_scalef32_pk_fp4_f32(q, v[2 * w + 1].x, v[2 * w + 1].y, sc, 2); q = __builtin_amdgcn_cvt_scalef32_pk_fp4_f32(q, v[2 * w + 1].z, v[2 * w + 1].w, sc, 3); wd[w] = q; }
            *(GAS v4u*)(ws + WS_UTAB + (size_t)r * TAB_REC + (which ? TAB_V : 0) + lane * 16) = (v4u){wd[0], wd[1], wd[2], wd[3]};
            ((unsigned char*)(ws + WS_UTAB))[(size_t)r * TAB_REC + (which ? TAB_VS : TAB_US) + lane] = (unsigned char)eb; }
    PHASE_END
    SEAM(13);
    PHASE_BEGIN(14)
        PHASE_ALIGN(PAD14);
        pg8::Gemm g{(const bf16*)(ws + WS_XN2), WS_T, S_, 2048, 2048, 2048, 2048, nullptr, 0}; pg8::StaticOrder S; S.init(S_, 2048, F.G, bidv);
        pg8::Epi<pg8::EM_SCORES> E{ws + WS_SCORES, nullptr, nullptr, nullptr, ws + WS_RSTD, nullptr, 1.f};
        pg8::gemm_phase<pg8::Epi<pg8::EM_SCORES>, pg8::StaticOrder, true, true>(F.lds + RING_OFF, g, S, E, F.wave);
    PHASE_END
    SEAM(14);
    PHASE_BEGIN(15)
        PHASE_ALIGN(PAD15);
        const float* SC = (const float*)(ws + WS_SCORES); const bf16* XN2 = (const bf16*)(ws + WS_XN2);
        const unsigned char* UT = (const unsigned char*)(ws + WS_UTAB);
        LAS unsigned* lst = (LAS unsigned*)(F.lds + RING_OFF + F.wave * 10240);
        for (int tb = gw; tb < S_ / 8; tb += NGW) {
            { const int tl = lane >> 3, h = lane & 7; const float* srow = SC + (size_t)(tb * 8 + tl) * 2048 + h * 256;
              float A[16], B[16];
#pragma unroll
              for (int p = 0; p < 2; ++p) { float top[16];
#pragma unroll
                  for (int k = 0; k < 16; ++k) top[k] = -INFINITY;
#pragma unroll 2
                  for (int i4 = 0; i4 < 32; ++i4) { const f32x4 v = *(const f32x4*)(srow + p * 128 + i4 * 4); const float ve[4] = {v.x, v.y, v.z, v.w};
#pragma unroll
                      for (int e = 0; e < 4; ++e) { float x = __uint_as_float((__float_as_uint(ve[e]) & 0xffffff80u) | (unsigned)(i4 * 4 + e));
#pragma unroll
                          for (int k = 15; k >= 1; --k) top[k] = __builtin_amdgcn_fmed3f(x, top[k - 1], top[k]);
                          top[0] = fmaxf(x, top[0]); } }
#pragma unroll
                  for (int k = 0; k < 16; ++k) { if (p == 0) A[k] = top[k]; else B[k] = top[k]; } }
              LAS unsigned* ixl = (LAS unsigned*)(F.lds + RING_OFF + F.wave * 10240 + 8192) + lane * 8;
              { unsigned wa[4], wb[4];
#pragma unroll
                for (int q = 0; q < 4; ++q) { wa[q] = 0u; wb[q] = 0u;
#pragma unroll
                    for (int e = 0; e < 4; ++e) { wa[q] |= (__float_as_uint(A[q * 4 + e]) & 127u) << (8 * e); wb[q] |= (__float_as_uint(B[q * 4 + e]) & 127u) << (8 * e); } }
                *(LAS v4u*)ixl = (v4u){wa[0], wa[1], wa[2], wa[3]}; *(LAS v4u*)(ixl + 4) = (v4u){wb[0], wb[1], wb[2], wb[3]}; }
              float cs[16];
#pragma unroll
              for (int k = 0; k < 16; ++k) cs[k] = -INFINITY;
#pragma unroll
              for (int i = 0; i < 16; ++i)
#pragma unroll
                  for (int j = 0; j < 16; ++j) if ((i + 1) * (j + 1) <= 16) {
                      float x = __uint_as_float((__float_as_uint(A[i] + B[j]) & 0xffffff00u) | (unsigned)(i * 16 + j));
#pragma unroll
                      for (int k = 15; k >= 1; --k) cs[k] = __builtin_amdgcn_fmed3f(x, cs[k - 1], cs[k]);
                      cs[0] = fmaxf(x, cs[0]); }
              LDS_WAIT(); asm volatile("" ::: "memory");
              const LAS unsigned char* ixb = (const LAS unsigned char*)ixl;
              unsigned cx[16]; float gsum = 0.f; const float cmax = cs[0];
#pragma unroll
              for (int k = 0; k < 16; ++k) { const unsigned ij = __float_as_uint(cs[k]) & 255u; cx[k] = ((unsigned)ixb[ij >> 4] << 7) | (unsigned)ixb[16 + (ij & 15u)]; cs[k] = __expf(cs[k] - cmax); gsum += cs[k]; }
              const float ginv = 1.f / gsum; LAS unsigned* lp = lst + (tl * 128 + h * 16) * 2;
#pragma unroll
              for (int k = 0; k < 16; k += 2) *(LAS v4u*)(lp + k * 2) = (v4u){cx[k], __float_as_uint(cs[k] * ginv), cx[k + 1], __float_as_uint(cs[k + 1] * ginv)}; }
            LDS_WAIT(); asm volatile("" ::: "memory");
#define PEER_LOAD(ROW, SC, IV, L0, ROFF, SOFF) do { asm volatile("" ::: "memory"); \
                _Pragma("unroll") for (int q = 0; q < 8; ++q) { const unsigned idx_ = (unsigned)__builtin_amdgcn_readlane((int)(IV), (L0) + q); const unsigned char* rec_ = UT + (size_t)idx_ * TAB_REC; \
                    ROW[q] = *(const GAS v4u*)(rec_ + (ROFF) + lane * 16); SC[q] = rec_[(SOFF) + lane]; } \
                asm volatile("" ::: "memory"); __builtin_amdgcn_sched_barrier(0); } while (0)
#define PEER_U(ROW, SC, P0) do { _Pragma("unroll") for (int q = 0; q < 8; ++q) { float da = 0.f, db = 0.f; const float su = __uint_as_float((unsigned)SC[q] << 23); \
                const unsigned uw[4] = {ROW[q].x, ROW[q].y, ROW[q].z, ROW[q].w}; \
                _Pragma("unroll") for (int w = 0; w < 4; ++w) {     \
                    da = __builtin_amdgcn_fdot2(xh2[4 * w], (h2_t)__builtin_amdgcn_cvt_scalef32_pk_f16_fp4(uw[w], su, 0), da, false); db = __builtin_amdgcn_fdot2(xh2[4 * w + 1], (h2_t)__builtin_amdgcn_cvt_scalef32_pk_f16_fp4(uw[w], su, 1), db, false); \
                    da = __builtin_amdgcn_fdot2(xh2[4 * w + 2], (h2_t)__builtin_amdgcn_cvt_scalef32_pk_f16_fp4(uw[w], su, 2), da, false); db = __builtin_amdgcn_fdot2(xh2[4 * w + 3], (h2_t)__builtin_amdgcn_cvt_scalef32_pk_f16_fp4(uw[w], su, 3), db, false); } \
                float pq = da + db; asm volatile("" : "+v"(pq)); part[(P0) + q] = pq; } } while (0)
#define PEER_V(ROW, SC, P0) do { h2_t hacc[16]; _Pragma("unroll") for (int i = 0; i < 16; ++i) hacc[i] = (h2_t){(_Float16)0.f, (_Float16)0.f}; \
              \
              \
            _Pragma("unroll") for (int q = 0; q < 8; ++q) { const float sv = __uint_as_float((unsigned)SC[q] << 23); \
                const float cs = __builtin_bit_cast(float, __builtin_amdgcn_readlane(__builtin_bit_cast(int, cf), (P0) + q)) * sv;     \
                const unsigned vw[4] = {ROW[q].x, ROW[q].y, ROW[q].z, ROW[q].w}; const _Float16 ch = (_Float16)cs; const h2_t cs2 = (h2_t){ch, ch}; \
                _Pragma("unroll") for (int w = 0; w < 4; ++w) { \
                    hacc[4 * w] = __builtin_elementwise_fma(cs2, (h2_t)__builtin_amdgcn_cvt_scalef32_pk_f16_fp4(vw[w], 1.0f, 0), hacc[4 * w]); hacc[4 * w + 1] = __builtin_elementwise_fma(cs2, (h2_t)__builtin_amdgcn_cvt_scalef32_pk_f16_fp4(vw[w], 1.0f, 1), hacc[4 * w + 1]); \
                    hacc[4 * w + 2] = __builtin_elementwise_fma(cs2, (h2_t)__builtin_amdgcn_cvt_scalef32_pk_f16_fp4(vw[w], 1.0f, 2), hacc[4 * w + 2]); hacc[4 * w + 3] = __builtin_elementwise_fma(cs2, (h2_t)__builtin_amdgcn_cvt_scalef32_pk_f16_fp4(vw[w], 1.0f, 3), hacc[4 * w + 3]); } \
                asm volatile("" : "+v"(hacc[0]), "+v"(hacc[1]), "+v"(hacc[2]), "+v"(hacc[3]), "+v"(hacc[4]), "+v"(hacc[5]), "+v"(hacc[6]), "+v"(hacc[7]), "+v"(hacc[8]), "+v"(hacc[9]), "+v"(hacc[10]), "+v"(hacc[11]), "+v"(hacc[12]), "+v"(hacc[13]), "+v"(hacc[14]), "+v"(hacc[15])); } \
            _Pragma("unroll") for (int i = 0; i < 16; ++i) acc2[i] += (f32x2){(float)hacc[i].x, (float)hacc[i].y}; } while (0)
            typedef _Float16 h2_t __attribute__((ext_vector_type(2)));
            h2_t xh2[16]; f32x2 acc2[16]; v4u rowA[8], rowB[8]; unsigned char scA[8], scB[8];
#pragma unroll 1
            for (int tl = 0; tl < 8; ++tl) { LAS unsigned long long* le = (LAS unsigned long long*)(lst + tl * 256);
                const unsigned long long e0_ = le[lane], e1_ = le[lane + 64];
                unsigned long long k0 = (e0_ << 32) | (e0_ >> 32), k1 = (e1_ << 32) | (e1_ >> 32);
#pragma unroll
                for (int k = 2; k <= 128; k <<= 1) {
#pragma unroll
                    for (int j = k >> 1; j >= 1; j >>= 1) {
                        if (j == 64) { const unsigned long long lo = k0 < k1 ? k0 : k1, hi = k0 < k1 ? k1 : k0; k0 = lo; k1 = hi; }
                        else {
                            const bool lower = (lane & j) == 0;
                            const bool up0 = k == 128 ? true : (k == 64 ? true : ((lane & k) == 0)), up1 = k == 128 ? true : (k == 64 ? false : ((lane & k) == 0));
                            const unsigned long long o0 = ((unsigned long long)__shfl_xor((unsigned)(k0 >> 32), j) << 32) | (unsigned long long)__shfl_xor((unsigned)k0, j);
                            const unsigned long long o1 = ((unsigned long long)__shfl_xor((unsigned)(k1 >> 32), j) << 32) | (unsigned long long)__shfl_xor((unsigned)k1, j);
                            const unsigned long long mn0 = k0 < o0 ? k0 : o0, mx0 = k0 < o0 ? o0 : k0, mn1 = k1 < o1 ? k1 : o1, mx1 = k1 < o1 ? o1 : k1;
                            k0 = (up0 == lower) ? mn0 : mx0; k1 = (up1 == lower) ? mn1 : mx1; } } }
                le[lane] = (k0 << 32) | (k0 >> 32); le[lane + 64] = (k1 << 32) | (k1 >> 32); }
            LDS_WAIT(); asm volatile("" ::: "memory");
            unsigned iv = lst[(lane & 7) * 2];
            PEER_LOAD(rowA, scA, iv, 0, 0, TAB_US);
#pragma unroll 1
            for (int e0 = 0; e0 < 1024; e0 += 8) { const int tl = e0 >> 7, t = tb * 8 + tl;
                if ((e0 & 127) == 0) {
                    const float rst = ((const float*)(ws + WS_RSTD))[t];
#pragma unroll
                    for (int j = 0; j < 8; ++j) { const unsigned long long w = *(const GAS unsigned long long*)(XN2 + (size_t)t * 2048 + 256 * j + 4 * lane);
                        xh2[2 * j] = (h2_t){(_Float16)(pg8::bflo((unsigned)w) * rst), (_Float16)(pg8::bfhi((unsigned)w) * rst)}; xh2[2 * j + 1] = (h2_t){(_Float16)(pg8::bflo((unsigned)(w >> 32)) * rst), (_Float16)(pg8::bfhi((unsigned)(w >> 32)) * rst)}; }
#pragma unroll
                    for (int e = 0; e < 16; ++e) acc2[e] = (f32x2){0.f, 0.f};
                }
                float part[8]; const unsigned ivn = lst[(e0 + 8 + (lane & 7)) * 2];
                PEER_LOAD(rowB, scB, iv, 0, TAB_V, TAB_VS);   PEER_U(rowA, scA, 0);
#pragma unroll
                for (int m = 4; m >= 1; m >>= 1) { const bool hi = (lane & m) != 0;
#pragma unroll
                    for (int i = 0; i < m; ++i) { const float keep = hi ? part[i + m] : part[i], send = hi ? part[i] : part[i + m]; part[i] = keep + __shfl_xor(send, m); } }
                float d = part[0] + __shfl_xor(part[0], 8); d += __shfl_xor(d, 16); d += __shfl_xor(d, 32);
                const float z = fabsf(d) * 0.70710678118f, tt = __builtin_amdgcn_rcpf(fmaf(0.3275911f, z, 1.f));
                const float pl = tt * fmaf(tt, fmaf(tt, fmaf(tt, fmaf(tt, 1.061405429f, -1.453152027f), 1.421413741f), -0.284496736f), 0.254829592f);
                const float act = 0.5f * d + 0.5f * fabsf(d) * (1.f - pl * __expf(-z * z));
                float cf = __uint_as_float(lst[(e0 + (lane & 7)) * 2 + 1]) * act;
                asm volatile("" : "+v"(cf));
                if (e0 + 8 < 1024) PEER_LOAD(rowA, scA, ivn, 0, 0, TAB_US);
                PEER_V(rowB, scB, 0); iv = ivn;
                if ((e0 & 127) == 120) {
                    float acc[32];
#pragma unroll
                    for (int e = 0; e < 16; ++e) { acc[2 * e] = acc2[e].x; acc[2 * e + 1] = acc2[e].y; }
                    float* orow = args.out + (size_t)t * 2048; const float* hrow = (const float*)(ws + WS_H2) + (size_t)t * 2048; float ss = 0.f;
#pragma unroll
                    for (int j = 0; j < 8; ++j) { const f32x4 a = *(const f32x4*)(hrow + 256 * j + 4 * lane);
                        acc[4 * j] += a.x; acc[4 * j + 1] += a.y; acc[4 * j + 2] += a.z; acc[4 * j + 3] += a.w; }
#pragma unroll
                    for (int e = 0; e < 32; ++e) ss += acc[e] * acc[e];
                    const float rstd = rsqrtf(wsum(ss) * (1.f / 2048.f) + 1e-6f);
#pragma unroll
                    for (int j = 0; j < 8; ++j) { const f32x4 g0 = *(const f32x4*)(in[27] + 256 * j + 4 * lane);
                        *(f32x4*)(orow + 256 * j + 4 * lane) = (f32x4){acc[4 * j] * rstd * g0.x, acc[4 * j + 1] * rstd * g0.y, acc[4 * j + 2] * rstd * g0.z, acc[4 * j + 3] * rstd * g0.w}; }
                }
            }
#undef PEER_LOAD
#undef PEER_U
#undef PEER_V
            LDS_WAIT(); asm volatile("" ::: "memory");
        }
    PHASE_END
#undef IN
#undef SEAM
}

extern "C" void kernel_launch(void* const* d_in, const int* in_sizes, int n_in, void* d_out, int out_size, void* d_ws, size_t ws_size, hipStream_t stream) {
    static int grid = 0;
    if (grid == 0) {
        if (n_in != 28 || in_sizes[0] != S_ * DM || out_size != S_ * DM || ws_size < WS_END) { fprintf(stderr, "kernel_launch: unexpected shapes: n_in %d in0 %d out %d ws %zu (need >= %zu)\n", n_in, n_in > 0 ? in_sizes[0] : -1, out_size, ws_size, (size_t)WS_END); grid = -1; return; }
        if (hipFuncSetAttribute((const void*)mk_fwd, hipFuncAttributeMaxDynamicSharedMemorySize, LDS_BYTES) != hipSuccess) { fprintf(stderr, "kernel_launch: hipFuncSetAttribute failed\n"); grid = -1; return; }
        int per_cu = 0;
        if (hipOccupancyMaxActiveBlocksPerMultiprocessor(&per_cu, (const void*)mk_fwd, NWAVES * 64, LDS_BYTES) != hipSuccess || per_cu < 1) fprintf(stderr, "kernel_launch: note: occupancy query reports %d\n", per_cu);
        (void)hipGetLastError();
        grid = 256;
    }
    if (grid < 0) return;
    (void)hipMemsetAsync((char*)d_ws + WS_CTL, 0, CTL_ZERO_BYTES, stream);
    Args a{};
    for (int i = 0; i < 28; ++i) a.in[i] = (const float*)d_in[i];
    a.out = (float*)d_out; a.ws = (unsigned char*)d_ws;
#if MK_PER_PHASE
    for (int p = 0; p < NPH; ++p) { a.ph_lo = p; a.ph_hi = p + 1; hipLaunchKernelGGL(mk_fwd, dim3(grid), dim3(NWAVES * 64), LDS_BYTES, stream, a); }
#else
    a.ph_lo = 0; a.ph_hi = NPH; hipLaunchKernelGGL(mk_fwd, dim3(grid), dim3(NWAVES * 64), LDS_BYTES, stream, a);
#endif
    const hipError_t le = hipPeekAtLastError();
    if (le != hipSuccess) fprintf(stderr, "kernel_launch: launch failed: %s\n", hipGetErrorName(le));
}
```
